# Optimizing an MI355X kernel written in HIP

```python
import jax, jax.numpy as jnp
from jax import lax
import numpy as np

D_MODEL = 2048
BATCH = 4
SEQ = 2048
DEPTH = 2

N_META = 16
HEAD_DIM = 128
ML_HEADS = 6
SB_HEADS = 6
POOL_WINDOWS = (2, 4, 8, 16)
POOL_GROUPS = 4
POOL_CH = 128
D_ML = ML_HEADS * HEAD_DIM
D_SB = SB_HEADS * HEAD_DIM
D_POOL = POOL_GROUPS * POOL_CH
D_MIX = D_ML + D_SB + D_POOL
ML_CHUNK = 64
SB_BLOCK = 128
CONV_W = 4
IN_SPLITS = (2 * D_ML, D_ML, D_ML, ML_HEADS, ML_HEADS, D_SB, D_SB, D_SB, D_POOL)
N_IN = 2 * D_ML + D_ML + D_ML + ML_HEADS + ML_HEADS + 3 * D_SB + D_POOL
N_EXPERTS = 64
TOP_K = 8
D_EXPERT = 512
D_SHARED = 512
ROUTED_SCALE = 2.5
EXPERT_BLOCK = 128
DN_ALPHA = (2 * DEPTH) ** 0.25
DN_BETA = (8 * DEPTH) ** -0.25
LN_EPS = 1e-5
RMS_EPS = 1e-6

kernel_name = "hybrid_mlstm_stickbreak_pool_moe_deepnorm"


def layer_norm(x, g, b):
    xf = x.astype(jnp.float32)
    mu = xf.mean(-1, keepdims=True)
    var = jnp.square(xf - mu).mean(-1, keepdims=True)
    return ((xf - mu) * lax.rsqrt(var + LN_EPS) * g + b).astype(x.dtype)


def rms_heads(h, g):
    H, d = h.shape[-2], h.shape[-1]
    return h * lax.rsqrt(jnp.square(h).mean(-1, keepdims=True) + RMS_EPS) * g.reshape(H, d).astype(jnp.float32)


def causal_conv(x, w):
    K, L = w.shape[0], x.shape[1]
    xp = jnp.pad(x, ((0, 0), (K - 1, 0), (0, 0)))
    return sum(xp[:, i:i + L] * w[i] for i in range(K))


def mlstm_chunk(state, inp):
    C, n, m = state
    q, k, v, li, lf = inp
    Lc = q.shape[2]
    b = jnp.cumsum(lf, axis=-1)
    causal = jnp.tril(jnp.ones((Lc, Lc), bool))
    D = jnp.where(causal, b[..., :, None] - b[..., None, :] + li[..., None, :], -jnp.inf)
    inter = b + m[..., None]
    m_t = jnp.maximum(inter, D.max(-1))
    w_inter = jnp.exp(inter - m_t)
    ws = jnp.exp(D - m_t[..., None]) * jnp.einsum("bhtk,bhsk->bhts", q, k)
    num = w_inter[..., None] * jnp.einsum("bhvk,bhtk->bhtv", C, q) + jnp.einsum("bhts,bhsv->bhtv", ws, v)
    den = w_inter * jnp.einsum("bhk,bhtk->bht", n, q) + ws.sum(-1)
    h = num / jnp.maximum(jnp.abs(den), jnp.exp(-m_t))[..., None]
    bL = b[..., -1]
    g = bL[..., None] - b + li
    m_new = jnp.maximum(bL + m, g.max(-1))
    wg = jnp.exp(g - m_new[..., None])
    decay = jnp.exp(bL + m - m_new)
    C_new = decay[..., None, None] * C + jnp.einsum("bhsv,bhsk->bhvk", v * wg[..., None], k)
    n_new = decay[..., None] * n + jnp.einsum("bhs,bhsk->bhk", wg, k)
    return (C_new, n_new, m_new), h


def mlstm(q, k, v, log_i, log_f):
    B, L, H, d = q.shape
    tr = lambda t: jnp.swapaxes(t.astype(jnp.float32), 1, 2)
    q = tr(q) * d ** -0.5
    k, v, li, lf = tr(k), tr(v), tr(log_i), tr(log_f)
    state = (jnp.zeros((B, H, d, d), jnp.float32), jnp.zeros((B, H, d), jnp.float32), jnp.zeros((B, H), jnp.float32))
    state, h_meta = mlstm_chunk(state, tuple(t[:, :, :N_META] for t in (q, k, v, li, lf)))
    n_chunks = (L - N_META) // ML_CHUNK

    def to_chunks(t):
        t = t[:, :, N_META:]
        return jnp.moveaxis(t.reshape((B, H, n_chunks, ML_CHUNK) + t.shape[3:]), 2, 0)

    _, h_rest = lax.scan(mlstm_chunk, state, tuple(to_chunks(t) for t in (q, k, v, li, lf)))
    h_rest = jnp.moveaxis(h_rest, 0, 2).reshape(B, H, L - N_META, d)
    return jnp.swapaxes(jnp.concatenate([h_meta, h_rest], axis=2), 1, 2)


def stick_breaking(q, k, v):
    B, L, H, d = q.shape
    tr = lambda t: jnp.swapaxes(t.astype(jnp.float32), 1, 2)
    q, k, v = tr(q) * d ** -0.5, tr(k), tr(v)
    bounds = [(0, N_META)] + [(s, min(s + SB_BLOCK, L)) for s in range(N_META, L, SB_BLOCK)]
    outs = []
    for t0, t1 in bounds:
        z = jnp.einsum("bhqd,bhkd->bhqk", q[:, :, t0:t1], k[:, :, :t1])
        causal = jnp.arange(t1)[None, :] < jnp.arange(t0, t1)[:, None]
        log_keep = jnp.where(causal, jax.nn.log_sigmoid(-z), 0.0)
        after = lax.cumsum(log_keep, axis=3, reverse=True) - log_keep
        a = jnp.where(causal, jnp.exp(jax.nn.log_sigmoid(z) + after), 0.0)
        outs.append(jnp.einsum("bhqk,bhkd->bhqd", a, v[:, :, :t1]))
    return jnp.swapaxes(jnp.concatenate(outs, axis=2), 1, 2)


def pool_mixer(u, pool_w, pool_scale):
    B, L, _ = u.shape
    uf = u.astype(jnp.float32)
    cs = jnp.concatenate([jnp.zeros((B, 1, D_POOL), jnp.float32), jnp.cumsum(uf, axis=1)], axis=1)
    csg = cs.reshape(B, L + 1, POOL_GROUPS, POOL_CH)
    ug = uf.reshape(B, L, POOL_GROUPS, POOL_CH)
    pos = jnp.arange(L)
    outs = []
    for g, w in enumerate(POOL_WINDOWS):
        lo = jnp.maximum(pos + 1 - w, 0)
        cnt = (pos + 1 - lo).astype(jnp.float32)
        mean = (csg[:, 1:, g] - csg[:, lo, g]) / cnt[None, :, None]
        outs.append(mean - ug[:, :, g])
    p = jnp.stack(outs, axis=2).astype(u.dtype)
    y = jnp.einsum("blgc,gcd->blgd", p, pool_w).reshape(B, L, D_POOL)
    return y * pool_scale


def hybrid_mixer(u, w_in, b_igate, b_fgate, conv_qk, ml_norm_g, sb_norm_g, pool_w, pool_scale, w_out):
    B, L, _ = u.shape
    proj = u @ w_in
    idx = [int(s) for s in np.cumsum(IN_SPLITS)[:-1]]
    ml_qk, ml_v, ml_o, ml_i, ml_f, sb_q, sb_k, sb_v, pool_in = jnp.split(proj, idx, axis=-1)
    heads = lambda t, H: t.reshape(B, L, H, HEAD_DIM)
    ml_q, ml_k = jnp.split(jax.nn.silu(causal_conv(ml_qk, conv_qk)), 2, axis=-1)
    log_i = (ml_i + b_igate).astype(jnp.float32)
    log_f = jax.nn.log_sigmoid((ml_f + b_fgate).astype(jnp.float32))
    h_ml = mlstm(heads(ml_q, ML_HEADS), heads(ml_k, ML_HEADS), heads(ml_v, ML_HEADS), log_i, log_f)
    h_ml = rms_heads(h_ml, ml_norm_g) * jax.nn.sigmoid(heads(ml_o, ML_HEADS).astype(jnp.float32))
    h_sb = rms_heads(stick_breaking(heads(sb_q, SB_HEADS), heads(sb_k, SB_HEADS), heads(sb_v, SB_HEADS)), sb_norm_g)
    h_pool = pool_mixer(pool_in, pool_w, pool_scale)
    cat = jnp.concatenate([h_ml.reshape(B, L, D_ML).astype(u.dtype), h_sb.reshape(B, L, D_SB).astype(u.dtype), h_pool], axis=-1)
    return cat @ w_out


def swiglu(x, w13, w2):
    gate, up = jnp.split(x @ w13, 2, axis=-1)
    return (jax.nn.silu(gate) * up) @ w2


def routed_experts(xt, idx, gate, w13, w2):
    T, D = xt.shape
    A = T * TOP_K
    e_flat = idx.reshape(-1)
    t_flat = jnp.repeat(jnp.arange(T, dtype=jnp.int32), TOP_K)
    w_flat = gate.reshape(-1)
    order = jnp.argsort(e_flat)
    e_s, t_s, w_s = e_flat[order], t_flat[order], w_flat[order]
    counts = jnp.bincount(e_flat, length=N_EXPERTS)
    padded = (counts + EXPERT_BLOCK - 1) // EXPERT_BLOCK * EXPERT_BLOCK
    off = jnp.cumsum(counts) - counts
    ends = jnp.cumsum(padded)
    poff = ends - padded
    pos = poff[e_s] + jnp.arange(A) - off[e_s]
    n_blocks = -(-A // EXPERT_BLOCK) + N_EXPERTS
    P = n_blocks * EXPERT_BLOCK
    buf_tok = jnp.full((P,), T, jnp.int32).at[pos].set(t_s)
    buf_w = jnp.zeros((P,), jnp.float32).at[pos].set(w_s)
    block_e = jnp.minimum(jnp.searchsorted(ends, jnp.arange(n_blocks) * EXPERT_BLOCK, side="right"), N_EXPERTS - 1)
    x_pad = jnp.concatenate([xt, jnp.zeros((1, D), xt.dtype)], axis=0)

    def run(args):
        tok, e = args
        return swiglu(x_pad[tok], w13[e], w2[e])

    y = lax.map(run, (buf_tok.reshape(n_blocks, EXPERT_BLOCK), block_e)).reshape(P, D)
    y = y * buf_w[:, None].astype(y.dtype)
    return jnp.zeros((T + 1, D), xt.dtype).at[buf_tok].add(y)[:T]


def moe_ffn(x, router_w, router_bias, exp_w13, exp_w2, sh_w13, sh_w2):
    B, L, D = x.shape
    xt = x.reshape(B * L, D)
    scores = jax.nn.sigmoid((xt @ router_w).astype(jnp.float32))
    _, idx = lax.top_k(scores + router_bias.astype(jnp.float32), TOP_K)
    gate = jnp.take_along_axis(scores, idx, axis=-1)
    gate = gate / gate.sum(-1, keepdims=True) * ROUTED_SCALE
    out = routed_experts(xt, idx, gate, exp_w13, exp_w2) + swiglu(xt, sh_w13, sh_w2)
    return out.reshape(B, L, D)


def setup_inputs(seed: int = 0) -> dict:
    key = jax.random.key(seed)
    ks = jax.random.split(key, 24)
    f32 = jnp.float32
    nrm = lambda k, shape, s: jax.random.normal(k, shape, f32) * s
    Lr = DEPTH
    return {
        "x": nrm(ks[0], (BATCH, SEQ, D_MODEL), 1.0),
        "meta": nrm(ks[1], (N_META, D_MODEL), 1.0),
        "ln_in_g": 1.0 + nrm(ks[2], (D_MODEL,), 0.02),
        "ln_in_b": nrm(ks[3], (D_MODEL,), 0.02),
        "w_in": nrm(ks[4], (Lr, D_MODEL, N_IN), D_MODEL ** -0.5),
        "b_igate": nrm(ks[5], (Lr, ML_HEADS), 0.1),
        "b_fgate": jnp.linspace(3.0, 6.0, ML_HEADS, dtype=f32) + nrm(ks[6], (Lr, ML_HEADS), 0.1),
        "conv_qk": nrm(ks[7], (Lr, CONV_W, 2 * D_ML), CONV_W ** -0.5),
        "ml_norm_g": 1.0 + nrm(ks[8], (Lr, D_ML), 0.02),
        "sb_norm_g": 1.0 + nrm(ks[9], (Lr, D_SB), 0.02),
        "pool_w": nrm(ks[10], (Lr, POOL_GROUPS, POOL_CH, POOL_CH), POOL_CH ** -0.5),
        "pool_scale": 1.0 + nrm(ks[11], (Lr, D_POOL), 0.02),
        "w_out": nrm(ks[12], (Lr, D_MIX, D_MODEL), D_MIX ** -0.5 * DN_BETA),
        "ln1_g": 1.0 + nrm(ks[13], (Lr, D_MODEL), 0.02),
        "ln1_b": nrm(ks[14], (Lr, D_MODEL), 0.02),
        "router_w": nrm(ks[15], (Lr, D_MODEL, N_EXPERTS), D_MODEL ** -0.5),
        "router_bias": nrm(ks[16], (Lr, N_EXPERTS), 0.01),
        "exp_w13": nrm(ks[17], (Lr, N_EXPERTS, D_MODEL, 2 * D_EXPERT), D_MODEL ** -0.5),
        "exp_w2": nrm(ks[18], (Lr, N_EXPERTS, D_EXPERT, D_MODEL), D_EXPERT ** -0.5 * DN_BETA),
        "sh_w13": nrm(ks[19], (Lr, D_MODEL, 2 * D_SHARED), D_MODEL ** -0.5),
        "sh_w2": nrm(ks[20], (Lr, D_SHARED, D_MODEL), D_SHARED ** -0.5 * DN_BETA),
        "ln2_g": 1.0 + nrm(ks[21], (Lr, D_MODEL), 0.02),
        "ln2_b": nrm(ks[22], (Lr, D_MODEL), 0.02),
    }


def reference(x, meta, ln_in_g, ln_in_b, w_in, b_igate, b_fgate, conv_qk, ml_norm_g, sb_norm_g, pool_w, pool_scale, w_out, ln1_g, ln1_b, router_w, router_bias, exp_w13, exp_w2, sh_w13, sh_w2, ln2_g, ln2_b):
    B = x.shape[0]
    h = jnp.concatenate([jnp.broadcast_to(meta[None].astype(x.dtype), (B, N_META, D_MODEL)), x], axis=1)
    h = layer_norm(h, ln_in_g, ln_in_b)
    for l in range(DEPTH):
        mix = hybrid_mixer(h, w_in[l], b_igate[l], b_fgate[l], conv_qk[l], ml_norm_g[l], sb_norm_g[l], pool_w[l], pool_scale[l], w_out[l])
        h = layer_norm(DN_ALPHA * h + mix, ln1_g[l], ln1_b[l])
        ffn = moe_ffn(h, router_w[l], router_bias[l], exp_w13[l], exp_w2[l], sh_w13[l], sh_w2[l])
        h = layer_norm(DN_ALPHA * h + ffn, ln2_g[l], ln2_b[l])
    return h[:, N_META:]
```

```cpp
#include <hip/hip_runtime.h>
#include <stdint.h>
#include <stdio.h>

constexpr int DM = 2048, NB = 4, SEQ = 2048, NMETA = 16, LSEQ = SEQ + NMETA, DEPTH = 2;
constexpr int TREAL = NB * SEQ;
constexpr int TALL = TREAL + NB * NMETA;
constexpr int HD = 128, NH = 6;
constexpr int N_IN = 5900;
constexpr int PROJ_W = 5888;
constexpr int PC_MLQK = 0, PC_MLV = 1536, PC_MLO = 2304, PC_SBQ = 3072, PC_SBK = 3840, PC_SBV = 4608, PC_POOL = 5376;
constexpr int NEXP = 64, TOPK = 8, DEXP = 512;
constexpr float ROUTED_SCALE = 2.5f;
constexpr float DN_ALPHA = 1.41421356237309515f;
constexpr float LN_EPS = 1e-5f, RMS_EPS = 1e-6f;
constexpr int SH_BASE = TALL * TOPK;
constexpr int PROWS = SH_BASE + TALL;

typedef unsigned short bf16_t;
typedef short bf16x8 __attribute__((ext_vector_type(8)));
typedef short s16x4 __attribute__((ext_vector_type(4)));
typedef float f32x16 __attribute__((ext_vector_type(16)));
typedef float f32x4 __attribute__((ext_vector_type(4)));
typedef float f32x2 __attribute__((ext_vector_type(2)));
typedef unsigned u32x4 __attribute__((ext_vector_type(4)));
typedef unsigned u32x2 __attribute__((ext_vector_type(2)));
#define LAS __attribute__((address_space(3)))

constexpr int NTHREADS = 512;
constexpr int LDS_BYTES = 144 * 1024;

__device__ __forceinline__ unsigned cvtpk(float lo, float hi) {
    unsigned r; asm volatile("v_cvt_pk_bf16_f32 %0, %1, %2" : "=v"(r) : "v"(lo), "v"(hi)); return r;
}
__device__ __forceinline__ float bf2f(bf16_t v) { return __uint_as_float(((unsigned)v) << 16); }
__device__ __forceinline__ float bflo(unsigned w) { return __uint_as_float(w << 16); }
__device__ __forceinline__ float bfhi(unsigned w) { return __uint_as_float(w & 0xffff0000u); }
__device__ __forceinline__ bf16_t f2bf(float f) { return (bf16_t)(cvtpk(f, 0.f) & 0xffffu); }
__device__ __forceinline__ int crow(int r, int hi) { return (r & 3) + 8 * (r >> 2) + 4 * hi; }
__device__ __forceinline__ float wave_sum(float v) {
#pragma unroll
    for (int o = 32; o >= 1; o >>= 1) v += __shfl_xor(v, o, 64);
    return v;
}
__device__ __forceinline__ float wave_max(float v) {
#pragma unroll
    for (int o = 32; o >= 1; o >>= 1) v = fmaxf(v, __shfl_xor(v, o, 64));
    return v;
}
__device__ __forceinline__ float sigmoidf_(float x) { return 1.f / (1.f + __expf(-x)); }
__device__ __forceinline__ float siluf_(float x) { return x / (1.f + __expf(-x)); }
__device__ __forceinline__ float logsigmoidf_(float x) { return fminf(x, 0.f) - log1pf(__expf(-fabsf(x))); }

__device__ __forceinline__ int tid_here() { int t = threadIdx.x; asm volatile("" : "+v"(t)); return t; }

__device__ __forceinline__ int row_of(int b, int l) { return l < NMETA ? TREAL + b * NMETA + l : b * SEQ + (l - NMETA); }

constexpr size_t al256(size_t x) { return (x + 255) / 256 * 256; }
constexpr size_t WS_CTL = 0;
constexpr size_t CTL_BYTES = 64 * 1024;
constexpr size_t CTL_CNT = 32 * 1024;
constexpr size_t WS_HB = al256(WS_CTL + CTL_BYTES);
constexpr size_t WS_PROJ = al256(WS_HB + (size_t)TALL * DM * 2);
constexpr size_t WS_GATES = al256(WS_PROJ + (size_t)TALL * PROJ_W * 2);
constexpr size_t WS_QKC = al256(WS_GATES + (size_t)TALL * 12 * 4);
constexpr size_t WS_CAT = al256(WS_QKC + (size_t)TALL * 1536 * 2);
constexpr size_t WS_S1 = al256(WS_CAT + (size_t)TALL * DM * 2);
constexpr size_t WS_H1 = al256(WS_S1 + (size_t)TALL * DM * 2);
constexpr size_t WS_ASGE = al256(WS_H1 + (size_t)TALL * DM * 2);
constexpr size_t WS_ASGS = al256(WS_ASGE + (size_t)TALL * 8 * 4);
constexpr size_t WS_TOKL = al256(WS_ASGS + (size_t)TALL * 8 * 4);
constexpr size_t WS_GATEL = al256(WS_TOKL + (size_t)NEXP * TALL * 4);
constexpr size_t WS_ACT = al256(WS_GATEL + (size_t)NEXP * TALL * 4);
constexpr size_t WS_Y = al256(WS_ACT + (size_t)PROWS * DEXP * 2);
constexpr size_t WS_END = al256(WS_Y + (size_t)PROWS * DM * 2);

struct Params {
    const float* x; const float* meta; const float* ln_in_g; const float* ln_in_b;
    const float* w_in; const float* b_igate; const float* b_fgate; const float* conv_qk;
    const float* ml_norm_g; const float* sb_norm_g; const float* pool_w; const float* pool_scale;
    const float* w_out; const float* ln1_g; const float* ln1_b; const float* router_w; const float* router_bias;
    const float* exp_w13; const float* exp_w2; const float* sh_w13; const float* sh_w2;
    const float* ln2_g; const float* ln2_b;
    float* out; unsigned char* ws;
    int ph_lo, ph_hi;
};
typedef const Params __attribute__((address_space(4)))* PP;
__device__ __forceinline__ PP get_params() {
    PP k = (PP)__builtin_amdgcn_kernarg_segment_ptr();
    asm volatile("" : "+s"(k));
    return k;
}

constexpr int TM = 192;
constexpr int G_AS = 0, G_BS = 65536, G_ROWS = 131072;
constexpr int G_LDS_END = G_ROWS + 1024;

__device__ __forceinline__ int swz_f(int n) { return ((n >> 2) & 7) ^ ((n >> 1) & 1); }

struct GemmOp {
    const bf16_t* X; int ldx;
    const float* W; int ldb;
    int cb0, cb1;
    int K;
};

template <class Epi>
__device__ __forceinline__ void gemm_tile(unsigned char* lds, const GemmOp& g, const Epi& epi) {
    const int tid = tid_here(), lane = tid & 63, wid = tid >> 6, wr = wid >> 2, wc = wid & 3, r32 = lane & 31, hi = lane >> 5;
    const int* rows = (const int*)(lds + G_ROWS);
    const int a_r = wid * 8 + (lane >> 3);
    unsigned a_off[3];
#pragma unroll
    for (int j = 0; j < 3; ++j) a_off[j] = (unsigned)rows[a_r + 64 * j] * (unsigned)g.ldx + (((lane & 7) ^ swz_f(a_r)) << 3);
    const int a_lds = (wid * 8) * 128 + lane * 16;
    const int kg = tid >> 6, nq = tid & 63;
    const int blk = nq >> 3, gq = nq & 7;
    const int b_col = ((blk & 1) ? g.cb1 : g.cb0) + (blk >> 1) * 32 + gq * 4;
    const int b_n0 = blk * 32 + 8 * (gq & 3) + 4 * (gq >> 2);
    const float* bp = g.W + (size_t)(kg * 8) * g.ldb + b_col;
    const int lanec = (hi ^ swz_f(r32)) << 4;
    const int a_rd = (wr * 32 + r32) * 128;
    const int b_rd = (wc * 64 + r32) * 128;

    f32x16 acc[2][3];
#pragma unroll
    for (int ni = 0; ni < 2; ++ni)
#pragma unroll
        for (int mi = 0; mi < 3; ++mi)
#pragma unroll
            for (int r = 0; r < 16; ++r) acc[ni][mi][r] = 0.f;

    f32x4 breg[8];
    const int nk = g.K >> 6;
#define G_DMA_A(kt, buf) do { \
        _Pragma("unroll") for (int j = 0; j < 3; ++j) __builtin_amdgcn_global_load_lds((const unsigned*)(g.X + a_off[j] + (kt) * 64), \
            (unsigned*)(lds + G_AS + (buf) * 32768 + a_lds + j * 8192), 16, 0, 0); } while (0)
#define G_LOAD(kt) do { \
        _Pragma("unroll") for (int j = 0; j < 8; ++j) breg[j] = *(const f32x4*)(bp + (size_t)((kt) * 64 + j) * g.ldb); } while (0)
#define G_WRITE(buf) do { \
        _Pragma("unroll") for (int i = 0; i < 4; ++i) { u32x4 w; \
            w.x = cvtpk(breg[0][i], breg[1][i]); w.y = cvtpk(breg[2][i], breg[3][i]); w.z = cvtpk(breg[4][i], breg[5][i]); w.w = cvtpk(breg[6][i], breg[7][i]); \
            const int n = b_n0 + i; *(u32x4*)(lds + G_BS + (buf) * 32768 + n * 128 + ((kg ^ swz_f(n)) << 4)) = w; } } while (0)

    G_LOAD(0);
    G_WRITE(0);
    __builtin_amdgcn_sched_barrier(0);
    G_DMA_A(0, 0);
    if (nk > 1) G_LOAD(1);
    for (int kt = 0; kt < nk; ++kt) {
        const int cur = kt & 1;
        __syncthreads();
        if (kt + 1 < nk) { G_WRITE(cur ^ 1); __builtin_amdgcn_sched_barrier(0); G_DMA_A(kt + 1, cur ^ 1); }
        if (kt + 2 < nk) { G_LOAD(kt + 2); }
        __builtin_amdgcn_sched_barrier(0);
        const unsigned char* As = lds + G_AS + cur * 32768;
        const unsigned char* Bs = lds + G_BS + cur * 32768;
#pragma unroll
        for (int ks = 0; ks < 4; ++ks) {
            const int co = (ks << 5) ^ lanec;
            bf16x8 xa[3], wb[2];
#pragma unroll
            for (int mi = 0; mi < 3; ++mi) xa[mi] = *(const bf16x8*)(As + a_rd + mi * 8192 + co);
#pragma unroll
            for (int ni = 0; ni < 2; ++ni) wb[ni] = *(const bf16x8*)(Bs + b_rd + ni * 4096 + co);
#pragma unroll
            for (int ni = 0; ni < 2; ++ni)
#pragma unroll
                for (int mi = 0; mi < 3; ++mi)
                    acc[ni][mi] = __builtin_amdgcn_mfma_f32_32x32x16_bf16(wb[ni], xa[mi], acc[ni][mi], 0, 0, 0);
        }
    }
#undef G_DMA_A
#undef G_LOAD
#undef G_WRITE
    epi(acc, wr, wc, r32, hi);
    __syncthreads();
}

struct EpiStoreBf16 {
    bf16_t* O; int ldo; int orow0; int nrows; int oc0, oc1;
    __device__ __forceinline__ void operator()(const f32x16 (&acc)[2][3], int wr, int wc, int r32, int hi) const {
#pragma unroll
        for (int mi = 0; mi < 3; ++mi) {
            const int tr = (2 * mi + wr) * 32 + r32;
            if (tr < nrows) {
#pragma unroll
                for (int ni = 0; ni < 2; ++ni) {
                    bf16_t* p = O + (size_t)(orow0 + tr) * ldo + (ni ? oc1 : oc0) + wc * 32 + 16 * hi;
                    u32x4 w0, w1; const f32x16& a = acc[ni][mi];
                    w0.x = cvtpk(a[0], a[1]); w0.y = cvtpk(a[2], a[3]); w0.z = cvtpk(a[4], a[5]); w0.w = cvtpk(a[6], a[7]);
                    w1.x = cvtpk(a[8], a[9]); w1.y = cvtpk(a[10], a[11]); w1.z = cvtpk(a[12], a[13]); w1.w = cvtpk(a[14], a[15]);
                    *(u32x4*)p = w0; *(u32x4*)(p + 8) = w1;
                }
            }
        }
    }
};


__device__ __forceinline__ void load_row32_f32(const float* src, int lane, float (&v)[32]) {
#pragma unroll
    for (int i = 0; i < 4; ++i) {
        const f32x4 a = *(const f32x4*)(src + i * 512 + lane * 8), b = *(const f32x4*)(src + i * 512 + lane * 8 + 4);
        v[i * 8 + 0] = a[0]; v[i * 8 + 1] = a[1]; v[i * 8 + 2] = a[2]; v[i * 8 + 3] = a[3];
        v[i * 8 + 4] = b[0]; v[i * 8 + 5] = b[1]; v[i * 8 + 6] = b[2]; v[i * 8 + 7] = b[3];
    }
}
__device__ __forceinline__ void load_row32_bf16(const bf16_t* src, int lane, float (&v)[32]) {
#pragma unroll
    for (int i = 0; i < 4; ++i) {
        const u32x4 a = *(const u32x4*)(src + i * 512 + lane * 8);
        v[i * 8 + 0] = bflo(a.x); v[i * 8 + 1] = bfhi(a.x); v[i * 8 + 2] = bflo(a.y); v[i * 8 + 3] = bfhi(a.y);
        v[i * 8 + 4] = bflo(a.z); v[i * 8 + 5] = bfhi(a.z); v[i * 8 + 6] = bflo(a.w); v[i * 8 + 7] = bfhi(a.w);
    }
}
__device__ __forceinline__ void ln_row32(float (&v)[32], const float* g, const float* bb, int lane) {
    float s = 0.f;
#pragma unroll
    for (int i = 0; i < 32; ++i) s += v[i];
    const float mu = wave_sum(s) * (1.f / DM);
    float q = 0.f;
#pragma unroll
    for (int i = 0; i < 32; ++i) { const float d = v[i] - mu; q += d * d; }
    const float rstd = rsqrtf(wave_sum(q) * (1.f / DM) + LN_EPS);
#pragma unroll
    for (int i = 0; i < 4; ++i) {
        const f32x4 g0 = *(const f32x4*)(g + i * 512 + lane * 8), g1 = *(const f32x4*)(g + i * 512 + lane * 8 + 4);
        const f32x4 b0 = *(const f32x4*)(bb + i * 512 + lane * 8), b1 = *(const f32x4*)(bb + i * 512 + lane * 8 + 4);
#pragma unroll
        for (int e = 0; e < 4; ++e) {
            v[i * 8 + e] = (v[i * 8 + e] - mu) * rstd * g0[e] + b0[e];
            v[i * 8 + 4 + e] = (v[i * 8 + 4 + e] - mu) * rstd * g1[e] + b1[e];
        }
    }
}
__device__ __forceinline__ void store_row32_bf16(bf16_t* dst, int lane, const float (&v)[32]) {
#pragma unroll
    for (int i = 0; i < 4; ++i) {
        u32x4 w; w.x = cvtpk(v[i * 8 + 0], v[i * 8 + 1]); w.y = cvtpk(v[i * 8 + 2], v[i * 8 + 3]); w.z = cvtpk(v[i * 8 + 4], v[i * 8 + 5]); w.w = cvtpk(v[i * 8 + 6], v[i * 8 + 7]);
        *(u32x4*)(dst + i * 512 + lane * 8) = w;
    }
}

__device__ __forceinline__ void phase_ln_in(PP p) {
    const int tid = tid_here(), lane = tid & 63, gw = blockIdx.x * 8 + (tid >> 6), nw = gridDim.x * 8;
    bf16_t* hb = (bf16_t*)(p->ws + WS_HB);
    for (int row = gw; row < TALL; row += nw) {
        const float* src = row < TREAL ? p->x + (size_t)row * DM : p->meta + (size_t)((row - TREAL) & 15) * DM;
        float v[32];
        load_row32_f32(src, lane, v);
        ln_row32(v, p->ln_in_g, p->ln_in_b, lane);
        store_row32_bf16(hb + (size_t)row * DM, lane, v);
    }
}

__device__ __forceinline__ void gates_item(unsigned char* lds, PP p, int layer, int item) {
    const int tid = tid_here(), lane = tid & 63, wid = tid >> 6;
    float* Wg = (float*)lds;
    const float* w = p->w_in + (size_t)layer * DM * N_IN + 3072;
    for (int i = tid; i < DM * 3; i += NTHREADS) { const int k = i / 3, c = i % 3; *(f32x4*)(Wg + k * 12 + c * 4) = *(const f32x4*)(w + (size_t)k * N_IN + c * 4); }
    __syncthreads();
    const bf16_t* hb = (const bf16_t*)(p->ws + WS_HB);
    float* gates = (float*)(p->ws + WS_GATES);
    for (int rr = 0; rr < 4; ++rr) {
        const int row = item * 32 + wid * 4 + rr;
        if (row < TALL) {
            float acc[12];
#pragma unroll
            for (int c = 0; c < 12; ++c) acc[c] = 0.f;
            const bf16_t* xr = hb + (size_t)row * DM;
            for (int i = 0; i < 32; ++i) {
                const int k = i * 64 + lane;
                const float xv = bf2f(xr[k]);
                const f32x4 w0 = *(const f32x4*)(Wg + k * 12), w1 = *(const f32x4*)(Wg + k * 12 + 4), w2 = *(const f32x4*)(Wg + k * 12 + 8);
#pragma unroll
                for (int e = 0; e < 4; ++e) { acc[e] += xv * w0[e]; acc[4 + e] += xv * w1[e]; acc[8 + e] += xv * w2[e]; }
            }
#pragma unroll
            for (int c = 0; c < 12; ++c) acc[c] = wave_sum(acc[c]);
            if (lane < 12) {
                float v = 0.f;
#pragma unroll
                for (int c = 0; c < 12; ++c) v = (lane == c) ? acc[c] : v;
                if (lane < 6) v += p->b_igate[layer * 6 + lane];
                else v = logsigmoidf_(v + p->b_fgate[layer * 6 + lane - 6]);
                gates[(size_t)row * 12 + lane] = v;
            }
        }
    }
    __syncthreads();
}

__device__ __forceinline__ void phase_conv(PP p, int layer) {
    const bf16_t* proj = (const bf16_t*)(p->ws + WS_PROJ);
    bf16_t* qkc = (bf16_t*)(p->ws + WS_QKC);
    const float* cw = p->conv_qk + (size_t)layer * 4 * 1536;
    const int total = TALL * 192;
    for (int idx = blockIdx.x * NTHREADS + tid_here(); idx < total; idx += gridDim.x * NTHREADS) {
        const int row = idx / 192, c0 = (idx % 192) * 8;
        int b, l;
        if (row < TREAL) { b = row >> 11; l = NMETA + (row & 2047); } else { b = (row - TREAL) >> 4; l = (row - TREAL) & 15; }
        float acc[8];
#pragma unroll
        for (int e = 0; e < 8; ++e) acc[e] = 0.f;
#pragma unroll
        for (int i = 0; i < 4; ++i) {
            const int ls = l - 3 + i;
            if (ls >= 0) {
                const u32x4 a = *(const u32x4*)(proj + (size_t)row_of(b, ls) * PROJ_W + PC_MLQK + c0);
                const f32x4 w0 = *(const f32x4*)(cw + i * 1536 + c0), w1 = *(const f32x4*)(cw + i * 1536 + c0 + 4);
                acc[0] += bflo(a.x) * w0[0]; acc[1] += bfhi(a.x) * w0[1]; acc[2] += bflo(a.y) * w0[2]; acc[3] += bfhi(a.y) * w0[3];
                acc[4] += bflo(a.z) * w1[0]; acc[5] += bfhi(a.z) * w1[1]; acc[6] += bflo(a.w) * w1[2]; acc[7] += bfhi(a.w) * w1[3];
            }
        }
        const float sc = c0 < 768 ? 0.08838834764831845f : 1.f;
#pragma unroll
        for (int e = 0; e < 8; ++e) acc[e] = siluf_(acc[e]) * sc;
        u32x4 w; w.x = cvtpk(acc[0], acc[1]); w.y = cvtpk(acc[2], acc[3]); w.z = cvtpk(acc[4], acc[5]); w.w = cvtpk(acc[6], acc[7]);
        *(u32x4*)(qkc + (size_t)row * 1536 + c0) = w;
    }
}

#define KSWZ(row, colB) ((row) * 256 + ((colB) ^ (((row) & 7) << 4)))
#define SBAR() __builtin_amdgcn_sched_barrier(0)
constexpr int MX_V = 0, MX_K = 16384, MX_C = 32768, MX_MQ = MX_C + 2112 * 4, MX_EM = MX_MQ + 1024, MX_WS = MX_EM + 1024, MX_END = MX_WS + 8 * 256;

__device__ __forceinline__ int v_st(int k, int c) { const int kk = (k & ~0xC) | ((k & 4) << 1) | ((k & 8) >> 1); return ((kk >> 3) * 4 + (c >> 5)) * 512 + ((kk & 7) * 32 + (c & 31)) * 2; }
__device__ __forceinline__ int v_rd_base(int lane) { return ((lane & 3) << 3) | (((lane >> 2) & 3) << 6) | (((lane >> 4) & 1) << 5) | (((lane >> 5) & 1) << 8); }
constexpr int v_rd_off(int d0, int ks, int half) { return d0 * 512 + ks * 4096 + half * 2048; }
template <int OFF> __device__ __forceinline__ s16x4 tr_read(int vb) {
    s16x4 r; asm volatile("ds_read_b64_tr_b16 %0, %1 offset:%2" : "=&v"(r) : "v"(vb), "i"(OFF) : "memory"); return r;
}
template <int D0> __device__ __forceinline__ void pv_one(f32x16& od, int vb, bf16x8 pa0, bf16x8 pa1, bf16x8 pa2, bf16x8 pa3) {
    const s16x4 l0 = tr_read<v_rd_off(D0, 0, 0)>(vb), h0 = tr_read<v_rd_off(D0, 0, 1)>(vb), l1 = tr_read<v_rd_off(D0, 1, 0)>(vb), h1 = tr_read<v_rd_off(D0, 1, 1)>(vb);
    const s16x4 l2 = tr_read<v_rd_off(D0, 2, 0)>(vb), h2 = tr_read<v_rd_off(D0, 2, 1)>(vb), l3 = tr_read<v_rd_off(D0, 3, 0)>(vb), h3 = tr_read<v_rd_off(D0, 3, 1)>(vb);
    asm volatile("s_waitcnt lgkmcnt(0)" ::: "memory"); SBAR();
#define PK(L, H) (bf16x8){L[0], L[1], L[2], L[3], H[0], H[1], H[2], H[3]}
    od = __builtin_amdgcn_mfma_f32_32x32x16_bf16(pa0, PK(l0, h0), od, 0, 0, 0);
    od = __builtin_amdgcn_mfma_f32_32x32x16_bf16(pa1, PK(l1, h1), od, 0, 0, 0);
    od = __builtin_amdgcn_mfma_f32_32x32x16_bf16(pa2, PK(l2, h2), od, 0, 0, 0);
    od = __builtin_amdgcn_mfma_f32_32x32x16_bf16(pa3, PK(l3, h3), od, 0, 0, 0);
#undef PK
}
__device__ __forceinline__ void qkt(f32x16& p0, f32x16& p1, const unsigned char* Ks, const bf16x8* qr, int r32, int hi) {
#pragma unroll
    for (int r = 0; r < 16; ++r) { p0[r] = 0.f; p1[r] = 0.f; }
#pragma unroll
    for (int d0 = 0; d0 < 8; ++d0) {
        const int cb = (d0 * 16 + hi * 8) * 2;
        const bf16x8 b0 = *(const bf16x8*)(Ks + KSWZ(r32, cb));
        const bf16x8 b1 = *(const bf16x8*)(Ks + KSWZ(32 + r32, cb));
        p0 = __builtin_amdgcn_mfma_f32_32x32x16_bf16(b0, qr[d0], p0, 0, 0, 0);
        p1 = __builtin_amdgcn_mfma_f32_32x32x16_bf16(b1, qr[d0], p1, 0, 0, 0);
    }
}
__device__ __forceinline__ float swap_sum(float v) {
    auto rr = __builtin_amdgcn_permlane32_swap(__float_as_uint(v), __float_as_uint(v), false, false);
    return __uint_as_float(rr[0]) + __uint_as_float(rr[1]);
}

#ifndef MIXER_INLINE
#define MIXER_INLINE __forceinline__
#endif
struct MixSrc { const bf16_t* Q; int ldq; const bf16_t* K; int ldk; const bf16_t* V; int ldv; };

template <int MODE>
__device__ MIXER_INLINE void mixer_item(unsigned char* lds, PP p, int layer, int b, int h, int j) {
    const int tid = tid_here(), wid = tid >> 6, lane = tid & 63, r32 = lane & 31, hi = lane >> 5;
    const bf16_t* proj = (const bf16_t*)(p->ws + WS_PROJ);
    const bf16_t* qkc = (const bf16_t*)(p->ws + WS_QKC);
    const float* gates = (const float*)(p->ws + WS_GATES);
    bf16_t* cat = (bf16_t*)(p->ws + WS_CAT);
    MixSrc S;
    if (MODE == 0) { S.Q = proj + PC_SBQ + h * HD; S.ldq = PROJ_W; S.K = proj + PC_SBK + h * HD; S.ldk = PROJ_W; S.V = proj + PC_SBV + h * HD; S.ldv = PROJ_W; }
    else { S.Q = qkc + h * HD; S.ldq = 1536; S.K = qkc + 768 + h * HD; S.ldk = 1536; S.V = proj + PC_MLV + h * HD; S.ldv = PROJ_W; }
    unsigned char* V_lds = lds + MX_V; unsigned char* K_lds = lds + MX_K;
    float* carr = (float*)(lds + MX_C); float* mqa = (float*)(lds + MX_MQ); float* ema = (float*)(lds + MX_EM);
    float* wsc = (float*)(lds + MX_WS) + wid * 64;

    const int s0 = 256 * j;
    const int qrow = b * SEQ + s0 + wid * 32 + r32;
    const int lq = NMETA + s0 + wid * 32 + r32;
    bf16x8 qr[8];
#pragma unroll
    for (int d0 = 0; d0 < 8; ++d0) qr[d0] = *(const bf16x8*)(S.Q + (size_t)qrow * S.ldq + d0 * 16 + hi * 8);

    float mq = 0.f;
    if (MODE == 1) {
        const int Lend = NMETA + s0 + 256;
        if (wid == 0) {
            float csum = 0.f, cmax = -3.0e38f;
            for (int base = 0; base < Lend; base += 64) {
                const int l = base + lane; const bool ok = l < Lend;
                const int row = row_of(b, ok ? l : 0);
                const float lf = ok ? gates[(size_t)row * 12 + 6 + h] : 0.f;
                const float li = ok ? gates[(size_t)row * 12 + h] : 0.f;
                float x = lf;
#pragma unroll
                for (int o = 1; o < 64; o <<= 1) { const float y = __shfl_up(x, o, 64); if (lane >= o) x += y; }
                const float cB = csum + x;
                const float c = ok ? li - cB : -3.0e38f;
                float mx = c;
#pragma unroll
                for (int o = 1; o < 64; o <<= 1) { const float y = __shfl_up(mx, o, 64); if (lane >= o) mx = fmaxf(mx, y); }
                const float pm = fmaxf(cmax, mx);
                if (ok) {
                    carr[l] = c;
                    if (l >= Lend - 256) { const float m0 = fmaxf(pm, 0.f); mqa[l - (Lend - 256)] = m0; ema[l - (Lend - 256)] = __expf(-(cB + m0)); }
                }
                csum = __shfl(cB, 63, 64); cmax = __shfl(pm, 63, 64);
            }
        }
        __syncthreads();
        mq = mqa[wid * 32 + r32];
    }

    const int ntiles = 4 * j + 5;
    const int last_tile = 1 + (s0 + 32 * wid + 31 - (MODE == 0 ? 1 : 0)) / 64;
    const int sr = tid >> 4, sc = (tid & 15) * 8;
    const int vst0 = v_st(sr, sc), vst1 = v_st(32 + sr, sc);
    const int vb0 = (int)(uintptr_t)(LAS unsigned char*)V_lds + v_rd_base(lane);
    bf16x8 vs0, vs1, ks0, ks1;
#define SLOAD(it) do { int r0_, r1_; \
        if ((it) == 0) { r0_ = TREAL + b * NMETA + (sr < NMETA ? sr : NMETA - 1); r1_ = TREAL + b * NMETA + NMETA - 1; } \
        else { r0_ = b * SEQ + 64 * ((it) - 1) + sr; r1_ = r0_ + 32; } \
        vs0 = *(const bf16x8*)(S.V + (size_t)r0_ * S.ldv + sc); vs1 = *(const bf16x8*)(S.V + (size_t)r1_ * S.ldv + sc); \
        ks0 = *(const bf16x8*)(S.K + (size_t)r0_ * S.ldk + sc); ks1 = *(const bf16x8*)(S.K + (size_t)r1_ * S.ldk + sc); } while (0)
#define SWRITE() do { *(bf16x8*)(V_lds + vst0) = vs0; *(bf16x8*)(V_lds + vst1) = vs1; \
        *(bf16x8*)(K_lds + KSWZ(sr, sc * 2)) = ks0; *(bf16x8*)(K_lds + KSWZ(32 + sr, sc * 2)) = ks1; } while (0)

    f32x16 o[4];
#pragma unroll
    for (int d = 0; d < 4; ++d)
#pragma unroll
        for (int r = 0; r < 16; ++r) o[d][r] = 0.f;
    float R = 0.f, den = 0.f;

    SLOAD(ntiles - 1);
    for (int it = ntiles - 1; it >= 0; --it) {
        __syncthreads();
        SWRITE();
        __syncthreads();
        if (it > 0) SLOAD(it - 1);
        if (it <= last_tile) {
            f32x16 p0, p1;
            qkt(p0, p1, K_lds, qr, r32, hi);
            const int lbase = it == 0 ? 0 : NMETA + 64 * (it - 1);
            int kmax = lq - lbase + (MODE == 1 ? 1 : 0);
            const int nvalid = it == 0 ? NMETA : 64;
            kmax = kmax < nvalid ? kmax : nvalid;
            if (MODE == 0) {
                float x[32];
#pragma unroll
                for (int r = 0; r < 16; ++r) {
                    const float z0 = crow(r, hi) < kmax ? p0[r] * 0.08838834764831845f : -1.0e30f;
                    const float z1 = 32 + crow(r, hi) < kmax ? p1[r] * 0.08838834764831845f : -1.0e30f;
                    p0[r] = z0; p1[r] = z1;
                    x[r] = -(fmaxf(z0, 0.f) + __logf(1.f + __expf(-fabsf(z0))));
                    x[16 + r] = -(fmaxf(z1, 0.f) + __logf(1.f + __expf(-fabsf(z1))));
                }
                float lo[8], up[8];
#pragma unroll
                for (int q = 0; q < 8; ++q) {
                    const float g = (x[4 * q] + x[4 * q + 1]) + (x[4 * q + 2] + x[4 * q + 3]);
                    auto rr = __builtin_amdgcn_permlane32_swap(__float_as_uint(g), __float_as_uint(g), false, false);
                    lo[q] = __uint_as_float(rr[0]); up[q] = __uint_as_float(rr[1]);
                }
                float run = R;
                float sown[8];
#pragma unroll
                for (int q = 7; q >= 0; --q) {
                    const float s_up = run; run += up[q];
                    const float s_lo = run; run += lo[q];
                    sown[q] = hi ? s_up : s_lo;
                }
                R = run;
#pragma unroll
                for (int q = 0; q < 8; ++q) {
                    const float t3 = x[4 * q + 3] + sown[q], t2 = x[4 * q + 2] + t3, t1 = x[4 * q + 1] + t2, t0 = x[4 * q] + t1;
                    x[4 * q] = t0; x[4 * q + 1] = t1; x[4 * q + 2] = t2; x[4 * q + 3] = t3;
                }
#pragma unroll
                for (int r = 0; r < 16; ++r) { p0[r] = __expf(p0[r] + x[r]); p1[r] = __expf(p1[r] + x[16 + r]); }
            } else {
#pragma unroll
                for (int q = 0; q < 8; ++q) {
                    const f32x4 c4 = *(const f32x4*)(carr + lbase + 8 * q + 4 * hi);
#pragma unroll
                    for (int i = 0; i < 4; ++i) {
                        const int kk = 8 * q + 4 * hi + i;
                        const float w = kk < kmax ? __expf(c4[i] - mq) : 0.f;
                        if (q < 4) { p0[4 * q + i] *= w; den += p0[4 * q + i]; } else { p1[4 * (q - 4) + i] *= w; den += p1[4 * (q - 4) + i]; }
                    }
                }
            }
            bf16x8 pa0, pa1, pa2, pa3;
#define PK4(P, BASE, OUT) do { unsigned a0 = cvtpk(P[BASE + 0], P[BASE + 1]), a1 = cvtpk(P[BASE + 2], P[BASE + 3]); \
        unsigned b0 = cvtpk(P[BASE + 4], P[BASE + 5]), b1 = cvtpk(P[BASE + 6], P[BASE + 7]); \
        auto r0 = __builtin_amdgcn_permlane32_swap(a0, b0, false, false); auto r1 = __builtin_amdgcn_permlane32_swap(a1, b1, false, false); \
        u32x4 w = {r0[0], r1[0], r0[1], r1[1]}; OUT = *reinterpret_cast<bf16x8*>(&w); } while (0)
            PK4(p0, 0, pa0); PK4(p0, 8, pa1); PK4(p1, 0, pa2); PK4(p1, 8, pa3);
#undef PK4
            pv_one<0>(o[0], vb0, pa0, pa1, pa2, pa3); pv_one<1>(o[1], vb0, pa0, pa1, pa2, pa3);
            pv_one<2>(o[2], vb0, pa0, pa1, pa2, pa3); pv_one<3>(o[3], vb0, pa0, pa1, pa2, pa3);
        }
    }
#undef SLOAD
#undef SWRITE
    float rden[16];
    if (MODE == 1) {
        den = swap_sum(den);
        if (hi == 0) wsc[r32] = den;
        asm volatile("s_waitcnt lgkmcnt(0)" ::: "memory");
#pragma unroll
        for (int r = 0; r < 16; ++r) { const int qi = crow(r, hi); rden[r] = 1.f / fmaxf(fabsf(wsc[qi]), ema[wid * 32 + qi]); }
#pragma unroll
        for (int d = 0; d < 4; ++d)
#pragma unroll
            for (int r = 0; r < 16; ++r) o[d][r] *= rden[r];
    }
    float ss[16];
#pragma unroll
    for (int r = 0; r < 16; ++r) ss[r] = o[0][r] * o[0][r] + o[1][r] * o[1][r] + o[2][r] * o[2][r] + o[3][r] * o[3][r];
#pragma unroll
    for (int off = 1; off < 32; off <<= 1)
#pragma unroll
        for (int r = 0; r < 16; ++r) ss[r] += __shfl_xor(ss[r], off, 64);
    const float* ng = (MODE == 0 ? p->sb_norm_g : p->ml_norm_g) + layer * 768 + h * HD;
    const int ccol = (MODE == 0 ? 768 : 0) + h * HD;
    float gv[4];
#pragma unroll
    for (int d = 0; d < 4; ++d) gv[d] = ng[d * 32 + r32];
#pragma unroll
    for (int r = 0; r < 16; ++r) {
        const float rn = rsqrtf(ss[r] * (1.f / HD) + RMS_EPS);
        const int orow = b * SEQ + s0 + wid * 32 + crow(r, hi);
#pragma unroll
        for (int d = 0; d < 4; ++d) {
            float v = o[d][r] * rn * gv[d];
            if (MODE == 1) v *= sigmoidf_(bf2f(proj[(size_t)orow * PROJ_W + PC_MLO + h * HD + d * 32 + r32]));
            cat[(size_t)orow * DM + ccol + d * 32 + r32] = f2bf(v);
        }
    }
    __syncthreads();
}

template <int MODE>
__device__ __forceinline__ void mixer_meta_item(unsigned char* lds, PP p, int layer, int b, int h) {
    const int tid = tid_here();
    const bf16_t* proj = (const bf16_t*)(p->ws + WS_PROJ);
    const bf16_t* qkc = (const bf16_t*)(p->ws + WS_QKC);
    const float* gates = (const float*)(p->ws + WS_GATES);
    bf16_t* cat = (bf16_t*)(p->ws + WS_CAT);
    MixSrc S;
    if (MODE == 0) { S.Q = proj + PC_SBQ + h * HD; S.ldq = PROJ_W; S.K = proj + PC_SBK + h * HD; S.ldk = PROJ_W; S.V = proj + PC_SBV + h * HD; S.ldv = PROJ_W; }
    else { S.Q = qkc + h * HD; S.ldq = 1536; S.K = qkc + 768 + h * HD; S.ldk = 1536; S.V = proj + PC_MLV + h * HD; S.ldv = PROJ_W; }
    float* Ss = (float*)lds; float* As = Ss + 256; float* dn = As + 256;
    const int row0 = TREAL + b * NMETA;
    if (tid < 256) {
        const int qi = tid >> 4, ki = tid & 15;
        const bf16_t* q = S.Q + (size_t)(row0 + qi) * S.ldq; const bf16_t* k = S.K + (size_t)(row0 + ki) * S.ldk;
        float s = 0.f;
        for (int d = 0; d < HD; ++d) s += bf2f(q[d]) * bf2f(k[d]);
        Ss[qi * 16 + ki] = s;
    }
    __syncthreads();
    if (tid < 16) {
        const int qi = tid;
        if (MODE == 0) {
            float R = 0.f;
            for (int jj = 15; jj >= 0; --jj) {
                float a = 0.f;
                if (jj < qi) {
                    const float z = Ss[qi * 16 + jj] * 0.08838834764831845f;
                    const float lk = -(fmaxf(z, 0.f) + __logf(1.f + __expf(-fabsf(z))));
                    a = __expf(z + lk + R); R += lk;
                }
                As[qi * 16 + jj] = a;
            }
            dn[qi] = 1.f;
        } else {
            float cB = 0.f, pm = -3.0e38f, cs[16];
            float cBq = 0.f;
            for (int jj = 0; jj < 16; ++jj) {
                cB += gates[(size_t)(row0 + jj) * 12 + 6 + h];
                cs[jj] = gates[(size_t)(row0 + jj) * 12 + h] - cB;
                if (jj <= qi) { pm = fmaxf(pm, cs[jj]); cBq = cB; }
            }
            const float m0 = fmaxf(pm, 0.f);
            float den = 0.f;
            for (int jj = 0; jj < 16; ++jj) {
                float a = 0.f;
                if (jj <= qi) { a = __expf(cs[jj] - m0) * Ss[qi * 16 + jj]; den += a; }
                As[qi * 16 + jj] = a;
            }
            dn[qi] = 1.f / fmaxf(fabsf(den), __expf(-(cBq + m0)));
        }
    }
    __syncthreads();
    {
        const int qi = tid >> 5, d4 = (tid & 31) * 4;
        float o[4] = {0.f, 0.f, 0.f, 0.f};
        for (int jj = 0; jj < 16; ++jj) {
            const float a = As[qi * 16 + jj];
            const u32x2 v = *(const u32x2*)(S.V + (size_t)(row0 + jj) * S.ldv + d4);
            o[0] += a * bflo(v.x); o[1] += a * bfhi(v.x); o[2] += a * bflo(v.y); o[3] += a * bfhi(v.y);
        }
        const float dd = dn[qi];
        float ss = 0.f;
#pragma unroll
        for (int e = 0; e < 4; ++e) { o[e] *= dd; ss += o[e] * o[e]; }
#pragma unroll
        for (int off = 1; off < 32; off <<= 1) ss += __shfl_xor(ss, off, 64);
        const float rn = rsqrtf(ss * (1.f / HD) + RMS_EPS);
        const float* ng = (MODE == 0 ? p->sb_norm_g : p->ml_norm_g) + layer * 768 + h * HD;
        const int ccol = (MODE == 0 ? 768 : 0) + h * HD;
        const int orow = row0 + qi;
#pragma unroll
        for (int e = 0; e < 4; ++e) {
            float v = o[e] * rn * ng[d4 + e];
            if (MODE == 1) v *= sigmoidf_(bf2f(proj[(size_t)orow * PROJ_W + PC_MLO + h * HD + d4 + e]));
            cat[(size_t)orow * DM + ccol + d4 + e] = f2bf(v);
        }
    }
    __syncthreads();
}

__device__ __forceinline__ void pool_item(unsigned char* lds, PP p, int layer, int b, int pb, int g) {
    const int tid = tid_here();
    const bf16_t* proj = (const bf16_t*)(p->ws + WS_PROJ);
    bf16_t* cat = (bf16_t*)(p->ws + WS_CAT);
    float* Wl = (float*)lds;
    float* Pl = Wl + 128 * 128;
    constexpr int PLD = 132;
    const int win = 2 << g;
    const float* W = p->pool_w + ((size_t)layer * 4 + g) * 128 * 128;
    for (int i = tid; i < 128 * 32; i += NTHREADS) *(f32x4*)(Wl + i * 4) = *(const f32x4*)(W + i * 4);
    const int l0 = pb * 128, nl = (LSEQ - l0) < 128 ? (LSEQ - l0) : 128;
    {
        const int c = tid & 127, ch = tid >> 7;
        const int lstart = l0 + ch * 32;
        float sum = 0.f;
        for (int t = 1; t < win; ++t) { const int ls = lstart - t; if (ls >= 0) sum += bf2f(proj[(size_t)row_of(b, ls) * PROJ_W + PC_POOL + g * 128 + c]); }
        for (int i = 0; i < 32; ++i) {
            const int l = lstart + i;
            float pv = 0.f;
            if (l < LSEQ) {
                const float u = bf2f(proj[(size_t)row_of(b, l) * PROJ_W + PC_POOL + g * 128 + c]);
                sum += u;
                const int cnt = (l + 1) < win ? (l + 1) : win;
                pv = bf2f(f2bf(sum / (float)cnt - u));
                const int lo = l - win + 1;
                if (lo >= 0) sum -= bf2f(proj[(size_t)row_of(b, lo) * PROJ_W + PC_POOL + g * 128 + c]);
            }
            Pl[(ch * 32 + i) * PLD + c] = pv;
        }
    }
    __syncthreads();
    {
        const int d = tid & 127, rg = tid >> 7;
        float acc[32];
#pragma unroll
        for (int i = 0; i < 32; ++i) acc[i] = 0.f;
        for (int c4 = 0; c4 < 128; c4 += 4) {
            const float w0 = Wl[(c4 + 0) * 128 + d], w1 = Wl[(c4 + 1) * 128 + d], w2 = Wl[(c4 + 2) * 128 + d], w3 = Wl[(c4 + 3) * 128 + d];
#pragma unroll
            for (int i = 0; i < 32; ++i) {
                const f32x4 pv = *(const f32x4*)(Pl + (rg * 32 + i) * PLD + c4);
                acc[i] += pv[0] * w0 + pv[1] * w1 + pv[2] * w2 + pv[3] * w3;
            }
        }
        const float sc = p->pool_scale[layer * 512 + g * 128 + d];
#pragma unroll
        for (int i = 0; i < 32; ++i) {
            const int li = rg * 32 + i;
            if (li < nl) cat[(size_t)row_of(b, l0 + li) * DM + 1536 + g * 128 + d] = f2bf(acc[i] * sc);
        }
    }
    __syncthreads();
}

struct EpiResid {
    const bf16_t* H; bf16_t* O; int orow0; int nrows; int oc0, oc1;
    __device__ __forceinline__ void operator()(const f32x16 (&acc)[2][3], int wr, int wc, int r32, int hi) const {
#pragma unroll
        for (int mi = 0; mi < 3; ++mi) {
            const int tr = (2 * mi + wr) * 32 + r32;
            if (tr < nrows) {
#pragma unroll
                for (int ni = 0; ni < 2; ++ni) {
                    const size_t o = (size_t)(orow0 + tr) * DM + (ni ? oc1 : oc0) + wc * 32 + 16 * hi;
                    const u32x4 h0 = *(const u32x4*)(H + o), h1 = *(const u32x4*)(H + o + 8);
                    const f32x16& a = acc[ni][mi];
                    u32x4 w0, w1;
                    w0.x = cvtpk(DN_ALPHA * bflo(h0.x) + a[0], DN_ALPHA * bfhi(h0.x) + a[1]); w0.y = cvtpk(DN_ALPHA * bflo(h0.y) + a[2], DN_ALPHA * bfhi(h0.y) + a[3]);
                    w0.z = cvtpk(DN_ALPHA * bflo(h0.z) + a[4], DN_ALPHA * bfhi(h0.z) + a[5]); w0.w = cvtpk(DN_ALPHA * bflo(h0.w) + a[6], DN_ALPHA * bfhi(h0.w) + a[7]);
                    w1.x = cvtpk(DN_ALPHA * bflo(h1.x) + a[8], DN_ALPHA * bfhi(h1.x) + a[9]); w1.y = cvtpk(DN_ALPHA * bflo(h1.y) + a[10], DN_ALPHA * bfhi(h1.y) + a[11]);
                    w1.z = cvtpk(DN_ALPHA * bflo(h1.z) + a[12], DN_ALPHA * bfhi(h1.z) + a[13]); w1.w = cvtpk(DN_ALPHA * bflo(h1.w) + a[14], DN_ALPHA * bfhi(h1.w) + a[15]);
                    *(u32x4*)(O + o) = w0; *(u32x4*)(O + o + 8) = w1;
                }
            }
        }
    }
};

constexpr int RT_W = 0, RT_X = 32768, RT_ST = RT_X + 32 * 132 * 4, RT_HIST = RT_ST + 256, RT_BASE = RT_HIST + 256, RT_END = RT_BASE + 256;
__device__ __forceinline__ void router_item(unsigned char* lds, PP p, int layer, int item, int M) {
    const int tid = tid_here(), lane = tid & 63, wid = tid >> 6;
    const bf16_t* S1 = (const bf16_t*)(p->ws + WS_S1);
    bf16_t* H1 = (bf16_t*)(p->ws + WS_H1);
    float* Wc = (float*)(lds + RT_W);
    float* Xc = (float*)(lds + RT_X);
    float* st = (float*)(lds + RT_ST);
    int* hist = (int*)(lds + RT_HIST); int* basev = (int*)(lds + RT_BASE);
    const float* g1 = p->ln1_g + layer * DM; const float* b1 = p->ln1_b + layer * DM;
    if (tid < 64) hist[tid] = 0;
    for (int rr = 0; rr < 4; ++rr) {
        const int lr = wid * 4 + rr, row = item * 32 + lr;
        if (row < M) {
            float v[32];
            load_row32_bf16(S1 + (size_t)row * DM, lane, v);
            float s = 0.f;
#pragma unroll
            for (int i = 0; i < 32; ++i) s += v[i];
            const float mu = wave_sum(s) * (1.f / DM);
            float q = 0.f;
#pragma unroll
            for (int i = 0; i < 32; ++i) { const float d = v[i] - mu; q += d * d; }
            const float rstd = rsqrtf(wave_sum(q) * (1.f / DM) + LN_EPS);
            if (lane == 0) { st[lr * 2] = mu; st[lr * 2 + 1] = rstd; }
#pragma unroll
            for (int i = 0; i < 4; ++i) {
                const f32x4 ga = *(const f32x4*)(g1 + i * 512 + lane * 8), gb = *(const f32x4*)(g1 + i * 512 + lane * 8 + 4);
                const f32x4 ba = *(const f32x4*)(b1 + i * 512 + lane * 8), bb = *(const f32x4*)(b1 + i * 512 + lane * 8 + 4);
#pragma unroll
                for (int e = 0; e < 4; ++e) { v[i * 8 + e] = (v[i * 8 + e] - mu) * rstd * ga[e] + ba[e]; v[i * 8 + 4 + e] = (v[i * 8 + 4 + e] - mu) * rstd * gb[e] + bb[e]; }
            }
            store_row32_bf16(H1 + (size_t)row * DM, lane, v);
        } else if (lane == 0) { st[lr * 2] = 0.f; st[lr * 2 + 1] = 0.f; }
    }
    __syncthreads();
    float lg[4] = {0.f, 0.f, 0.f, 0.f};
    const float* rw = p->router_w + (size_t)layer * DM * NEXP;
    for (int kc = 0; kc < 16; ++kc) {
        for (int i = tid; i < 128 * 16; i += NTHREADS) *(f32x4*)(Wc + i * 4) = *(const f32x4*)(rw + (size_t)kc * 128 * 64 + i * 4);
        {
            const int lr = tid >> 4, k8 = (tid & 15) * 8, row = item * 32 + lr;
            const int rowc = row < M ? row : M - 1;
            const u32x4 a = *(const u32x4*)(S1 + (size_t)rowc * DM + kc * 128 + k8);
            const float mu = st[lr * 2], rstd = st[lr * 2 + 1];
            const f32x4 ga = *(const f32x4*)(g1 + kc * 128 + k8), gb = *(const f32x4*)(g1 + kc * 128 + k8 + 4);
            const f32x4 ba = *(const f32x4*)(b1 + kc * 128 + k8), bb = *(const f32x4*)(b1 + kc * 128 + k8 + 4);
            f32x4 x0, x1;
            x0[0] = (bflo(a.x) - mu) * rstd * ga[0] + ba[0]; x0[1] = (bfhi(a.x) - mu) * rstd * ga[1] + ba[1];
            x0[2] = (bflo(a.y) - mu) * rstd * ga[2] + ba[2]; x0[3] = (bfhi(a.y) - mu) * rstd * ga[3] + ba[3];
            x1[0] = (bflo(a.z) - mu) * rstd * gb[0] + bb[0]; x1[1] = (bfhi(a.z) - mu) * rstd * gb[1] + bb[1];
            x1[2] = (bflo(a.w) - mu) * rstd * gb[2] + bb[2]; x1[3] = (bfhi(a.w) - mu) * rstd * gb[3] + bb[3];
            *(f32x4*)(Xc + lr * 132 + k8) = x0; *(f32x4*)(Xc + lr * 132 + k8 + 4) = x1;
        }
        __syncthreads();
        for (int k4 = 0; k4 < 128; k4 += 4) {
            const float w0 = Wc[(k4 + 0) * 64 + lane], w1 = Wc[(k4 + 1) * 64 + lane], w2 = Wc[(k4 + 2) * 64 + lane], w3 = Wc[(k4 + 3) * 64 + lane];
#pragma unroll
            for (int rr = 0; rr < 4; ++rr) {
                const f32x4 xv = *(const f32x4*)(Xc + (wid * 4 + rr) * 132 + k4);
                lg[rr] += xv[0] * w0 + xv[1] * w1 + xv[2] * w2 + xv[3] * w3;
            }
        }
        __syncthreads();
    }
    const float bias = p->router_bias[layer * NEXP + lane];
    int my_e[4], my_rank[4]; float my_g[4];
    for (int rr = 0; rr < 4; ++rr) {
        const int row = item * 32 + wid * 4 + rr;
        const float score = 1.f / (1.f + __expf(-lg[rr]));
        float sel = score + bias;
        int e_k = 0; float s_k = 0.f; float ssum = 0.f;
        for (int k = 0; k < TOPK; ++k) {
            const float m = wave_max(sel);
            const unsigned long long bal = __ballot(sel == m);
            const int idx = __ffsll((long long)bal) - 1;
            const float sc = __shfl(score, idx, 64);
            ssum += sc;
            if (lane == k) { e_k = idx; s_k = sc; }
            if (lane == idx) sel = -3.0e38f;
        }
        my_e[rr] = e_k; my_g[rr] = s_k / ssum * ROUTED_SCALE; my_rank[rr] = 0;
        if (lane < TOPK && row < M) my_rank[rr] = atomicAdd(&hist[e_k], 1);
    }
    __syncthreads();
    int* cnt = (int*)(p->ws + WS_CTL + CTL_CNT) + layer * 64;
    if (tid < 64) basev[tid] = atomicAdd(&cnt[tid], hist[tid]);
    __syncthreads();
    int* asg_e = (int*)(p->ws + WS_ASGE); int* asg_s = (int*)(p->ws + WS_ASGS);
    int* tokl = (int*)(p->ws + WS_TOKL); float* gatel = (float*)(p->ws + WS_GATEL);
    for (int rr = 0; rr < 4; ++rr) {
        const int row = item * 32 + wid * 4 + rr;
        if (lane < TOPK && row < M) {
            const int e = my_e[rr], slot = basev[e] + my_rank[rr];
            asg_e[row * 8 + lane] = e; asg_s[row * 8 + lane] = slot;
            tokl[(size_t)e * TALL + slot] = row; gatel[(size_t)e * TALL + slot] = my_g[rr];
        }
    }
    __syncthreads();
}

constexpr int MS_BASE = G_LDS_END;
constexpr int MS_CNT = MS_BASE, MS_OFF = MS_BASE + 66 * 4, MS_TP = MS_BASE + 132 * 4, MS_END = MS_BASE + 200 * 4;
__device__ __forceinline__ void moe_tables(unsigned char* lds, PP p, int layer, int M) {
    int* c = (int*)(lds + MS_CNT); int* o = (int*)(lds + MS_OFF); int* tp = (int*)(lds + MS_TP);
    if (threadIdx.x == 0) {
        const int* cnt = (const int*)(p->ws + WS_CTL + CTL_CNT) + layer * 64;
        int acc = 0, t = 0;
        for (int e = 0; e < 64; ++e) { const int n = __hip_atomic_load(&cnt[e], __ATOMIC_RELAXED, __HIP_MEMORY_SCOPE_AGENT); c[e] = n; o[e] = acc; tp[e] = t; acc += n; t += (n + TM - 1) / TM; }
        c[64] = M; o[64] = SH_BASE; tp[64] = t; t += (M + TM - 1) / TM; tp[65] = t;
    }
    __syncthreads();
}
__device__ __forceinline__ void moe_decode(const unsigned char* lds, int id, int ntn, int& e, int& nt, int& m) {
    const int* tp = (const int*)(lds + MS_TP);
    int lo = 0;
    for (int k = 0; k < 65; ++k) if (tp[k + 1] * ntn <= id) lo = k + 1;
    e = lo; const int rem = id - tp[e] * ntn, nm = tp[e + 1] - tp[e];
    nt = rem / nm; m = rem % nm;
}

struct EpiSwiglu {
    bf16_t* O; int orow0; int nrows; int oc;
    __device__ __forceinline__ void operator()(const f32x16 (&acc)[2][3], int wr, int wc, int r32, int hi) const {
#pragma unroll
        for (int mi = 0; mi < 3; ++mi) {
            const int tr = (2 * mi + wr) * 32 + r32;
            if (tr < nrows) {
                float v[16];
#pragma unroll
                for (int r = 0; r < 16; ++r) { const float gte = acc[0][mi][r]; v[r] = gte / (1.f + __expf(-gte)) * acc[1][mi][r]; }
                u32x4 w0, w1;
                w0.x = cvtpk(v[0], v[1]); w0.y = cvtpk(v[2], v[3]); w0.z = cvtpk(v[4], v[5]); w0.w = cvtpk(v[6], v[7]);
                w1.x = cvtpk(v[8], v[9]); w1.y = cvtpk(v[10], v[11]); w1.z = cvtpk(v[12], v[13]); w1.w = cvtpk(v[14], v[15]);
                bf16_t* q = O + (size_t)(orow0 + tr) * DEXP + oc + wc * 32 + 16 * hi;
                *(u32x4*)q = w0; *(u32x4*)(q + 8) = w1;
            }
        }
    }
};
struct EpiScaleStore {
    bf16_t* O; int orow0; int nrows; int oc0, oc1; const float* gate;
    __device__ __forceinline__ void operator()(const f32x16 (&acc)[2][3], int wr, int wc, int r32, int hi) const {
#pragma unroll
        for (int mi = 0; mi < 3; ++mi) {
            const int tr = (2 * mi + wr) * 32 + r32;
            if (tr < nrows) {
                const float gsc = gate ? gate[tr] : 1.f;
#pragma unroll
                for (int ni = 0; ni < 2; ++ni) {
                    const f32x16& a = acc[ni][mi];
                    u32x4 w0, w1;
                    w0.x = cvtpk(a[0] * gsc, a[1] * gsc); w0.y = cvtpk(a[2] * gsc, a[3] * gsc); w0.z = cvtpk(a[4] * gsc, a[5] * gsc); w0.w = cvtpk(a[6] * gsc, a[7] * gsc);
                    w1.x = cvtpk(a[8] * gsc, a[9] * gsc); w1.y = cvtpk(a[10] * gsc, a[11] * gsc); w1.z = cvtpk(a[12] * gsc, a[13] * gsc); w1.w = cvtpk(a[14] * gsc, a[15] * gsc);
                    bf16_t* q = O + (size_t)(orow0 + tr) * DM + (ni ? oc1 : oc0) + wc * 32 + 16 * hi;
                    *(u32x4*)q = w0; *(u32x4*)(q + 8) = w1;
                }
            }
        }
    }
};

__device__ __forceinline__ void moe_gemm1_item(unsigned char* lds, PP p, int layer, int id) {
    int e, nt, m; moe_decode(lds, id, 4, e, nt, m);
    const int* c = (const int*)(lds + MS_CNT); const int* o = (const int*)(lds + MS_OFF);
    const int cnt = c[e], nvalid = (cnt - m * TM) < TM ? (cnt - m * TM) : TM;
    int* rows = (int*)(lds + G_ROWS);
    if (threadIdx.x < TM) {
        const int slot = m * TM + ((int)threadIdx.x < nvalid ? (int)threadIdx.x : nvalid - 1);
        rows[threadIdx.x] = e < 64 ? ((const int*)(p->ws + WS_TOKL))[(size_t)e * TALL + slot] : slot;
    }
    __syncthreads();
    const float* W = e < 64 ? p->exp_w13 + ((size_t)layer * 64 + e) * DM * 1024 : p->sh_w13 + (size_t)layer * DM * 1024;
    GemmOp g{(const bf16_t*)(p->ws + WS_H1), DM, W, 1024, nt * 128, 512 + nt * 128, DM};
    EpiSwiglu ep{(bf16_t*)(p->ws + WS_ACT), o[e] + m * TM, nvalid, nt * 128};
    gemm_tile(lds, g, ep);
}
__device__ __forceinline__ void moe_gemm2_item(unsigned char* lds, PP p, int layer, int id) {
    int e, nt, m; moe_decode(lds, id, 8, e, nt, m);
    const int* c = (const int*)(lds + MS_CNT); const int* o = (const int*)(lds + MS_OFF);
    const int cnt = c[e], nvalid = (cnt - m * TM) < TM ? (cnt - m * TM) : TM;
    const int pos0 = o[e] + m * TM;
    int* rows = (int*)(lds + G_ROWS);
    if (threadIdx.x < TM) rows[threadIdx.x] = pos0 + ((int)threadIdx.x < nvalid ? (int)threadIdx.x : nvalid - 1);
    __syncthreads();
    const float* W = e < 64 ? p->exp_w2 + ((size_t)layer * 64 + e) * DEXP * DM : p->sh_w2 + (size_t)layer * DEXP * DM;
    GemmOp g{(const bf16_t*)(p->ws + WS_ACT), DEXP, W, DM, nt * 256, nt * 256 + 128, DEXP};
    EpiScaleStore ep{(bf16_t*)(p->ws + WS_Y), pos0, nvalid, nt * 256, nt * 256 + 128, e < 64 ? (const float*)(p->ws + WS_GATEL) + (size_t)e * TALL + m * TM : nullptr};
    gemm_tile(lds, g, ep);
}

__device__ __forceinline__ void phase_combine(unsigned char* lds, PP p, int layer, int M) {
    const int tid = tid_here(), lane = tid & 63, gw = blockIdx.x * 8 + (tid >> 6), nw = gridDim.x * 8;
    const int* o = (const int*)(lds + MS_OFF);
    const bf16_t* H1 = (const bf16_t*)(p->ws + WS_H1); const bf16_t* Y = (const bf16_t*)(p->ws + WS_Y);
    const int* asg_e = (const int*)(p->ws + WS_ASGE); const int* asg_s = (const int*)(p->ws + WS_ASGS);
    bf16_t* hb = (bf16_t*)(p->ws + WS_HB);
    for (int row = gw; row < M; row += nw) {
        float v[32], t[32];
        load_row32_bf16(H1 + (size_t)row * DM, lane, v);
#pragma unroll
        for (int i = 0; i < 32; ++i) v[i] *= DN_ALPHA;
        load_row32_bf16(Y + (size_t)(SH_BASE + row) * DM, lane, t);
#pragma unroll
        for (int i = 0; i < 32; ++i) v[i] += t[i];
        for (int k = 0; k < TOPK; ++k) {
            const int e = asg_e[row * 8 + k], s = asg_s[row * 8 + k];
            load_row32_bf16(Y + (size_t)(o[e] + s) * DM, lane, t);
#pragma unroll
            for (int i = 0; i < 32; ++i) v[i] += t[i];
        }
        ln_row32(v, p->ln2_g + layer * DM, p->ln2_b + layer * DM, lane);
        if (layer == DEPTH - 1) {
#pragma unroll
            for (int i = 0; i < 4; ++i) {
                float* dst = p->out + (size_t)row * DM + i * 512 + lane * 8;
                *(f32x4*)dst = (f32x4){v[i * 8], v[i * 8 + 1], v[i * 8 + 2], v[i * 8 + 3]};
                *(f32x4*)(dst + 4) = (f32x4){v[i * 8 + 4], v[i * 8 + 5], v[i * 8 + 6], v[i * 8 + 7]};
            }
        } else {
            store_row32_bf16(hb + (size_t)row * DM, lane, v);
        }
    }
}

#define XB_TMO      128
#define XB_XCNT(j)  (256  + 64 * (j))
#define XB_XSUB(j)  (1280 + 64 * (j))
#define XB_XGEN(j)  (2304 + 64 * (j))
#define XB_TOP      3328
#define XB_TOPGEN   3392
#define XCD_BAR_WORDS 3456
#define XB_SPIN_CAP (1u << 18)

__device__ __forceinline__ unsigned xb_ld(unsigned* p)              { return __hip_atomic_load(p, __ATOMIC_RELAXED, __HIP_MEMORY_SCOPE_AGENT); }
__device__ __forceinline__ unsigned xb_add(unsigned* p, unsigned v) { return __hip_atomic_fetch_add(p, v, __ATOMIC_RELAXED, __HIP_MEMORY_SCOPE_AGENT); }
__device__ __forceinline__ unsigned xb_xcc_id() { return (unsigned)__builtin_amdgcn_s_getreg((3 << 11) | 20) & 0xFu; }
#define XB_SPIN(cond, bar) do { unsigned _sp = 0; while (cond) { __builtin_amdgcn_s_sleep(1); \
    if ((++_sp & 255u) == 0u) { if (xb_ld(&(bar)[XB_TMO])) break; if (_sp > XB_SPIN_CAP) { atomicAdd(&(bar)[XB_TMO], 1u); break; } } } } while (0)

struct XcdBarrier { unsigned* bar; unsigned x; volatile LAS unsigned* st; };

__device__ __forceinline__ XcdBarrier xcd_barrier_post(unsigned* bar, volatile LAS unsigned* st) {
    XcdBarrier b; b.bar = bar; b.x = xb_xcc_id(); b.st = st;
    if (threadIdx.x == 0) (void)xb_add(&bar[XB_XCNT(b.x)], 1u);
    return b;
}
__device__ __forceinline__ void xcd_barrier_complete(unsigned* bar, unsigned x, unsigned& nloc, unsigned& nx) {
    const unsigned G = gridDim.x * gridDim.y * gridDim.z;
    unsigned sum, cnt, mine, sp = 0u;
    for (;;) {
        sum = 0u; cnt = 0u; mine = 0u;
#pragma unroll
        for (unsigned j = 0; j < 16; ++j) { const unsigned c = xb_ld(&bar[XB_XCNT(j)]); sum += c; cnt += (c > 0u) ? 1u : 0u; mine = (j == x) ? c : mine; }
        if (sum == G) break;
        __builtin_amdgcn_s_sleep(1);
        if ((++sp & 255u) == 0u) { if (xb_ld(&bar[XB_TMO])) break; if (sp > XB_SPIN_CAP) { atomicAdd(&bar[XB_TMO], 1u); break; } }
    }
    nloc = mine > 0u ? mine : 1u; nx = cnt > 0u ? cnt : 1u;
}
__device__ __forceinline__ void xcd_barrier(const XcdBarrier& b) {
    asm volatile("s_waitcnt vmcnt(0)" ::: "memory");
    __syncthreads();
    if (threadIdx.x == 0) {
        unsigned* bar = b.bar;
        __builtin_amdgcn_s_waitcnt(0);
        unsigned nloc = b.st[0], nx = b.st[1];
        if (nloc == 0u) { xcd_barrier_complete(bar, b.x, nloc, nx); b.st[0] = nloc; b.st[1] = nx; }
        const unsigned old = xb_add(&bar[XB_XSUB(b.x)], 1u);
        const unsigned gen = old / nloc;
        if (old + 1u == (gen + 1u) * nloc) {
            __builtin_amdgcn_fence(__ATOMIC_RELEASE, "agent");
            asm volatile("s_waitcnt vmcnt(0)" ::: "memory");
            const unsigned og = xb_add(&bar[XB_TOP], 1u);
            const unsigned tg = og / nx;
            if (og + 1u == (tg + 1u) * nx) xb_add(&bar[XB_TOPGEN], 1u);
            else XB_SPIN(xb_ld(&bar[XB_TOPGEN]) == tg, bar);
            __builtin_amdgcn_fence(__ATOMIC_ACQUIRE, "agent");
            xb_add(&bar[XB_XGEN(b.x)], 1u);
            asm volatile("s_waitcnt vmcnt(0)" ::: "memory");
        } else {
            XB_SPIN(xb_ld(&bar[XB_XGEN(b.x)]) == gen, bar);
            __builtin_amdgcn_fence(__ATOMIC_ACQUIRE, "agent");
            asm volatile("s_waitcnt vmcnt(0)" ::: "memory");
        }
    }
    __syncthreads();
}

constexpr int NPHASES = 1 + 8 * DEPTH;
constexpr int XBW_OFF = LDS_BYTES - 16;

__global__ void __launch_bounds__(NTHREADS, 2) fwd_kernel(Params p_by_value) {
    extern __shared__ __attribute__((aligned(16))) unsigned char lds[];
    const int tid = threadIdx.x, G = gridDim.x, bx = blockIdx.x;
    const int vcu = (G % 8 == 0) ? (bx % 8) * (G / 8) + bx / 8 : bx;
    PP p = get_params();
    const int lo = p->ph_lo, hi = p->ph_hi;
    if (tid == 0) *(uint4*)(lds + XBW_OFF) = make_uint4(0u, 0u, 0u, 0u);
    __syncthreads();
    XcdBarrier bar; bar.bar = (unsigned*)(p->ws + WS_CTL); bar.x = 0; bar.st = (volatile LAS unsigned*)(LAS unsigned char*)(lds + XBW_OFF);
    if (hi - lo > 1) bar = xcd_barrier_post((unsigned*)(p->ws + WS_CTL), (volatile LAS unsigned*)(LAS unsigned char*)(lds + XBW_OFF));
#ifndef PHMASK
#define PHMASK 0x1FF
#endif
#define IN(k) (lo <= (k) && (k) < hi)
#define EN(b) (((PHMASK) >> (b)) & 1)
#ifndef MXMASK
#define MXMASK 0x1F
#endif
#define MXEN(b) (((MXMASK) >> (b)) & 1)
#define SEAM(k) do { if (IN((k) + 1)) xcd_barrier(bar); } while (0)

    if (EN(8) && IN(0)) { p = get_params(); phase_ln_in(p); SEAM(0); }

    for (int layer = 0; layer < DEPTH; ++layer) {
        const int pb = 1 + 8 * layer;
        const int M = (layer == DEPTH - 1) ? TREAL : TALL;
        if (EN(0) && IN(pb + 0)) { p = get_params();
            int* rows = (int*)(lds + G_ROWS);
            for (int id = vcu; id < 989; id += G) {
                int mt, nt;
                if (id < 920) { const int grp = id / 184, r = id % 184; nt = r >> 3; mt = grp * 8 + (r & 7); } else { const int r = id - 920; nt = r / 3; mt = 40 + r % 3; }
                if (tid < TM) rows[tid] = mt * TM + tid;
                __syncthreads();
                const int wcol = nt < 12 ? nt * 256 : 3084 + (nt - 12) * 256;
                GemmOp g{(const bf16_t*)(p->ws + WS_HB), DM, p->w_in + (size_t)layer * DM * N_IN, N_IN, wcol, wcol + 128, DM};
                EpiStoreBf16 e{(bf16_t*)(p->ws + WS_PROJ), PROJ_W, mt * TM, TM, nt * 256, nt * 256 + 128};
                gemm_tile(lds, g, e);
            }
            for (int id = G - 1 - vcu; id < 258; id += G) gates_item(lds, p, layer, id);
            SEAM(pb + 0);
        }
        if (EN(1) && IN(pb + 1)) { p = get_params(); phase_conv(p, layer); SEAM(pb + 1); }
        if (EN(2) && IN(pb + 2)) { p = get_params();
            int r = 0;
            for (int base = 0; base < 704; base += G, ++r) {
                const int id = base + ((r & 1) ? (G - 1 - bx) : bx);
                if (id < 704) {
                    if (id < 384) {
                        const int j = 7 - id / 48, rem = id % 48, mode = rem / 24, bh = rem % 24;
                        if (MXEN(0) && mode == 0) mixer_item<0>(lds, p, layer, bh / 6, bh % 6, j); else if (MXEN(1)) mixer_item<1>(lds, p, layer, bh / 6, bh % 6, j);
                    } else if (id < 656) {
                        const int q = id - 384, g = q & 3, rb = q >> 2;
                        if (MXEN(2)) pool_item(lds, p, layer, rb / 17, rb % 17, g);
                    } else {
                        const int q = id - 656, mode = q / 24, bh = q % 24;
                        if (MXEN(3) && mode == 0) mixer_meta_item<0>(lds, p, layer, bh / 6, bh % 6); else if (MXEN(4)) mixer_meta_item<1>(lds, p, layer, bh / 6, bh % 6);
                    }
                }
            }
            SEAM(pb + 2);
        }
        if (EN(3) && IN(pb + 3)) { p = get_params();
            int* rows = (int*)(lds + G_ROWS);
            const int ntile = ((M + TM - 1) / TM) * 8;
            for (int id = vcu; id < ntile; id += G) {
                const int mt = id >> 3, nt = id & 7;
                if (tid < TM) { const int r = mt * TM + tid; rows[tid] = r < M ? r : M - 1; }
                __syncthreads();
                GemmOp g{(const bf16_t*)(p->ws + WS_CAT), DM, p->w_out + (size_t)layer * DM * DM, DM, nt * 256, nt * 256 + 128, DM};
                EpiResid e{(const bf16_t*)(p->ws + WS_HB), (bf16_t*)(p->ws + WS_S1), mt * TM, M - mt * TM, nt * 256, nt * 256 + 128};
                gemm_tile(lds, g, e);
            }
            SEAM(pb + 3);
        }
        if (EN(4) && IN(pb + 4)) { p = get_params();
            const int nit = (M + 31) >> 5;
            for (int id = bx; id < nit; id += G) router_item(lds, p, layer, id, M);
            SEAM(pb + 4);
        }
        if (EN(5) && IN(pb + 5)) { p = get_params();
            moe_tables(lds, p, layer, M);
            const int nit = ((const int*)(lds + MS_TP))[65] * 4;
            for (int id = vcu; id < nit; id += G) moe_gemm1_item(lds, p, layer, id);
            SEAM(pb + 5);
        }
        if (EN(6) && IN(pb + 6)) { p = get_params();
            moe_tables(lds, p, layer, M);
            const int nit = ((const int*)(lds + MS_TP))[65] * 8;
            for (int id = vcu; id < nit; id += G) moe_gemm2_item(lds, p, layer, id);
            SEAM(pb + 6);
        }
        if (EN(7) && IN(pb + 7)) { p = get_params();
            moe_tables(lds, p, layer, M);
            phase_combine(lds, p, layer, M);
            __syncthreads();
            SEAM(pb + 7);
        }
    }
#undef IN
#undef SEAM
}

#ifndef N_LAUNCH_MODE
#define N_LAUNCH_MODE 0
#endif
extern "C" void kernel_launch(void* const* d_in, const int* in_sizes, int n_in, void* d_out, int out_size, void* d_ws, size_t ws_size, hipStream_t stream) {
    static int grid = 0;
    if (grid == 0) {
        if (n_in != 23 || ws_size < WS_END) { fprintf(stderr, "kernel_launch: unexpected n_in %d or ws %zu < %zu\n", n_in, ws_size, (size_t)WS_END); grid = -1; return; }
        int dev = 0, cus = 0, per_cu = 0;
        if (hipGetDevice(&dev) != hipSuccess || hipDeviceGetAttribute(&cus, hipDeviceAttributeMultiprocessorCount, dev) != hipSuccess) { grid = -1; return; }
        if (hipFuncSetAttribute((const void*)fwd_kernel, hipFuncAttributeMaxDynamicSharedMemorySize, LDS_BYTES) != hipSuccess) { fprintf(stderr, "kernel_launch: hipFuncSetAttribute failed\n"); grid = -1; return; }
        if (hipOccupancyMaxActiveBlocksPerMultiprocessor(&per_cu, (const void*)fwd_kernel, NTHREADS, LDS_BYTES) != hipSuccess || per_cu < 1)
            fprintf(stderr, "kernel_launch: occupancy query reports %d blocks per CU\n", per_cu);
        (void)hipGetLastError();
        grid = cus;
    }
    if (grid < 0) return;
    if (hipMemsetAsync((char*)d_ws + WS_CTL, 0, CTL_BYTES, stream) != hipSuccess) return;
    Params p{};
    const float* const* in = (const float* const*)d_in;
    p.x = in[0]; p.meta = in[1]; p.ln_in_g = in[2]; p.ln_in_b = in[3]; p.w_in = in[4]; p.b_igate = in[5]; p.b_fgate = in[6]; p.conv_qk = in[7];
    p.ml_norm_g = in[8]; p.sb_norm_g = in[9]; p.pool_w = in[10]; p.pool_scale = in[11]; p.w_out = in[12]; p.ln1_g = in[13]; p.ln1_b = in[14];
    p.router_w = in[15]; p.router_bias = in[16]; p.exp_w13 = in[17]; p.exp_w2 = in[18]; p.sh_w13 = in[19]; p.sh_w2 = in[20]; p.ln2_g = in[21]; p.ln2_b = in[22];
    p.out = (float*)d_out; p.ws = (unsigned char*)d_ws;
#if N_LAUNCH_MODE == 1
    p.ph_lo = 0; p.ph_hi = NPHASES;
    hipLaunchKernelGGL(fwd_kernel, dim3(grid), dim3(NTHREADS), LDS_BYTES, stream, p);
#else
    for (int ph = 0; ph < NPHASES; ++ph) {
        p.ph_lo = ph; p.ph_hi = ph + 1;
        hipLaunchKernelGGL(fwd_kernel, dim3(grid), dim3(NTHREADS), LDS_BYTES, stream, p);
    }
#endif
    const hipError_t le = hipPeekAtLastError();
    if (le != hipSuccess) fprintf(stderr, "kernel_launch: launch failed: %s\n", hipGetErrorName(le));
}
```

```cpp
#include <hip/hip_runtime.h>
#include <stdint.h>
#include <stdio.h>

constexpr int DM = 2048, NB = 4, SEQ = 2048, NMETA = 16, LSEQ = SEQ + NMETA, DEPTH = 2;
constexpr int TREAL = NB * SEQ;
constexpr int TALL = TREAL + NB * NMETA;
constexpr int HD = 128, NH = 6;
constexpr int N_IN = 5900;
constexpr int PROJ_W = 5888;
constexpr int PC_MLQK = 0, PC_MLV = 1536, PC_MLO = 2304, PC_SBQ = 3072, PC_SBK = 3840, PC_SBV = 4608, PC_POOL = 5376;
constexpr int NEXP = 64, TOPK = 8, DEXP = 512;
constexpr float ROUTED_SCALE = 2.5f;
constexpr float DN_ALPHA = 1.41421356237309515f;
constexpr float LN_EPS = 1e-5f, RMS_EPS = 1e-6f;
constexpr int SH_BASE = TALL * TOPK;
constexpr int PROWS = SH_BASE + TALL;

typedef unsigned short bf16_t;
typedef short bf16x8 __attribute__((ext_vector_type(8)));
typedef short s16x4 __attribute__((ext_vector_type(4)));
typedef float f32x16 __attribute__((ext_vector_type(16)));
typedef float f32x4 __attribute__((ext_vector_type(4)));
typedef float f32x2 __attribute__((ext_vector_type(2)));
typedef unsigned u32x4 __attribute__((ext_vector_type(4)));
typedef unsigned u32x2 __attribute__((ext_vector_type(2)));
#define LAS __attribute__((address_space(3)))

constexpr int NTHREADS = 512;
constexpr int LDS_BYTES = 144 * 1024;

__device__ __forceinline__ unsigned cvtpk(float lo, float hi) {
    unsigned r; asm volatile("v_cvt_pk_bf16_f32 %0, %1, %2" : "=v"(r) : "v"(lo), "v"(hi)); return r;
}
__device__ __forceinline__ float bf2f(bf16_t v) { return __uint_as_float(((unsigned)v) << 16); }
__device__ __forceinline__ float bflo(unsigned w) { return __uint_as_float(w << 16); }
__device__ __forceinline__ float bfhi(unsigned w) { return __uint_as_float(w & 0xffff0000u); }
__device__ __forceinline__ bf16_t f2bf(float f) { return (bf16_t)(cvtpk(f, 0.f) & 0xffffu); }
__device__ __forceinline__ int crow(int r, int hi) { return (r & 3) + 8 * (r >> 2) + 4 * hi; }
__device__ __forceinline__ float wave_sum(float v) {
#pragma unroll
    for (int o = 32; o >= 1; o >>= 1) v += __shfl_xor(v, o, 64);
    return v;
}
__device__ __forceinline__ float wave_max(float v) {
#pragma unroll
    for (int o = 32; o >= 1; o >>= 1) v = fmaxf(v, __shfl_xor(v, o, 64));
    return v;
}
__device__ __forceinline__ float sigmoidf_(float x) { return 1.f / (1.f + __expf(-x)); }
__device__ __forceinline__ float siluf_(float x) { return x / (1.f + __expf(-x)); }
__device__ __forceinline__ float logsigmoidf_(float x) { return fminf(x, 0.f) - log1pf(__expf(-fabsf(x))); }

__device__ __forceinline__ int tid_here() { int t = threadIdx.x; asm volatile("" : "+v"(t)); return t; }

__device__ __forceinline__ int row_of(int b, int l) { return l < NMETA ? TREAL + b * NMETA + l : b * SEQ + (l - NMETA); }

constexpr size_t al256(size_t x) { return (x + 255) / 256 * 256; }
constexpr size_t WS_CTL = 0;
constexpr size_t CTL_BYTES = 64 * 1024;
constexpr size_t CTL_CNT = 32 * 1024;
constexpr size_t WS_HB = al256(WS_CTL + CTL_BYTES);
constexpr size_t WS_PROJ = al256(WS_HB + (size_t)TALL * DM * 2);
constexpr size_t WS_GATES = al256(WS_PROJ + (size_t)TALL * PROJ_W * 2);
constexpr size_t WS_QKC = al256(WS_GATES + (size_t)TALL * 12 * 4);
constexpr size_t WS_CAT = al256(WS_QKC + (size_t)TALL * 1536 * 2);
constexpr size_t WS_S1 = al256(WS_CAT + (size_t)TALL * DM * 2);
constexpr size_t WS_H1 = al256(WS_S1 + (size_t)TALL * DM * 2);
constexpr size_t WS_ASGE = al256(WS_H1 + (size_t)TALL * DM * 2);
constexpr size_t WS_ASGS = al256(WS_ASGE + (size_t)TALL * 8 * 4);
constexpr size_t WS_TOKL = al256(WS_ASGS + (size_t)TALL * 8 * 4);
constexpr size_t WS_GATEL = al256(WS_TOKL + (size_t)NEXP * TALL * 4);
constexpr size_t WS_ACT = al256(WS_GATEL + (size_t)NEXP * TALL * 4);
constexpr size_t WS_Y = al256(WS_ACT + (size_t)PROWS * DEXP * 2);
constexpr size_t WS_END = al256(WS_Y + (size_t)PROWS * DM * 2);

struct Params {
    const float* x; const float* meta; const float* ln_in_g; const float* ln_in_b;
    const float* w_in; const float* b_igate; const float* b_fgate; const float* conv_qk;
    const float* ml_norm_g; const float* sb_norm_g; const float* pool_w; const float* pool_scale;
    const float* w_out; const float* ln1_g; const float* ln1_b; const float* router_w; const float* router_bias;
    const float* exp_w13; const float* exp_w2; const float* sh_w13; const float* sh_w2;
    const float* ln2_g; const float* ln2_b;
    float* out; unsigned char* ws;
    int ph_lo, ph_hi;
};
typedef const Params __attribute__((address_space(4)))* PP;
__device__ __forceinline__ PP get_params() {
    PP k = (PP)__builtin_amdgcn_kernarg_segment_ptr();
    asm volatile("" : "+s"(k));
    return k;
}

constexpr int TM = 192;
constexpr int G_AS = 0, G_BS = 65536, G_ROWS = 131072;
constexpr int G_LDS_END = G_ROWS + 1024;

__device__ __forceinline__ int swz_f(int n) { return ((n >> 2) & 7) ^ ((n >> 1) & 1); }

struct GemmOp {
    const bf16_t* X; int ldx;
    const float* W; int ldb;
    int cb0, cb1;
    int K;
};

template <class Epi>
__device__ __forceinline__ void gemm_tile(unsigned char* lds, const GemmOp& g, const Epi& epi) {
    const int tid = tid_here(), lane = tid & 63, wid = tid >> 6, wr = wid >> 2, wc = wid & 3, r32 = lane & 31, hi = lane >> 5;
    const int* rows = (const int*)(lds + G_ROWS);
    const int a_r = wid * 8 + (lane >> 3);
    unsigned a_off[3];
#pragma unroll
    for (int j = 0; j < 3; ++j) a_off[j] = (unsigned)rows[a_r + 64 * j] * (unsigned)g.ldx + (((lane & 7) ^ swz_f(a_r)) << 3);
    const int a_lds = (wid * 8) * 128 + lane * 16;
    const int kg = tid >> 6, nq = tid & 63;
    const int blk = nq >> 3, gq = nq & 7;
    const int b_col = ((blk & 1) ? g.cb1 : g.cb0) + (blk >> 1) * 32 + gq * 4;
    const int b_n0 = blk * 32 + 8 * (gq & 3) + 4 * (gq >> 2);
    const float* bp = g.W + (size_t)(kg * 8) * g.ldb + b_col;
    const int lanec = (hi ^ swz_f(r32)) << 4;
    const int a_rd = (wr * 32 + r32) * 128;
    const int b_rd = (wc * 64 + r32) * 128;

    f32x16 acc[2][3];
#pragma unroll
    for (int ni = 0; ni < 2; ++ni)
#pragma unroll
        for (int mi = 0; mi < 3; ++mi)
#pragma unroll
            for (int r = 0; r < 16; ++r) acc[ni][mi][r] = 0.f;

    f32x4 breg[8];
    const int nk = g.K >> 6;
#define G_DMA_A(kt, buf) do { \
        _Pragma("unroll") for (int j = 0; j < 3; ++j) __builtin_amdgcn_global_load_lds((const unsigned*)(g.X + a_off[j] + (kt) * 64), \
            (unsigned*)(lds + G_AS + (buf) * 32768 + a_lds + j * 8192), 16, 0, 0); } while (0)
#define G_LOAD(kt) do { \
        _Pragma("unroll") for (int j = 0; j < 8; ++j) breg[j] = *(const f32x4*)(bp + (size_t)((kt) * 64 + j) * g.ldb); } while (0)
#define G_WRITE(buf) do { \
        _Pragma("unroll") for (int i = 0; i < 4; ++i) { u32x4 w; \
            w.x = cvtpk(breg[0][i], breg[1][i]); w.y = cvtpk(breg[2][i], breg[3][i]); w.z = cvtpk(breg[4][i], breg[5][i]); w.w = cvtpk(breg[6][i], breg[7][i]); \
            const int n = b_n0 + i; *(u32x4*)(lds + G_BS + (buf) * 32768 + n * 128 + ((kg ^ swz_f(n)) << 4)) = w; } } while (0)

    G_LOAD(0);
    G_WRITE(0);
    __builtin_amdgcn_sched_barrier(0);
    G_DMA_A(0, 0);
    if (nk > 1) G_LOAD(1);
    for (int kt = 0; kt < nk; ++kt) {
        const int cur = kt & 1;
        __syncthreads();
        if (kt + 1 < nk) { G_WRITE(cur ^ 1); __builtin_amdgcn_sched_barrier(0); G_DMA_A(kt + 1, cur ^ 1); }
        if (kt + 2 < nk) { G_LOAD(kt + 2); }
        __builtin_amdgcn_sched_barrier(0);
        const unsigned char* As = lds + G_AS + cur * 32768;
        const unsigned char* Bs = lds + G_BS + cur * 32768;
#pragma unroll
        for (int ks = 0; ks < 4; ++ks) {
            const int co = (ks << 5) ^ lanec;
            bf16x8 xa[3], wb[2];
#pragma unroll
            for (int mi = 0; mi < 3; ++mi) xa[mi] = *(const bf16x8*)(As + a_rd + mi * 8192 + co);
#pragma unroll
            for (int ni = 0; ni < 2; ++ni) wb[ni] = *(const bf16x8*)(Bs + b_rd + ni * 4096 + co);
#pragma unroll
            for (int ni = 0; ni < 2; ++ni)
#pragma unroll
                for (int mi = 0; mi < 3; ++mi)
                    acc[ni][mi] = __builtin_amdgcn_mfma_f32_32x32x16_bf16(wb[ni], xa[mi], acc[ni][mi], 0, 0, 0);
        }
    }
#undef G_DMA_A
#undef G_LOAD
#undef G_WRITE
    epi(acc, wr, wc, r32, hi);
    __syncthreads();
}

struct EpiStoreBf16 {
    bf16_t* O; int ldo; int orow0; int nrows; int oc0, oc1;
    __device__ __forceinline__ void operator()(const f32x16 (&acc)[2][3], int wr, int wc, int r32, int hi) const {
#pragma unroll
        for (int mi = 0; mi < 3; ++mi) {
            const int tr = (2 * mi + wr) * 32 + r32;
            if (tr < nrows) {
#pragma unroll
                for (int ni = 0; ni < 2; ++ni) {
                    bf16_t* p = O + (size_t)(orow0 + tr) * ldo + (ni ? oc1 : oc0) + wc * 32 + 16 * hi;
                    u32x4 w0, w1; const f32x16& a = acc[ni][mi];
                    w0.x = cvtpk(a[0], a[1]); w0.y = cvtpk(a[2], a[3]); w0.z = cvtpk(a[4], a[5]); w0.w = cvtpk(a[6], a[7]);
                    w1.x = cvtpk(a[8], a[9]); w1.y = cvtpk(a[10], a[11]); w1.z = cvtpk(a[12], a[13]); w1.w = cvtpk(a[14], a[15]);
                    *(u32x4*)p = w0; *(u32x4*)(p + 8) = w1;
                }
            }
        }
    }
};


__device__ __forceinline__ void load_row32_f32(const float* src, int lane, float (&v)[32]) {
#pragma unroll
    for (int i = 0; i < 4; ++i) {
        const f32x4 a = *(const f32x4*)(src + i * 512 + lane * 8), b = *(const f32x4*)(src + i * 512 + lane * 8 + 4);
        v[i * 8 + 0] = a[0]; v[i * 8 + 1] = a[1]; v[i * 8 + 2] = a[2]; v[i * 8 + 3] = a[3];
        v[i * 8 + 4] = b[0]; v[i * 8 + 5] = b[1]; v[i * 8 + 6] = b[2]; v[i * 8 + 7] = b[3];
    }
}
__device__ __forceinline__ void load_row32_bf16(const bf16_t* src, int lane, float (&v)[32]) {
#pragma unroll
    for (int i = 0; i < 4; ++i) {
        const u32x4 a = *(const u32x4*)(src + i * 512 + lane * 8);
        v[i * 8 + 0] = bflo(a.x); v[i * 8 + 1] = bfhi(a.x); v[i * 8 + 2] = bflo(a.y); v[i * 8 + 3] = bfhi(a.y);
        v[i * 8 + 4] = bflo(a.z); v[i * 8 + 5] = bfhi(a.z); v[i * 8 + 6] = bflo(a.w); v[i * 8 + 7] = bfhi(a.w);
    }
}
__device__ __forceinline__ void ln_row32(float (&v)[32], const float* g, const float* bb, int lane) {
    float s = 0.f;
#pragma unroll
    for (int i = 0; i < 32; ++i) s += v[i];
    const float mu = wave_sum(s) * (1.f / DM);
    float q = 0.f;
#pragma unroll
    for (int i = 0; i < 32; ++i) { const float d = v[i] - mu; q += d * d; }
    const float rstd = rsqrtf(wave_sum(q) * (1.f / DM) + LN_EPS);
#pragma unroll
    for (int i = 0; i < 4; ++i) {
        const f32x4 g0 = *(const f32x4*)(g + i * 512 + lane * 8), g1 = *(const f32x4*)(g + i * 512 + lane * 8 + 4);
        const f32x4 b0 = *(const f32x4*)(bb + i * 512 + lane * 8), b1 = *(const f32x4*)(bb + i * 512 + lane * 8 + 4);
#pragma unroll
        for (int e = 0; e < 4; ++e) {
            v[i * 8 + e] = (v[i * 8 + e] - mu) * rstd * g0[e] + b0[e];
            v[i * 8 + 4 + e] = (v[i * 8 + 4 + e] - mu) * rstd * g1[e] + b1[e];
        }
    }
}
__device__ __forceinline__ void store_row32_bf16(bf16_t* dst, int lane, const float (&v)[32]) {
#pragma unroll
    for (int i = 0; i < 4; ++i) {
        u32x4 w; w.x = cvtpk(v[i * 8 + 0], v[i * 8 + 1]); w.y = cvtpk(v[i * 8 + 2], v[i * 8 + 3]); w.z = cvtpk(v[i * 8 + 4], v[i * 8 + 5]); w.w = cvtpk(v[i * 8 + 6], v[i * 8 + 7]);
        *(u32x4*)(dst + i * 512 + lane * 8) = w;
    }
}

__device__ __forceinline__ void phase_ln_in(PP p) {
    const int tid = tid_here(), lane = tid & 63, gw = blockIdx.x * 8 + (tid >> 6), nw = gridDim.x * 8;
    bf16_t* hb = (bf16_t*)(p->ws + WS_HB);
    for (int row = gw; row < TALL; row += nw) {
        const float* src = row < TREAL ? p->x + (size_t)row * DM : p->meta + (size_t)((row - TREAL) & 15) * DM;
        float v[32];
        load_row32_f32(src, lane, v);
        ln_row32(v, p->ln_in_g, p->ln_in_b, lane);
        store_row32_bf16(hb + (size_t)row * DM, lane, v);
    }
}

__device__ __forceinline__ void gates_item(unsigned char* lds, PP p, int layer, int item) {
    const int tid = tid_here(), lane = tid & 63, wid = tid >> 6;
    float* Wg = (float*)lds;
    const float* w = p->w_in + (size_t)layer * DM * N_IN + 3072;
    for (int i = tid; i < DM * 3; i += NTHREADS) { const int k = i / 3, c = i % 3; *(f32x4*)(Wg + k * 12 + c * 4) = *(const f32x4*)(w + (size_t)k * N_IN + c * 4); }
    __syncthreads();
    const bf16_t* hb = (const bf16_t*)(p->ws + WS_HB);
    float* gates = (float*)(p->ws + WS_GATES);
    for (int rr = 0; rr < 4; ++rr) {
        const int row = item * 32 + wid * 4 + rr;
        if (row < TALL) {
            float acc[12];
#pragma unroll
            for (int c = 0; c < 12; ++c) acc[c] = 0.f;
            const bf16_t* xr = hb + (size_t)row * DM;
            for (int i = 0; i < 32; ++i) {
                const int k = i * 64 + lane;
                const float xv = bf2f(xr[k]);
                const f32x4 w0 = *(const f32x4*)(Wg + k * 12), w1 = *(const f32x4*)(Wg + k * 12 + 4), w2 = *(const f32x4*)(Wg + k * 12 + 8);
#pragma unroll
                for (int e = 0; e < 4; ++e) { acc[e] += xv * w0[e]; acc[4 + e] += xv * w1[e]; acc[8 + e] += xv * w2[e]; }
            }
#pragma unroll
            for (int c = 0; c < 12; ++c) acc[c] = wave_sum(acc[c]);
            if (lane < 12) {
                float v = 0.f;
#pragma unroll
                for (int c = 0; c < 12; ++c) v = (lane == c) ? acc[c] : v;
                if (lane < 6) v += p->b_igate[layer * 6 + lane];
                else v = logsigmoidf_(v + p->b_fgate[layer * 6 + lane - 6]);
                gates[(size_t)row * 12 + lane] = v;
            }
        }
    }
    __syncthreads();
}

__device__ __forceinline__ void phase_conv(PP p, int layer) {
    const bf16_t* proj = (const bf16_t*)(p->ws + WS_PROJ);
    bf16_t* qkc = (bf16_t*)(p->ws + WS_QKC);
    const float* cw = p->conv_qk + (size_t)layer * 4 * 1536;
    const int total = TALL * 192;
    for (int idx = blockIdx.x * NTHREADS + tid_here(); idx < total; idx += gridDim.x * NTHREADS) {
        const int row = idx / 192, c0 = (idx % 192) * 8;
        int b, l;
        if (row < TREAL) { b = row >> 11; l = NMETA + (row & 2047); } else { b = (row - TREAL) >> 4; l = (row - TREAL) & 15; }
        float acc[8];
#pragma unroll
        for (int e = 0; e < 8; ++e) acc[e] = 0.f;
#pragma unroll
        for (int i = 0; i < 4; ++i) {
            const int ls = l - 3 + i;
            if (ls >= 0) {
                const u32x4 a = *(const u32x4*)(proj + (size_t)row_of(b, ls) * PROJ_W + PC_MLQK + c0);
                const f32x4 w0 = *(const f32x4*)(cw + i * 1536 + c0), w1 = *(const f32x4*)(cw + i * 1536 + c0 + 4);
                acc[0] += bflo(a.x) * w0[0]; acc[1] += bfhi(a.x) * w0[1]; acc[2] += bflo(a.y) * w0[2]; acc[3] += bfhi(a.y) * w0[3];
                acc[4] += bflo(a.z) * w1[0]; acc[5] += bfhi(a.z) * w1[1]; acc[6] += bflo(a.w) * w1[2]; acc[7] += bfhi(a.w) * w1[3];
            }
        }
        const float sc = c0 < 768 ? 0.08838834764831845f : 1.f;
#pragma unroll
        for (int e = 0; e < 8; ++e) acc[e] = siluf_(acc[e]) * sc;
        u32x4 w; w.x = cvtpk(acc[0], acc[1]); w.y = cvtpk(acc[2], acc[3]); w.z = cvtpk(acc[4], acc[5]); w.w = cvtpk(acc[6], acc[7]);
        *(u32x4*)(qkc + (size_t)row * 1536 + c0) = w;
    }
}

#define KSWZ(row, colB) ((row) * 256 + ((colB) ^ (((row) & 7) << 4)))
#define SBAR() __builtin_amdgcn_sched_barrier(0)
constexpr int MX_V = 0, MX_K = 16384, MX_C = 32768, MX_MQ = MX_C + 2112 * 4, MX_EM = MX_MQ + 1024, MX_WS = MX_EM + 1024, MX_END = MX_WS + 8 * 256;

__device__ __forceinline__ int v_st(int k, int c) { const int kk = (k & ~0xC) | ((k & 4) << 1) | ((k & 8) >> 1); return ((kk >> 3) * 4 + (c >> 5)) * 512 + ((kk & 7) * 32 + (c & 31)) * 2; }
__device__ __forceinline__ int v_rd_base(int lane) { return ((lane & 3) << 3) | (((lane >> 2) & 3) << 6) | (((lane >> 4) & 1) << 5) | (((lane >> 5) & 1) << 8); }
constexpr int v_rd_off(int d0, int ks, int half) { return d0 * 512 + ks * 4096 + half * 2048; }
template <int OFF> __device__ __forceinline__ s16x4 tr_read(int vb) {
    s16x4 r; asm volatile("ds_read_b64_tr_b16 %0, %1 offset:%2" : "=&v"(r) : "v"(vb), "i"(OFF) : "memory"); return r;
}
template <int D0> __device__ __forceinline__ void pv_one(f32x16& od, int vb, bf16x8 pa0, bf16x8 pa1, bf16x8 pa2, bf16x8 pa3) {
    const s16x4 l0 = tr_read<v_rd_off(D0, 0, 0)>(vb), h0 = tr_read<v_rd_off(D0, 0, 1)>(vb), l1 = tr_read<v_rd_off(D0, 1, 0)>(vb), h1 = tr_read<v_rd_off(D0, 1, 1)>(vb);
    const s16x4 l2 = tr_read<v_rd_off(D0, 2, 0)>(vb), h2 = tr_read<v_rd_off(D0, 2, 1)>(vb), l3 = tr_read<v_rd_off(D0, 3, 0)>(vb), h3 = tr_read<v_rd_off(D0, 3, 1)>(vb);
    asm volatile("s_waitcnt lgkmcnt(0)" ::: "memory"); SBAR();
#define PK(L, H) (bf16x8){L[0], L[1], L[2], L[3], H[0], H[1], H[2], H[3]}
    od = __builtin_amdgcn_mfma_f32_32x32x16_bf16(pa0, PK(l0, h0), od, 0, 0, 0);
    od = __builtin_amdgcn_mfma_f32_32x32x16_bf16(pa1, PK(l1, h1), od, 0, 0, 0);
    od = __builtin_amdgcn_mfma_f32_32x32x16_bf16(pa2, PK(l2, h2), od, 0, 0, 0);
    od = __builtin_amdgcn_mfma_f32_32x32x16_bf16(pa3, PK(l3, h3), od, 0, 0, 0);
#undef PK
}
__device__ __forceinline__ void qkt(f32x16& p0, f32x16& p1, const unsigned char* Ks, const bf16x8* qr, int r32, int hi) {
#pragma unroll
    for (int r = 0; r < 16; ++r) { p0[r] = 0.f; p1[r] = 0.f; }
#pragma unroll
    for (int d0 = 0; d0 < 8; ++d0) {
        const int cb = (d0 * 16 + hi * 8) * 2;
        const bf16x8 b0 = *(const bf16x8*)(Ks + KSWZ(r32, cb));
        const bf16x8 b1 = *(const bf16x8*)(Ks + KSWZ(32 + r32, cb));
        p0 = __builtin_amdgcn_mfma_f32_32x32x16_bf16(b0, qr[d0], p0, 0, 0, 0);
        p1 = __builtin_amdgcn_mfma_f32_32x32x16_bf16(b1, qr[d0], p1, 0, 0, 0);
    }
}
__device__ __forceinline__ float swap_sum(float v) {
    auto rr = __builtin_amdgcn_permlane32_swap(__float_as_uint(v), __float_as_uint(v), false, false);
    return __uint_as_float(rr[0]) + __uint_as_float(rr[1]);
}

#ifndef MIXER_INLINE
#define MIXER_INLINE __forceinline__
#endif
struct MixSrc { const bf16_t* Q; int ldq; const bf16_t* K; int ldk; const bf16_t* V; int ldv; };

template <int MODE>
__device__ MIXER_INLINE void mixer_item(unsigned char* lds, PP p, int layer, int b, int h, int j) {
    const int tid = tid_here(), wid = tid >> 6, lane = tid & 63, r32 = lane & 31, hi = lane >> 5;
    const bf16_t* proj = (const bf16_t*)(p->ws + WS_PROJ);
    const bf16_t* qkc = (const bf16_t*)(p->ws + WS_QKC);
    const float* gates = (const float*)(p->ws + WS_GATES);
    bf16_t* cat = (bf16_t*)(p->ws + WS_CAT);
    MixSrc S;
    if (MODE == 0) { S.Q = proj + PC_SBQ + h * HD; S.ldq = PROJ_W; S.K = proj + PC_SBK + h * HD; S.ldk = PROJ_W; S.V = proj + PC_SBV + h * HD; S.ldv = PROJ_W; }
    else { S.Q = qkc + h * HD; S.ldq = 1536; S.K = qkc + 768 + h * HD; S.ldk = 1536; S.V = proj + PC_MLV + h * HD; S.ldv = PROJ_W; }
    unsigned char* V_lds = lds + MX_V; unsigned char* K_lds = lds + MX_K;
    float* carr = (float*)(lds + MX_C); float* mqa = (float*)(lds + MX_MQ); float* ema = (float*)(lds + MX_EM);
    float* wsc = (float*)(lds + MX_WS) + wid * 64;

    const int s0 = 256 * j;
    const int qrow = b * SEQ + s0 + wid * 32 + r32;
    const int lq = NMETA + s0 + wid * 32 + r32;
    bf16x8 qr[8];
#pragma unroll
    for (int d0 = 0; d0 < 8; ++d0) qr[d0] = *(const bf16x8*)(S.Q + (size_t)qrow * S.ldq + d0 * 16 + hi * 8);

    float mq = 0.f;
    if (MODE == 1) {
        const int Lend = NMETA + s0 + 256;
        if (wid == 0) {
            float csum = 0.f, cmax = -3.0e38f;
            for (int base = 0; base < Lend; base += 64) {
                const int l = base + lane; const bool ok = l < Lend;
                const int row = row_of(b, ok ? l : 0);
                const float lf = ok ? gates[(size_t)row * 12 + 6 + h] : 0.f;
                const float li = ok ? gates[(size_t)row * 12 + h] : 0.f;
                float x = lf;
#pragma unroll
                for (int o = 1; o < 64; o <<= 1) { const float y = __shfl_up(x, o, 64); if (lane >= o) x += y; }
                const float cB = csum + x;
                const float c = ok ? li - cB : -3.0e38f;
                float mx = c;
#pragma unroll
                for (int o = 1; o < 64; o <<= 1) { const float y = __shfl_up(mx, o, 64); if (lane >= o) mx = fmaxf(mx, y); }
                const float pm = fmaxf(cmax, mx);
                if (ok) {
                    carr[l] = c;
                    if (l >= Lend - 256) { const float m0 = fmaxf(pm, 0.f); mqa[l - (Lend - 256)] = m0; ema[l - (Lend - 256)] = __expf(-(cB + m0)); }
                }
                csum = __shfl(cB, 63, 64); cmax = __shfl(pm, 63, 64);
            }
        }
        __syncthreads();
        mq = mqa[wid * 32 + r32];
    }

    const int ntiles = 4 * j + 5;
    const int last_tile = 1 + (s0 + 32 * wid + 31 - (MODE == 0 ? 1 : 0)) / 64;
    const int sr = tid >> 4, sc = (tid & 15) * 8;
    const int vst0 = v_st(sr, sc), vst1 = v_st(32 + sr, sc);
    const int vb0 = (int)(uintptr_t)(LAS unsigned char*)V_lds + v_rd_base(lane);
    bf16x8 vs0, vs1, ks0, ks1;
#define SLOAD(it) do { int r0_, r1_; \
        if ((it) == 0) { r0_ = TREAL + b * NMETA + (sr < NMETA ? sr : NMETA - 1); r1_ = TREAL + b * NMETA + NMETA - 1; } \
        else { r0_ = b * SEQ + 64 * ((it) - 1) + sr; r1_ = r0_ + 32; } \
        vs0 = *(const bf16x8*)(S.V + (size_t)r0_ * S.ldv + sc); vs1 = *(const bf16x8*)(S.V + (size_t)r1_ * S.ldv + sc); \
        ks0 = *(const bf16x8*)(S.K + (size_t)r0_ * S.ldk + sc); ks1 = *(const bf16x8*)(S.K + (size_t)r1_ * S.ldk + sc); } while (0)
#define SWRITE() do { *(bf16x8*)(V_lds + vst0) = vs0; *(bf16x8*)(V_lds + vst1) = vs1; \
        *(bf16x8*)(K_lds + KSWZ(sr, sc * 2)) = ks0; *(bf16x8*)(K_lds + KSWZ(32 + sr, sc * 2)) = ks1; } while (0)

    f32x16 o[4];
#pragma unroll
    for (int d = 0; d < 4; ++d)
#pragma unroll
        for (int r = 0; r < 16; ++r) o[d][r] = 0.f;
    float R = 0.f, den = 0.f;

    SLOAD(ntiles - 1);
    for (int it = ntiles - 1; it >= 0; --it) {
        __syncthreads();
        SWRITE();
        __syncthreads();
        if (it > 0) SLOAD(it - 1);
        if (it <= last_tile) {
            f32x16 p0, p1;
            qkt(p0, p1, K_lds, qr, r32, hi);
            const int lbase = it == 0 ? 0 : NMETA + 64 * (it - 1);
            int kmax = lq - lbase + (MODE == 1 ? 1 : 0);
            const int nvalid = it == 0 ? NMETA : 64;
            kmax = kmax < nvalid ? kmax : nvalid;
            if (MODE == 0) {
                float x[32];
#pragma unroll
                for (int r = 0; r < 16; ++r) {
                    const float z0 = crow(r, hi) < kmax ? p0[r] * 0.08838834764831845f : -1.0e30f;
                    const float z1 = 32 + crow(r, hi) < kmax ? p1[r] * 0.08838834764831845f : -1.0e30f;
                    p0[r] = z0; p1[r] = z1;
                    x[r] = -(fmaxf(z0, 0.f) + __logf(1.f + __expf(-fabsf(z0))));
                    x[16 + r] = -(fmaxf(z1, 0.f) + __logf(1.f + __expf(-fabsf(z1))));
                }
                float lo[8], up[8];
#pragma unroll
                for (int q = 0; q < 8; ++q) {
                    const float g = (x[4 * q] + x[4 * q + 1]) + (x[4 * q + 2] + x[4 * q + 3]);
                    auto rr = __builtin_amdgcn_permlane32_swap(__float_as_uint(g), __float_as_uint(g), false, false);
                    lo[q] = __uint_as_float(rr[0]); up[q] = __uint_as_float(rr[1]);
                }
                float run = R;
                float sown[8];
#pragma unroll
                for (int q = 7; q >= 0; --q) {
                    const float s_up = run; run += up[q];
                    const float s_lo = run; run += lo[q];
                    sown[q] = hi ? s_up : s_lo;
                }
                R = run;
#pragma unroll
                for (int q = 0; q < 8; ++q) {
                    const float t3 = x[4 * q + 3] + sown[q], t2 = x[4 * q + 2] + t3, t1 = x[4 * q + 1] + t2, t0 = x[4 * q] + t1;
                    x[4 * q] = t0; x[4 * q + 1] = t1; x[4 * q + 2] = t2; x[4 * q + 3] = t3;
                }
#pragma unroll
                for (int r = 0; r < 16; ++r) { p0[r] = __expf(p0[r] + x[r]); p1[r] = __expf(p1[r] + x[16 + r]); }
            } else {
#pragma unroll
                for (int q = 0; q < 8; ++q) {
                    const f32x4 c4 = *(const f32x4*)(carr + lbase + 8 * q + 4 * hi);
#pragma unroll
                    for (int i = 0; i < 4; ++i) {
                        const int kk = 8 * q + 4 * hi + i;
                        const float w = kk < kmax ? __expf(c4[i] - mq) : 0.f;
                        if (q < 4) { p0[4 * q + i] *= w; den += p0[4 * q + i]; } else { p1[4 * (q - 4) + i] *= w; den += p1[4 * (q - 4) + i]; }
                    }
                }
            }
            bf16x8 pa0, pa1, pa2, pa3;
#define PK4(P, BASE, OUT) do { unsigned a0 = cvtpk(P[BASE + 0], P[BASE + 1]), a1 = cvtpk(P[BASE + 2], P[BASE + 3]); \
        unsigned b0 = cvtpk(P[BASE + 4], P[BASE + 5]), b1 = cvtpk(P[BASE + 6], P[BASE + 7]); \
        auto r0 = __builtin_amdgcn_permlane32_swap(a0, b0, false, false); auto r1 = __builtin_amdgcn_permlane32_swap(a1, b1, false, false); \
        u32x4 w = {r0[0], r1[0], r0[1], r1[1]}; OUT = *reinterpret_cast<bf16x8*>(&w); } while (0)
            PK4(p0, 0, pa0); PK4(p0, 8, pa1); PK4(p1, 0, pa2); PK4(p1, 8, pa3);
#undef PK4
            pv_one<0>(o[0], vb0, pa0, pa1, pa2, pa3); pv_one<1>(o[1], vb0, pa0, pa1, pa2, pa3);
            pv_one<2>(o[2], vb0, pa0, pa1, pa2, pa3); pv_one<3>(o[3], vb0, pa0, pa1, pa2, pa3);
        }
    }
#undef SLOAD
#undef SWRITE
    float rden[16];
    if (MODE == 1) {
        den = swap_sum(den);
        if (hi == 0) wsc[r32] = den;
        asm volatile("s_waitcnt lgkmcnt(0)" ::: "memory");
#pragma unroll
        for (int r = 0; r < 16; ++r) { const int qi = crow(r, hi); rden[r] = 1.f / fmaxf(fabsf(wsc[qi]), ema[wid * 32 + qi]); }
#pragma unroll
        for (int d = 0; d < 4; ++d)
#pragma unroll
            for (int r = 0; r < 16; ++r) o[d][r] *= rden[r];
    }
    float ss[16];
#pragma unroll
    for (int r = 0; r < 16; ++r) ss[r] = o[0][r] * o[0][r] + o[1][r] * o[1][r] + o[2][r] * o[2][r] + o[3][r] * o[3][r];
#pragma unroll
    for (int off = 1; off < 32; off <<= 1)
#pragma unroll
        for (int r = 0; r < 16; ++r) ss[r] += __shfl_xor(ss[r], off, 64);
    const float* ng = (MODE == 0 ? p->sb_norm_g : p->ml_norm_g) + layer * 768 + h * HD;
    const int ccol = (MODE == 0 ? 768 : 0) + h * HD;
    float gv[4];
#pragma unroll
    for (int d = 0; d < 4; ++d) gv[d] = ng[d * 32 + r32];
#pragma unroll
    for (int r = 0; r < 16; ++r) {
        const float rn = rsqrtf(ss[r] * (1.f / HD) + RMS_EPS);
        const int orow = b * SEQ + s0 + wid * 32 + crow(r, hi);
#pragma unroll
        for (int d = 0; d < 4; ++d) {
            float v = o[d][r] * rn * gv[d];
            if (MODE == 1) v *= sigmoidf_(bf2f(proj[(size_t)orow * PROJ_W + PC_MLO + h * HD + d * 32 + r32]));
            cat[(size_t)orow * DM + ccol + d * 32 + r32] = f2bf(v);
        }
    }
    __syncthreads();
}

template <int MODE>
__device__ __forceinline__ void mixer_meta_item(unsigned char* lds, PP p, int layer, int b, int h) {
    const int tid = tid_here();
    const bf16_t* proj = (const bf16_t*)(p->ws + WS_PROJ);
    const bf16_t* qkc = (const bf16_t*)(p->ws + WS_QKC);
    const float* gates = (const float*)(p->ws + WS_GATES);
    bf16_t* cat = (bf16_t*)(p->ws + WS_CAT);
    MixSrc S;
    if (MODE == 0) { S.Q = proj + PC_SBQ + h * HD; S.ldq = PROJ_W; S.K = proj + PC_SBK + h * HD; S.ldk = PROJ_W; S.V = proj + PC_SBV + h * HD; S.ldv = PROJ_W; }
    else { S.Q = qkc + h * HD; S.ldq = 1536; S.K = qkc + 768 + h * HD; S.ldk = 1536; S.V = proj + PC_MLV + h * HD; S.ldv = PROJ_W; }
    float* Ss = (float*)lds; float* As = Ss + 256; float* dn = As + 256;
    const int row0 = TREAL + b * NMETA;
    if (tid < 256) {
        const int qi = tid >> 4, ki = tid & 15;
        const bf16_t* q = S.Q + (size_t)(row0 + qi) * S.ldq; const bf16_t* k = S.K + (size_t)(row0 + ki) * S.ldk;
        float s = 0.f;
        for (int d = 0; d < HD; ++d) s += bf2f(q[d]) * bf2f(k[d]);
        Ss[qi * 16 + ki] = s;
    }
    __syncthreads();
    if (tid < 16) {
        const int qi = tid;
        if (MODE == 0) {
            float R = 0.f;
            for (int jj = 15; jj >= 0; --jj) {
                float a = 0.f;
                if (jj < qi) {
                    const float z = Ss[qi * 16 + jj] * 0.08838834764831845f;
                    const float lk = -(fmaxf(z, 0.f) + __logf(1.f + __expf(-fabsf(z))));
                    a = __expf(z + lk + R); R += lk;
                }
                As[qi * 16 + jj] = a;
            }
            dn[qi] = 1.f;
        } else {
            float cB = 0.f, pm = -3.0e38f, cs[16];
            float cBq = 0.f;
            for (int jj = 0; jj < 16; ++jj) {
                cB += gates[(size_t)(row0 + jj) * 12 + 6 + h];
                cs[jj] = gates[(size_t)(row0 + jj) * 12 + h] - cB;
                if (jj <= qi) { pm = fmaxf(pm, cs[jj]); cBq = cB; }
            }
            const float m0 = fmaxf(pm, 0.f);
            float den = 0.f;
            for (int jj = 0; jj < 16; ++jj) {
                float a = 0.f;
                if (jj <= qi) { a = __expf(cs[jj] - m0) * Ss[qi * 16 + jj]; den += a; }
                As[qi * 16 + jj] = a;
            }
            dn[qi] = 1.f / fmaxf(fabsf(den), __expf(-(cBq + m0)));
        }
    }
    __syncthreads();
    {
        const int qi = tid >> 5, d4 = (tid & 31) * 4;
        float o[4] = {0.f, 0.f, 0.f, 0.f};
        for (int jj = 0; jj < 16; ++jj) {
            const float a = As[qi * 16 + jj];
            const u32x2 v = *(const u32x2*)(S.V + (size_t)(row0 + jj) * S.ldv + d4);
            o[0] += a * bflo(v.x); o[1] += a * bfhi(v.x); o[2] += a * bflo(v.y); o[3] += a * bfhi(v.y);
        }
        const float dd = dn[qi];
        float ss = 0.f;
#pragma unroll
        for (int e = 0; e < 4; ++e) { o[e] *= dd; ss += o[e] * o[e]; }
#pragma unroll
        for (int off = 1; off < 32; off <<= 1) ss += __shfl_xor(ss, off, 64);
        const float rn = rsqrtf(ss * (1.f / HD) + RMS_EPS);
        const float* ng = (MODE == 0 ? p->sb_norm_g : p->ml_norm_g) + layer * 768 + h * HD;
        const int ccol = (MODE == 0 ? 768 : 0) + h * HD;
        const int orow = row0 + qi;
#pragma unroll
        for (int e = 0; e < 4; ++e) {
            float v = o[e] * rn * ng[d4 + e];
            if (MODE == 1) v *= sigmoidf_(bf2f(proj[(size_t)orow * PROJ_W + PC_MLO + h * HD + d4 + e]));
            cat[(size_t)orow * DM + ccol + d4 + e] = f2bf(v);
        }
    }
    __syncthreads();
}

__device__ __forceinline__ void pool_item(unsigned char* lds, PP p, int layer, int b, int pb, int g) {
    const int tid = tid_here();
    const bf16_t* proj = (const bf16_t*)(p->ws + WS_PROJ);
    bf16_t* cat = (bf16_t*)(p->ws + WS_CAT);
    float* Wl = (float*)lds;
    float* Pl = Wl + 128 * 128;
    constexpr int PLD = 132;
    const int win = 2 << g;
    const float* W = p->pool_w + ((size_t)layer * 4 + g) * 128 * 128;
    for (int i = tid; i < 128 * 32; i += NTHREADS) *(f32x4*)(Wl + i * 4) = *(const f32x4*)(W + i * 4);
    const int l0 = pb * 128, nl = (LSEQ - l0) < 128 ? (LSEQ - l0) : 128;
    {
        const int c = tid & 127, ch = tid >> 7;
        const int lstart = l0 + ch * 32;
        float sum = 0.f;
        for (int t = 1; t < win; ++t) { const int ls = lstart - t; if (ls >= 0) sum += bf2f(proj[(size_t)row_of(b, ls) * PROJ_W + PC_POOL + g * 128 + c]); }
        for (int i = 0; i < 32; ++i) {
            const int l = lstart + i;
            float pv = 0.f;
            if (l < LSEQ) {
                const float u = bf2f(proj[(size_t)row_of(b, l) * PROJ_W + PC_POOL + g * 128 + c]);
                sum += u;
                const int cnt = (l + 1) < win ? (l + 1) : win;
                pv = bf2f(f2bf(sum / (float)cnt - u));
                const int lo = l - win + 1;
                if (lo >= 0) sum -= bf2f(proj[(size_t)row_of(b, lo) * PROJ_W + PC_POOL + g * 128 + c]);
            }
            Pl[(ch * 32 + i) * PLD + c] = pv;
        }
    }
    __syncthreads();
    {
        const int d = tid & 127, rg = tid >> 7;
        float acc[32];
#pragma unroll
        for (int i = 0; i < 32; ++i) acc[i] = 0.f;
        for (int c4 = 0; c4 < 128; c4 += 4) {
            const float w0 = Wl[(c4 + 0) * 128 + d], w1 = Wl[(c4 + 1) * 128 + d], w2 = Wl[(c4 + 2) * 128 + d], w3 = Wl[(c4 + 3) * 128 + d];
#pragma unroll
            for (int i = 0; i < 32; ++i) {
                const f32x4 pv = *(const f32x4*)(Pl + (rg * 32 + i) * PLD + c4);
                acc[i] += pv[0] * w0 + pv[1] * w1 + pv[2] * w2 + pv[3] * w3;
            }
        }
        const float sc = p->pool_scale[layer * 512 + g * 128 + d];
#pragma unroll
        for (int i = 0; i < 32; ++i) {
            const int li = rg * 32 + i;
            if (li < nl) cat[(size_t)row_of(b, l0 + li) * DM + 1536 + g * 128 + d] = f2bf(acc[i] * sc);
        }
    }
    __syncthreads();
}

struct EpiResid {
    const bf16_t* H; bf16_t* O; int orow0; int nrows; int oc0, oc1;
    __device__ __forceinline__ void operator()(const f32x16 (&acc)[2][3], int wr, int wc, int r32, int hi) const {
#pragma unroll
        for (int mi = 0; mi < 3; ++mi) {
            const int tr = (2 * mi + wr) * 32 + r32;
            if (tr < nrows) {
#pragma unroll
                for (int ni = 0; ni < 2; ++ni) {
                    const size_t o = (size_t)(orow0 + tr) * DM + (ni ? oc1 : oc0) + wc * 32 + 16 * hi;
                    const u32x4 h0 = *(const u32x4*)(H + o), h1 = *(const u32x4*)(H + o + 8);
                    const f32x16& a = acc[ni][mi];
                    u32x4 w0, w1;
                    w0.x = cvtpk(DN_ALPHA * bflo(h0.x) + a[0], DN_ALPHA * bfhi(h0.x) + a[1]); w0.y = cvtpk(DN_ALPHA * bflo(h0.y) + a[2], DN_ALPHA * bfhi(h0.y) + a[3]);
                    w0.z = cvtpk(DN_ALPHA * bflo(h0.z) + a[4], DN_ALPHA * bfhi(h0.z) + a[5]); w0.w = cvtpk(DN_ALPHA * bflo(h0.w) + a[6], DN_ALPHA * bfhi(h0.w) + a[7]);
                    w1.x = cvtpk(DN_ALPHA * bflo(h1.x) + a[8], DN_ALPHA * bfhi(h1.x) + a[9]); w1.y = cvtpk(DN_ALPHA * bflo(h1.y) + a[10], DN_ALPHA * bfhi(h1.y) + a[11]);
                    w1.z = cvtpk(DN_ALPHA * bflo(h1.z) + a[12], DN_ALPHA * bfhi(h1.z) + a[13]); w1.w = cvtpk(DN_ALPHA * bflo(h1.w) + a[14], DN_ALPHA * bfhi(h1.w) + a[15]);
                    *(u32x4*)(O + o) = w0; *(u32x4*)(O + o + 8) = w1;
                }
            }
        }
    }
};

constexpr int RT_W = 0, RT_X = 32768, RT_ST = RT_X + 32 * 132 * 4, RT_HIST = RT_ST + 256, RT_BASE = RT_HIST + 256, RT_END = RT_BASE + 256;
__device__ __forceinline__ void router_item(unsigned char* lds, PP p, int layer, int item, int M) {
    const int tid = tid_here(), lane = tid & 63, wid = tid >> 6;
    const bf16_t* S1 = (const bf16_t*)(p->ws + WS_S1);
    bf16_t* H1 = (bf16_t*)(p->ws + WS_H1);
    float* Wc = (float*)(lds + RT_W);
    float* Xc = (float*)(lds + RT_X);
    float* st = (float*)(lds + RT_ST);
    int* hist = (int*)(lds + RT_HIST); int* basev = (int*)(lds + RT_BASE);
    const float* g1 = p->ln1_g + layer * DM; const float* b1 = p->ln1_b + layer * DM;
    if (tid < 64) hist[tid] = 0;
    for (int rr = 0; rr < 4; ++rr) {
        const int lr = wid * 4 + rr, row = item * 32 + lr;
        if (row < M) {
            float v[32];
            load_row32_bf16(S1 + (size_t)row * DM, lane, v);
            float s = 0.f;
#pragma unroll
            for (int i = 0; i < 32; ++i) s += v[i];
            const float mu = wave_sum(s) * (1.f / DM);
            float q = 0.f;
#pragma unroll
            for (int i = 0; i < 32; ++i) { const float d = v[i] - mu; q += d * d; }
            const float rstd = rsqrtf(wave_sum(q) * (1.f / DM) + LN_EPS);
            if (lane == 0) { st[lr * 2] = mu; st[lr * 2 + 1] = rstd; }
#pragma unroll
            for (int i = 0; i < 4; ++i) {
                const f32x4 ga = *(const f32x4*)(g1 + i * 512 + lane * 8), gb = *(const f32x4*)(g1 + i * 512 + lane * 8 + 4);
                const f32x4 ba = *(const f32x4*)(b1 + i * 512 + lane * 8), bb = *(const f32x4*)(b1 + i * 512 + lane * 8 + 4);
#pragma unroll
                for (int e = 0; e < 4; ++e) { v[i * 8 + e] = (v[i * 8 + e] - mu) * rstd * ga[e] + ba[e]; v[i * 8 + 4 + e] = (v[i * 8 + 4 + e] - mu) * rstd * gb[e] + bb[e]; }
            }
            store_row32_bf16(H1 + (size_t)row * DM, lane, v);
        } else if (lane == 0) { st[lr * 2] = 0.f; st[lr * 2 + 1] = 0.f; }
    }
    __syncthreads();
    float lg[4] = {0.f, 0.f, 0.f, 0.f};
    const float* rw = p->router_w + (size_t)layer * DM * NEXP;
    for (int kc = 0; kc < 16; ++kc) {
        for (int i = tid; i < 128 * 16; i += NTHREADS) *(f32x4*)(Wc + i * 4) = *(const f32x4*)(rw + (size_t)kc * 128 * 64 + i * 4);
        {
            const int lr = tid >> 4, k8 = (tid & 15) * 8, row = item * 32 + lr;
            const int rowc = row < M ? row : M - 1;
            const u32x4 a = *(const u32x4*)(S1 + (size_t)rowc * DM + kc * 128 + k8);
            const float mu = st[lr * 2], rstd = st[lr * 2 + 1];
            const f32x4 ga = *(const f32x4*)(g1 + kc * 128 + k8), gb = *(const f32x4*)(g1 + kc * 128 + k8 + 4);
            const f32x4 ba = *(const f32x4*)(b1 + kc * 128 + k8), bb = *(const f32x4*)(b1 + kc * 128 + k8 + 4);
            f32x4 x0, x1;
            x0[0] = (bflo(a.x) - mu) * rstd * ga[0] + ba[0]; x0[1] = (bfhi(a.x) - mu) * rstd * ga[1] + ba[1];
            x0[2] = (bflo(a.y) - mu) * rstd * ga[2] + ba[2]; x0[3] = (bfhi(a.y) - mu) * rstd * ga[3] + ba[3];
            x1[0] = (bflo(a.z) - mu) * rstd * gb[0] + bb[0]; x1[1] = (bfhi(a.z) - mu) * rstd * gb[1] + bb[1];
            x1[2] = (bflo(a.w) - mu) * rstd * gb[2] + bb[2]; x1[3] = (bfhi(a.w) - mu) * rstd * gb[3] + bb[3];
            *(f32x4*)(Xc + lr * 132 + k8) = x0; *(f32x4*)(Xc + lr * 132 + k8 + 4) = x1;
        }
        __syncthreads();
        for (int k4 = 0; k4 < 128; k4 += 4) {
            const float w0 = Wc[(k4 + 0) * 64 + lane], w1 = Wc[(k4 + 1) * 64 + lane], w2 = Wc[(k4 + 2) * 64 + lane], w3 = Wc[(k4 + 3) * 64 + lane];
#pragma unroll
            for (int rr = 0; rr < 4; ++rr) {
                const f32x4 xv = *(const f32x4*)(Xc + (wid * 4 + rr) * 132 + k4);
                lg[rr] += xv[0] * w0 + xv[1] * w1 + xv[2] * w2 + xv[3] * w3;
            }
        }
        __syncthreads();
    }
    const float bias = p->router_bias[layer * NEXP + lane];
    int my_e[4], my_rank[4]; float my_g[4];
    for (int rr = 0; rr < 4; ++rr) {
        const int row = item * 32 + wid * 4 + rr;
        const float score = 1.f / (1.f + __expf(-lg[rr]));
        float sel = score + bias;
        int e_k = 0; float s_k = 0.f; float ssum = 0.f;
        for (int k = 0; k < TOPK; ++k) {
            const float m = wave_max(sel);
            const unsigned long long bal = __ballot(sel == m);
            const int idx = __ffsll((long long)bal) - 1;
            const float sc = __shfl(score, idx, 64);
            ssum += sc;
            if (lane == k) { e_k = idx; s_k = sc; }
            if (lane == idx) sel = -3.0e38f;
        }
        my_e[rr] = e_k; my_g[rr] = s_k / ssum * ROUTED_SCALE; my_rank[rr] = 0;
        if (lane < TOPK && row < M) my_rank[rr] = atomicAdd(&hist[e_k], 1);
    }
    __syncthreads();
    int* cnt = (int*)(p->ws + WS_CTL + CTL_CNT) + layer * 64;
    if (tid < 64) basev[tid] = atomicAdd(&cnt[tid], hist[tid]);
    __syncthreads();
    int* asg_e = (int*)(p->ws + WS_ASGE); int* asg_s = (int*)(p->ws + WS_ASGS);
    int* tokl = (int*)(p->ws + WS_TOKL); float* gatel = (float*)(p->ws + WS_GATEL);
    for (int rr = 0; rr < 4; ++rr) {
        const int row = item * 32 + wid * 4 + rr;
        if (lane < TOPK && row < M) {
            const int e = my_e[rr], slot = basev[e] + my_rank[rr];
            asg_e[row * 8 + lane] = e; asg_s[row * 8 + lane] = slot;
            tokl[(size_t)e * TALL + slot] = row; gatel[(size_t)e * TALL + slot] = my_g[rr];
        }
    }
    __syncthreads();
}

constexpr int MS_BASE = G_LDS_END;
constexpr int MS_CNT = MS_BASE, MS_OFF = MS_BASE + 66 * 4, MS_TP = MS_BASE + 132 * 4, MS_END = MS_BASE + 200 * 4;
__device__ __forceinline__ void moe_tables(unsigned char* lds, PP p, int layer, int M) {
    int* c = (int*)(lds + MS_CNT); int* o = (int*)(lds + MS_OFF); int* tp = (int*)(lds + MS_TP);
    if (threadIdx.x == 0) {
        const int* cnt = (const int*)(p->ws + WS_CTL + CTL_CNT) + layer * 64;
        int acc = 0, t = 0;
        for (int e = 0; e < 64; ++e) { const int n = __hip_atomic_load(&cnt[e], __ATOMIC_RELAXED, __HIP_MEMORY_SCOPE_AGENT); c[e] = n; o[e] = acc; tp[e] = t; acc += n; t += (n + TM - 1) / TM; }
        c[64] = M; o[64] = SH_BASE; tp[64] = t; t += (M + TM - 1) / TM; tp[65] = t;
    }
    __syncthreads();
}
__device__ __forceinline__ void moe_decode(const unsigned char* lds, int id, int ntn, int& e, int& nt, int& m) {
    const int* tp = (const int*)(lds + MS_TP);
    int lo = 0;
    for (int k = 0; k < 65; ++k) if (tp[k + 1] * ntn <= id) lo = k + 1;
    e = lo; const int rem = id - tp[e] * ntn, nm = tp[e + 1] - tp[e];
    nt = rem / nm; m = rem % nm;
}

struct EpiSwiglu {
    bf16_t* O; int orow0; int nrows; int oc;
    __device__ __forceinline__ void operator()(const f32x16 (&acc)[2][3], int wr, int wc, int r32, int hi) const {
#pragma unroll
        for (int mi = 0; mi < 3; ++mi) {
            const int tr = (2 * mi + wr) * 32 + r32;
            if (tr < nrows) {
                float v[16];
#pragma unroll
                for (int r = 0; r < 16; ++r) { const float gte = acc[0][mi][r]; v[r] = gte / (1.f + __expf(-gte)) * acc[1][mi][r]; }
                u32x4 w0, w1;
                w0.x = cvtpk(v[0], v[1]); w0.y = cvtpk(v[2], v[3]); w0.z = cvtpk(v[4], v[5]); w0.w = cvtpk(v[6], v[7]);
                w1.x = cvtpk(v[8], v[9]); w1.y = cvtpk(v[10], v[11]); w1.z = cvtpk(v[12], v[13]); w1.w = cvtpk(v[14], v[15]);
                bf16_t* q = O + (size_t)(orow0 + tr) * DEXP + oc + wc * 32 + 16 * hi;
                *(u32x4*)q = w0; *(u32x4*)(q + 8) = w1;
            }
        }
    }
};
struct EpiScaleStore {
    bf16_t* O; int orow0; int nrows; int oc0, oc1; const float* gate;
    __device__ __forceinline__ void operator()(const f32x16 (&acc)[2][3], int wr, int wc, int r32, int hi) const {
#pragma unroll
        for (int mi = 0; mi < 3; ++mi) {
            const int tr = (2 * mi + wr) * 32 + r32;
            if (tr < nrows) {
                const float gsc = gate ? gate[tr] : 1.f;
#pragma unroll
                for (int ni = 0; ni < 2; ++ni) {
                    const f32x16& a = acc[ni][mi];
                    u32x4 w0, w1;
                    w0.x = cvtpk(a[0] * gsc, a[1] * gsc); w0.y = cvtpk(a[2] * gsc, a[3] * gsc); w0.z = cvtpk(a[4] * gsc, a[5] * gsc); w0.w = cvtpk(a[6] * gsc, a[7] * gsc);
                    w1.x = cvtpk(a[8] * gsc, a[9] * gsc); w1.y = cvtpk(a[10] * gsc, a[11] * gsc); w1.z = cvtpk(a[12] * gsc, a[13] * gsc); w1.w = cvtpk(a[14] * gsc, a[15] * gsc);
                    bf16_t* q = O + (size_t)(orow0 + tr) * DM + (ni ? oc1 : oc0) + wc * 32 + 16 * hi;
                    *(u32x4*)q = w0; *(u32x4*)(q + 8) = w1;
                }
            }
        }
    }
};

__device__ __forceinline__ void moe_gemm1_item(unsigned char* lds, PP p, int layer, int id) {
    int e, nt, m; moe_decode(lds, id, 4, e, nt, m);
    const int* c = (const int*)(lds + MS_CNT); const int* o = (const int*)(lds + MS_OFF);
    const int cnt = c[e], nvalid = (cnt - m * TM) < TM ? (cnt - m * TM) : TM;
    int* rows = (int*)(lds + G_ROWS);
    if (threadIdx.x < TM) {
        const int slot = m * TM + ((int)threadIdx.x < nvalid ? (int)threadIdx.x : nvalid - 1);
        rows[threadIdx.x] = e < 64 ? ((const int*)(p->ws + WS_TOKL))[(size_t)e * TALL + slot] : slot;
    }
    __syncthreads();
    const float* W = e < 64 ? p->exp_w13 + ((size_t)layer * 64 + e) * DM * 1024 : p->sh_w13 + (size_t)layer * DM * 1024;
    GemmOp g{(const bf16_t*)(p->ws + WS_H1), DM, W, 1024, nt * 128, 512 + nt * 128, DM};
    EpiSwiglu ep{(bf16_t*)(p->ws + WS_ACT), o[e] + m * TM, nvalid, nt * 128};
    gemm_tile(lds, g, ep);
}
__device__ __forceinline__ void moe_gemm2_item(unsigned char* lds, PP p, int layer, int id) {
    int e, nt, m; moe_decode(lds, id, 8, e, nt, m);
    const int* c = (const int*)(lds + MS_CNT); const int* o = (const int*)(lds + MS_OFF);
    const int cnt = c[e], nvalid = (cnt - m * TM) < TM ? (cnt - m * TM) : TM;
    const int pos0 = o[e] + m * TM;
    int* rows = (int*)(lds + G_ROWS);
    if (threadIdx.x < TM) rows[threadIdx.x] = pos0 + ((int)threadIdx.x < nvalid ? (int)threadIdx.x : nvalid - 1);
    __syncthreads();
    const float* W = e < 64 ? p->exp_w2 + ((size_t)layer * 64 + e) * DEXP * DM : p->sh_w2 + (size_t)layer * DEXP * DM;
    GemmOp g{(const bf16_t*)(p->ws + WS_ACT), DEXP, W, DM, nt * 256, nt * 256 + 128, DEXP};
    EpiScaleStore ep{(bf16_t*)(p->ws + WS_Y), pos0, nvalid, nt * 256, nt * 256 + 128, e < 64 ? (const float*)(p->ws + WS_GATEL) + (size_t)e * TALL + m * TM : nullptr};
    gemm_tile(lds, g, ep);
}

__device__ __forceinline__ void phase_combine(unsigned char* lds, PP p, int layer, int M) {
    const int tid = tid_here(), lane = tid & 63, gw = blockIdx.x * 8 + (tid >> 6), nw = gridDim.x * 8;
    const int* o = (const int*)(lds + MS_OFF);
    const bf16_t* H1 = (const bf16_t*)(p->ws + WS_H1); const bf16_t* Y = (const bf16_t*)(p->ws + WS_Y);
    const int* asg_e = (const int*)(p->ws + WS_ASGE); const int* asg_s = (const int*)(p->ws + WS_ASGS);
    bf16_t* hb = (bf16_t*)(p->ws + WS_HB);
    for (int row = gw; row < M; row += nw) {
        float v[32], t[32];
        load_row32_bf16(H1 + (size_t)row * DM, lane, v);
#pragma unroll
        for (int i = 0; i < 32; ++i) v[i] *= DN_ALPHA;
        load_row32_bf16(Y + (size_t)(SH_BASE + row) * DM, lane, t);
#pragma unroll
        for (int i = 0; i < 32; ++i) v[i] += t[i];
        for (int k = 0; k < TOPK; ++k) {
            const int e = asg_e[row * 8 + k], s = asg_s[row * 8 + k];
            load_row32_bf16(Y + (size_t)(o[e] + s) * DM, lane, t);
#pragma unroll
            for (int i = 0; i < 32; ++i) v[i] += t[i];
        }
        ln_row32(v, p->ln2_g + layer * DM, p->ln2_b + layer * DM, lane);
        if (layer == DEPTH - 1) {
#pragma unroll
            for (int i = 0; i < 4; ++i) {
                float* dst = p->out + (size_t)row * DM + i * 512 + lane * 8;
                *(f32x4*)dst = (f32x4){v[i * 8], v[i * 8 + 1], v[i * 8 + 2], v[i * 8 + 3]};
                *(f32x4*)(dst + 4) = (f32x4){v[i * 8 + 4], v[i * 8 + 5], v[i * 8 + 6], v[i * 8 + 7]};
            }
        } else {
            store_row32_bf16(hb + (size_t)row * DM, lane, v);
        }
    }
}

#define XB_TMO      128
#define XB_XCNT(j)  (256  + 64 * (j))
#define XB_XSUB(j)  (1280 + 64 * (j))
#define XB_XGEN(j)  (2304 + 64 * (j))
#define XB_TOP      3328
#define XB_TOPGEN   3392
#define XCD_BAR_WORDS 3456
#define XB_SPIN_CAP (1u << 18)

__device__ __forceinline__ unsigned xb_ld(unsigned* p)              { return __hip_atomic_load(p, __ATOMIC_RELAXED, __HIP_MEMORY_SCOPE_AGENT); }
__device__ __forceinline__ unsigned xb_add(unsigned* p, unsigned v) { return __hip_atomic_fetch_add(p, v, __ATOMIC_RELAXED, __HIP_MEMORY_SCOPE_AGENT); }
__device__ __forceinline__ unsigned xb_xcc_id() { return (unsigned)__builtin_amdgcn_s_getreg((3 << 11) | 20) & 0xFu; }
#define XB_SPIN(cond, bar) do { unsigned _sp = 0; while (cond) { __builtin_amdgcn_s_sleep(1); \
    if ((++_sp & 255u) == 0u) { if (xb_ld(&(bar)[XB_TMO])) break; if (_sp > XB_SPIN_CAP) { atomicAdd(&(bar)[XB_TMO], 1u); break; } } } } while (0)

struct XcdBarrier { unsigned* bar; unsigned x; volatile LAS unsigned* st; };

__device__ __forceinline__ XcdBarrier xcd_barrier_post(unsigned* bar, volatile LAS unsigned* st) {
    XcdBarrier b; b.bar = bar; b.x = xb_xcc_id(); b.st = st;
    if (threadIdx.x == 0) (void)xb_add(&bar[XB_XCNT(b.x)], 1u);
    return b;
}
__device__ __forceinline__ void xcd_barrier_complete(unsigned* bar, unsigned x, unsigned& nloc, unsigned& nx) {
    const unsigned G = gridDim.x * gridDim.y * gridDim.z;
    unsigned sum, cnt, mine, sp = 0u;
    for (;;) {
        sum = 0u; cnt = 0u; mine = 0u;
#pragma unroll
        for (unsigned j = 0; j < 16; ++j) { const unsigned c = xb_ld(&bar[XB_XCNT(j)]); sum += c; cnt += (c > 0u) ? 1u : 0u; mine = (j == x) ? c : mine; }
        if (sum == G) break;
        __builtin_amdgcn_s_sleep(1);
        if ((++sp & 255u) == 0u) { if (xb_ld(&bar[XB_TMO])) break; if (sp > XB_SPIN_CAP) { atomicAdd(&bar[XB_TMO], 1u); break; } }
    }
    nloc = mine > 0u ? mine : 1u; nx = cnt > 0u ? cnt : 1u;
}
__device__ __forceinline__ void xcd_barrier(const XcdBarrier& b) {
    asm volatile("s_waitcnt vmcnt(0)" ::: "memory");
    __syncthreads();
    if (threadIdx.x == 0) {
        unsigned* bar = b.bar;
        __builtin_amdgcn_s_waitcnt(0);
        unsigned nloc = b.st[0], nx = b.st[1];
        if (nloc == 0u) { xcd_barrier_complete(bar, b.x, nloc, nx); b.st[0] = nloc; b.st[1] = nx; }
        const unsigned old = xb_add(&bar[XB_XSUB(b.x)], 1u);
        const unsigned gen = old / nloc;
        if (old + 1u == (gen + 1u) * nloc) {
            __builtin_amdgcn_fence(__ATOMIC_RELEASE, "agent");
            asm volatile("s_waitcnt vmcnt(0)" ::: "memory");
            const unsigned og = xb_add(&bar[XB_TOP], 1u);
            const unsigned tg = og / nx;
            if (og + 1u == (tg + 1u) * nx) xb_add(&bar[XB_TOPGEN], 1u);
            else XB_SPIN(xb_ld(&bar[XB_TOPGEN]) == tg, bar);
            __builtin_amdgcn_fence(__ATOMIC_ACQUIRE, "agent");
            xb_add(&bar[XB_XGEN(b.x)], 1u);
            asm volatile("s_waitcnt vmcnt(0)" ::: "memory");
        } else {
            XB_SPIN(xb_ld(&bar[XB_XGEN(b.x)]) == gen, bar);
            __builtin_amdgcn_fence(__ATOMIC_ACQUIRE, "agent");
            asm volatile("s_waitcnt vmcnt(0)" ::: "memory");
        }
    }
    __syncthreads();
}

constexpr int NPHASES = 1 + 8 * DEPTH;
constexpr int XBW_OFF = LDS_BYTES - 16;

__global__ void __launch_bounds__(NTHREADS, 2) fwd_kernel(Params p_by_value) {
    extern __shared__ __attribute__((aligned(16))) unsigned char lds[];
    const int tid = threadIdx.x, G = gridDim.x, bx = blockIdx.x;
    const int vcu = (G % 8 == 0) ? (bx % 8) * (G / 8) + bx / 8 : bx;
    PP p = get_params();
    const int lo = p->ph_lo, hi = p->ph_hi;
    if (tid == 0) *(uint4*)(lds + XBW_OFF) = make_uint4(0u, 0u, 0u, 0u);
    __syncthreads();
    XcdBarrier bar; bar.bar = (unsigned*)(p->ws + WS_CTL); bar.x = 0; bar.st = (volatile LAS unsigned*)(LAS unsigned char*)(lds + XBW_OFF);
    if (hi - lo > 1) bar = xcd_barrier_post((unsigned*)(p->ws + WS_CTL), (volatile LAS unsigned*)(LAS unsigned char*)(lds + XBW_OFF));
#ifndef PHMASK
#define PHMASK 0x1FF
#endif
#define IN(k) (lo <= (k) && (k) < hi)
#define EN(b) (((PHMASK) >> (b)) & 1)
#ifndef MXMASK
#define MXMASK 0x1F
#endif
#define MXEN(b) (((MXMASK) >> (b)) & 1)
#define SEAM(k) do { if (IN((k) + 1)) xcd_barrier(bar); } while (0)

    if (EN(8) && IN(0)) { p = get_params(); phase_ln_in(p); SEAM(0); }

    for (int layer = 0; layer < DEPTH; ++layer) {
        const int pb = 1 + 8 * layer;
        const int M = (layer == DEPTH - 1) ? TREAL : TALL;
        if (EN(0) && IN(pb + 0)) { p = get_params();
            int* rows = (int*)(lds + G_ROWS);
            for (int id = vcu; id < 989; id += G) {
                int mt, nt;
                if (id < 920) { const int grp = id / 184, r = id % 184; nt = r >> 3; mt = grp * 8 + (r & 7); } else { const int r = id - 920; nt = r / 3; mt = 40 + r % 3; }
                if (tid < TM) rows[tid] = mt * TM + tid;
                __syncthreads();
                const int wcol = nt < 12 ? nt * 256 : 3084 + (nt - 12) * 256;
                GemmOp g{(const bf16_t*)(p->ws + WS_HB), DM, p->w_in + (size_t)layer * DM * N_IN, N_IN, wcol, wcol + 128, DM};
                EpiStoreBf16 e{(bf16_t*)(p->ws + WS_PROJ), PROJ_W, mt * TM, TM, nt * 256, nt * 256 + 128};
                gemm_tile(lds, g, e);
            }
            for (int id = G - 1 - vcu; id < 258; id += G) gates_item(lds, p, layer, id);
            SEAM(pb + 0);
        }
        if (EN(1) && IN(pb + 1)) { p = get_params(); phase_conv(p, layer); SEAM(pb + 1); }
        if (EN(2) && IN(pb + 2)) { p = get_params();
            int r = 0;
            for (int base = 0; base < 704; base += G, ++r) {
                const int id = base + ((r & 1) ? (G - 1 - bx) : bx);
                if (id < 704) {
                    if (id < 384) {
                        const int j = 7 - id / 48, rem = id % 48, mode = rem / 24, bh = rem % 24;
                        if (MXEN(0) && mode == 0) mixer_item<0>(lds, p, layer, bh / 6, bh % 6, j); else if (MXEN(1)) mixer_item<1>(lds, p, layer, bh / 6, bh % 6, j);
                    } else if (id < 656) {
                        const int q = id - 384, g = q & 3, rb = q >> 2;
                        if (MXEN(2)) pool_item(lds, p, layer, rb / 17, rb % 17, g);
                    } else {
                        const int q = id - 656, mode = q / 24, bh = q % 24;
                        if (MXEN(3) && mode == 0) mixer_meta_item<0>(lds, p, layer, bh / 6, bh % 6); else if (MXEN(4)) mixer_meta_item<1>(lds, p, layer, bh / 6, bh % 6);
                    }
                }
            }
            SEAM(pb + 2);
        }
        if (EN(3) && IN(pb + 3)) { p = get_params();
            int* rows = (int*)(lds + G_ROWS);
            const int ntile = ((M + TM - 1) / TM) * 8;
            for (int id = vcu; id < ntile; id += G) {
                const int mt = id >> 3, nt = id & 7;
                if (tid < TM) { const int r = mt * TM + tid; rows[tid] = r < M ? r : M - 1; }
                __syncthreads();
                GemmOp g{(const bf16_t*)(p->ws + WS_CAT), DM, p->w_out + (size_t)layer * DM * DM, DM, nt * 256, nt * 256 + 128, DM};
                EpiResid e{(const bf16_t*)(p->ws + WS_HB), (bf16_t*)(p->ws + WS_S1), mt * TM, M - mt * TM, nt * 256, nt * 256 + 128};
                gemm_tile(lds, g, e);
            }
            SEAM(pb + 3);
        }
        if (EN(4) && IN(pb + 4)) { p = get_params();
            const int nit = (M + 31) >> 5;
            for (int id = bx; id < nit; id += G) router_item(lds, p, layer, id, M);
            SEAM(pb + 4);
        }
        if (EN(5) && IN(pb + 5)) { p = get_params();
            moe_tables(lds, p, layer, M);
            const int nit = ((const int*)(lds + MS_TP))[65] * 4;
            for (int id = vcu; id < nit; id += G) moe_gemm1_item(lds, p, layer, id);
            SEAM(pb + 5);
        }
        if (EN(6) && IN(pb + 6)) { p = get_params();
            moe_tables(lds, p, layer, M);
            const int nit = ((const int*)(lds + MS_TP))[65] * 8;
            for (int id = vcu; id < nit; id += G) moe_gemm2_item(lds, p, layer, id);
            SEAM(pb + 6);
        }
        if (EN(7) && IN(pb + 7)) { p = get_params();
            moe_tables(lds, p, layer, M);
            phase_combine(lds, p, layer, M);
            __syncthreads();
            SEAM(pb + 7);
        }
    }
#undef IN
#undef SEAM
}

#ifndef N_LAUNCH_MODE
#define N_LAUNCH_MODE 1
#endif
extern "C" void kernel_launch(void* const* d_in, const int* in_sizes, int n_in, void* d_out, int out_size, void* d_ws, size_t ws_size, hipStream_t stream) {
    static int grid = 0;
    if (grid == 0) {
        if (n_in != 23 || ws_size < WS_END) { fprintf(stderr, "kernel_launch: unexpected n_in %d or ws %zu < %zu\n", n_in, ws_size, (size_t)WS_END); grid = -1; return; }
        int dev = 0, cus = 0, per_cu = 0;
        if (hipGetDevice(&dev) != hipSuccess || hipDeviceGetAttribute(&cus, hipDeviceAttributeMultiprocessorCount, dev) != hipSuccess) { grid = -1; return; }
        if (hipFuncSetAttribute((const void*)fwd_kernel, hipFuncAttributeMaxDynamicSharedMemorySize, LDS_BYTES) != hipSuccess) { fprintf(stderr, "kernel_launch: hipFuncSetAttribute failed\n"); grid = -1; return; }
        if (hipOccupancyMaxActiveBlocksPerMultiprocessor(&per_cu, (const void*)fwd_kernel, NTHREADS, LDS_BYTES) != hipSuccess || per_cu < 1)
            fprintf(stderr, "kernel_launch: occupancy query reports %d blocks per CU\n", per_cu);
        (void)hipGetLastError();
        grid = cus;
    }
    if (grid < 0) return;
    if (hipMemsetAsync((char*)d_ws + WS_CTL, 0, CTL_BYTES, stream) != hipSuccess) return;
    Params p{};
    const float* const* in = (const float* const*)d_in;
    p.x = in[0]; p.meta = in[1]; p.ln_in_g = in[2]; p.ln_in_b = in[3]; p.w_in = in[4]; p.b_igate = in[5]; p.b_fgate = in[6]; p.conv_qk = in[7];
    p.ml_norm_g = in[8]; p.sb_norm_g = in[9]; p.pool_w = in[10]; p.pool_scale = in[11]; p.w_out = in[12]; p.ln1_g = in[13]; p.ln1_b = in[14];
    p.router_w = in[15]; p.router_bias = in[16]; p.exp_w13 = in[17]; p.exp_w2 = in[18]; p.sh_w13 = in[19]; p.sh_w2 = in[20]; p.ln2_g = in[21]; p.ln2_b = in[22];
    p.out = (float*)d_out; p.ws = (unsigned char*)d_ws;
#if N_LAUNCH_MODE == 1
    p.ph_lo = 0; p.ph_hi = NPHASES;
    hipLaunchKernelGGL(fwd_kernel, dim3(grid), dim3(NTHREADS), LDS_BYTES, stream, p);
#else
    for (int ph = 0; ph < NPHASES; ++ph) {
        p.ph_lo = ph; p.ph_hi = ph + 1;
        hipLaunchKernelGGL(fwd_kernel, dim3(grid), dim3(NTHREADS), LDS_BYTES, stream, p);
    }
#endif
    const hipError_t le = hipPeekAtLastError();
    if (le != hipSuccess) fprintf(stderr, "kernel_launch: launch failed: %s\n", hipGetErrorName(le));
}
```

```cpp
#include <hip/hip_runtime.h>
#include <stdint.h>
#include <stdio.h>

constexpr int DM = 2048, NB = 4, SEQ = 2048, NMETA = 16, LSEQ = SEQ + NMETA, DEPTH = 2;
constexpr int TREAL = NB * SEQ;
constexpr int TALL = TREAL + NB * NMETA;
constexpr int HD = 128, NH = 6;
constexpr int N_IN = 5900;
constexpr int PROJ_W = 5888;
constexpr int PC_MLQK = 0, PC_MLV = 1536, PC_MLO = 2304, PC_SBQ = 3072, PC_SBK = 3840, PC_SBV = 4608, PC_POOL = 5376;
constexpr int NEXP = 64, TOPK = 8, DEXP = 512;
constexpr float ROUTED_SCALE = 2.5f;
constexpr float DN_ALPHA = 1.41421356237309515f;
constexpr float LN_EPS = 1e-5f, RMS_EPS = 1e-6f;
constexpr int SH_BASE = TALL * TOPK;
constexpr int PROWS = SH_BASE + TALL;

typedef unsigned short bf16_t;
typedef short bf16x8 __attribute__((ext_vector_type(8)));
typedef short s16x4 __attribute__((ext_vector_type(4)));
typedef float f32x16 __attribute__((ext_vector_type(16)));
typedef float f32x4 __attribute__((ext_vector_type(4)));
typedef float f32x2 __attribute__((ext_vector_type(2)));
typedef unsigned u32x4 __attribute__((ext_vector_type(4)));
typedef unsigned u32x2 __attribute__((ext_vector_type(2)));
#define LAS __attribute__((address_space(3)))

constexpr int NTHREADS = 512;
constexpr int LDS_BYTES = 144 * 1024;

__device__ __forceinline__ unsigned cvtpk(float lo, float hi) {
    unsigned r; asm volatile("v_cvt_pk_bf16_f32 %0, %1, %2" : "=v"(r) : "v"(lo), "v"(hi)); return r;
}
__device__ __forceinline__ float bf2f(bf16_t v) { return __uint_as_float(((unsigned)v) << 16); }
__device__ __forceinline__ float bflo(unsigned w) { return __uint_as_float(w << 16); }
__device__ __forceinline__ float bfhi(unsigned w) { return __uint_as_float(w & 0xffff0000u); }
__device__ __forceinline__ bf16_t f2bf(float f) { return (bf16_t)(cvtpk(f, 0.f) & 0xffffu); }
__device__ __forceinline__ int crow(int r, int hi) { return (r & 3) + 8 * (r >> 2) + 4 * hi; }
__device__ __forceinline__ float wave_sum(float v) {
#pragma unroll
    for (int o = 32; o >= 1; o >>= 1) v += __shfl_xor(v, o, 64);
    return v;
}
__device__ __forceinline__ float wave_max(float v) {
#pragma unroll
    for (int o = 32; o >= 1; o >>= 1) v = fmaxf(v, __shfl_xor(v, o, 64));
    return v;
}
__device__ __forceinline__ float sigmoidf_(float x) { return 1.f / (1.f + __expf(-x)); }
__device__ __forceinline__ float siluf_(float x) { return x / (1.f + __expf(-x)); }
__device__ __forceinline__ float logsigmoidf_(float x) { return fminf(x, 0.f) - log1pf(__expf(-fabsf(x))); }

__device__ __forceinline__ int tid_here() { int t = threadIdx.x; asm volatile("" : "+v"(t)); return t; }

__device__ __forceinline__ int row_of(int b, int l) { return l < NMETA ? TREAL + b * NMETA + l : b * SEQ + (l - NMETA); }

constexpr size_t al256(size_t x) { return (x + 255) / 256 * 256; }
constexpr size_t WS_CTL = 0;
constexpr size_t CTL_BYTES = 64 * 1024;
constexpr size_t CTL_CNT = 32 * 1024;
constexpr size_t WS_HB = al256(WS_CTL + CTL_BYTES);
constexpr size_t WS_PROJ = al256(WS_HB + (size_t)TALL * DM * 2);
constexpr size_t WS_GATES = al256(WS_PROJ + (size_t)TALL * PROJ_W * 2);
constexpr size_t WS_QKC = al256(WS_GATES + (size_t)TALL * 12 * 4);
constexpr size_t WS_CAT = al256(WS_QKC + (size_t)TALL * 1536 * 2);
constexpr size_t WS_S1 = al256(WS_CAT + (size_t)TALL * DM * 2);
constexpr size_t WS_H1 = al256(WS_S1 + (size_t)TALL * DM * 2);
constexpr size_t WS_ASGE = al256(WS_H1 + (size_t)TALL * DM * 2);
constexpr size_t WS_ASGS = al256(WS_ASGE + (size_t)TALL * 8 * 4);
constexpr size_t WS_TOKL = al256(WS_ASGS + (size_t)TALL * 8 * 4);
constexpr size_t WS_GATEL = al256(WS_TOKL + (size_t)NEXP * TALL * 4);
constexpr size_t WS_ACT = al256(WS_GATEL + (size_t)NEXP * TALL * 4);
constexpr size_t WS_Y = al256(WS_ACT + (size_t)PROWS * DEXP * 2);
constexpr size_t WS_END = al256(WS_Y + (size_t)PROWS * DM * 2);

struct Params {
    const float* x; const float* meta; const float* ln_in_g; const float* ln_in_b;
    const float* w_in; const float* b_igate; const float* b_fgate; const float* conv_qk;
    const float* ml_norm_g; const float* sb_norm_g; const float* pool_w; const float* pool_scale;
    const float* w_out; const float* ln1_g; const float* ln1_b; const float* router_w; const float* router_bias;
    const float* exp_w13; const float* exp_w2; const float* sh_w13; const float* sh_w2;
    const float* ln2_g; const float* ln2_b;
    float* out; unsigned char* ws;
    int ph_lo, ph_hi;
};
typedef const Params __attribute__((address_space(4)))* PP;
__device__ __forceinline__ PP get_params() {
    PP k = (PP)__builtin_amdgcn_kernarg_segment_ptr();
    asm volatile("" : "+s"(k));
    return k;
}

constexpr int TM = 192;
constexpr int A_SLOT = 24576;
constexpr int G_AS = 0, G_BS = 3 * A_SLOT, G_ROWS = G_BS + 65536;
constexpr int G_LDS_END = G_ROWS + 1024;

__device__ __forceinline__ int swz_f(int n) { return ((n >> 2) & 7) ^ ((n >> 1) & 1); }

struct GemmOp {
    const bf16_t* X; int ldx;
    const float* W; int ldb;
    int cb0, cb1;
    int K;
};

#define BSET_WAIT(N, S) asm volatile("s_waitcnt vmcnt(" #N ") lgkmcnt(0)" : "+v"(S[0]), "+v"(S[1]), "+v"(S[2]), "+v"(S[3]), "+v"(S[4]), "+v"(S[5]), "+v"(S[6]), "+v"(S[7]) :: "memory")

template <class Epi>
__device__ __forceinline__ void gemm_tile(unsigned char* lds, const GemmOp& g, const Epi& epi) {
    const int tid = tid_here(), lane = tid & 63, wid = __builtin_amdgcn_readfirstlane(tid >> 6), wr = wid >> 2, wc = wid & 3, r32 = lane & 31, hi = lane >> 5;
    const int* rows = (const int*)(lds + G_ROWS);
    const int a_r = wid * 8 + (lane >> 3);
    unsigned a_off[3];
#pragma unroll
    for (int j = 0; j < 3; ++j) a_off[j] = (unsigned)rows[a_r + 64 * j] * (unsigned)g.ldx + (((lane & 7) ^ swz_f(a_r)) << 3);
    const int a_lds = wid * 1024;
    const int kg = wid, nq = lane;
    const int blk = nq >> 3, gq = nq & 7;
    const int b_col = ((blk & 1) ? g.cb1 : g.cb0) + (blk >> 1) * 32 + gq * 4;
    const int b_n0 = blk * 32 + 8 * (gq & 3) + 4 * (gq >> 2);
    const int wa0 = G_BS + b_n0 * 128 + ((kg ^ swz_f(b_n0)) << 4);
    const int wa2 = G_BS + (b_n0 + 2) * 128 + ((kg ^ swz_f(b_n0 + 2)) << 4);
    const unsigned long long wa_ = (unsigned long long)g.W;
    const char* Wu = (const char*)(((unsigned long long)(unsigned)__builtin_amdgcn_readfirstlane((int)(wa_ >> 32)) << 32) | (unsigned)__builtin_amdgcn_readfirstlane((int)wa_));
    const int ldbu = __builtin_amdgcn_readfirstlane(g.ldb);
    const unsigned b_voff = (unsigned)((kg * 8 * ldbu + b_col) * 4);
    const size_t ldb4 = (size_t)ldbu * 4;
    const int lanec = (hi ^ swz_f(r32)) << 4;
    int ard[4], brd[4];
#pragma unroll
    for (int ks = 0; ks < 4; ++ks) { ard[ks] = G_AS + (wr * 32 + r32) * 128 + ((ks << 5) ^ lanec); brd[ks] = G_BS + (wc * 64 + r32) * 128 + ((ks << 5) ^ lanec); }

    f32x16 acc[2][3];
#pragma unroll
    for (int ni = 0; ni < 2; ++ni)
#pragma unroll
        for (int mi = 0; mi < 3; ++mi)
#pragma unroll
            for (int r = 0; r < 16; ++r) acc[ni][mi][r] = 0.f;

    f32x4 s0[8], s1[8];
    const int nk = g.K >> 6;
#define G_DMA_A(kt, slot_off) do { \
        _Pragma("unroll") for (int j = 0; j < 3; ++j) __builtin_amdgcn_global_load_lds((const unsigned*)(g.X + a_off[j] + (kt) * 64), \
            (unsigned*)(lds + G_AS + (slot_off) + a_lds + j * 8192), 16, 0, 0); } while (0)
#define G_LOADB(S, kt) do { const char* wb_ = Wu + (size_t)(kt) * 64 * ldb4; \
        _Pragma("unroll") for (int j = 0; j < 8; ++j) asm volatile("global_load_dwordx4 %0, %1, %2" : "=v"(S[j]) : "v"(b_voff), "s"(wb_ + j * ldb4) : "memory"); } while (0)
#define G_WRITEB(S, buf) do { u32x4 w_; \
        w_.x = cvtpk(S[0][0], S[1][0]); w_.y = cvtpk(S[2][0], S[3][0]); w_.z = cvtpk(S[4][0], S[5][0]); w_.w = cvtpk(S[6][0], S[7][0]); *(u32x4*)(lds + wa0 + (buf) * 32768) = w_; \
        w_.x = cvtpk(S[0][1], S[1][1]); w_.y = cvtpk(S[2][1], S[3][1]); w_.z = cvtpk(S[4][1], S[5][1]); w_.w = cvtpk(S[6][1], S[7][1]); *(u32x4*)(lds + wa0 + (buf) * 32768 + 128) = w_; \
        w_.x = cvtpk(S[0][2], S[1][2]); w_.y = cvtpk(S[2][2], S[3][2]); w_.z = cvtpk(S[4][2], S[5][2]); w_.w = cvtpk(S[6][2], S[7][2]); *(u32x4*)(lds + wa2 + (buf) * 32768) = w_; \
        w_.x = cvtpk(S[0][3], S[1][3]); w_.y = cvtpk(S[2][3], S[3][3]); w_.z = cvtpk(S[4][3], S[5][3]); w_.w = cvtpk(S[6][3], S[7][3]); *(u32x4*)(lds + wa2 + (buf) * 32768 + 128) = w_; } while (0)
#define G_FRAGS(F, acur_, buf, ks) do { \
        _Pragma("unroll") for (int mi = 0; mi < 3; ++mi) F[mi] = *(const bf16x8*)(lds + ard[ks] + (acur_) + mi * 8192); \
        _Pragma("unroll") for (int ni = 0; ni < 2; ++ni) F[3 + ni] = *(const bf16x8*)(lds + brd[ks] + (buf) * 32768 + ni * 4096); } while (0)
#define G_MMA(F) do { \
        _Pragma("unroll") for (int ni = 0; ni < 2; ++ni) \
        _Pragma("unroll") for (int mi = 0; mi < 3; ++mi) acc[ni][mi] = __builtin_amdgcn_mfma_f32_32x32x16_bf16(F[3 + ni], F[mi], acc[ni][mi], 0, 0, 0); } while (0)
#define G_STEP(kt, SW, WAITN, DO_WRITE, DO_DMA, DO_LOAD) do { \
        BSET_WAIT(WAITN, SW); \
        __builtin_amdgcn_s_barrier(); \
        bf16x8 f0[5], f1[5]; \
        G_FRAGS(f0, a_cur, (kt) & 1, 0); \
        if (DO_WRITE) { G_WRITEB(SW, ((kt) + 1) & 1); } \
        __builtin_amdgcn_sched_barrier(0); \
        if (DO_DMA) { G_DMA_A((kt) + 2, a_nn); } \
        if (DO_LOAD) { G_LOADB(SW, (kt) + 3); } \
        __builtin_amdgcn_sched_barrier(0); \
        G_FRAGS(f1, a_cur, (kt) & 1, 1); __builtin_amdgcn_sched_barrier(0); G_MMA(f0); __builtin_amdgcn_sched_barrier(0); \
        G_FRAGS(f0, a_cur, (kt) & 1, 2); __builtin_amdgcn_sched_barrier(0); G_MMA(f1); __builtin_amdgcn_sched_barrier(0); \
        G_FRAGS(f1, a_cur, (kt) & 1, 3); __builtin_amdgcn_sched_barrier(0); G_MMA(f0); __builtin_amdgcn_sched_barrier(0); \
        G_MMA(f1); \
        a_cur = a_cur + A_SLOT; a_cur = a_cur >= 3 * A_SLOT ? 0 : a_cur; a_nn = a_nn + A_SLOT; a_nn = a_nn >= 3 * A_SLOT ? 0 : a_nn; } while (0)

    int a_cur = 0, a_nn = 2 * A_SLOT;
    G_DMA_A(0, 0); __builtin_amdgcn_sched_barrier(0);
    G_LOADB(s0, 0); __builtin_amdgcn_sched_barrier(0);
    G_DMA_A(1, A_SLOT); __builtin_amdgcn_sched_barrier(0);
    G_LOADB(s1, 1); __builtin_amdgcn_sched_barrier(0);
    BSET_WAIT(11, s0);
    G_WRITEB(s0, 0); __builtin_amdgcn_sched_barrier(0);
    G_LOADB(s0, 2); __builtin_amdgcn_sched_barrier(0);
    int kt = 0;
    G_STEP(kt, s1, 8, true, true, true); ++kt;
    for (; kt <= nk - 5; kt += 2) { G_STEP(kt, s0, 11, true, true, true); G_STEP(kt + 1, s1, 11, true, true, true); }
    G_STEP(kt, s0, 11, true, true, false); ++kt;
    G_STEP(kt, s1, 3, true, false, false); ++kt;
    G_STEP(kt, s0, 0, false, false, false);
#undef G_DMA_A
#undef G_LOADB
#undef G_WRITEB
#undef G_FRAGS
#undef G_MMA
#undef G_STEP
    epi(acc, wr, wc, r32, hi);
    __syncthreads();
}

struct EpiStoreBf16 {
    bf16_t* O; int ldo; int orow0; int nrows; int oc0, oc1;
    __device__ __forceinline__ void operator()(const f32x16 (&acc)[2][3], int wr, int wc, int r32, int hi) const {
#pragma unroll
        for (int mi = 0; mi < 3; ++mi) {
            const int tr = (2 * mi + wr) * 32 + r32;
            if (tr < nrows) {
#pragma unroll
                for (int ni = 0; ni < 2; ++ni) {
                    bf16_t* p = O + (size_t)(orow0 + tr) * ldo + (ni ? oc1 : oc0) + wc * 32 + 16 * hi;
                    u32x4 w0, w1; const f32x16& a = acc[ni][mi];
                    w0.x = cvtpk(a[0], a[1]); w0.y = cvtpk(a[2], a[3]); w0.z = cvtpk(a[4], a[5]); w0.w = cvtpk(a[6], a[7]);
                    w1.x = cvtpk(a[8], a[9]); w1.y = cvtpk(a[10], a[11]); w1.z = cvtpk(a[12], a[13]); w1.w = cvtpk(a[14], a[15]);
                    *(u32x4*)p = w0; *(u32x4*)(p + 8) = w1;
                }
            }
        }
    }
};


__device__ __forceinline__ void load_row32_f32(const float* src, int lane, float (&v)[32]) {
#pragma unroll
    for (int i = 0; i < 4; ++i) {
        const f32x4 a = *(const f32x4*)(src + i * 512 + lane * 8), b = *(const f32x4*)(src + i * 512 + lane * 8 + 4);
        v[i * 8 + 0] = a[0]; v[i * 8 + 1] = a[1]; v[i * 8 + 2] = a[2]; v[i * 8 + 3] = a[3];
        v[i * 8 + 4] = b[0]; v[i * 8 + 5] = b[1]; v[i * 8 + 6] = b[2]; v[i * 8 + 7] = b[3];
    }
}
__device__ __forceinline__ void load_row32_bf16(const bf16_t* src, int lane, float (&v)[32]) {
#pragma unroll
    for (int i = 0; i < 4; ++i) {
        const u32x4 a = *(const u32x4*)(src + i * 512 + lane * 8);
        v[i * 8 + 0] = bflo(a.x); v[i * 8 + 1] = bfhi(a.x); v[i * 8 + 2] = bflo(a.y); v[i * 8 + 3] = bfhi(a.y);
        v[i * 8 + 4] = bflo(a.z); v[i * 8 + 5] = bfhi(a.z); v[i * 8 + 6] = bflo(a.w); v[i * 8 + 7] = bfhi(a.w);
    }
}
__device__ __forceinline__ void ln_row32(float (&v)[32], const float* g, const float* bb, int lane) {
    float s = 0.f;
#pragma unroll
    for (int i = 0; i < 32; ++i) s += v[i];
    const float mu = wave_sum(s) * (1.f / DM);
    float q = 0.f;
#pragma unroll
    for (int i = 0; i < 32; ++i) { const float d = v[i] - mu; q += d * d; }
    const float rstd = rsqrtf(wave_sum(q) * (1.f / DM) + LN_EPS);
#pragma unroll
    for (int i = 0; i < 4; ++i) {
        const f32x4 g0 = *(const f32x4*)(g + i * 512 + lane * 8), g1 = *(const f32x4*)(g + i * 512 + lane * 8 + 4);
        const f32x4 b0 = *(const f32x4*)(bb + i * 512 + lane * 8), b1 = *(const f32x4*)(bb + i * 512 + lane * 8 + 4);
#pragma unroll
        for (int e = 0; e < 4; ++e) {
            v[i * 8 + e] = (v[i * 8 + e] - mu) * rstd * g0[e] + b0[e];
            v[i * 8 + 4 + e] = (v[i * 8 + 4 + e] - mu) * rstd * g1[e] + b1[e];
        }
    }
}
__device__ __forceinline__ void store_row32_bf16(bf16_t* dst, int lane, const float (&v)[32]) {
#pragma unroll
    for (int i = 0; i < 4; ++i) {
        u32x4 w; w.x = cvtpk(v[i * 8 + 0], v[i * 8 + 1]); w.y = cvtpk(v[i * 8 + 2], v[i * 8 + 3]); w.z = cvtpk(v[i * 8 + 4], v[i * 8 + 5]); w.w = cvtpk(v[i * 8 + 6], v[i * 8 + 7]);
        *(u32x4*)(dst + i * 512 + lane * 8) = w;
    }
}

__device__ __forceinline__ void phase_ln_in(PP p) {
    const int tid = tid_here(), lane = tid & 63, gw = blockIdx.x * 8 + (tid >> 6), nw = gridDim.x * 8;
    bf16_t* hb = (bf16_t*)(p->ws + WS_HB);
    for (int row = gw; row < TALL; row += nw) {
        const float* src = row < TREAL ? p->x + (size_t)row * DM : p->meta + (size_t)((row - TREAL) & 15) * DM;
        float v[32];
        load_row32_f32(src, lane, v);
        ln_row32(v, p->ln_in_g, p->ln_in_b, lane);
        store_row32_bf16(hb + (size_t)row * DM, lane, v);
    }
}

__device__ __forceinline__ void gates_item(unsigned char* lds, PP p, int layer, int item) {
    const int tid = tid_here(), lane = tid & 63, wid = tid >> 6;
    float* Wg = (float*)lds;
    const float* w = p->w_in + (size_t)layer * DM * N_IN + 3072;
    for (int i = tid; i < DM * 3; i += NTHREADS) { const int k = i / 3, c = i % 3; *(f32x4*)(Wg + k * 12 + c * 4) = *(const f32x4*)(w + (size_t)k * N_IN + c * 4); }
    __syncthreads();
    const bf16_t* hb = (const bf16_t*)(p->ws + WS_HB);
    float* gates = (float*)(p->ws + WS_GATES);
    for (int rr = 0; rr < 4; ++rr) {
        const int row = item * 32 + wid * 4 + rr;
        if (row < TALL) {
            float acc[12];
#pragma unroll
            for (int c = 0; c < 12; ++c) acc[c] = 0.f;
            const bf16_t* xr = hb + (size_t)row * DM;
            for (int i = 0; i < 32; ++i) {
                const int k = i * 64 + lane;
                const float xv = bf2f(xr[k]);
                const f32x4 w0 = *(const f32x4*)(Wg + k * 12), w1 = *(const f32x4*)(Wg + k * 12 + 4), w2 = *(const f32x4*)(Wg + k * 12 + 8);
#pragma unroll
                for (int e = 0; e < 4; ++e) { acc[e] += xv * w0[e]; acc[4 + e] += xv * w1[e]; acc[8 + e] += xv * w2[e]; }
            }
#pragma unroll
            for (int c = 0; c < 12; ++c) acc[c] = wave_sum(acc[c]);
            if (lane < 12) {
                float v = 0.f;
#pragma unroll
                for (int c = 0; c < 12; ++c) v = (lane == c) ? acc[c] : v;
                if (lane < 6) v += p->b_igate[layer * 6 + lane];
                else v = logsigmoidf_(v + p->b_fgate[layer * 6 + lane - 6]);
                gates[(size_t)row * 12 + lane] = v;
            }
        }
    }
    __syncthreads();
}

__device__ __forceinline__ void phase_conv(PP p, int layer) {
    const bf16_t* proj = (const bf16_t*)(p->ws + WS_PROJ);
    bf16_t* qkc = (bf16_t*)(p->ws + WS_QKC);
    const float* cw = p->conv_qk + (size_t)layer * 4 * 1536;
    const int total = TALL * 192;
    for (int idx = blockIdx.x * NTHREADS + tid_here(); idx < total; idx += gridDim.x * NTHREADS) {
        const int row = idx / 192, c0 = (idx % 192) * 8;
        int b, l;
        if (row < TREAL) { b = row >> 11; l = NMETA + (row & 2047); } else { b = (row - TREAL) >> 4; l = (row - TREAL) & 15; }
        float acc[8];
#pragma unroll
        for (int e = 0; e < 8; ++e) acc[e] = 0.f;
#pragma unroll
        for (int i = 0; i < 4; ++i) {
            const int ls = l - 3 + i;
            if (ls >= 0) {
                const u32x4 a = *(const u32x4*)(proj + (size_t)row_of(b, ls) * PROJ_W + PC_MLQK + c0);
                const f32x4 w0 = *(const f32x4*)(cw + i * 1536 + c0), w1 = *(const f32x4*)(cw + i * 1536 + c0 + 4);
                acc[0] += bflo(a.x) * w0[0]; acc[1] += bfhi(a.x) * w0[1]; acc[2] += bflo(a.y) * w0[2]; acc[3] += bfhi(a.y) * w0[3];
                acc[4] += bflo(a.z) * w1[0]; acc[5] += bfhi(a.z) * w1[1]; acc[6] += bflo(a.w) * w1[2]; acc[7] += bfhi(a.w) * w1[3];
            }
        }
        const float sc = c0 < 768 ? 0.08838834764831845f : 1.f;
#pragma unroll
        for (int e = 0; e < 8; ++e) acc[e] = siluf_(acc[e]) * sc;
        u32x4 w; w.x = cvtpk(acc[0], acc[1]); w.y = cvtpk(acc[2], acc[3]); w.z = cvtpk(acc[4], acc[5]); w.w = cvtpk(acc[6], acc[7]);
        *(u32x4*)(qkc + (size_t)row * 1536 + c0) = w;
    }
}

#define KSWZ(row, colB) ((row) * 256 + ((colB) ^ (((row) & 7) << 4)))
#define SBAR() __builtin_amdgcn_sched_barrier(0)
constexpr int MX_V = 0, MX_K = 16384, MX_C = 32768, MX_MQ = MX_C + 2112 * 4, MX_EM = MX_MQ + 1024, MX_WS = MX_EM + 1024, MX_END = MX_WS + 8 * 256;

__device__ __forceinline__ int v_st(int k, int c) { const int kk = (k & ~0xC) | ((k & 4) << 1) | ((k & 8) >> 1); return ((kk >> 3) * 4 + (c >> 5)) * 512 + ((kk & 7) * 32 + (c & 31)) * 2; }
__device__ __forceinline__ int v_rd_base(int lane) { return ((lane & 3) << 3) | (((lane >> 2) & 3) << 6) | (((lane >> 4) & 1) << 5) | (((lane >> 5) & 1) << 8); }
constexpr int v_rd_off(int d0, int ks, int half) { return d0 * 512 + ks * 4096 + half * 2048; }
template <int OFF> __device__ __forceinline__ s16x4 tr_read(int vb) {
    s16x4 r; asm volatile("ds_read_b64_tr_b16 %0, %1 offset:%2" : "=&v"(r) : "v"(vb), "i"(OFF) : "memory"); return r;
}
template <int D0> __device__ __forceinline__ void pv_one(f32x16& od, int vb, bf16x8 pa0, bf16x8 pa1, bf16x8 pa2, bf16x8 pa3) {
    const s16x4 l0 = tr_read<v_rd_off(D0, 0, 0)>(vb), h0 = tr_read<v_rd_off(D0, 0, 1)>(vb), l1 = tr_read<v_rd_off(D0, 1, 0)>(vb), h1 = tr_read<v_rd_off(D0, 1, 1)>(vb);
    const s16x4 l2 = tr_read<v_rd_off(D0, 2, 0)>(vb), h2 = tr_read<v_rd_off(D0, 2, 1)>(vb), l3 = tr_read<v_rd_off(D0, 3, 0)>(vb), h3 = tr_read<v_rd_off(D0, 3, 1)>(vb);
    asm volatile("s_waitcnt lgkmcnt(0)" ::: "memory"); SBAR();
#define PK(L, H) (bf16x8){L[0], L[1], L[2], L[3], H[0], H[1], H[2], H[3]}
    od = __builtin_amdgcn_mfma_f32_32x32x16_bf16(pa0, PK(l0, h0), od, 0, 0, 0);
    od = __builtin_amdgcn_mfma_f32_32x32x16_bf16(pa1, PK(l1, h1), od, 0, 0, 0);
    od = __builtin_amdgcn_mfma_f32_32x32x16_bf16(pa2, PK(l2, h2), od, 0, 0, 0);
    od = __builtin_amdgcn_mfma_f32_32x32x16_bf16(pa3, PK(l3, h3), od, 0, 0, 0);
#undef PK
}
__device__ __forceinline__ void qkt(f32x16& p0, f32x16& p1, const unsigned char* Ks, const bf16x8* qr, int r32, int hi) {
#pragma unroll
    for (int r = 0; r < 16; ++r) { p0[r] = 0.f; p1[r] = 0.f; }
#pragma unroll
    for (int d0 = 0; d0 < 8; ++d0) {
        const int cb = (d0 * 16 + hi * 8) * 2;
        const bf16x8 b0 = *(const bf16x8*)(Ks + KSWZ(r32, cb));
        const bf16x8 b1 = *(const bf16x8*)(Ks + KSWZ(32 + r32, cb));
        p0 = __builtin_amdgcn_mfma_f32_32x32x16_bf16(b0, qr[d0], p0, 0, 0, 0);
        p1 = __builtin_amdgcn_mfma_f32_32x32x16_bf16(b1, qr[d0], p1, 0, 0, 0);
    }
}
__device__ __forceinline__ float swap_sum(float v) {
    auto rr = __builtin_amdgcn_permlane32_swap(__float_as_uint(v), __float_as_uint(v), false, false);
    return __uint_as_float(rr[0]) + __uint_as_float(rr[1]);
}

#ifndef MIXER_INLINE
#define MIXER_INLINE __forceinline__
#endif
struct MixSrc { const bf16_t* Q; int ldq; const bf16_t* K; int ldk; const bf16_t* V; int ldv; };

template <int MODE>
__device__ MIXER_INLINE void mixer_item(unsigned char* lds, PP p, int layer, int b, int h, int j) {
    const int tid = tid_here(), wid = tid >> 6, lane = tid & 63, r32 = lane & 31, hi = lane >> 5;
    const bf16_t* proj = (const bf16_t*)(p->ws + WS_PROJ);
    const bf16_t* qkc = (const bf16_t*)(p->ws + WS_QKC);
    const float* gates = (const float*)(p->ws + WS_GATES);
    bf16_t* cat = (bf16_t*)(p->ws + WS_CAT);
    MixSrc S;
    if (MODE == 0) { S.Q = proj + PC_SBQ + h * HD; S.ldq = PROJ_W; S.K = proj + PC_SBK + h * HD; S.ldk = PROJ_W; S.V = proj + PC_SBV + h * HD; S.ldv = PROJ_W; }
    else { S.Q = qkc + h * HD; S.ldq = 1536; S.K = qkc + 768 + h * HD; S.ldk = 1536; S.V = proj + PC_MLV + h * HD; S.ldv = PROJ_W; }
    unsigned char* V_lds = lds + MX_V; unsigned char* K_lds = lds + MX_K;
    float* carr = (float*)(lds + MX_C); float* mqa = (float*)(lds + MX_MQ); float* ema = (float*)(lds + MX_EM);
    float* wsc = (float*)(lds + MX_WS) + wid * 64;

    const int s0 = 256 * j;
    const int qrow = b * SEQ + s0 + wid * 32 + r32;
    const int lq = NMETA + s0 + wid * 32 + r32;
    bf16x8 qr[8];
#pragma unroll
    for (int d0 = 0; d0 < 8; ++d0) qr[d0] = *(const bf16x8*)(S.Q + (size_t)qrow * S.ldq + d0 * 16 + hi * 8);

    float mq = 0.f;
    if (MODE == 1) {
        const int Lend = NMETA + s0 + 256;
        if (wid == 0) {
            float csum = 0.f, cmax = -3.0e38f;
            for (int base = 0; base < Lend; base += 64) {
                const int l = base + lane; const bool ok = l < Lend;
                const int row = row_of(b, ok ? l : 0);
                const float lf = ok ? gates[(size_t)row * 12 + 6 + h] : 0.f;
                const float li = ok ? gates[(size_t)row * 12 + h] : 0.f;
                float x = lf;
#pragma unroll
                for (int o = 1; o < 64; o <<= 1) { const float y = __shfl_up(x, o, 64); if (lane >= o) x += y; }
                const float cB = csum + x;
                const float c = ok ? li - cB : -3.0e38f;
                float mx = c;
#pragma unroll
                for (int o = 1; o < 64; o <<= 1) { const float y = __shfl_up(mx, o, 64); if (lane >= o) mx = fmaxf(mx, y); }
                const float pm = fmaxf(cmax, mx);
                if (ok) {
                    carr[l] = c;
                    if (l >= Lend - 256) { const float m0 = fmaxf(pm, 0.f); mqa[l - (Lend - 256)] = m0; ema[l - (Lend - 256)] = __expf(-(cB + m0)); }
                }
                csum = __shfl(cB, 63, 64); cmax = __shfl(pm, 63, 64);
            }
        }
        __syncthreads();
        mq = mqa[wid * 32 + r32];
    }

    const int ntiles = 4 * j + 5;
    const int last_tile = 1 + (s0 + 32 * wid + 31 - (MODE == 0 ? 1 : 0)) / 64;
    const int sr = tid >> 4, sc = (tid & 15) * 8;
    const int vst0 = v_st(sr, sc), vst1 = v_st(32 + sr, sc);
    const int vb0 = (int)(uintptr_t)(LAS unsigned char*)V_lds + v_rd_base(lane);
    bf16x8 vs0, vs1, ks0, ks1;
#define SLOAD(it) do { int r0_, r1_; \
        if ((it) == 0) { r0_ = TREAL + b * NMETA + (sr < NMETA ? sr : NMETA - 1); r1_ = TREAL + b * NMETA + NMETA - 1; } \
        else { r0_ = b * SEQ + 64 * ((it) - 1) + sr; r1_ = r0_ + 32; } \
        vs0 = *(const bf16x8*)(S.V + (size_t)r0_ * S.ldv + sc); vs1 = *(const bf16x8*)(S.V + (size_t)r1_ * S.ldv + sc); \
        ks0 = *(const bf16x8*)(S.K + (size_t)r0_ * S.ldk + sc); ks1 = *(const bf16x8*)(S.K + (size_t)r1_ * S.ldk + sc); } while (0)
#define SWRITE() do { *(bf16x8*)(V_lds + vst0) = vs0; *(bf16x8*)(V_lds + vst1) = vs1; \
        *(bf16x8*)(K_lds + KSWZ(sr, sc * 2)) = ks0; *(bf16x8*)(K_lds + KSWZ(32 + sr, sc * 2)) = ks1; } while (0)

    f32x16 o[4];
#pragma unroll
    for (int d = 0; d < 4; ++d)
#pragma unroll
        for (int r = 0; r < 16; ++r) o[d][r] = 0.f;
    float R = 0.f, den = 0.f;

    SLOAD(ntiles - 1);
    for (int it = ntiles - 1; it >= 0; --it) {
        __syncthreads();
        SWRITE();
        __syncthreads();
        if (it > 0) SLOAD(it - 1);
        if (it <= last_tile) {
            f32x16 p0, p1;
            qkt(p0, p1, K_lds, qr, r32, hi);
            const int lbase = it == 0 ? 0 : NMETA + 64 * (it - 1);
            int kmax = lq - lbase + (MODE == 1 ? 1 : 0);
            const int nvalid = it == 0 ? NMETA : 64;
            kmax = kmax < nvalid ? kmax : nvalid;
            if (MODE == 0) {
                float x[32];
#pragma unroll
                for (int r = 0; r < 16; ++r) {
                    const float z0 = crow(r, hi) < kmax ? p0[r] * 0.08838834764831845f : -1.0e30f;
                    const float z1 = 32 + crow(r, hi) < kmax ? p1[r] * 0.08838834764831845f : -1.0e30f;
                    p0[r] = z0; p1[r] = z1;
                    x[r] = -(fmaxf(z0, 0.f) + __logf(1.f + __expf(-fabsf(z0))));
                    x[16 + r] = -(fmaxf(z1, 0.f) + __logf(1.f + __expf(-fabsf(z1))));
                }
                float lo[8], up[8];
#pragma unroll
                for (int q = 0; q < 8; ++q) {
                    const float g = (x[4 * q] + x[4 * q + 1]) + (x[4 * q + 2] + x[4 * q + 3]);
                    auto rr = __builtin_amdgcn_permlane32_swap(__float_as_uint(g), __float_as_uint(g), false, false);
                    lo[q] = __uint_as_float(rr[0]); up[q] = __uint_as_float(rr[1]);
                }
                float run = R;
                float sown[8];
#pragma unroll
                for (int q = 7; q >= 0; --q) {
                    const float s_up = run; run += up[q];
                    const float s_lo = run; run += lo[q];
                    sown[q] = hi ? s_up : s_lo;
                }
                R = run;
#pragma unroll
                for (int q = 0; q < 8; ++q) {
                    const float t3 = x[4 * q + 3] + sown[q], t2 = x[4 * q + 2] + t3, t1 = x[4 * q + 1] + t2, t0 = x[4 * q] + t1;
                    x[4 * q] = t0; x[4 * q + 1] = t1; x[4 * q + 2] = t2; x[4 * q + 3] = t3;
                }
#pragma unroll
                for (int r = 0; r < 16; ++r) { p0[r] = __expf(p0[r] + x[r]); p1[r] = __expf(p1[r] + x[16 + r]); }
            } else {
#pragma unroll
                for (int q = 0; q < 8; ++q) {
                    const f32x4 c4 = *(const f32x4*)(carr + lbase + 8 * q + 4 * hi);
#pragma unroll
                    for (int i = 0; i < 4; ++i) {
                        const int kk = 8 * q + 4 * hi + i;
                        const float w = kk < kmax ? __expf(c4[i] - mq) : 0.f;
                        if (q < 4) { p0[4 * q + i] *= w; den += p0[4 * q + i]; } else { p1[4 * (q - 4) + i] *= w; den += p1[4 * (q - 4) + i]; }
                    }
                }
            }
            bf16x8 pa0, pa1, pa2, pa3;
#define PK4(P, BASE, OUT) do { unsigned a0 = cvtpk(P[BASE + 0], P[BASE + 1]), a1 = cvtpk(P[BASE + 2], P[BASE + 3]); \
        unsigned b0 = cvtpk(P[BASE + 4], P[BASE + 5]), b1 = cvtpk(P[BASE + 6], P[BASE + 7]); \
        auto r0 = __builtin_amdgcn_permlane32_swap(a0, b0, false, false); auto r1 = __builtin_amdgcn_permlane32_swap(a1, b1, false, false); \
        u32x4 w = {r0[0], r1[0], r0[1], r1[1]}; OUT = *reinterpret_cast<bf16x8*>(&w); } while (0)
            PK4(p0, 0, pa0); PK4(p0, 8, pa1); PK4(p1, 0, pa2); PK4(p1, 8, pa3);
#undef PK4
            pv_one<0>(o[0], vb0, pa0, pa1, pa2, pa3); pv_one<1>(o[1], vb0, pa0, pa1, pa2, pa3);
            pv_one<2>(o[2], vb0, pa0, pa1, pa2, pa3); pv_one<3>(o[3], vb0, pa0, pa1, pa2, pa3);
        }
    }
#undef SLOAD
#undef SWRITE
    float rden[16];
    if (MODE == 1) {
        den = swap_sum(den);
        if (hi == 0) wsc[r32] = den;
        asm volatile("s_waitcnt lgkmcnt(0)" ::: "memory");
#pragma unroll
        for (int r = 0; r < 16; ++r) { const int qi = crow(r, hi); rden[r] = 1.f / fmaxf(fabsf(wsc[qi]), ema[wid * 32 + qi]); }
#pragma unroll
        for (int d = 0; d < 4; ++d)
#pragma unroll
            for (int r = 0; r < 16; ++r) o[d][r] *= rden[r];
    }
    float ss[16];
#pragma unroll
    for (int r = 0; r < 16; ++r) ss[r] = o[0][r] * o[0][r] + o[1][r] * o[1][r] + o[2][r] * o[2][r] + o[3][r] * o[3][r];
#pragma unroll
    for (int off = 1; off < 32; off <<= 1)
#pragma unroll
        for (int r = 0; r < 16; ++r) ss[r] += __shfl_xor(ss[r], off, 64);
    const float* ng = (MODE == 0 ? p->sb_norm_g : p->ml_norm_g) + layer * 768 + h * HD;
    const int ccol = (MODE == 0 ? 768 : 0) + h * HD;
    float gv[4];
#pragma unroll
    for (int d = 0; d < 4; ++d) gv[d] = ng[d * 32 + r32];
#pragma unroll
    for (int r = 0; r < 16; ++r) {
        const float rn = rsqrtf(ss[r] * (1.f / HD) + RMS_EPS);
        const int orow = b * SEQ + s0 + wid * 32 + crow(r, hi);
#pragma unroll
        for (int d = 0; d < 4; ++d) {
            float v = o[d][r] * rn * gv[d];
            if (MODE == 1) v *= sigmoidf_(bf2f(proj[(size_t)orow * PROJ_W + PC_MLO + h * HD + d * 32 + r32]));
            cat[(size_t)orow * DM + ccol + d * 32 + r32] = f2bf(v);
        }
    }
    __syncthreads();
}

template <int MODE>
__device__ __forceinline__ void mixer_meta_item(unsigned char* lds, PP p, int layer, int b, int h) {
    const int tid = tid_here();
    const bf16_t* proj = (const bf16_t*)(p->ws + WS_PROJ);
    const bf16_t* qkc = (const bf16_t*)(p->ws + WS_QKC);
    const float* gates = (const float*)(p->ws + WS_GATES);
    bf16_t* cat = (bf16_t*)(p->ws + WS_CAT);
    MixSrc S;
    if (MODE == 0) { S.Q = proj + PC_SBQ + h * HD; S.ldq = PROJ_W; S.K = proj + PC_SBK + h * HD; S.ldk = PROJ_W; S.V = proj + PC_SBV + h * HD; S.ldv = PROJ_W; }
    else { S.Q = qkc + h * HD; S.ldq = 1536; S.K = qkc + 768 + h * HD; S.ldk = 1536; S.V = proj + PC_MLV + h * HD; S.ldv = PROJ_W; }
    float* Ss = (float*)lds; float* As = Ss + 256; float* dn = As + 256;
    const int row0 = TREAL + b * NMETA;
    if (tid < 256) {
        const int qi = tid >> 4, ki = tid & 15;
        const bf16_t* q = S.Q + (size_t)(row0 + qi) * S.ldq; const bf16_t* k = S.K + (size_t)(row0 + ki) * S.ldk;
        float s = 0.f;
        for (int d = 0; d < HD; ++d) s += bf2f(q[d]) * bf2f(k[d]);
        Ss[qi * 16 + ki] = s;
    }
    __syncthreads();
    if (tid < 16) {
        const int qi = tid;
        if (MODE == 0) {
            float R = 0.f;
            for (int jj = 15; jj >= 0; --jj) {
                float a = 0.f;
                if (jj < qi) {
                    const float z = Ss[qi * 16 + jj] * 0.08838834764831845f;
                    const float lk = -(fmaxf(z, 0.f) + __logf(1.f + __expf(-fabsf(z))));
                    a = __expf(z + lk + R); R += lk;
                }
                As[qi * 16 + jj] = a;
            }
            dn[qi] = 1.f;
        } else {
            float cB = 0.f, pm = -3.0e38f, cs[16];
            float cBq = 0.f;
            for (int jj = 0; jj < 16; ++jj) {
                cB += gates[(size_t)(row0 + jj) * 12 + 6 + h];
                cs[jj] = gates[(size_t)(row0 + jj) * 12 + h] - cB;
                if (jj <= qi) { pm = fmaxf(pm, cs[jj]); cBq = cB; }
            }
            const float m0 = fmaxf(pm, 0.f);
            float den = 0.f;
            for (int jj = 0; jj < 16; ++jj) {
                float a = 0.f;
                if (jj <= qi) { a = __expf(cs[jj] - m0) * Ss[qi * 16 + jj]; den += a; }
                As[qi * 16 + jj] = a;
            }
            dn[qi] = 1.f / fmaxf(fabsf(den), __expf(-(cBq + m0)));
        }
    }
    __syncthreads();
    {
        const int qi = tid >> 5, d4 = (tid & 31) * 4;
        float o[4] = {0.f, 0.f, 0.f, 0.f};
        for (int jj = 0; jj < 16; ++jj) {
            const float a = As[qi * 16 + jj];
            const u32x2 v = *(const u32x2*)(S.V + (size_t)(row0 + jj) * S.ldv + d4);
            o[0] += a * bflo(v.x); o[1] += a * bfhi(v.x); o[2] += a * bflo(v.y); o[3] += a * bfhi(v.y);
        }
        const float dd = dn[qi];
        float ss = 0.f;
#pragma unroll
        for (int e = 0; e < 4; ++e) { o[e] *= dd; ss += o[e] * o[e]; }
#pragma unroll
        for (int off = 1; off < 32; off <<= 1) ss += __shfl_xor(ss, off, 64);
        const float rn = rsqrtf(ss * (1.f / HD) + RMS_EPS);
        const float* ng = (MODE == 0 ? p->sb_norm_g : p->ml_norm_g) + layer * 768 + h * HD;
        const int ccol = (MODE == 0 ? 768 : 0) + h * HD;
        const int orow = row0 + qi;
#pragma unroll
        for (int e = 0; e < 4; ++e) {
            float v = o[e] * rn * ng[d4 + e];
            if (MODE == 1) v *= sigmoidf_(bf2f(proj[(size_t)orow * PROJ_W + PC_MLO + h * HD + d4 + e]));
            cat[(size_t)orow * DM + ccol + d4 + e] = f2bf(v);
        }
    }
    __syncthreads();
}

__device__ __forceinline__ void pool_item(unsigned char* lds, PP p, int layer, int b, int pb, int g) {
    const int tid = tid_here();
    const bf16_t* proj = (const bf16_t*)(p->ws + WS_PROJ);
    bf16_t* cat = (bf16_t*)(p->ws + WS_CAT);
    float* Wl = (float*)lds;
    float* Pl = Wl + 128 * 128;
    constexpr int PLD = 132;
    const int win = 2 << g;
    const float* W = p->pool_w + ((size_t)layer * 4 + g) * 128 * 128;
    for (int i = tid; i < 128 * 32; i += NTHREADS) *(f32x4*)(Wl + i * 4) = *(const f32x4*)(W + i * 4);
    const int l0 = pb * 128, nl = (LSEQ - l0) < 128 ? (LSEQ - l0) : 128;
    {
        const int c = tid & 127, ch = tid >> 7;
        const int lstart = l0 + ch * 32;
        float sum = 0.f;
        for (int t = 1; t < win; ++t) { const int ls = lstart - t; if (ls >= 0) sum += bf2f(proj[(size_t)row_of(b, ls) * PROJ_W + PC_POOL + g * 128 + c]); }
        for (int i = 0; i < 32; ++i) {
            const int l = lstart + i;
            float pv = 0.f;
            if (l < LSEQ) {
                const float u = bf2f(proj[(size_t)row_of(b, l) * PROJ_W + PC_POOL + g * 128 + c]);
                sum += u;
                const int cnt = (l + 1) < win ? (l + 1) : win;
                pv = bf2f(f2bf(sum / (float)cnt - u));
                const int lo = l - win + 1;
                if (lo >= 0) sum -= bf2f(proj[(size_t)row_of(b, lo) * PROJ_W + PC_POOL + g * 128 + c]);
            }
            Pl[(ch * 32 + i) * PLD + c] = pv;
        }
    }
    __syncthreads();
    {
        const int d = tid & 127, rg = tid >> 7;
        float acc[32];
#pragma unroll
        for (int i = 0; i < 32; ++i) acc[i] = 0.f;
        for (int c4 = 0; c4 < 128; c4 += 4) {
            const float w0 = Wl[(c4 + 0) * 128 + d], w1 = Wl[(c4 + 1) * 128 + d], w2 = Wl[(c4 + 2) * 128 + d], w3 = Wl[(c4 + 3) * 128 + d];
#pragma unroll
            for (int i = 0; i < 32; ++i) {
                const f32x4 pv = *(const f32x4*)(Pl + (rg * 32 + i) * PLD + c4);
                acc[i] += pv[0] * w0 + pv[1] * w1 + pv[2] * w2 + pv[3] * w3;
            }
        }
        const float sc = p->pool_scale[layer * 512 + g * 128 + d];
#pragma unroll
        for (int i = 0; i < 32; ++i) {
            const int li = rg * 32 + i;
            if (li < nl) cat[(size_t)row_of(b, l0 + li) * DM + 1536 + g * 128 + d] = f2bf(acc[i] * sc);
        }
    }
    __syncthreads();
}

struct EpiResid {
    const bf16_t* H; bf16_t* O; int orow0; int nrows; int oc0, oc1;
    __device__ __forceinline__ void operator()(const f32x16 (&acc)[2][3], int wr, int wc, int r32, int hi) const {
#pragma unroll
        for (int mi = 0; mi < 3; ++mi) {
            const int tr = (2 * mi + wr) * 32 + r32;
            if (tr < nrows) {
#pragma unroll
                for (int ni = 0; ni < 2; ++ni) {
                    const size_t o = (size_t)(orow0 + tr) * DM + (ni ? oc1 : oc0) + wc * 32 + 16 * hi;
                    const u32x4 h0 = *(const u32x4*)(H + o), h1 = *(const u32x4*)(H + o + 8);
                    const f32x16& a = acc[ni][mi];
                    u32x4 w0, w1;
                    w0.x = cvtpk(DN_ALPHA * bflo(h0.x) + a[0], DN_ALPHA * bfhi(h0.x) + a[1]); w0.y = cvtpk(DN_ALPHA * bflo(h0.y) + a[2], DN_ALPHA * bfhi(h0.y) + a[3]);
                    w0.z = cvtpk(DN_ALPHA * bflo(h0.z) + a[4], DN_ALPHA * bfhi(h0.z) + a[5]); w0.w = cvtpk(DN_ALPHA * bflo(h0.w) + a[6], DN_ALPHA * bfhi(h0.w) + a[7]);
                    w1.x = cvtpk(DN_ALPHA * bflo(h1.x) + a[8], DN_ALPHA * bfhi(h1.x) + a[9]); w1.y = cvtpk(DN_ALPHA * bflo(h1.y) + a[10], DN_ALPHA * bfhi(h1.y) + a[11]);
                    w1.z = cvtpk(DN_ALPHA * bflo(h1.z) + a[12], DN_ALPHA * bfhi(h1.z) + a[13]); w1.w = cvtpk(DN_ALPHA * bflo(h1.w) + a[14], DN_ALPHA * bfhi(h1.w) + a[15]);
                    *(u32x4*)(O + o) = w0; *(u32x4*)(O + o + 8) = w1;
                }
            }
        }
    }
};

constexpr int RT_W = 0, RT_X = 32768, RT_ST = RT_X + 32 * 132 * 4, RT_HIST = RT_ST + 256, RT_BASE = RT_HIST + 256, RT_END = RT_BASE + 256;
__device__ __forceinline__ void router_item(unsigned char* lds, PP p, int layer, int item, int M) {
    const int tid = tid_here(), lane = tid & 63, wid = tid >> 6;
    const bf16_t* S1 = (const bf16_t*)(p->ws + WS_S1);
    bf16_t* H1 = (bf16_t*)(p->ws + WS_H1);
    float* Wc = (float*)(lds + RT_W);
    float* Xc = (float*)(lds + RT_X);
    float* st = (float*)(lds + RT_ST);
    int* hist = (int*)(lds + RT_HIST); int* basev = (int*)(lds + RT_BASE);
    const float* g1 = p->ln1_g + layer * DM; const float* b1 = p->ln1_b + layer * DM;
    if (tid < 64) hist[tid] = 0;
    for (int rr = 0; rr < 4; ++rr) {
        const int lr = wid * 4 + rr, row = item * 32 + lr;
        if (row < M) {
            float v[32];
            load_row32_bf16(S1 + (size_t)row * DM, lane, v);
            float s = 0.f;
#pragma unroll
            for (int i = 0; i < 32; ++i) s += v[i];
            const float mu = wave_sum(s) * (1.f / DM);
            float q = 0.f;
#pragma unroll
            for (int i = 0; i < 32; ++i) { const float d = v[i] - mu; q += d * d; }
            const float rstd = rsqrtf(wave_sum(q) * (1.f / DM) + LN_EPS);
            if (lane == 0) { st[lr * 2] = mu; st[lr * 2 + 1] = rstd; }
#pragma unroll
            for (int i = 0; i < 4; ++i) {
                const f32x4 ga = *(const f32x4*)(g1 + i * 512 + lane * 8), gb = *(const f32x4*)(g1 + i * 512 + lane * 8 + 4);
                const f32x4 ba = *(const f32x4*)(b1 + i * 512 + lane * 8), bb = *(const f32x4*)(b1 + i * 512 + lane * 8 + 4);
#pragma unroll
                for (int e = 0; e < 4; ++e) { v[i * 8 + e] = (v[i * 8 + e] - mu) * rstd * ga[e] + ba[e]; v[i * 8 + 4 + e] = (v[i * 8 + 4 + e] - mu) * rstd * gb[e] + bb[e]; }
            }
            store_row32_bf16(H1 + (size_t)row * DM, lane, v);
        } else if (lane == 0) { st[lr * 2] = 0.f; st[lr * 2 + 1] = 0.f; }
    }
    __syncthreads();
    float lg[4] = {0.f, 0.f, 0.f, 0.f};
    const float* rw = p->router_w + (size_t)layer * DM * NEXP;
    for (int kc = 0; kc < 16; ++kc) {
        for (int i = tid; i < 128 * 16; i += NTHREADS) *(f32x4*)(Wc + i * 4) = *(const f32x4*)(rw + (size_t)kc * 128 * 64 + i * 4);
        {
            const int lr = tid >> 4, k8 = (tid & 15) * 8, row = item * 32 + lr;
            const int rowc = row < M ? row : M - 1;
            const u32x4 a = *(const u32x4*)(S1 + (size_t)rowc * DM + kc * 128 + k8);
            const float mu = st[lr * 2], rstd = st[lr * 2 + 1];
            const f32x4 ga = *(const f32x4*)(g1 + kc * 128 + k8), gb = *(const f32x4*)(g1 + kc * 128 + k8 + 4);
            const f32x4 ba = *(const f32x4*)(b1 + kc * 128 + k8), bb = *(const f32x4*)(b1 + kc * 128 + k8 + 4);
            f32x4 x0, x1;
            x0[0] = (bflo(a.x) - mu) * rstd * ga[0] + ba[0]; x0[1] = (bfhi(a.x) - mu) * rstd * ga[1] + ba[1];
            x0[2] = (bflo(a.y) - mu) * rstd * ga[2] + ba[2]; x0[3] = (bfhi(a.y) - mu) * rstd * ga[3] + ba[3];
            x1[0] = (bflo(a.z) - mu) * rstd * gb[0] + bb[0]; x1[1] = (bfhi(a.z) - mu) * rstd * gb[1] + bb[1];
            x1[2] = (bflo(a.w) - mu) * rstd * gb[2] + bb[2]; x1[3] = (bfhi(a.w) - mu) * rstd * gb[3] + bb[3];
            *(f32x4*)(Xc + lr * 132 + k8) = x0; *(f32x4*)(Xc + lr * 132 + k8 + 4) = x1;
        }
        __syncthreads();
        for (int k4 = 0; k4 < 128; k4 += 4) {
            const float w0 = Wc[(k4 + 0) * 64 + lane], w1 = Wc[(k4 + 1) * 64 + lane], w2 = Wc[(k4 + 2) * 64 + lane], w3 = Wc[(k4 + 3) * 64 + lane];
#pragma unroll
            for (int rr = 0; rr < 4; ++rr) {
                const f32x4 xv = *(const f32x4*)(Xc + (wid * 4 + rr) * 132 + k4);
                lg[rr] += xv[0] * w0 + xv[1] * w1 + xv[2] * w2 + xv[3] * w3;
            }
        }
        __syncthreads();
    }
    const float bias = p->router_bias[layer * NEXP + lane];
    int my_e[4], my_rank[4]; float my_g[4];
    for (int rr = 0; rr < 4; ++rr) {
        const int row = item * 32 + wid * 4 + rr;
        const float score = 1.f / (1.f + __expf(-lg[rr]));
        float sel = score + bias;
        int e_k = 0; float s_k = 0.f; float ssum = 0.f;
        for (int k = 0; k < TOPK; ++k) {
            const float m = wave_max(sel);
            const unsigned long long bal = __ballot(sel == m);
            const int idx = __ffsll((long long)bal) - 1;
            const float sc = __shfl(score, idx, 64);
            ssum += sc;
            if (lane == k) { e_k = idx; s_k = sc; }
            if (lane == idx) sel = -3.0e38f;
        }
        my_e[rr] = e_k; my_g[rr] = s_k / ssum * ROUTED_SCALE; my_rank[rr] = 0;
        if (lane < TOPK && row < M) my_rank[rr] = atomicAdd(&hist[e_k], 1);
    }
    __syncthreads();
    int* cnt = (int*)(p->ws + WS_CTL + CTL_CNT) + layer * 64;
    if (tid < 64) basev[tid] = atomicAdd(&cnt[tid], hist[tid]);
    __syncthreads();
    int* asg_e = (int*)(p->ws + WS_ASGE); int* asg_s = (int*)(p->ws + WS_ASGS);
    int* tokl = (int*)(p->ws + WS_TOKL); float* gatel = (float*)(p->ws + WS_GATEL);
    for (int rr = 0; rr < 4; ++rr) {
        const int row = item * 32 + wid * 4 + rr;
        if (lane < TOPK && row < M) {
            const int e = my_e[rr], slot = basev[e] + my_rank[rr];
            asg_e[row * 8 + lane] = e; asg_s[row * 8 + lane] = slot;
            tokl[(size_t)e * TALL + slot] = row; gatel[(size_t)e * TALL + slot] = my_g[rr];
        }
    }
    __syncthreads();
}

constexpr int MS_BASE = G_LDS_END;
constexpr int MS_CNT = MS_BASE, MS_OFF = MS_BASE + 66 * 4, MS_TP = MS_BASE + 132 * 4, MS_END = MS_BASE + 200 * 4;
__device__ __forceinline__ void moe_tables(unsigned char* lds, PP p, int layer, int M) {
    int* c = (int*)(lds + MS_CNT); int* o = (int*)(lds + MS_OFF); int* tp = (int*)(lds + MS_TP);
    if (threadIdx.x == 0) {
        const int* cnt = (const int*)(p->ws + WS_CTL + CTL_CNT) + layer * 64;
        int acc = 0, t = 0;
        for (int e = 0; e < 64; ++e) { const int n = __hip_atomic_load(&cnt[e], __ATOMIC_RELAXED, __HIP_MEMORY_SCOPE_AGENT); c[e] = n; o[e] = acc; tp[e] = t; acc += n; t += (n + TM - 1) / TM; }
        c[64] = M; o[64] = SH_BASE; tp[64] = t; t += (M + TM - 1) / TM; tp[65] = t;
    }
    __syncthreads();
}
__device__ __forceinline__ void moe_decode(const unsigned char* lds, int id, int ntn, int& e, int& nt, int& m) {
    const int* tp = (const int*)(lds + MS_TP);
    int lo = 0;
    for (int k = 0; k < 65; ++k) if (tp[k + 1] * ntn <= id) lo = k + 1;
    e = lo; const int rem = id - tp[e] * ntn, nm = tp[e + 1] - tp[e];
    nt = rem / nm; m = rem % nm;
}

struct EpiSwiglu {
    bf16_t* O; int orow0; int nrows; int oc;
    __device__ __forceinline__ void operator()(const f32x16 (&acc)[2][3], int wr, int wc, int r32, int hi) const {
#pragma unroll
        for (int mi = 0; mi < 3; ++mi) {
            const int tr = (2 * mi + wr) * 32 + r32;
            if (tr < nrows) {
                float v[16];
#pragma unroll
                for (int r = 0; r < 16; ++r) { const float gte = acc[0][mi][r]; v[r] = gte / (1.f + __expf(-gte)) * acc[1][mi][r]; }
                u32x4 w0, w1;
                w0.x = cvtpk(v[0], v[1]); w0.y = cvtpk(v[2], v[3]); w0.z = cvtpk(v[4], v[5]); w0.w = cvtpk(v[6], v[7]);
                w1.x = cvtpk(v[8], v[9]); w1.y = cvtpk(v[10], v[11]); w1.z = cvtpk(v[12], v[13]); w1.w = cvtpk(v[14], v[15]);
                bf16_t* q = O + (size_t)(orow0 + tr) * DEXP + oc + wc * 32 + 16 * hi;
                *(u32x4*)q = w0; *(u32x4*)(q + 8) = w1;
            }
        }
    }
};
struct EpiScaleStore {
    bf16_t* O; int orow0; int nrows; int oc0, oc1; const float* gate;
    __device__ __forceinline__ void operator()(const f32x16 (&acc)[2][3], int wr, int wc, int r32, int hi) const {
#pragma unroll
        for (int mi = 0; mi < 3; ++mi) {
            const int tr = (2 * mi + wr) * 32 + r32;
            if (tr < nrows) {
                const float gsc = gate ? gate[tr] : 1.f;
#pragma unroll
                for (int ni = 0; ni < 2; ++ni) {
                    const f32x16& a = acc[ni][mi];
                    u32x4 w0, w1;
                    w0.x = cvtpk(a[0] * gsc, a[1] * gsc); w0.y = cvtpk(a[2] * gsc, a[3] * gsc); w0.z = cvtpk(a[4] * gsc, a[5] * gsc); w0.w = cvtpk(a[6] * gsc, a[7] * gsc);
                    w1.x = cvtpk(a[8] * gsc, a[9] * gsc); w1.y = cvtpk(a[10] * gsc, a[11] * gsc); w1.z = cvtpk(a[12] * gsc, a[13] * gsc); w1.w = cvtpk(a[14] * gsc, a[15] * gsc);
                    bf16_t* q = O + (size_t)(orow0 + tr) * DM + (ni ? oc1 : oc0) + wc * 32 + 16 * hi;
                    *(u32x4*)q = w0; *(u32x4*)(q + 8) = w1;
                }
            }
        }
    }
};

__device__ __forceinline__ void moe_gemm1_item(unsigned char* lds, PP p, int layer, int id) {
    int e, nt, m; moe_decode(lds, id, 4, e, nt, m);
    const int* c = (const int*)(lds + MS_CNT); const int* o = (const int*)(lds + MS_OFF);
    const int cnt = c[e], nvalid = (cnt - m * TM) < TM ? (cnt - m * TM) : TM;
    int* rows = (int*)(lds + G_ROWS);
    if (threadIdx.x < TM) {
        const int slot = m * TM + ((int)threadIdx.x < nvalid ? (int)threadIdx.x : nvalid - 1);
        rows[threadIdx.x] = e < 64 ? ((const int*)(p->ws + WS_TOKL))[(size_t)e * TALL + slot] : slot;
    }
    __syncthreads();
    const float* W = e < 64 ? p->exp_w13 + ((size_t)layer * 64 + e) * DM * 1024 : p->sh_w13 + (size_t)layer * DM * 1024;
    GemmOp g{(const bf16_t*)(p->ws + WS_H1), DM, W, 1024, nt * 128, 512 + nt * 128, DM};
    EpiSwiglu ep{(bf16_t*)(p->ws + WS_ACT), o[e] + m * TM, nvalid, nt * 128};
    gemm_tile(lds, g, ep);
}
__device__ __forceinline__ void moe_gemm2_item(unsigned char* lds, PP p, int layer, int id) {
    int e, nt, m; moe_decode(lds, id, 8, e, nt, m);
    const int* c = (const int*)(lds + MS_CNT); const int* o = (const int*)(lds + MS_OFF);
    const int cnt = c[e], nvalid = (cnt - m * TM) < TM ? (cnt - m * TM) : TM;
    const int pos0 = o[e] + m * TM;
    int* rows = (int*)(lds + G_ROWS);
    if (threadIdx.x < TM) rows[threadIdx.x] = pos0 + ((int)threadIdx.x < nvalid ? (int)threadIdx.x : nvalid - 1);
    __syncthreads();
    const float* W = e < 64 ? p->exp_w2 + ((size_t)layer * 64 + e) * DEXP * DM : p->sh_w2 + (size_t)layer * DEXP * DM;
    GemmOp g{(const bf16_t*)(p->ws + WS_ACT), DEXP, W, DM, nt * 256, nt * 256 + 128, DEXP};
    EpiScaleStore ep{(bf16_t*)(p->ws + WS_Y), pos0, nvalid, nt * 256, nt * 256 + 128, e < 64 ? (const float*)(p->ws + WS_GATEL) + (size_t)e * TALL + m * TM : nullptr};
    gemm_tile(lds, g, ep);
}

__device__ __forceinline__ void phase_combine(unsigned char* lds, PP p, int layer, int M) {
    const int tid = tid_here(), lane = tid & 63, gw = blockIdx.x * 8 + (tid >> 6), nw = gridDim.x * 8;
    const int* o = (const int*)(lds + MS_OFF);
    const bf16_t* H1 = (const bf16_t*)(p->ws + WS_H1); const bf16_t* Y = (const bf16_t*)(p->ws + WS_Y);
    const int* asg_e = (const int*)(p->ws + WS_ASGE); const int* asg_s = (const int*)(p->ws + WS_ASGS);
    bf16_t* hb = (bf16_t*)(p->ws + WS_HB);
    for (int row = gw; row < M; row += nw) {
        float v[32], t[32];
        load_row32_bf16(H1 + (size_t)row * DM, lane, v);
#pragma unroll
        for (int i = 0; i < 32; ++i) v[i] *= DN_ALPHA;
        load_row32_bf16(Y + (size_t)(SH_BASE + row) * DM, lane, t);
#pragma unroll
        for (int i = 0; i < 32; ++i) v[i] += t[i];
        for (int k = 0; k < TOPK; ++k) {
            const int e = asg_e[row * 8 + k], s = asg_s[row * 8 + k];
            load_row32_bf16(Y + (size_t)(o[e] + s) * DM, lane, t);
#pragma unroll
            for (int i = 0; i < 32; ++i) v[i] += t[i];
        }
        ln_row32(v, p->ln2_g + layer * DM, p->ln2_b + layer * DM, lane);
        if (layer == DEPTH - 1) {
#pragma unroll
            for (int i = 0; i < 4; ++i) {
                float* dst = p->out + (size_t)row * DM + i * 512 + lane * 8;
                *(f32x4*)dst = (f32x4){v[i * 8], v[i * 8 + 1], v[i * 8 + 2], v[i * 8 + 3]};
                *(f32x4*)(dst + 4) = (f32x4){v[i * 8 + 4], v[i * 8 + 5], v[i * 8 + 6], v[i * 8 + 7]};
            }
        } else {
            store_row32_bf16(hb + (size_t)row * DM, lane, v);
        }
    }
}

#define XB_TMO      128
#define XB_XCNT(j)  (256  + 64 * (j))
#define XB_XSUB(j)  (1280 + 64 * (j))
#define XB_XGEN(j)  (2304 + 64 * (j))
#define XB_TOP      3328
#define XB_TOPGEN   3392
#define XCD_BAR_WORDS 3456
#define XB_SPIN_CAP (1u << 18)

__device__ __forceinline__ unsigned xb_ld(unsigned* p)              { return __hip_atomic_load(p, __ATOMIC_RELAXED, __HIP_MEMORY_SCOPE_AGENT); }
__device__ __forceinline__ unsigned xb_add(unsigned* p, unsigned v) { return __hip_atomic_fetch_add(p, v, __ATOMIC_RELAXED, __HIP_MEMORY_SCOPE_AGENT); }
__device__ __forceinline__ unsigned xb_xcc_id() { return (unsigned)__builtin_amdgcn_s_getreg((3 << 11) | 20) & 0xFu; }
#define XB_SPIN(cond, bar) do { unsigned _sp = 0; while (cond) { __builtin_amdgcn_s_sleep(1); \
    if ((++_sp & 255u) == 0u) { if (xb_ld(&(bar)[XB_TMO])) break; if (_sp > XB_SPIN_CAP) { atomicAdd(&(bar)[XB_TMO], 1u); break; } } } } while (0)

struct XcdBarrier { unsigned* bar; unsigned x; volatile LAS unsigned* st; };

__device__ __forceinline__ XcdBarrier xcd_barrier_post(unsigned* bar, volatile LAS unsigned* st) {
    XcdBarrier b; b.bar = bar; b.x = xb_xcc_id(); b.st = st;
    if (threadIdx.x == 0) (void)xb_add(&bar[XB_XCNT(b.x)], 1u);
    return b;
}
__device__ __forceinline__ void xcd_barrier_complete(unsigned* bar, unsigned x, unsigned& nloc, unsigned& nx) {
    const unsigned G = gridDim.x * gridDim.y * gridDim.z;
    unsigned sum, cnt, mine, sp = 0u;
    for (;;) {
        sum = 0u; cnt = 0u; mine = 0u;
#pragma unroll
        for (unsigned j = 0; j < 16; ++j) { const unsigned c = xb_ld(&bar[XB_XCNT(j)]); sum += c; cnt += (c > 0u) ? 1u : 0u; mine = (j == x) ? c : mine; }
        if (sum == G) break;
        __builtin_amdgcn_s_sleep(1);
        if ((++sp & 255u) == 0u) { if (xb_ld(&bar[XB_TMO])) break; if (sp > XB_SPIN_CAP) { atomicAdd(&bar[XB_TMO], 1u); break; } }
    }
    nloc = mine > 0u ? mine : 1u; nx = cnt > 0u ? cnt : 1u;
}
__device__ __forceinline__ void xcd_barrier(const XcdBarrier& b) {
    asm volatile("s_waitcnt vmcnt(0)" ::: "memory");
    __syncthreads();
    if (threadIdx.x == 0) {
        unsigned* bar = b.bar;
        __builtin_amdgcn_s_waitcnt(0);
        unsigned nloc = b.st[0], nx = b.st[1];
        if (nloc == 0u) { xcd_barrier_complete(bar, b.x, nloc, nx); b.st[0] = nloc; b.st[1] = nx; }
        const unsigned old = xb_add(&bar[XB_XSUB(b.x)], 1u);
        const unsigned gen = old / nloc;
        if (old + 1u == (gen + 1u) * nloc) {
            __builtin_amdgcn_fence(__ATOMIC_RELEASE, "agent");
            asm volatile("s_waitcnt vmcnt(0)" ::: "memory");
            const unsigned og = xb_add(&bar[XB_TOP], 1u);
            const unsigned tg = og / nx;
            if (og + 1u == (tg + 1u) * nx) xb_add(&bar[XB_TOPGEN], 1u);
            else XB_SPIN(xb_ld(&bar[XB_TOPGEN]) == tg, bar);
            __builtin_amdgcn_fence(__ATOMIC_ACQUIRE, "agent");
            xb_add(&bar[XB_XGEN(b.x)], 1u);
            asm volatile("s_waitcnt vmcnt(0)" ::: "memory");
        } else {
            XB_SPIN(xb_ld(&bar[XB_XGEN(b.x)]) == gen, bar);
            __builtin_amdgcn_fence(__ATOMIC_ACQUIRE, "agent");
            asm volatile("s_waitcnt vmcnt(0)" ::: "memory");
        }
    }
    __syncthreads();
}

constexpr int NPHASES = 1 + 8 * DEPTH;
constexpr int XBW_OFF = LDS_BYTES - 16;

__global__ void __launch_bounds__(NTHREADS, 2) fwd_kernel(Params p_by_value) {
    extern __shared__ __attribute__((aligned(16))) unsigned char lds[];
    const int tid = threadIdx.x, G = gridDim.x, bx = blockIdx.x;
    const int vcu = (G % 8 == 0) ? (bx % 8) * (G / 8) + bx / 8 : bx;
    PP p = get_params();
    const int lo = p->ph_lo, hi = p->ph_hi;
    if (tid == 0) *(uint4*)(lds + XBW_OFF) = make_uint4(0u, 0u, 0u, 0u);
    __syncthreads();
    XcdBarrier bar; bar.bar = (unsigned*)(p->ws + WS_CTL); bar.x = 0; bar.st = (volatile LAS unsigned*)(LAS unsigned char*)(lds + XBW_OFF);
    if (hi - lo > 1) bar = xcd_barrier_post((unsigned*)(p->ws + WS_CTL), (volatile LAS unsigned*)(LAS unsigned char*)(lds + XBW_OFF));
#ifndef PHMASK
#define PHMASK 0x1FF
#endif
#define IN(k) (lo <= (k) && (k) < hi)
#define EN(b) (((PHMASK) >> (b)) & 1)
#ifndef REPMASK
#define REPMASK 0
#endif
#define REPEAT(k) for (int rep_ = 0; rep_ <= (((REPMASK) >> (k)) & 1); ++rep_)
#define REPBAR() do { if (rep_) xcd_barrier(bar); } while (0)
#ifndef MXMASK
#define MXMASK 0x3F
#endif
#define MXEN(b) (((MXMASK) >> (b)) & 1)
#define SEAM(k) do { if (IN((k) + 1)) xcd_barrier(bar); } while (0)

    if (EN(8) && IN(0)) { p = get_params(); phase_ln_in(p); SEAM(0); }

    for (int layer = 0; layer < DEPTH; ++layer) {
        const int pb = 1 + 8 * layer;
        const int M = (layer == DEPTH - 1) ? TREAL : TALL;
        if (EN(0) && IN(pb + 0)) REPEAT(0) { p = get_params(); REPBAR();
            int* rows = (int*)(lds + G_ROWS);
            for (int id = vcu; id < 989; id += G) {
                int mt, nt;
                if (id < 920) { const int grp = id / 184, r = id % 184; nt = r >> 3; mt = grp * 8 + (r & 7); } else { const int r = id - 920; nt = r / 3; mt = 40 + r % 3; }
                if (tid < TM) rows[tid] = mt * TM + tid;
                __syncthreads();
                const int wcol = nt < 12 ? nt * 256 : 3084 + (nt - 12) * 256;
                GemmOp g{(const bf16_t*)(p->ws + WS_HB), DM, p->w_in + (size_t)layer * DM * N_IN, N_IN, wcol, wcol + 128, DM};
                EpiStoreBf16 e{(bf16_t*)(p->ws + WS_PROJ), PROJ_W, mt * TM, TM, nt * 256, nt * 256 + 128};
                gemm_tile(lds, g, e);
            }
            for (int id = G - 1 - vcu; id < 258 && MXEN(5); id += G) gates_item(lds, p, layer, id);
            SEAM(pb + 0);
        }
        if (EN(1) && IN(pb + 1)) REPEAT(1) { p = get_params(); REPBAR(); phase_conv(p, layer); SEAM(pb + 1); }
        if (EN(2) && IN(pb + 2)) REPEAT(2) { p = get_params(); REPBAR();
            int r = 0;
            for (int base = 0; base < 704; base += G, ++r) {
                const int id = base + ((r & 1) ? (G - 1 - bx) : bx);
                if (id < 704) {
                    if (id < 384) {
                        const int j = 7 - id / 48, rem = id % 48, mode = rem / 24, bh = rem % 24;
                        if (MXEN(0) && mode == 0) mixer_item<0>(lds, p, layer, bh / 6, bh % 6, j); else if (MXEN(1)) mixer_item<1>(lds, p, layer, bh / 6, bh % 6, j);
                    } else if (id < 656) {
                        const int q = id - 384, g = q & 3, rb = q >> 2;
                        if (MXEN(2)) pool_item(lds, p, layer, rb / 17, rb % 17, g);
                    } else {
                        const int q = id - 656, mode = q / 24, bh = q % 24;
                        if (MXEN(3) && mode == 0) mixer_meta_item<0>(lds, p, layer, bh / 6, bh % 6); else if (MXEN(4)) mixer_meta_item<1>(lds, p, layer, bh / 6, bh % 6);
                    }
                }
            }
            SEAM(pb + 2);
        }
        if (EN(3) && IN(pb + 3)) REPEAT(3) { p = get_params(); REPBAR();
            int* rows = (int*)(lds + G_ROWS);
            const int ntile = ((M + TM - 1) / TM) * 8;
            for (int id = vcu; id < ntile; id += G) {
                const int mt = id >> 3, nt = id & 7;
                if (tid < TM) { const int r = mt * TM + tid; rows[tid] = r < M ? r : M - 1; }
                __syncthreads();
                GemmOp g{(const bf16_t*)(p->ws + WS_CAT), DM, p->w_out + (size_t)layer * DM * DM, DM, nt * 256, nt * 256 + 128, DM};
                EpiResid e{(const bf16_t*)(p->ws + WS_HB), (bf16_t*)(p->ws + WS_S1), mt * TM, M - mt * TM, nt * 256, nt * 256 + 128};
                gemm_tile(lds, g, e);
            }
            SEAM(pb + 3);
        }
        if (EN(4) && IN(pb + 4)) REPEAT(4) { p = get_params(); REPBAR();
            const int nit = (M + 31) >> 5;
            for (int id = bx; id < nit; id += G) router_item(lds, p, layer, id, M);
            SEAM(pb + 4);
        }
        if (EN(5) && IN(pb + 5)) REPEAT(5) { p = get_params(); REPBAR();
            moe_tables(lds, p, layer, M);
            const int nit = ((const int*)(lds + MS_TP))[65] * 4;
            for (int id = vcu; id < nit; id += G) moe_gemm1_item(lds, p, layer, id);
            SEAM(pb + 5);
        }
        if (EN(6) && IN(pb + 6)) REPEAT(6) { p = get_params(); REPBAR();
            moe_tables(lds, p, layer, M);
            const int nit = ((const int*)(lds + MS_TP))[65] * 8;
            for (int id = vcu; id < nit; id += G) moe_gemm2_item(lds, p, layer, id);
            SEAM(pb + 6);
        }
        if (EN(7) && IN(pb + 7)) REPEAT(7) { p = get_params(); REPBAR();
            moe_tables(lds, p, layer, M);
            phase_combine(lds, p, layer, M);
            __syncthreads();
            SEAM(pb + 7);
        }
    }
#undef IN
#undef SEAM
}

#ifndef N_LAUNCH_MODE
#define N_LAUNCH_MODE 1
#endif
extern "C" void kernel_launch(void* const* d_in, const int* in_sizes, int n_in, void* d_out, int out_size, void* d_ws, size_t ws_size, hipStream_t stream) {
    static int grid = 0;
    if (grid == 0) {
        if (n_in != 23 || ws_size < WS_END) { fprintf(stderr, "kernel_launch: unexpected n_in %d or ws %zu < %zu\n", n_in, ws_size, (size_t)WS_END); grid = -1; return; }
        int dev = 0, cus = 0, per_cu = 0;
        if (hipGetDevice(&dev) != hipSuccess || hipDeviceGetAttribute(&cus, hipDeviceAttributeMultiprocessorCount, dev) != hipSuccess) { grid = -1; return; }
        if (hipFuncSetAttribute((const void*)fwd_kernel, hipFuncAttributeMaxDynamicSharedMemorySize, LDS_BYTES) != hipSuccess) { fprintf(stderr, "kernel_launch: hipFuncSetAttribute failed\n"); grid = -1; return; }
        if (hipOccupancyMaxActiveBlocksPerMultiprocessor(&per_cu, (const void*)fwd_kernel, NTHREADS, LDS_BYTES) != hipSuccess || per_cu < 1)
            fprintf(stderr, "kernel_launch: occupancy query reports %d blocks per CU\n", per_cu);
        (void)hipGetLastError();
        grid = cus;
    }
    if (grid < 0) return;
    if (hipMemsetAsync((char*)d_ws + WS_CTL, 0, CTL_BYTES, stream) != hipSuccess) return;
    Params p{};
    const float* const* in = (const float* const*)d_in;
    p.x = in[0]; p.meta = in[1]; p.ln_in_g = in[2]; p.ln_in_b = in[3]; p.w_in = in[4]; p.b_igate = in[5]; p.b_fgate = in[6]; p.conv_qk = in[7];
    p.ml_norm_g = in[8]; p.sb_norm_g = in[9]; p.pool_w = in[10]; p.pool_scale = in[11]; p.w_out = in[12]; p.ln1_g = in[13]; p.ln1_b = in[14];
    p.router_w = in[15]; p.router_bias = in[16]; p.exp_w13 = in[17]; p.exp_w2 = in[18]; p.sh_w13 = in[19]; p.sh_w2 = in[20]; p.ln2_g = in[21]; p.ln2_b = in[22];
    p.out = (float*)d_out; p.ws = (unsigned char*)d_ws;
#if N_LAUNCH_MODE == 1
    p.ph_lo = 0; p.ph_hi = NPHASES;
    hipLaunchKernelGGL(fwd_kernel, dim3(grid), dim3(NTHREADS), LDS_BYTES, stream, p);
#else
    for (int ph = 0; ph < NPHASES; ++ph) {
        p.ph_lo = ph; p.ph_hi = ph + 1;
        hipLaunchKernelGGL(fwd_kernel, dim3(grid), dim3(NTHREADS), LDS_BYTES, stream, p);
    }
#endif
    const hipError_t le = hipPeekAtLastError();
    if (le != hipSuccess) fprintf(stderr, "kernel_launch: launch failed: %s\n", hipGetErrorName(le));
}
```

```cpp
#define REPMASK 16
#define REPLAYER 1
#define REP_P4_RESET 1
#define USE_FP8_EXPERTS 1
#define FUSE_CONV 1
#ifndef CONV_A_BUDGET
#define CONV_A_BUDGET 0
#endif
#include <hip/hip_runtime.h>
#include <stdint.h>
#include <stdio.h>

constexpr int DM = 2048, NB = 4, SEQ = 2048, NMETA = 16, LSEQ = SEQ + NMETA, DEPTH = 2;
constexpr int TREAL = NB * SEQ;
constexpr int TALL = TREAL + NB * NMETA;
constexpr int HD = 128, NH = 6;
constexpr int N_IN = 5900;
constexpr int PROJ_W = 5888;
constexpr int PC_MLQK = 0, PC_MLV = 1536, PC_MLO = 2304, PC_SBQ = 3072, PC_SBK = 3840, PC_SBV = 4608, PC_POOL = 5376;
constexpr int NEXP = 64, TOPK = 8, DEXP = 512;
constexpr float ROUTED_SCALE = 2.5f;
constexpr float DN_ALPHA = 1.41421356237309515f;
constexpr float LN_EPS = 1e-5f, RMS_EPS = 1e-6f;
constexpr int SH_BASE = TALL * TOPK;
constexpr int PROWS = SH_BASE + TALL;

typedef unsigned short bf16_t;
typedef short bf16x8 __attribute__((ext_vector_type(8)));
typedef short s16x4 __attribute__((ext_vector_type(4)));
typedef float f32x16 __attribute__((ext_vector_type(16)));
typedef float f32x4 __attribute__((ext_vector_type(4)));
typedef float f32x2 __attribute__((ext_vector_type(2)));
typedef unsigned u32x4 __attribute__((ext_vector_type(4)));
typedef unsigned u32x2 __attribute__((ext_vector_type(2)));
#define LAS __attribute__((address_space(3)))

constexpr int NTHREADS = 512;
constexpr int LDS_BYTES = 144 * 1024;

__device__ __forceinline__ unsigned cvtpk(float lo, float hi) {
    unsigned r; asm volatile("v_cvt_pk_bf16_f32 %0, %1, %2" : "=v"(r) : "v"(lo), "v"(hi)); return r;
}
__device__ __forceinline__ float bf2f(bf16_t v) { return __uint_as_float(((unsigned)v) << 16); }
__device__ __forceinline__ float bflo(unsigned w) { return __uint_as_float(w << 16); }
__device__ __forceinline__ float bfhi(unsigned w) { return __uint_as_float(w & 0xffff0000u); }
__device__ __forceinline__ bf16_t f2bf(float f) { return (bf16_t)(cvtpk(f, 0.f) & 0xffffu); }
__device__ __forceinline__ unsigned pk4_fp8(float a, float b, float c, float d) { int w = __builtin_amdgcn_cvt_pk_fp8_f32(a, b, 0, false); w = __builtin_amdgcn_cvt_pk_fp8_f32(c, d, w, true); return (unsigned)w; }
__device__ __forceinline__ float fp8_round(float x, float s) { int w = __builtin_amdgcn_cvt_pk_fp8_f32(x * s, 0.f, 0, false); return __builtin_amdgcn_cvt_f32_fp8(w, 0) / s; }
__device__ __forceinline__ int crow(int r, int hi) { return (r & 3) + 8 * (r >> 2) + 4 * hi; }
template <int CTRL> __device__ __forceinline__ float dpp_mov(float v) {
    return __builtin_bit_cast(float, __builtin_amdgcn_update_dpp(0, __builtin_bit_cast(int, v), CTRL, 0xf, 0xf, true));
}
__device__ __forceinline__ float rdlane(float v, int l) { return __builtin_bit_cast(float, __builtin_amdgcn_readlane(__builtin_bit_cast(int, v), l)); }
__device__ __forceinline__ float wave_sum(float v) {
    v += dpp_mov<0xB1>(v); v += dpp_mov<0x4E>(v); v += dpp_mov<0x141>(v); v += dpp_mov<0x140>(v);
    return (rdlane(v, 0) + rdlane(v, 16)) + (rdlane(v, 32) + rdlane(v, 48));
}
__device__ __forceinline__ float wave_max(float v) {
    v = fmaxf(v, dpp_mov<0xB1>(v)); v = fmaxf(v, dpp_mov<0x4E>(v)); v = fmaxf(v, dpp_mov<0x141>(v)); v = fmaxf(v, dpp_mov<0x140>(v));
    return fmaxf(fmaxf(rdlane(v, 0), rdlane(v, 16)), fmaxf(rdlane(v, 32), rdlane(v, 48)));
}
__device__ __forceinline__ float sigmoidf_(float x) { return 1.f / (1.f + __expf(-x)); }
__device__ __forceinline__ float siluf_(float x) { return x / (1.f + __expf(-x)); }
__device__ __forceinline__ float logsigmoidf_(float x) { return fminf(x, 0.f) - __logf(1.f + __expf(-fabsf(x))); }

#if defined(DBG_TIMING) || defined(DBG_TIMING_BF) || defined(DBG_MIX) || defined(DBG_TQ) || defined(DBG_PHN)
#define DBG_ANY 1
__device__ unsigned long long dbg_acc[8];
#ifndef DBG_BLOCK
#define DBG_BLOCK 0
#endif
#ifndef DBG_WAVE
#define DBG_WAVE 0
#endif
#endif
__device__ __forceinline__ int tid_here() { int t = threadIdx.x; asm volatile("" : "+v"(t)); return t; }
__device__ __forceinline__ int sgpr_here(int x) { asm volatile("" : "+s"(x)); return x; }
__device__ __forceinline__ unsigned char* lds_here(unsigned char* l) { LAS unsigned char* q = (LAS unsigned char*)l; asm volatile("" : "+s"(q)); return (unsigned char*)q; }

__device__ __forceinline__ int row_of(int b, int l) { return l < NMETA ? TREAL + b * NMETA + l : b * SEQ + (l - NMETA); }

constexpr size_t al256(size_t x) { return (x + 255) / 256 * 256; }
constexpr size_t WS_CTL = 0;
constexpr size_t CTL_BYTES = 64 * 1024;
constexpr size_t CTL_CNT = 32 * 1024;
constexpr int CNT_STRIDE = 32, CNT_LAYER = 64 * CNT_STRIDE, CNT_QWORD = DEPTH * CNT_LAYER;
constexpr size_t WS_HB = al256(WS_CTL + CTL_BYTES);
constexpr size_t WS_PROJ = al256(WS_HB + (size_t)TALL * DM * 2);
constexpr size_t WS_GATES = al256(WS_PROJ + (size_t)TALL * PROJ_W * 2);
constexpr size_t WS_QKC = al256(WS_GATES + (size_t)TALL * 12 * 4);
constexpr size_t WS_CAT = al256(WS_QKC + (size_t)TALL * 1536 * 2);
constexpr size_t WS_S1 = al256(WS_CAT + (size_t)TALL * DM * 2);
constexpr size_t WS_H1 = al256(WS_S1 + (size_t)TALL * DM * 2);
constexpr size_t WS_ASGE = al256(WS_H1 + (size_t)TALL * DM * 2);
constexpr size_t WS_ASGS = al256(WS_ASGE + (size_t)TALL * 8 * 4);
constexpr size_t WS_TOKL = al256(WS_ASGS + (size_t)TALL * 8 * 4);
constexpr size_t WS_GATEL = al256(WS_TOKL + (size_t)NEXP * TALL * 4);
constexpr size_t WS_ACT = al256(WS_GATEL + (size_t)NEXP * TALL * 4);
constexpr size_t WS_Y = al256(WS_ACT + (size_t)PROWS * DEXP * 2);
constexpr size_t WT_IN = 0, WT_OUT = (size_t)PROJ_W * DM, WT_SH13 = WT_OUT + (size_t)DM * DM, WT_SH2 = WT_SH13 + (size_t)1024 * DM, WT_POOL = WT_SH2 + (size_t)DM * DEXP, WT_LAYER = WT_POOL + (size_t)4 * 128 * 128;
constexpr size_t WS_WT = al256(WS_Y + (size_t)PROWS * DM * 2);
constexpr size_t WS_W13Q = al256(WS_WT + (size_t)DEPTH * WT_LAYER * 2);
constexpr size_t W13Q_LAYER = (size_t)NEXP * 1024 * DM, W2Q_LAYER = (size_t)NEXP * DM * DEXP;
constexpr size_t WS_W2Q = al256(WS_W13Q + DEPTH * W13Q_LAYER);
constexpr size_t WS_H1Q = al256(WS_W2Q + DEPTH * W2Q_LAYER);
constexpr size_t WS_ACTQ = al256(WS_H1Q + (size_t)TALL * DM);
constexpr size_t WS_SHQ = al256(WS_ACTQ + (size_t)PROWS * DEXP);
constexpr size_t SHQ_LAYER = (size_t)1024 * DM + (size_t)DM * DEXP;
constexpr size_t WS_DUMP = al256(WS_SHQ + (size_t)DEPTH * SHQ_LAYER);
constexpr size_t RWF_LAYER = (size_t)128 * 4 * 64 * 16;
constexpr size_t WS_RWF = al256(WS_DUMP + 65536);
constexpr size_t WS_END = al256(WS_RWF + DEPTH * RWF_LAYER);

struct Params {
    const float* x; const float* meta; const float* ln_in_g; const float* ln_in_b;
    const float* w_in; const float* b_igate; const float* b_fgate; const float* conv_qk;
    const float* ml_norm_g; const float* sb_norm_g; const float* pool_w; const float* pool_scale;
    const float* w_out; const float* ln1_g; const float* ln1_b; const float* router_w; const float* router_bias;
    const float* exp_w13; const float* exp_w2; const float* sh_w13; const float* sh_w2;
    const float* ln2_g; const float* ln2_b;
    float* out; unsigned char* ws;
    int ph_lo, ph_hi;
};
typedef const Params __attribute__((address_space(4)))* PP;
__device__ __forceinline__ PP get_params() {
    PP k = (PP)__builtin_amdgcn_kernarg_segment_ptr();
    asm volatile("" : "+s"(k));
    return k;
}

constexpr int TM = 192;
constexpr int A_SLOT = 24576;
constexpr int G_AS = 0, G_BS = 3 * A_SLOT, G_ROWS = G_BS + 65536;
constexpr int G_LDS_END = G_ROWS + 1024;

__device__ __forceinline__ int swz_f(int n) { return ((n >> 2) & 7) ^ ((n >> 1) & 1); }

struct GemmOp {
    const bf16_t* X; int ldx;
    const float* W; int ldb;
    int cb0, cb1;
    int K;
    int cstep;
};

#define BSET_WAIT(N, S) asm volatile("s_waitcnt vmcnt(" #N ") lgkmcnt(0)" : "+v"(S[0]), "+v"(S[1]), "+v"(S[2]), "+v"(S[3]), "+v"(S[4]), "+v"(S[5]), "+v"(S[6]), "+v"(S[7]) :: "memory")

template <int NPASS, class Epi>
__device__ __forceinline__ void gemm_tile(unsigned char* lds_in, const GemmOp& g, Epi& epi) {
    unsigned char* lds = lds_here(lds_in);
    const int tid = tid_here(), lane = tid & 63, wid = __builtin_amdgcn_readfirstlane(tid >> 6), wr = wid >> 2, wc = wid & 3, r32 = lane & 31, hi = lane >> 5;
    const int* rows = (const int*)(lds + G_ROWS);
    const int a_r = wid * 8 + (lane >> 3);
    unsigned a_off[3];
#pragma unroll
    for (int j = 0; j < 3; ++j) a_off[j] = (unsigned)rows[a_r + 64 * j] * (unsigned)g.ldx + (((lane & 7) ^ swz_f(a_r)) << 3);
    const int a_lds = wid * 1024;
    const int kg = wid, nq = lane;
    const int blk = nq >> 3, gq = nq & 7;
    const int b_col = ((blk & 1) ? g.cb1 : g.cb0) + (blk >> 1) * 32 + gq * 4;
    const int b_n0 = blk * 32 + 8 * (gq & 3) + 4 * (gq >> 2);
    const int wa0 = G_BS + b_n0 * 128 + ((kg ^ swz_f(b_n0)) << 4);
    const int wa2 = G_BS + (b_n0 + 2) * 128 + ((kg ^ swz_f(b_n0 + 2)) << 4);
    const unsigned long long wa_ = (unsigned long long)g.W;
    const char* Wu = (const char*)(((unsigned long long)(unsigned)__builtin_amdgcn_readfirstlane((int)(wa_ >> 32)) << 32) | (unsigned)__builtin_amdgcn_readfirstlane((int)wa_));
    const int ldbu = __builtin_amdgcn_readfirstlane(g.ldb);
    unsigned b_voff = (unsigned)((kg * 8 * ldbu + b_col) * 4);
    const size_t ldb4 = (size_t)ldbu * 4;
    const int lanec = (hi ^ swz_f(r32)) << 4;
    int ard[4], brd[4];
#pragma unroll
    for (int ks = 0; ks < 4; ++ks) { ard[ks] = G_AS + (wr * 32 + r32) * 128 + ((ks << 5) ^ lanec); brd[ks] = G_BS + (wc * 64 + r32) * 128 + ((ks << 5) ^ lanec); }

    f32x16 acc[2][3];

    f32x4 s0[8], s1[8];
    const int nk = g.K >> 6;
#define G_DMA_A(kt, slot_off) do { \
        _Pragma("unroll") for (int j = 0; j < 3; ++j) __builtin_amdgcn_global_load_lds((const unsigned*)(g.X + a_off[j] + (kt) * 64), \
            (unsigned*)(lds + G_AS + (slot_off) + a_lds + j * 8192), 16, 0, 0); } while (0)
#define G_LOADB(S, kt) do { const char* wb_ = Wu + (size_t)(kt) * 64 * ldb4; \
        _Pragma("unroll") for (int j = 0; j < 8; ++j) asm volatile("global_load_dwordx4 %0, %1, %2" : "=v"(S[j]) : "v"(b_voff), "s"(wb_ + j * ldb4) : "memory"); } while (0)
#define G_WRITEB(S, buf) do { u32x4 w_; \
        w_.x = cvtpk(S[0][0], S[1][0]); w_.y = cvtpk(S[2][0], S[3][0]); w_.z = cvtpk(S[4][0], S[5][0]); w_.w = cvtpk(S[6][0], S[7][0]); *(u32x4*)(lds + wa0 + (buf) * 32768) = w_; \
        w_.x = cvtpk(S[0][1], S[1][1]); w_.y = cvtpk(S[2][1], S[3][1]); w_.z = cvtpk(S[4][1], S[5][1]); w_.w = cvtpk(S[6][1], S[7][1]); *(u32x4*)(lds + wa0 + (buf) * 32768 + 128) = w_; \
        w_.x = cvtpk(S[0][2], S[1][2]); w_.y = cvtpk(S[2][2], S[3][2]); w_.z = cvtpk(S[4][2], S[5][2]); w_.w = cvtpk(S[6][2], S[7][2]); *(u32x4*)(lds + wa2 + (buf) * 32768) = w_; \
        w_.x = cvtpk(S[0][3], S[1][3]); w_.y = cvtpk(S[2][3], S[3][3]); w_.z = cvtpk(S[4][3], S[5][3]); w_.w = cvtpk(S[6][3], S[7][3]); *(u32x4*)(lds + wa2 + (buf) * 32768 + 128) = w_; } while (0)
#define G_FRAGS(F, acur_, buf, ks) do { \
        _Pragma("unroll") for (int mi = 0; mi < 3; ++mi) F[mi] = *(const bf16x8*)(lds + ard[ks] + (acur_) + mi * 8192); \
        _Pragma("unroll") for (int ni = 0; ni < 2; ++ni) F[3 + ni] = *(const bf16x8*)(lds + brd[ks] + (buf) * 32768 + ni * 4096); } while (0)
#define G_MMA(F) do { \
        _Pragma("unroll") for (int ni = 0; ni < 2; ++ni) \
        _Pragma("unroll") for (int mi = 0; mi < 3; ++mi) acc[ni][mi] = __builtin_amdgcn_mfma_f32_32x32x16_bf16(F[3 + ni], F[mi], acc[ni][mi], 0, 0, 0); } while (0)
#define SB0() __builtin_amdgcn_sched_barrier(0)
#define G_MMA1(F, q) do { const int ni_ = (q) / 3, mi_ = (q) % 3; \
        acc[ni_][mi_] = __builtin_amdgcn_mfma_f32_32x32x16_bf16(F[3 + ni_], F[mi_], acc[ni_][mi_], 0, 0, 0); } while (0)
#define G_MMA2(F, pr) do { G_MMA1(F, 2 * (pr)); G_MMA1(F, 2 * (pr) + 1); } while (0)
#define G_WPIECE(S, buf, i, WA, OFF) do { u32x4 w_; \
        w_.x = cvtpk(S[0][i], S[1][i]); w_.y = cvtpk(S[2][i], S[3][i]); w_.z = cvtpk(S[4][i], S[5][i]); w_.w = cvtpk(S[6][i], S[7][i]); *(u32x4*)(lds + WA + (buf) * 32768 + OFF) = w_; } while (0)
#define G_DMA1(kt, slot_off, j) __builtin_amdgcn_global_load_lds((const unsigned*)(g.X + a_off[j] + (kt) * 64), (unsigned*)(lds + G_AS + (slot_off) + a_lds + (j) * 8192), 16, 0, 0)
#define G_LOAD1(S, kt, j) asm volatile("global_load_dwordx4 %0, %1, %2" : "=v"(S[j]) : "v"(b_voff), "s"(Wu + ((size_t)(kt) * 64 + (j)) * ldb4) : "memory")
#define SETWAIT(N, S) asm volatile("s_waitcnt vmcnt(" #N ")" : "+v"(S[0]), "+v"(S[1]), "+v"(S[2]), "+v"(S[3]), "+v"(S[4]), "+v"(S[5]), "+v"(S[6]), "+v"(S[7]) :: "memory")
#define G_STEP(kt, SW, TOPW, BARW, DO_WRITE, DO_DMA, DO_LOAD, HAS_NEXT) do { \
        if (DO_WRITE) { SETWAIT(TOPW, SW); } \
        G_FRAGS(f1, a_cur, (kt) & 1, 1); SB0(); \
        if (DO_WRITE) G_WPIECE(SW, ((kt) + 1) & 1, 0, wa0, 0);   SB0(); G_MMA2(f0, 0); SB0(); \
        if (DO_WRITE) G_WPIECE(SW, ((kt) + 1) & 1, 1, wa0, 128); SB0(); G_MMA2(f0, 1); SB0(); \
        if (DO_WRITE) G_WPIECE(SW, ((kt) + 1) & 1, 2, wa2, 0);   SB0(); G_MMA2(f0, 2); SB0(); \
        if (DO_WRITE) G_WPIECE(SW, ((kt) + 1) & 1, 3, wa2, 128); SB0(); \
        G_FRAGS(f0, a_cur, (kt) & 1, 2); SB0(); \
        if (DO_DMA) G_DMA1((kt) + 2, a_nn, 0); SB0(); G_MMA2(f1, 0); SB0(); \
        if (DO_DMA) G_DMA1((kt) + 2, a_nn, 1); if (DO_LOAD) { G_LOAD1(SW, (kt) + 3, 0); G_LOAD1(SW, (kt) + 3, 1); } SB0(); G_MMA2(f1, 1); SB0(); \
        if (DO_DMA) G_DMA1((kt) + 2, a_nn, 2); if (DO_LOAD) { G_LOAD1(SW, (kt) + 3, 2); G_LOAD1(SW, (kt) + 3, 3); } SB0(); G_MMA2(f1, 2); SB0(); \
        G_FRAGS(f1, a_cur, (kt) & 1, 3); SB0(); \
        if (DO_LOAD) { G_LOAD1(SW, (kt) + 3, 4); G_LOAD1(SW, (kt) + 3, 5); } SB0(); G_MMA2(f0, 0); SB0(); \
        if (DO_LOAD) { G_LOAD1(SW, (kt) + 3, 6); G_LOAD1(SW, (kt) + 3, 7); } SB0(); G_MMA2(f0, 1); SB0(); \
        G_MMA2(f0, 2); SB0(); \
        a_cur = a_cur + A_SLOT; a_cur = a_cur >= 3 * A_SLOT ? 0 : a_cur; a_nn = a_nn + A_SLOT; a_nn = a_nn >= 3 * A_SLOT ? 0 : a_nn; \
        if (HAS_NEXT) { DBG_T0(); asm volatile("s_waitcnt vmcnt(" #BARW ") lgkmcnt(0)" ::: "memory"); DBG_T1(); \
            __builtin_amdgcn_s_barrier(); DBG_T2(); \
            G_FRAGS(f0, a_cur, ((kt) + 1) & 1, 0); SB0(); } \
        G_MMA2(f1, 0); G_MMA2(f1, 1); G_MMA2(f1, 2); SB0(); } while (0)

#ifdef DBG_TIMING
    unsigned long long dt0_ = 0, dt1_ = 0, dwait_ = 0, dbar_ = 0; const unsigned long long dstart_ = __builtin_amdgcn_s_memtime();
#define DBG_T0() dt0_ = __builtin_amdgcn_s_memtime()
#define DBG_T1() do { dt1_ = __builtin_amdgcn_s_memtime(); dwait_ += dt1_ - dt0_; } while (0)
#define DBG_T2() do { dbar_ += __builtin_amdgcn_s_memtime() - dt1_; } while (0)
#else
#define DBG_T0()
#define DBG_T1()
#define DBG_T2()
#endif
    G_DMA_A(0, 0); __builtin_amdgcn_sched_barrier(0);
    G_LOADB(s0, 0); __builtin_amdgcn_sched_barrier(0);
    G_DMA_A(1, A_SLOT); __builtin_amdgcn_sched_barrier(0);
    G_LOADB(s1, 1); __builtin_amdgcn_sched_barrier(0);
#pragma unroll
    for (int pass = 0; pass < NPASS; ++pass) {
#pragma unroll
    for (int ni = 0; ni < 2; ++ni)
#pragma unroll
        for (int mi = 0; mi < 3; ++mi)
#pragma unroll
            for (int r = 0; r < 16; ++r) acc[ni][mi][r] = 0.f;
    int a_cur = 0, a_nn = 2 * A_SLOT;
    BSET_WAIT(11, s0);
    G_WRITEB(s0, 0); __builtin_amdgcn_sched_barrier(0);
    G_LOADB(s0, 2); __builtin_amdgcn_sched_barrier(0);
    asm volatile("s_waitcnt lgkmcnt(0)" ::: "memory");
    __builtin_amdgcn_s_barrier();
    bf16x8 f0[5], f1[5];
    G_FRAGS(f0, 0, 0, 0); SB0();
    int kt = 0;
    G_STEP(kt, s1, 8, 17, true, true, true, true); ++kt;
    for (; kt <= nk - 5; kt += 2) { G_STEP(kt, s0, 11, 17, true, true, true, true); G_STEP(kt + 1, s1, 11, 17, true, true, true, true); }
    G_STEP(kt, s0, 11, 9, true, true, false, true); ++kt;
    G_STEP(kt, s1, 3, 0, true, false, false, true); ++kt;
    G_STEP(kt, s0, 0, 0, false, false, false, false);
    {
      const int t2 = tid_here(), l2 = t2 & 63, w2 = __builtin_amdgcn_readfirstlane(t2 >> 6);
      epi.pre(w2 >> 2, l2 & 31);
      if (pass + 1 < NPASS) {
          asm volatile("s_waitcnt vmcnt(0) lgkmcnt(0)" ::: "memory"); epi.pin();
          __builtin_amdgcn_s_barrier();
          b_voff += (unsigned)(g.cstep * 4);
          G_DMA_A(0, 0); __builtin_amdgcn_sched_barrier(0);
          G_LOADB(s0, 0); __builtin_amdgcn_sched_barrier(0);
          G_DMA_A(1, A_SLOT); __builtin_amdgcn_sched_barrier(0);
          G_LOADB(s1, 1); __builtin_amdgcn_sched_barrier(0);
      }
      epi(acc, w2 >> 2, w2 & 3, l2 & 31, l2 >> 5, pass); }
    }
#ifdef DBG_TIMING
    { const unsigned long long dtot_ = __builtin_amdgcn_s_memtime() - dstart_;
      if (blockIdx.x == DBG_BLOCK && tid == DBG_WAVE * 64) { unsigned long long* d = (unsigned long long*)(lds + 0) ; (void)d;
        atomicAdd(&dbg_acc[0], dwait_); atomicAdd(&dbg_acc[1], dbar_); atomicAdd(&dbg_acc[2], dtot_); atomicAdd(&dbg_acc[3], (unsigned long long)nk); } }
#endif
#undef DBG_T0
#undef DBG_T1
#undef DBG_T2
#undef G_DMA_A
#undef G_LOADB
#undef G_WRITEB
#undef G_FRAGS
#undef G_MMA
#undef G_STEP
#undef SETWAIT
#undef G_MMA1
#undef G_MMA2
#undef G_WPIECE
#undef G_DMA1
#undef G_LOAD1
    __syncthreads();
}

template <int NMI> struct EpiStoreBf16 {
    bf16_t* O; int ldo; int orow0; int nrows; int oc0, oc1;
    __device__ __forceinline__ void pre(int, int) {}
    __device__ __forceinline__ void pin() {}
    __device__ __forceinline__ void operator()(const f32x16 (&acc)[2][NMI], int wr, int wc, int r32, int hi, int = 0) const {
#pragma unroll
        for (int mi = 0; mi < NMI; ++mi) {
            const int tr = (2 * mi + wr) * 32 + r32;
            if (tr < nrows) {
#pragma unroll
                for (int ni = 0; ni < 2; ++ni) {
                    bf16_t* p = O + (size_t)(orow0 + tr) * ldo + (ni ? oc1 : oc0) + wc * 32 + 16 * hi;
                    u32x4 w0, w1; const f32x16& a = acc[ni][mi];
                    w0.x = cvtpk(a[0], a[1]); w0.y = cvtpk(a[2], a[3]); w0.z = cvtpk(a[4], a[5]); w0.w = cvtpk(a[6], a[7]);
                    w1.x = cvtpk(a[8], a[9]); w1.y = cvtpk(a[10], a[11]); w1.z = cvtpk(a[12], a[13]); w1.w = cvtpk(a[14], a[15]);
                    *(u32x4*)p = w0; *(u32x4*)(p + 8) = w1;
                }
            }
        }
    }
};


constexpr int TMB = 256;
#ifdef EXP_DMA2X
#define EXP_DMA2 true
#define VMW(n) VMW2_##n
#define VMW2_8 16
#define VMW2_4 8
#define VMW2_0 0
#else
#define EXP_DMA2 false
#define VMW(n) n
#endif
#define XSTR(x) STR(x)
#define STR(x) #x
constexpr int BF_AS = 0, BF_BS = 65536, BF_ROWS = 131072, BF_SLOT = 16384;
struct GemmOpBf { const bf16_t* X; int ldx; const bf16_t* Wt; int ldw; int cb0, cb1; int K; };

template <class Epi>
__device__ __forceinline__ void gemm_tile_bf(unsigned char* lds_in, const GemmOpBf& g, const Epi& epi) {
    unsigned char* lds = lds_here(lds_in);
    const int tid = tid_here(), lane = tid & 63, wid = __builtin_amdgcn_readfirstlane(tid >> 6), wr = wid >> 2, wc = wid & 3, r32 = lane & 31, hi = lane >> 5;
    const int* rows = (const int*)(lds + BF_ROWS);
    unsigned a_off[2], b_off[2];
#pragma unroll
    for (int jj = 0; jj < 2; ++jj) {
        const int r = jj * 128 + wid * 16 + (lane >> 2);
        const int cpos = ((lane & 3) ^ ((r >> 2) & 3)) << 3;
        a_off[jj] = (unsigned)rows[r] * (unsigned)g.ldx + cpos;
        const int rho = r & 31, gcol = (((r >> 5) & 1) ? g.cb1 : g.cb0) + (r >> 6) * 32 + 16 * ((rho >> 2) & 1) + (rho & 3) + 4 * (rho >> 3);
        b_off[jj] = (unsigned)gcol * (unsigned)g.ldw + cpos;
    }
    const int p_lds = wid * 1024;
    const int lanec = (hi ^ ((r32 >> 2) & 3)) << 4;
    const int ard = BF_AS + (wr * 32 + r32) * 64, brd = BF_BS + (wc * 64 + r32) * 64;
    const int co0 = lanec, co1 = 32 ^ lanec;

    f32x16 acc[2][4];
#pragma unroll
    for (int ni = 0; ni < 2; ++ni)
#pragma unroll
        for (int mi = 0; mi < 4; ++mi)
#pragma unroll
            for (int r = 0; r < 16; ++r) acc[ni][mi][r] = 0.f;
    const int nk = g.K >> 5;
#define BF_DMA(kt, slot, which) do { BF_DMA_1(kt, slot, which); if (EXP_DMA2) BF_DMA_1(kt, slot, which); } while (0)
#define BF_DMA_1(kt, slot, which) do { \
        if ((which) < 2) __builtin_amdgcn_global_load_lds((const unsigned*)(g.X + a_off[(which) & 1] + (kt) * 32), (unsigned*)(lds + BF_AS + (slot) * BF_SLOT + p_lds + ((which) & 1) * 8192), 16, 0, 0); \
        else __builtin_amdgcn_global_load_lds((const unsigned*)(g.Wt + b_off[(which) & 1] + (kt) * 32), (unsigned*)(lds + BF_BS + (slot) * BF_SLOT + p_lds + ((which) & 1) * 8192), 16, 0, 0); } while (0)
#define BF_FRAGS(F, slot, co) do { \
        _Pragma("unroll") for (int mi = 0; mi < 4; ++mi) F[mi] = *(const bf16x8*)(lds + ard + (slot) * BF_SLOT + mi * 4096 + (co)); \
        _Pragma("unroll") for (int ni = 0; ni < 2; ++ni) F[4 + ni] = *(const bf16x8*)(lds + brd + (slot) * BF_SLOT + ni * 2048 + (co)); } while (0)
#define BF_MMA1(F, q) do { const int ni_ = (q) >> 2, mi_ = (q) & 3; \
        acc[ni_][mi_] = __builtin_amdgcn_mfma_f32_32x32x16_bf16(F[4 + ni_], F[mi_], acc[ni_][mi_], 0, 0, 0); } while (0)
#define BF_MMA2(F, pr) do { BF_MMA1(F, 2 * (pr)); BF_MMA1(F, 2 * (pr) + 1); } while (0)
#define SB0() __builtin_amdgcn_sched_barrier(0)
#define BF_STEP(kt, slot, WAITN, DO_ISSUE, HAS_NEXT) do { \
        BF_FRAGS(f1, slot, co1); SB0(); \
        BF_MMA2(f0, 0); BF_MMA2(f0, 1); BF_MMA2(f0, 2); BF_MMA2(f0, 3); SB0(); \
        if (HAS_NEXT) { BDBG_T0(); asm volatile("s_waitcnt vmcnt(" XSTR(VMW(WAITN)) ")" ::: "memory"); BDBG_T1(); \
            __builtin_amdgcn_s_barrier(); BDBG_T2(); \
            BF_FRAGS(f0, ((slot) + 1) & 3, co0); SB0(); } \
        if (DO_ISSUE) BF_DMA((kt) + 3, ((slot) + 3) & 3, 0); SB0(); BF_MMA2(f1, 0); SB0(); \
        if (DO_ISSUE) BF_DMA((kt) + 3, ((slot) + 3) & 3, 2); SB0(); BF_MMA2(f1, 1); SB0(); \
        if (DO_ISSUE) BF_DMA((kt) + 3, ((slot) + 3) & 3, 1); SB0(); BF_MMA2(f1, 2); SB0(); \
        if (DO_ISSUE) BF_DMA((kt) + 3, ((slot) + 3) & 3, 3); SB0(); BF_MMA2(f1, 3); SB0(); } while (0)

#ifdef DBG_TIMING_BF
    unsigned long long dt0_ = 0, dt1_ = 0, dwait_ = 0, dbar_ = 0; const unsigned long long dstart_ = __builtin_amdgcn_s_memtime(); const unsigned long long drt_ = __builtin_amdgcn_s_memrealtime();
#define BDBG_T0() dt0_ = __builtin_amdgcn_s_memtime()
#define BDBG_T1() do { dt1_ = __builtin_amdgcn_s_memtime(); dwait_ += dt1_ - dt0_; } while (0)
#define BDBG_T2() do { dbar_ += __builtin_amdgcn_s_memtime() - dt1_; } while (0)
#else
#define BDBG_T0()
#define BDBG_T1()
#define BDBG_T2()
#endif
#pragma unroll
    for (int t = 0; t < 3; ++t) { BF_DMA(t, t, 0); BF_DMA(t, t, 2); BF_DMA(t, t, 1); BF_DMA(t, t, 3); }
    SB0();
    asm volatile("s_waitcnt vmcnt(" XSTR(VMW(8)) ")" ::: "memory");
    __builtin_amdgcn_s_barrier();
    bf16x8 f0[6], f1[6];
    BF_FRAGS(f0, 0, co0); SB0();
    int kt = 0;
    for (; kt < nk - 4; kt += 4) {
        BF_STEP(kt, 0, 4, true, true); BF_STEP(kt + 1, 1, 4, true, true); BF_STEP(kt + 2, 2, 4, true, true); BF_STEP(kt + 3, 3, 4, true, true);
    }
    BF_STEP(kt, 0, 4, true, true); BF_STEP(kt + 1, 1, 4, false, true); BF_STEP(kt + 2, 2, 0, false, true); BF_STEP(kt + 3, 3, 0, false, false);
#ifdef DBG_TIMING_BF
    { const unsigned long long dtot_ = __builtin_amdgcn_s_memtime() - dstart_; const unsigned long long drtot_ = __builtin_amdgcn_s_memrealtime() - drt_;
      if (tid == DBG_WAVE * 64) { atomicAdd(&dbg_acc[0], DBG_SEL == 4 ? drtot_ : dwait_); atomicAdd(&dbg_acc[1], dbar_); atomicAdd(&dbg_acc[2], dtot_); atomicAdd(&dbg_acc[3], (unsigned long long)nk); if (DBG_SEL == 5) atomicMax(&dbg_acc[1], dtot_ / (unsigned long long)nk); } }
#endif
#undef BDBG_T0
#undef BDBG_T1
#undef BDBG_T2
#undef BF_DMA
#undef BF_DMA_1
#undef BF_FRAGS
#undef BF_MMA1
#undef BF_MMA2
#undef BF_STEP
    __syncthreads();
    {
      const int t2 = tid_here(), l2 = t2 & 63, w2 = __builtin_amdgcn_readfirstlane(t2 >> 6);
      epi(acc, w2 >> 2, w2 & 3, l2 & 31, l2 >> 5); }
    __syncthreads();
}

typedef int i32x8 __attribute__((ext_vector_type(8)));
struct GemmOpQ { const unsigned char* X; int ldx; const unsigned char* Wt; int ldw; int cb0, cb1; int K; int cstep; int nrows; };
constexpr int WQ_SCALE_BYTE = 0x79;

template <int NPASS, int NMIU, class Epi>
__device__ __forceinline__ void gemm_tile_q(unsigned char* lds_in, const GemmOpQ& g, Epi& epi) {
    unsigned char* lds = lds_here(lds_in);
#ifdef DBG_TQ
    const unsigned long long dq0_ = __builtin_amdgcn_s_memtime(); unsigned long long dq1_ = 0;
#endif
    const int tid = tid_here(), lane = tid & 63, wid = __builtin_amdgcn_readfirstlane(tid >> 6), wr = wid >> 2, wc = wid & 3, r32 = lane & 31, hi = lane >> 5;
    const int* rows = (const int*)(lds + BF_ROWS);
    unsigned a_off[2], b_off[2];
#pragma unroll
    for (int jj = 0; jj < 2; ++jj) {
        const int r = jj * 128 + wid * 16 + (lane >> 2);
        const int cpos = ((lane & 3) ^ ((r >> 2) & 3)) << 4;
        a_off[jj] = (unsigned)rows[r] * (unsigned)g.ldx + cpos;
        const int rho = r & 31, gcol = (((r >> 5) & 1) ? g.cb1 : g.cb0) + (r >> 6) * 32 + 16 * ((rho >> 2) & 1) + (rho & 3) + 4 * (rho >> 3);
        b_off[jj] = (unsigned)gcol * (unsigned)g.ldw + cpos;
    }
    const int p_lds = wid * 1024;
    const int c0 = ((2 * hi) ^ ((r32 >> 2) & 3)) << 4;
    const int ard = BF_AS + (wr * 32 + r32) * 64, brd = BF_BS + (wc * 64 + r32) * 64;
    constexpr int nmi = NMIU;

    f32x16 acc[2][4];
    const int nk = g.K >> 6;
#define Q_DMA(kt, slot, which) do { \
        if ((which) < 2) __builtin_amdgcn_global_load_lds((const unsigned*)(g.X + a_off[(which) & 1] + (kt) * 64), (unsigned*)(lds + BF_AS + (slot) * BF_SLOT + p_lds + ((which) & 1) * 8192), 16, 0, 0); \
        else __builtin_amdgcn_global_load_lds((const unsigned*)(g.Wt + b_off[(which) & 1] + (kt) * 64), (unsigned*)(lds + BF_BS + (slot) * BF_SLOT + p_lds + ((which) & 1) * 8192), 16, 0, 0); } while (0)
#define Q_FRAG(dst, base) do { typedef int i32x4_ __attribute__((ext_vector_type(4))); \
        const i32x4_ lo_ = *(const i32x4_*)(lds + (base) + c0), hi_ = *(const i32x4_*)(lds + (base) + (c0 ^ 16)); \
        dst = __builtin_shufflevector(lo_, hi_, 0, 1, 2, 3, 4, 5, 6, 7); } while (0)
#define Q_MMA(ni, mi) acc[ni][mi] = __builtin_amdgcn_mfma_scale_f32_32x32x64_f8f6f4(fw[ni], fx[mi], acc[ni][mi], 0, 0, 0, WQ_SCALE_BYTE * 0x01010101, 0, 0x7f7f7f7f)
#define Q_MMAX(FWv, FXv, ni, mi, j) acc[ni][mi] = __builtin_amdgcn_mfma_scale_f32_32x32x64_f8f6f4(FWv[ni], FXv[j], acc[ni][mi], 0, 0, 0, WQ_SCALE_BYTE * 0x01010101, 0, 0x7f7f7f7f)
#define Q_STEP(kt, slot, WAITN, DO_ISSUE, HAS_NEXT, FW, FXA, FWN, FXAN) do { \
        i32x8 fxb[2]; \
        Q_FRAG(FXA[0], ard + (slot) * BF_SLOT); if (nmi > 1) Q_FRAG(FXA[1], ard + (slot) * BF_SLOT + 4096); \
        if (nmi > 2) Q_FRAG(fxb[0], ard + (slot) * BF_SLOT + 8192); \
        if (nmi > 3) Q_FRAG(fxb[1], ard + (slot) * BF_SLOT + 12288); SB0(); \
        if (nmi > 0) { Q_MMAX(FW, FXA, 0, 0, 0); Q_MMAX(FW, FXA, 1, 0, 0); } if (nmi > 1) { Q_MMAX(FW, FXA, 0, 1, 1); Q_MMAX(FW, FXA, 1, 1, 1); } SB0(); \
        if (HAS_NEXT) { asm volatile("s_waitcnt vmcnt(" #WAITN ")" ::: "memory"); \
            __builtin_amdgcn_s_barrier(); \
            if (nmi > 0) { Q_FRAG(FWN[0], brd + (((slot) + 1) & 3) * BF_SLOT); Q_FRAG(FWN[1], brd + (((slot) + 1) & 3) * BF_SLOT + 2048); } SB0(); } \
        if (DO_ISSUE) Q_DMA((kt) + 3, ((slot) + 3) & 3, 0); SB0(); if (nmi > 2) Q_MMAX(FW, fxb, 0, 2, 0); SB0(); \
        if (DO_ISSUE) Q_DMA((kt) + 3, ((slot) + 3) & 3, 2); SB0(); if (nmi > 2) Q_MMAX(FW, fxb, 1, 2, 0); SB0(); \
        if (DO_ISSUE) Q_DMA((kt) + 3, ((slot) + 3) & 3, 1); SB0(); if (nmi > 3) Q_MMAX(FW, fxb, 0, 3, 1); SB0(); \
        if (DO_ISSUE) Q_DMA((kt) + 3, ((slot) + 3) & 3, 3); SB0(); if (nmi > 3) Q_MMAX(FW, fxb, 1, 3, 1); SB0(); } while (0)

#pragma unroll
    for (int t = 0; t < 3; ++t) { Q_DMA(t, t, 0); Q_DMA(t, t, 2); Q_DMA(t, t, 1); Q_DMA(t, t, 3); }
    SB0();
#pragma unroll
    for (int pass = 0; pass < NPASS; ++pass) {
#pragma unroll
    for (int ni = 0; ni < 2; ++ni)
#pragma unroll
        for (int mi = 0; mi < 4; ++mi)
#pragma unroll
            for (int r = 0; r < 16; ++r) acc[ni][mi][r] = 0.f;
    asm volatile("s_waitcnt vmcnt(8)" ::: "memory");
    __builtin_amdgcn_s_barrier();
    i32x8 fw0[2], fx0[2], fw1[2], fx1[2];
    if (nmi > 0) { Q_FRAG(fw0[0], brd); Q_FRAG(fw0[1], brd + 2048); } SB0();
    int kt = 0;
    for (; kt < nk - 4; kt += 4) {
        Q_STEP(kt, 0, 4, true, true, fw0, fx0, fw1, fx1); Q_STEP(kt + 1, 1, 4, true, true, fw1, fx1, fw0, fx0);
        Q_STEP(kt + 2, 2, 4, true, true, fw0, fx0, fw1, fx1); Q_STEP(kt + 3, 3, 4, true, true, fw1, fx1, fw0, fx0);
    }
    Q_STEP(kt, 0, 4, true, true, fw0, fx0, fw1, fx1); Q_STEP(kt + 1, 1, 4, false, true, fw1, fx1, fw0, fx0);
    Q_STEP(kt + 2, 2, 0, false, true, fw0, fx0, fw1, fx1); Q_STEP(kt + 3, 3, 0, false, false, fw1, fx1, fw0, fx0);
#ifdef DBG_TQ
    dq1_ = __builtin_amdgcn_s_memtime();
#endif
#pragma unroll
    for (int ni = 0; ni < 2; ++ni)
#pragma unroll
        for (int mi = 0; mi < 4; ++mi) asm volatile("" : "+v"(acc[ni][mi]));
    { const int t2 = tid_here(), l2 = t2 & 63, w2 = __builtin_amdgcn_readfirstlane(t2 >> 6);
      if (pass == 0) epi.pre(w2 >> 2, l2 & 31);
      if (NPASS == 1) __syncthreads();
      if (pass + 1 < NPASS) {
          asm volatile("s_waitcnt vmcnt(0) lgkmcnt(0)" ::: "memory"); epi.pin();
          __builtin_amdgcn_s_barrier();
          b_off[0] += (unsigned)g.cstep * (unsigned)g.ldw; b_off[1] += (unsigned)g.cstep * (unsigned)g.ldw;
          _Pragma("unroll") for (int t = 0; t < 3; ++t) { Q_DMA(t, t, 0); Q_DMA(t, t, 2); Q_DMA(t, t, 1); Q_DMA(t, t, 3); }
          SB0();
      }
      epi(acc, w2 >> 2, w2 & 3, l2 & 31, l2 >> 5, pass); }
    }
#undef Q_DMA
#undef Q_FRAG
#undef Q_MMA
#undef Q_MMAX
#undef Q_STEP
    __syncthreads();
#ifdef DBG_TQ
    if (g.K == DBG_TQ && tid_here() == 0) { const unsigned long long dq2_ = __builtin_amdgcn_s_memtime(); atomicAdd(&dbg_acc[0], dq1_ - dq0_); atomicAdd(&dbg_acc[2], dq2_ - dq0_); atomicAdd(&dbg_acc[3], 1ull); }
#endif
}

constexpr int R_AS = 0, R_BS = 65536, R_ROWS = 131072;
struct Gemm2Op { const unsigned char* X; const unsigned char* Wt; bf16_t* Y; const float* gate; int yrow0; int nrows; bf16_t* dump; };

__device__ __forceinline__ void gemm2_resident(unsigned char* lds_in, const Gemm2Op& g) {
    unsigned char* lds = lds_here(lds_in);
    const int tid = tid_here(), lane = tid & 63, wid = __builtin_amdgcn_readfirstlane(tid >> 6), wr = wid >> 2, wc = wid & 3, r32 = lane & 31, hi = lane >> 5;
    const int* rows = (const int*)(lds + R_ROWS);
    const int xr = wid * 16 + (lane >> 2);
    const unsigned x_off = (unsigned)rows[xr] * (unsigned)DEXP + ((((lane & 3) ^ ((xr >> 2) & 3))) << 4);
    unsigned b_off[2];
#pragma unroll
    for (int jj = 0; jj < 2; ++jj) {
        const int r = jj * 128 + wid * 16 + (lane >> 2);
        const int cpos = ((lane & 3) ^ ((r >> 2) & 3)) << 4;
        const int rho = r & 31, gcol = ((r >> 5) & 1) * 128 + (r >> 6) * 32 + 16 * ((rho >> 2) & 1) + (rho & 3) + 4 * (rho >> 3);
        b_off[jj] = (unsigned)gcol * (unsigned)DEXP + cpos;
    }
    const int p_lds = wid * 1024;
    const int c0 = ((2 * hi) ^ ((r32 >> 2) & 3)) << 4;
    const int ard = R_AS + (wr * 64 + r32) * 64, brd = R_BS + (wc * 64 + r32) * 64;
    float gsc[2];
#pragma unroll
    for (int mi = 0; mi < 2; ++mi) gsc[mi] = g.gate ? g.gate[wr * 64 + mi * 32 + r32] : 1.f;
    asm volatile("s_waitcnt vmcnt(0)" : "+v"(gsc[0]), "+v"(gsc[1]) :: "memory");

#define R_DMAX(ks) __builtin_amdgcn_global_load_lds((const unsigned*)(g.X + x_off + (ks) * 64), (unsigned*)(lds + R_AS + (ks) * 8192 + p_lds), 16, 0, 0)
#define R_DMAW(s, slot, jj) __builtin_amdgcn_global_load_lds((const unsigned*)(g.Wt + (size_t)((s) >> 3) * 256 * DEXP + b_off[jj] + ((s) & 7) * 64), (unsigned*)(lds + R_BS + (slot) * BF_SLOT + p_lds + (jj) * 8192), 16, 0, 0)
#define R_FRAG(dst, base) do { typedef int i32x4_ __attribute__((ext_vector_type(4))); \
        const i32x4_ lo_ = *(const i32x4_*)(lds + (base) + c0), hi_ = *(const i32x4_*)(lds + (base) + (c0 ^ 16)); \
        dst = __builtin_shufflevector(lo_, hi_, 0, 1, 2, 3, 4, 5, 6, 7); } while (0)
#define R_MMA(ni, mi) acc[ni][mi] = __builtin_amdgcn_mfma_scale_f32_32x32x64_f8f6f4(fw[ni], fx[mi], acc[ni][mi], 0, 0, 0, WQ_SCALE_BYTE * 0x01010101, 0, 0x7f7f7f7f)
#define R_STEP(s, ks, WAITN, DO_ISSUE) do { \
        asm volatile("s_waitcnt vmcnt(" #WAITN ")" ::: "memory"); \
        __builtin_amdgcn_s_barrier(); \
        i32x8 fx[2], fw[2]; \
        R_FRAG(fw[0], brd + ((ks) & 3) * BF_SLOT); R_FRAG(fw[1], brd + ((ks) & 3) * BF_SLOT + 2048); \
        R_FRAG(fx[0], ard + (ks) * 8192); R_FRAG(fx[1], ard + (ks) * 8192 + 2048); SB0(); \
        if (DO_ISSUE) R_DMAW((s) + 3, ((ks) + 3) & 3, 0); SB0(); R_MMA(0, 0); R_MMA(1, 0); SB0(); \
        if (DO_ISSUE) R_DMAW((s) + 3, ((ks) + 3) & 3, 1); SB0(); R_MMA(0, 1); R_MMA(1, 1); SB0(); } while (0)
#define R_STORE(nt) do { \
        _Pragma("unroll") for (int ni = 0; ni < 2; ++ni) _Pragma("unroll") for (int mi = 0; mi < 2; ++mi) asm volatile("" : "+v"(acc[ni][mi])); \
        _Pragma("unroll") for (int mi = 0; mi < 2; ++mi) { const int tr = wr * 64 + mi * 32 + r32; \
            _Pragma("unroll") for (int ni = 0; ni < 2; ++ni) { const f32x16& a = acc[ni][mi]; const float sc = gsc[mi]; u32x4 w0, w1; \
                w0.x = cvtpk(a[0] * sc, a[1] * sc); w0.y = cvtpk(a[2] * sc, a[3] * sc); w0.z = cvtpk(a[4] * sc, a[5] * sc); w0.w = cvtpk(a[6] * sc, a[7] * sc); \
                w1.x = cvtpk(a[8] * sc, a[9] * sc); w1.y = cvtpk(a[10] * sc, a[11] * sc); w1.z = cvtpk(a[12] * sc, a[13] * sc); w1.w = cvtpk(a[14] * sc, a[15] * sc); \
                bf16_t* q = tr < g.nrows ? g.Y + (size_t)(g.yrow0 + tr) * DM + (nt) * 256 + ni * 128 + wc * 32 + 16 * hi : g.dump + tid * 16;     \
                *(u32x4*)q = w0; *(u32x4*)(q + 8) = w1; } } } while (0)

#pragma unroll
    for (int ks = 0; ks < 8; ++ks) R_DMAX(ks);
#pragma unroll
    for (int t = 0; t < 3; ++t) { R_DMAW(t, t, 0); R_DMAW(t, t, 1); }
    SB0();
    f32x16 acc[2][2];
#define R_ZERO() do { _Pragma("unroll") for (int ni = 0; ni < 2; ++ni) _Pragma("unroll") for (int mi = 0; mi < 2; ++mi) _Pragma("unroll") for (int r = 0; r < 16; ++r) acc[ni][mi][r] = 0.f; } while (0)
    R_ZERO();
    R_STEP(0, 0, 4, true); R_STEP(1, 1, 4, true); R_STEP(2, 2, 4, true); R_STEP(3, 3, 4, true);
    R_STEP(4, 4, 4, true); R_STEP(5, 5, 4, true); R_STEP(6, 6, 4, true); R_STEP(7, 7, 4, true);
    R_STORE(0);
#pragma nounroll
    for (int nt = 1; nt < 7; ++nt) {
        const int s0 = nt * 8;
        R_ZERO();
        R_STEP(s0 + 0, 0, 12, true); R_STEP(s0 + 1, 1, 12, true); R_STEP(s0 + 2, 2, 12, true); R_STEP(s0 + 3, 3, 4, true);
        R_STEP(s0 + 4, 4, 4, true); R_STEP(s0 + 5, 5, 4, true); R_STEP(s0 + 6, 6, 4, true); R_STEP(s0 + 7, 7, 4, true);
        R_STORE(nt);
    }
    R_ZERO();
    R_STEP(56, 0, 12, true); R_STEP(57, 1, 12, true); R_STEP(58, 2, 12, true); R_STEP(59, 3, 4, true);
    R_STEP(60, 4, 4, true); R_STEP(61, 5, 4, false); R_STEP(62, 6, 2, false); R_STEP(63, 7, 0, false);
    R_STORE(7);
#undef R_DMAX
#undef R_DMAW
#undef R_FRAG
#undef R_MMA
#undef R_STEP
#undef R_STORE
#undef R_ZERO
    __syncthreads();
}

__device__ __forceinline__ void load_row32_f32(const float* src, int lane, float (&v)[32]) {
#pragma unroll
    for (int i = 0; i < 4; ++i) {
        const f32x4 a = *(const f32x4*)(src + i * 512 + lane * 8), b = *(const f32x4*)(src + i * 512 + lane * 8 + 4);
        v[i * 8 + 0] = a[0]; v[i * 8 + 1] = a[1]; v[i * 8 + 2] = a[2]; v[i * 8 + 3] = a[3];
        v[i * 8 + 4] = b[0]; v[i * 8 + 5] = b[1]; v[i * 8 + 6] = b[2]; v[i * 8 + 7] = b[3];
    }
}
__device__ __forceinline__ void load_row32_bf16(const bf16_t* src, int lane, float (&v)[32]) {
#pragma unroll
    for (int i = 0; i < 4; ++i) {
        const u32x4 a = *(const u32x4*)(src + i * 512 + lane * 8);
        v[i * 8 + 0] = bflo(a.x); v[i * 8 + 1] = bfhi(a.x); v[i * 8 + 2] = bflo(a.y); v[i * 8 + 3] = bfhi(a.y);
        v[i * 8 + 4] = bflo(a.z); v[i * 8 + 5] = bfhi(a.z); v[i * 8 + 6] = bflo(a.w); v[i * 8 + 7] = bfhi(a.w);
    }
}
__device__ __forceinline__ void ln_row32(float (&v)[32], const float* g, const float* bb, int lane) {
    float s = 0.f;
#pragma unroll
    for (int i = 0; i < 32; ++i) s += v[i];
    const float mu = wave_sum(s) * (1.f / DM);
    float q = 0.f;
#pragma unroll
    for (int i = 0; i < 32; ++i) { const float d = v[i] - mu; q += d * d; }
    const float rstd = rsqrtf(wave_sum(q) * (1.f / DM) + LN_EPS);
#pragma unroll
    for (int i = 0; i < 4; ++i) {
        const f32x4 g0 = *(const f32x4*)(g + i * 512 + lane * 8), g1 = *(const f32x4*)(g + i * 512 + lane * 8 + 4);
        const f32x4 b0 = *(const f32x4*)(bb + i * 512 + lane * 8), b1 = *(const f32x4*)(bb + i * 512 + lane * 8 + 4);
#pragma unroll
        for (int e = 0; e < 4; ++e) {
            v[i * 8 + e] = (v[i * 8 + e] - mu) * rstd * g0[e] + b0[e];
            v[i * 8 + 4 + e] = (v[i * 8 + 4 + e] - mu) * rstd * g1[e] + b1[e];
        }
    }
}
__device__ __forceinline__ void store_row32_bf16(bf16_t* dst, int lane, const float (&v)[32]) {
#pragma unroll
    for (int i = 0; i < 4; ++i) {
        u32x4 w; w.x = cvtpk(v[i * 8 + 0], v[i * 8 + 1]); w.y = cvtpk(v[i * 8 + 2], v[i * 8 + 3]); w.z = cvtpk(v[i * 8 + 4], v[i * 8 + 5]); w.w = cvtpk(v[i * 8 + 6], v[i * 8 + 7]);
        *(u32x4*)(dst + i * 512 + lane * 8) = w;
    }
}


constexpr int WG_LDS = 0;
__device__ __forceinline__ void stage_gate_weights(unsigned char* lds, PP p, int layer) {
    float* Wg = (float*)(lds + WG_LDS);
    const float* w = p->w_in + (size_t)layer * DM * N_IN + 3072;
    const int tid = tid_here();
    for (int i = tid; i < DM * 3; i += NTHREADS) {
        const int k = i / 3, c = (i % 3) * 4;
        const f32x4 a = *(const f32x4*)(w + (size_t)k * N_IN + c);
        Wg[(c + 0) * DM + k] = a[0]; Wg[(c + 1) * DM + k] = a[1]; Wg[(c + 2) * DM + k] = a[2]; Wg[(c + 3) * DM + k] = a[3];
    }
    __syncthreads();
}
__device__ __forceinline__ void row_gates(const unsigned char* lds, PP p, int layer, int row, int lane, const float (&v)[32]) {
    const float* Wg = (const float*)(lds + WG_LDS);
    float g = 0.f;
#pragma nounroll
    for (int c = 0; c < 12; ++c) {
        float a = 0.f;
#pragma unroll
        for (int i = 0; i < 4; ++i) {
            const f32x4 w0 = *(const f32x4*)(Wg + c * DM + i * 512 + lane * 8), w1 = *(const f32x4*)(Wg + c * DM + i * 512 + lane * 8 + 4);
            a += v[i * 8 + 0] * w0[0] + v[i * 8 + 1] * w0[1] + v[i * 8 + 2] * w0[2] + v[i * 8 + 3] * w0[3]
               + v[i * 8 + 4] * w1[0] + v[i * 8 + 5] * w1[1] + v[i * 8 + 6] * w1[2] + v[i * 8 + 7] * w1[3];
        }
        a = wave_sum(a);
        g = (lane == c) ? a : g;
    }
    if (lane < 12) {
        if (lane < 6) g += p->b_igate[layer * 6 + lane];
        else g = logsigmoidf_(g + p->b_fgate[layer * 6 + lane - 6]);
        ((float*)(p->ws + WS_GATES))[(size_t)row * 12 + lane] = g;
    }
}

__device__ __forceinline__ void phase_ln_in(unsigned char* lds, PP p, int bx, int G) {
    stage_gate_weights(lds, p, 0);
    const int tid = tid_here(), lane = tid & 63, gw = bx * 8 + (tid >> 6), nw = G * 8;
    bf16_t* hb = (bf16_t*)(p->ws + WS_HB);
    for (int row = gw; row < TALL; row += nw) {
        const float* src = row < TREAL ? p->x + (size_t)row * DM : p->meta + (size_t)((row - TREAL) & 15) * DM;
        float v[32];
        load_row32_f32(src, lane, v);
        ln_row32(v, p->ln_in_g, p->ln_in_b, lane);
        store_row32_bf16(hb + (size_t)row * DM, lane, v);
        row_gates(lds, p, 0, row, lane, v);
    }
}

__device__ __forceinline__ void gates_item(unsigned char* lds_in, PP p, int layer, int item) {
    unsigned char* lds = lds_here(lds_in);
    const int tid = tid_here(), lane = tid & 63, wid = tid >> 6;
    float* Wg = (float*)lds;
    const float* w = p->w_in + (size_t)layer * DM * N_IN + 3072;
    for (int i = tid; i < DM * 3; i += NTHREADS) { const int k = i / 3, c = i % 3; *(f32x4*)(Wg + k * 12 + c * 4) = *(const f32x4*)(w + (size_t)k * N_IN + c * 4); }
    __syncthreads();
    const bf16_t* hb = (const bf16_t*)(p->ws + WS_HB);
    float* gates = (float*)(p->ws + WS_GATES);
    for (int rr = 0; rr < 4; ++rr) {
        const int row = item * 32 + wid * 4 + rr;
        if (row < TALL) {
            float acc[12];
#pragma unroll
            for (int c = 0; c < 12; ++c) acc[c] = 0.f;
            const bf16_t* xr = hb + (size_t)row * DM;
            for (int i = 0; i < 32; ++i) {
                const int k = i * 64 + lane;
                const float xv = bf2f(xr[k]);
                const f32x4 w0 = *(const f32x4*)(Wg + k * 12), w1 = *(const f32x4*)(Wg + k * 12 + 4), w2 = *(const f32x4*)(Wg + k * 12 + 8);
#pragma unroll
                for (int e = 0; e < 4; ++e) { acc[e] += xv * w0[e]; acc[4 + e] += xv * w1[e]; acc[8 + e] += xv * w2[e]; }
            }
#pragma unroll
            for (int c = 0; c < 12; ++c) acc[c] = wave_sum(acc[c]);
            if (lane < 12) {
                float v = 0.f;
#pragma unroll
                for (int c = 0; c < 12; ++c) v = (lane == c) ? acc[c] : v;
                if (lane < 6) v += p->b_igate[layer * 6 + lane];
                else v = logsigmoidf_(v + p->b_fgate[layer * 6 + lane - 6]);
                gates[(size_t)row * 12 + lane] = v;
            }
        }
    }
    __syncthreads();
}

__device__ __forceinline__ void phase_conv(PP p, int layer, int bx, int G) {
    const bf16_t* proj = (const bf16_t*)(p->ws + WS_PROJ);
    bf16_t* qkc = (bf16_t*)(p->ws + WS_QKC);
    const float* cw = p->conv_qk + (size_t)layer * 4 * 1536;
    const int total = TALL * 192;
    for (int idx = bx * NTHREADS + tid_here(); idx < total; idx += G * NTHREADS) {
        const int row = idx / 192, c0 = (idx % 192) * 8;
        int b, l;
        if (row < TREAL) { b = row >> 11; l = NMETA + (row & 2047); } else { b = (row - TREAL) >> 4; l = (row - TREAL) & 15; }
        float acc[8];
#pragma unroll
        for (int e = 0; e < 8; ++e) acc[e] = 0.f;
#pragma unroll
        for (int i = 0; i < 4; ++i) {
            const int ls = l - 3 + i;
            if (ls >= 0) {
                const u32x4 a = *(const u32x4*)(proj + (size_t)row_of(b, ls) * PROJ_W + PC_MLQK + c0);
                const f32x4 w0 = *(const f32x4*)(cw + i * 1536 + c0), w1 = *(const f32x4*)(cw + i * 1536 + c0 + 4);
                acc[0] += bflo(a.x) * w0[0]; acc[1] += bfhi(a.x) * w0[1]; acc[2] += bflo(a.y) * w0[2]; acc[3] += bfhi(a.y) * w0[3];
                acc[4] += bflo(a.z) * w1[0]; acc[5] += bfhi(a.z) * w1[1]; acc[6] += bflo(a.w) * w1[2]; acc[7] += bfhi(a.w) * w1[3];
            }
        }
        const float sc = c0 < 768 ? 0.08838834764831845f : 1.f;
#pragma unroll
        for (int e = 0; e < 8; ++e) acc[e] = siluf_(acc[e]) * sc;
        u32x4 w; w.x = cvtpk(acc[0], acc[1]); w.y = cvtpk(acc[2], acc[3]); w.z = cvtpk(acc[4], acc[5]); w.w = cvtpk(acc[6], acc[7]);
        *(u32x4*)(qkc + (size_t)row * 1536 + c0) = w;
    }
}

template <int NB>
__device__ __forceinline__ void transpose_strip(unsigned char* lds_in, const float* src, int ldsrc, int scol0, int k0, bf16_t* dst, int K, int n0) {
    unsigned char* lds = lds_here(lds_in);
    const int tid = tid_here();
    bf16_t* T = (bf16_t*)(lds + 100352);
    {
        const int k = tid >> 3, c8 = (tid & 7) * 8;
        f32x4 a[NB], b[NB];
#pragma unroll
        for (int q = 0; q < NB; ++q) { a[q] = *(const f32x4*)(src + (size_t)(k0 + k) * ldsrc + scol0 + q * 64 + c8); b[q] = *(const f32x4*)(src + (size_t)(k0 + k) * ldsrc + scol0 + q * 64 + c8 + 4); }
#pragma unroll
        for (int q = 0; q < NB; ++q) {
            bf16_t* Tq = T + (q * 64 + c8) * 66 + k;
            Tq[0 * 66] = f2bf(a[q][0]); Tq[1 * 66] = f2bf(a[q][1]); Tq[2 * 66] = f2bf(a[q][2]); Tq[3 * 66] = f2bf(a[q][3]);
            Tq[4 * 66] = f2bf(b[q][0]); Tq[5 * 66] = f2bf(b[q][1]); Tq[6 * 66] = f2bf(b[q][2]); Tq[7 * 66] = f2bf(b[q][3]);
        }
    }
    __syncthreads();
    {
        const int n = tid >> 3, k8 = (tid & 7) * 8;
#pragma unroll
        for (int q = 0; q < NB; ++q) {
            const unsigned* r = (const unsigned*)(T + (q * 64 + n) * 66 + k8);
            u32x4 w; w.x = r[0]; w.y = r[1]; w.z = r[2]; w.w = r[3];
            *(u32x4*)(dst + (size_t)(n0 + q * 64 + n) * K + k0 + k8) = w;
        }
    }
    __syncthreads();
}
__device__ __forceinline__ void phase_convert(unsigned char* lds, PP p, int bx, int G) {
    bf16_t* wt = (bf16_t*)(p->ws + WS_WT);
    constexpr int N_IN_S = 32 * 23, N_OUT_S = 32 * 8, N_S13_S = 32 * 4, N_S2_S = 8 * 8, N_PL_S = 8, PER_LAYER = N_IN_S + N_OUT_S + N_S13_S + N_S2_S + N_PL_S;
    for (int id = bx; id < DEPTH * PER_LAYER; id += G) {
        const int layer = id / PER_LAYER; int r = id % PER_LAYER;
        bf16_t* base = wt + (size_t)layer * WT_LAYER;
        if (r < N_IN_S) { const int nb = r >> 5, kb = r & 31, n0 = nb * 256; transpose_strip<4>(lds, p->w_in + (size_t)layer * DM * N_IN, N_IN, n0 < 3072 ? n0 : n0 + 12, kb * 64, base + WT_IN, DM, n0); continue; }
        r -= N_IN_S;
        if (r < N_OUT_S) { const int nb = r >> 5, kb = r & 31; transpose_strip<4>(lds, p->w_out + (size_t)layer * DM * DM, DM, nb * 256, kb * 64, base + WT_OUT, DM, nb * 256); continue; }
        r -= N_OUT_S;
        if (r < N_S13_S) { const int nb = r >> 5, kb = r & 31; transpose_strip<4>(lds, p->sh_w13 + (size_t)layer * DM * 1024, 1024, nb * 256, kb * 64, base + WT_SH13, DM, nb * 256); continue; }
        r -= N_S13_S;
        if (r < N_S2_S) { const int nb = r >> 3, kb = r & 7; transpose_strip<4>(lds, p->sh_w2 + (size_t)layer * DEXP * DM, DM, nb * 256, kb * 64, base + WT_SH2, DEXP, nb * 256); continue; }
        r -= N_S2_S;
        { const int g = r >> 1, kb = r & 1;
          transpose_strip<2>(lds, p->pool_w + ((size_t)layer * 4 + g) * 128 * 128, 128, 0, kb * 64, base + WT_POOL + (size_t)g * 128 * 128, 128, 0); }
    }
}

#define KSWZ(row, colB) ((row) * 256 + ((colB) ^ (((row) & 7) << 4)))
#define SBAR() __builtin_amdgcn_sched_barrier(0)
constexpr int MX_V = 0, MX_K = 16384, MX_BUF = 32768, MX_C = 65536, MX_MQ = MX_C + 2112 * 4, MX_EM = MX_MQ + 1024, MX_WS = MX_EM + 1024, MX_Q = 77824, MX_END = MX_Q + 65536;

__device__ __forceinline__ int v_st(int k, int c) { const int kk = (k & ~0xC) | ((k & 4) << 1) | ((k & 8) >> 1); return ((kk >> 3) * 4 + (c >> 5)) * 512 + ((kk & 7) * 32 + (c & 31)) * 2; }
__device__ __forceinline__ int v_rd_base(int lane) { return ((lane & 3) << 3) | (((lane >> 2) & 3) << 6) | (((lane >> 4) & 1) << 5) | (((lane >> 5) & 1) << 8); }
constexpr int v_rd_off(int d0, int ks, int half) { return d0 * 512 + ks * 4096 + half * 2048; }
template <int OFF> __device__ __forceinline__ s16x4 tr_read(int vb) {
    s16x4 r; asm volatile("ds_read_b64_tr_b16 %0, %1 offset:%2" : "=&v"(r) : "v"(vb), "i"(OFF) : "memory"); return r;
}
template <int D0> __device__ __forceinline__ void pv_one(f32x16& od, int vb, bf16x8 pa0, bf16x8 pa1, bf16x8 pa2, bf16x8 pa3) {
    const s16x4 l0 = tr_read<v_rd_off(D0, 0, 0)>(vb), h0 = tr_read<v_rd_off(D0, 0, 1)>(vb), l1 = tr_read<v_rd_off(D0, 1, 0)>(vb), h1 = tr_read<v_rd_off(D0, 1, 1)>(vb);
    const s16x4 l2 = tr_read<v_rd_off(D0, 2, 0)>(vb), h2 = tr_read<v_rd_off(D0, 2, 1)>(vb), l3 = tr_read<v_rd_off(D0, 3, 0)>(vb), h3 = tr_read<v_rd_off(D0, 3, 1)>(vb);
    asm volatile("s_waitcnt lgkmcnt(0)" ::: "memory"); SBAR();
#define PK(L, H) (bf16x8){L[0], L[1], L[2], L[3], H[0], H[1], H[2], H[3]}
    __builtin_amdgcn_s_setprio(1);
    od = __builtin_amdgcn_mfma_f32_32x32x16_bf16(pa0, PK(l0, h0), od, 0, 0, 0);
    od = __builtin_amdgcn_mfma_f32_32x32x16_bf16(pa1, PK(l1, h1), od, 0, 0, 0);
    od = __builtin_amdgcn_mfma_f32_32x32x16_bf16(pa2, PK(l2, h2), od, 0, 0, 0);
    od = __builtin_amdgcn_mfma_f32_32x32x16_bf16(pa3, PK(l3, h3), od, 0, 0, 0);
    __builtin_amdgcn_s_setprio(0);
#undef PK
}
__device__ __forceinline__ void qkt(f32x16& p0, f32x16& p1, const unsigned char* Ks, const unsigned char* Qw, int r32, int hi) {
#pragma unroll
    for (int r = 0; r < 16; ++r) { p0[r] = 0.f; p1[r] = 0.f; }
#pragma unroll
    for (int d0 = 0; d0 < 8; ++d0) {
        const int cb = (d0 * 16 + hi * 8) * 2;
        const bf16x8 b0 = *(const bf16x8*)(Ks + KSWZ(r32, cb));
        const bf16x8 b1 = *(const bf16x8*)(Ks + KSWZ(32 + r32, cb));
        const bf16x8 q = *(const bf16x8*)(Qw + KSWZ(r32, cb));
        p0 = __builtin_amdgcn_mfma_f32_32x32x16_bf16(b0, q, p0, 0, 0, 0);
        p1 = __builtin_amdgcn_mfma_f32_32x32x16_bf16(b1, q, p1, 0, 0, 0);
    }
}
__device__ __forceinline__ float swap_sum(float v) {
    auto rr = __builtin_amdgcn_permlane32_swap(__float_as_uint(v), __float_as_uint(v), false, false);
    return __uint_as_float(rr[0]) + __uint_as_float(rr[1]);
}

#ifndef MIXER_INLINE
#define MIXER_INLINE __forceinline__
#endif
struct MixSrc { const bf16_t* Q; int ldq; const bf16_t* K; int ldk; const bf16_t* V; int ldv; };

template <int MODE>
__device__ MIXER_INLINE void mixer_item(unsigned char* lds_in, PP p, int layer, int b, int h, int j) {
    unsigned char* lds = lds_here(lds_in);
    const int tid = tid_here(), wid = tid >> 6, lane = tid & 63, r32 = lane & 31, hi = lane >> 5;
    const bf16_t* proj = (const bf16_t*)(p->ws + WS_PROJ);
    const bf16_t* qkc = (const bf16_t*)(p->ws + WS_QKC);
    const float* gates = (const float*)(p->ws + WS_GATES);
    bf16_t* cat = (bf16_t*)(p->ws + WS_CAT);
    MixSrc S;
    if (MODE == 0) { S.Q = proj + PC_SBQ + h * HD; S.ldq = PROJ_W; S.K = proj + PC_SBK + h * HD; S.ldk = PROJ_W; S.V = proj + PC_SBV + h * HD; S.ldv = PROJ_W; }
    else { S.Q = qkc + h * HD; S.ldq = 1536; S.K = qkc + 768 + h * HD; S.ldk = 1536; S.V = proj + PC_MLV + h * HD; S.ldv = PROJ_W; }
    unsigned char* V_lds = lds + MX_V; unsigned char* K_lds = lds + MX_K;
    float* carr = (float*)(lds + MX_C); float* mqa = (float*)(lds + MX_MQ); float* ema = (float*)(lds + MX_EM);
    float* wsc = (float*)(lds + MX_WS) + wid * 64;

    const int s0 = 256 * j;
    const int qrow = b * SEQ + s0 + wid * 32 + r32;
    const int lq = NMETA + s0 + wid * 32 + r32;
    unsigned char* Qw = lds + MX_Q + wid * 32 * 256;
#pragma unroll
    for (int d0 = 0; d0 < 8; ++d0) *(bf16x8*)(Qw + KSWZ(r32, (d0 * 16 + hi * 8) * 2)) = *(const bf16x8*)(S.Q + (size_t)qrow * S.ldq + d0 * 16 + hi * 8);

    float mq = 0.f;
    if (MODE == 1) {
        const int Lend = NMETA + s0 + 256;
        if (wid == 0) {
            float csum = 0.f, cmax = -3.0e38f;
            for (int base0 = 0; base0 < Lend; base0 += 512) {
                float lfv[8], liv[8];
#pragma unroll
                for (int u = 0; u < 8; ++u) {
                    const int l = base0 + u * 64 + lane; const bool ok = l < Lend;
                    const int row = row_of(b, ok ? l : 0);
                    lfv[u] = ok ? gates[(size_t)row * 12 + 6 + h] : 0.f;
                    liv[u] = ok ? gates[(size_t)row * 12 + h] : 0.f;
                }
#pragma unroll
                for (int u = 0; u < 8; ++u) {
                    const int l = base0 + u * 64 + lane; const bool ok = l < Lend;
                    float x = lfv[u];
#pragma unroll
                    for (int o2 = 1; o2 < 64; o2 <<= 1) { const float y = __shfl_up(x, o2, 64); if (lane >= o2) x += y; }
                    const float cB = csum + x;
                    const float c = ok ? liv[u] - cB : -3.0e38f;
                    float mx = c;
#pragma unroll
                    for (int o2 = 1; o2 < 64; o2 <<= 1) { const float y = __shfl_up(mx, o2, 64); if (lane >= o2) mx = fmaxf(mx, y); }
                    const float pm = fmaxf(cmax, mx);
                    if (ok) {
                        carr[l] = c;
                        if (l >= Lend - 256) { const float m0 = fmaxf(pm, 0.f); mqa[l - (Lend - 256)] = m0; ema[l - (Lend - 256)] = __expf(-(cB + m0)); }
                    }
                    csum = __shfl(cB, 63, 64); cmax = __shfl(pm, 63, 64);
                }
            }
        }
        __syncthreads();
        mq = mqa[wid * 32 + r32];
    }

    const int ntiles = 4 * j + 5;
    const int last_tile = 1 + (s0 + 32 * wid + 31 - (MODE == 0 ? 1 : 0)) / 64;
    const int sr = tid >> 4, sc = (tid & 15) * 8;
    const int vst0 = v_st(sr, sc), vst1 = v_st(32 + sr, sc);
    const int vb0 = (int)(uintptr_t)(LAS unsigned char*)V_lds + v_rd_base(lane);
    bf16x8 vs0, vs1, ks0, ks1;
#define SLOAD(it) do { int r0_, r1_; \
        if ((it) == 0) { r0_ = TREAL + b * NMETA + (sr < NMETA ? sr : NMETA - 1); r1_ = TREAL + b * NMETA + NMETA - 1; } \
        else { r0_ = b * SEQ + 64 * ((it) - 1) + sr; r1_ = r0_ + 32; } \
        vs0 = *(const bf16x8*)(S.V + (size_t)r0_ * S.ldv + sc); vs1 = *(const bf16x8*)(S.V + (size_t)r1_ * S.ldv + sc); \
        ks0 = *(const bf16x8*)(S.K + (size_t)r0_ * S.ldk + sc); ks1 = *(const bf16x8*)(S.K + (size_t)r1_ * S.ldk + sc); } while (0)
#define SWRITE(bo) do { *(bf16x8*)(V_lds + (bo) + vst0) = vs0; *(bf16x8*)(V_lds + (bo) + vst1) = vs1; \
        *(bf16x8*)(K_lds + (bo) + KSWZ(sr, sc * 2)) = ks0; *(bf16x8*)(K_lds + (bo) + KSWZ(32 + sr, sc * 2)) = ks1; } while (0)

    f32x16 o[4];
#pragma unroll
    for (int d = 0; d < 4; ++d)
#pragma unroll
        for (int r = 0; r < 16; ++r) o[d][r] = 0.f;
    float R = (MODE == 0) ? 1.f : 0.f, den = 0.f;

    SLOAD(ntiles - 1);
    SWRITE(((ntiles - 1) & 1) * MX_BUF);
    if (ntiles > 1) SLOAD(ntiles - 2);
    for (int it = ntiles - 1; it >= 0; --it) {
        const int bo = (it & 1) * MX_BUF;
        __syncthreads();
        if (MODE == 0 && it < ntiles - 1) {
            const volatile int* fl = (const volatile int*)(lds + MX_MQ) + ((it + 1) & 1) * 8;
            const int any = fl[0] | fl[1] | fl[2] | fl[3] | fl[4] | fl[5] | fl[6] | fl[7];
            if (__builtin_amdgcn_readfirstlane(any) == 0) break;
        }
        if (it > 0) { SWRITE(MX_BUF - bo); if (it > 1) SLOAD(it - 2); }
        if (it <= last_tile) {
            f32x16 p0, p1;
            qkt(p0, p1, K_lds + bo, Qw, r32, hi);
            const int lbase = it == 0 ? 0 : NMETA + 64 * (it - 1);
            int kmax = lq - lbase + (MODE == 1 ? 1 : 0);
            const int nvalid = it == 0 ? NMETA : 64;
            kmax = kmax < nvalid ? kmax : nvalid;
            if (MODE == 0) {
                constexpr float SC = 0.08838834764831845f * 1.4426950408889634f;
                float x[32];
#pragma unroll
                for (int r = 0; r < 16; ++r) {
                    const float z0 = crow(r, hi) < kmax ? fminf(p0[r] * SC, 60.f) : -1.0e30f;
                    const float z1 = 32 + crow(r, hi) < kmax ? fminf(p1[r] * SC, 60.f) : -1.0e30f;
                    const float e0 = __builtin_amdgcn_exp2f(z0), e1 = __builtin_amdgcn_exp2f(z1);
                    const float k0 = __builtin_amdgcn_rcpf(1.f + e0), k1 = __builtin_amdgcn_rcpf(1.f + e1);
                    x[r] = k0; x[16 + r] = k1; p0[r] = e0 * k0; p1[r] = e1 * k1;
                }
                float run = R;
                float sown[8];
#pragma unroll
                for (int q = 7; q >= 0; --q) {
                    const float g = (x[4 * q] * x[4 * q + 1]) * (x[4 * q + 2] * x[4 * q + 3]);
                    auto rr = __builtin_amdgcn_permlane32_swap(__float_as_uint(g), __float_as_uint(g), false, false);
                    const float lo_q = __uint_as_float(rr[0]), up_q = __uint_as_float(rr[1]);
                    const float s_up = run; run *= up_q;
                    const float s_lo = run; run *= lo_q;
                    sown[q] = hi ? s_up : s_lo;
                }
                R = run;
#pragma unroll
                for (int q = 0; q < 8; ++q) {
                    const float E3 = sown[q], E2 = E3 * x[4 * q + 3], E1 = E2 * x[4 * q + 2], E0 = E1 * x[4 * q + 1];
                    if (q < 4) { p0[4 * q] *= E0; p0[4 * q + 1] *= E1; p0[4 * q + 2] *= E2; p0[4 * q + 3] *= E3; }
                    else { p1[4 * (q - 4)] *= E0; p1[4 * (q - 4) + 1] *= E1; p1[4 * (q - 4) + 2] *= E2; p1[4 * (q - 4) + 3] *= E3; }
                }
            } else {
#pragma unroll
                for (int q = 0; q < 8; ++q) {
                    const f32x4 c4 = *(const f32x4*)(carr + lbase + 8 * q + 4 * hi);
#pragma unroll
                    for (int i = 0; i < 4; ++i) {
                        const int kk = 8 * q + 4 * hi + i;
                        const float w = kk < kmax ? __expf(c4[i] - mq) : 0.f;
                        if (q < 4) { p0[4 * q + i] *= w; den += p0[4 * q + i]; } else { p1[4 * (q - 4) + i] *= w; den += p1[4 * (q - 4) + i]; }
                    }
                }
            }
            bf16x8 pa0, pa1, pa2, pa3;
#define PK4(P, BASE, OUT) do { unsigned a0 = cvtpk(P[BASE + 0], P[BASE + 1]), a1 = cvtpk(P[BASE + 2], P[BASE + 3]); \
        unsigned b0 = cvtpk(P[BASE + 4], P[BASE + 5]), b1 = cvtpk(P[BASE + 6], P[BASE + 7]); \
        auto r0 = __builtin_amdgcn_permlane32_swap(a0, b0, false, false); auto r1 = __builtin_amdgcn_permlane32_swap(a1, b1, false, false); \
        u32x4 w = {r0[0], r1[0], r0[1], r1[1]}; OUT = *reinterpret_cast<bf16x8*>(&w); } while (0)
            PK4(p0, 0, pa0); PK4(p0, 8, pa1); PK4(p1, 0, pa2); PK4(p1, 8, pa3);
#undef PK4
            pv_one<0>(o[0], vb0 + bo, pa0, pa1, pa2, pa3); pv_one<1>(o[1], vb0 + bo, pa0, pa1, pa2, pa3);
            pv_one<2>(o[2], vb0 + bo, pa0, pa1, pa2, pa3); pv_one<3>(o[3], vb0 + bo, pa0, pa1, pa2, pa3);
        }
        if (MODE == 0) {
            const bool alive = (it > last_tile) || (__ballot(R > 0.f) != 0ull);
            if (lane == 0) ((volatile int*)(lds + MX_MQ))[(it & 1) * 8 + wid] = alive ? 1 : 0;
        }
    }
#undef SLOAD
#undef SWRITE
    float rden[16];
    if (MODE == 1) {
        den = swap_sum(den);
        if (hi == 0) wsc[r32] = den;
        asm volatile("s_waitcnt lgkmcnt(0)" ::: "memory");
#pragma unroll
        for (int r = 0; r < 16; ++r) { const int qi = crow(r, hi); rden[r] = 1.f / fmaxf(fabsf(wsc[qi]), ema[wid * 32 + qi]); }
#pragma unroll
        for (int d = 0; d < 4; ++d)
#pragma unroll
            for (int r = 0; r < 16; ++r) o[d][r] *= rden[r];
    }
    float ss[16];
#pragma unroll
    for (int r = 0; r < 16; ++r) ss[r] = o[0][r] * o[0][r] + o[1][r] * o[1][r] + o[2][r] * o[2][r] + o[3][r] * o[3][r];
#pragma unroll
    for (int off = 1; off < 32; off <<= 1)
#pragma unroll
        for (int r = 0; r < 16; ++r) ss[r] += __shfl_xor(ss[r], off, 64);
    const float* ng = (MODE == 0 ? p->sb_norm_g : p->ml_norm_g) + layer * 768 + h * HD;
    const int ccol = (MODE == 0 ? 768 : 0) + h * HD;
    float gv[4];
#pragma unroll
    for (int d = 0; d < 4; ++d) gv[d] = ng[d * 32 + r32];
#pragma unroll
    for (int r = 0; r < 16; ++r) {
        const float rn = rsqrtf(ss[r] * (1.f / HD) + RMS_EPS);
        const int orow = b * SEQ + s0 + wid * 32 + crow(r, hi);
#pragma unroll
        for (int d = 0; d < 4; ++d) {
            float v = o[d][r] * rn * gv[d];
            if (MODE == 1) v *= sigmoidf_(bf2f(proj[(size_t)orow * PROJ_W + PC_MLO + h * HD + d * 32 + r32]));
            cat[(size_t)orow * DM + ccol + d * 32 + r32] = f2bf(v);
        }
    }
    __syncthreads();
}

template <int MODE>
__device__ __forceinline__ void mixer_meta_item(unsigned char* lds_in, PP p, int layer, int b, int h) {
    unsigned char* lds = lds_here(lds_in);
    const int tid = tid_here();
    const bf16_t* proj = (const bf16_t*)(p->ws + WS_PROJ);
    const bf16_t* qkc = (const bf16_t*)(p->ws + WS_QKC);
    const float* gates = (const float*)(p->ws + WS_GATES);
    bf16_t* cat = (bf16_t*)(p->ws + WS_CAT);
    MixSrc S;
    if (MODE == 0) { S.Q = proj + PC_SBQ + h * HD; S.ldq = PROJ_W; S.K = proj + PC_SBK + h * HD; S.ldk = PROJ_W; S.V = proj + PC_SBV + h * HD; S.ldv = PROJ_W; }
    else { S.Q = qkc + h * HD; S.ldq = 1536; S.K = qkc + 768 + h * HD; S.ldk = 1536; S.V = proj + PC_MLV + h * HD; S.ldv = PROJ_W; }
    float* Ss = (float*)lds; float* As = Ss + 256; float* dn = As + 256;
    const int row0 = TREAL + b * NMETA;
    if (tid < 256) {
        const int qi = tid >> 4, ki = tid & 15;
        const bf16_t* q = S.Q + (size_t)(row0 + qi) * S.ldq; const bf16_t* k = S.K + (size_t)(row0 + ki) * S.ldk;
        float s = 0.f;
        for (int d = 0; d < HD; ++d) s += bf2f(q[d]) * bf2f(k[d]);
        Ss[qi * 16 + ki] = s;
    }
    __syncthreads();
    if (tid < 16) {
        const int qi = tid;
        if (MODE == 0) {
            float R = 0.f;
            for (int jj = 15; jj >= 0; --jj) {
                float a = 0.f;
                if (jj < qi) {
                    const float z = Ss[qi * 16 + jj] * 0.08838834764831845f;
                    const float lk = -(fmaxf(z, 0.f) + __logf(1.f + __expf(-fabsf(z))));
                    a = __expf(z + lk + R); R += lk;
                }
                As[qi * 16 + jj] = a;
            }
            dn[qi] = 1.f;
        } else {
            float cB = 0.f, pm = -3.0e38f, cs[16];
            float cBq = 0.f;
            for (int jj = 0; jj < 16; ++jj) {
                cB += gates[(size_t)(row0 + jj) * 12 + 6 + h];
                cs[jj] = gates[(size_t)(row0 + jj) * 12 + h] - cB;
                if (jj <= qi) { pm = fmaxf(pm, cs[jj]); cBq = cB; }
            }
            const float m0 = fmaxf(pm, 0.f);
            float den = 0.f;
            for (int jj = 0; jj < 16; ++jj) {
                float a = 0.f;
                if (jj <= qi) { a = __expf(cs[jj] - m0) * Ss[qi * 16 + jj]; den += a; }
                As[qi * 16 + jj] = a;
            }
            dn[qi] = 1.f / fmaxf(fabsf(den), __expf(-(cBq + m0)));
        }
    }
    __syncthreads();
    {
        const int qi = tid >> 5, d4 = (tid & 31) * 4;
        float o[4] = {0.f, 0.f, 0.f, 0.f};
        for (int jj = 0; jj < 16; ++jj) {
            const float a = As[qi * 16 + jj];
            const u32x2 v = *(const u32x2*)(S.V + (size_t)(row0 + jj) * S.ldv + d4);
            o[0] += a * bflo(v.x); o[1] += a * bfhi(v.x); o[2] += a * bflo(v.y); o[3] += a * bfhi(v.y);
        }
        const float dd = dn[qi];
        float ss = 0.f;
#pragma unroll
        for (int e = 0; e < 4; ++e) { o[e] *= dd; ss += o[e] * o[e]; }
#pragma unroll
        for (int off = 1; off < 32; off <<= 1) ss += __shfl_xor(ss, off, 64);
        const float rn = rsqrtf(ss * (1.f / HD) + RMS_EPS);
        const float* ng = (MODE == 0 ? p->sb_norm_g : p->ml_norm_g) + layer * 768 + h * HD;
        const int ccol = (MODE == 0 ? 768 : 0) + h * HD;
        const int orow = row0 + qi;
#pragma unroll
        for (int e = 0; e < 4; ++e) {
            float v = o[e] * rn * ng[d4 + e];
            if (MODE == 1) v *= sigmoidf_(bf2f(proj[(size_t)orow * PROJ_W + PC_MLO + h * HD + d4 + e]));
            cat[(size_t)orow * DM + ccol + d4 + e] = f2bf(v);
        }
    }
    __syncthreads();
}

constexpr int PL_U = 0, PL_P = 36864, PL_W = PL_P + 32768;
__device__ __forceinline__ void pool_item(unsigned char* lds_in, PP p, int layer, int b, int pb, int g) {
    unsigned char* lds = lds_here(lds_in);
    const int tid = tid_here(), lane = tid & 63, wid = tid >> 6, r32 = lane & 31, hi = lane >> 5;
    const bf16_t* proj = (const bf16_t*)(p->ws + WS_PROJ);
    bf16_t* cat = (bf16_t*)(p->ws + WS_CAT);
    const bf16_t* wt = (const bf16_t*)(p->ws + WS_WT) + (size_t)layer * WT_LAYER + WT_POOL + (size_t)g * 128 * 128;
    const int win = 2 << g;
    const int l0 = pb * 128, nl = (LSEQ - l0) < 128 ? (LSEQ - l0) : 128;
    for (int idx = tid; idx < 143 * 16; idx += NTHREADS) {
        const int li = idx >> 4, ch = idx & 15, l = l0 - 15 + li;
        u32x4 v = {0u, 0u, 0u, 0u};
        if (l >= 0 && l < LSEQ) v = *(const u32x4*)(proj + (size_t)row_of(b, l) * PROJ_W + PC_POOL + g * 128 + ch * 8);
        *(u32x4*)(lds + PL_U + li * 256 + ch * 16) = v;
    }
    for (int idx = tid; idx < 128 * 16; idx += NTHREADS) {
        const int d = idx >> 4, ch = idx & 15;
        *(u32x4*)(lds + PL_W + KSWZ(d, ch * 16)) = *(const u32x4*)(wt + (size_t)d * 128 + ch * 8);
    }
    __syncthreads();
    {
        const int c = tid & 127, chn = tid >> 7;
        const bf16_t* U = (const bf16_t*)(lds + PL_U);
        const int i0 = chn * 32;
        float sum = 0.f;
        for (int t = 1; t < win; ++t) sum += bf2f(U[(15 + i0 - t) * 128 + c]);
        for (int i = 0; i < 32; ++i) {
            const int l = l0 + i0 + i;
            const float u = bf2f(U[(15 + i0 + i) * 128 + c]);
            sum += u;
            const int cnt = (l + 1) < win ? (l + 1) : win;
            const float pv = sum / (float)cnt - u;
            sum -= bf2f(U[(15 + i0 + i - win + 1) * 128 + c]);
            *(bf16_t*)(lds + PL_P + KSWZ(i0 + i, c * 2)) = f2bf(pv);
        }
    }
    __syncthreads();
    {
        const int rt = wid >> 1, ch2 = wid & 1;
        f32x16 acc0, acc1;
#pragma unroll
        for (int r = 0; r < 16; ++r) { acc0[r] = 0.f; acc1[r] = 0.f; }
#pragma unroll
        for (int ks = 0; ks < 8; ++ks) {
            const int cb = (ks * 16 + hi * 8) * 2;
            const bf16x8 pf = *(const bf16x8*)(lds + PL_P + KSWZ(rt * 32 + r32, cb));
            const bf16x8 w0 = *(const bf16x8*)(lds + PL_W + KSWZ(ch2 * 64 + r32, cb));
            const bf16x8 w1 = *(const bf16x8*)(lds + PL_W + KSWZ(ch2 * 64 + 32 + r32, cb));
            acc0 = __builtin_amdgcn_mfma_f32_32x32x16_bf16(w0, pf, acc0, 0, 0, 0);
            acc1 = __builtin_amdgcn_mfma_f32_32x32x16_bf16(w1, pf, acc1, 0, 0, 0);
        }
        const int li = rt * 32 + r32;
        if (li < nl) {
            bf16_t* orow = cat + (size_t)row_of(b, l0 + li) * DM + 1536 + g * 128 + ch2 * 64;
            const float* sc = p->pool_scale + layer * 512 + g * 128 + ch2 * 64;
#pragma unroll
            for (int q = 0; q < 4; ++q) {
                const int d0 = 8 * q + 4 * hi;
                const f32x4 s0 = *(const f32x4*)(sc + d0), s1 = *(const f32x4*)(sc + 32 + d0);
                u32x2 w0, w1;
                w0.x = cvtpk(acc0[4 * q] * s0[0], acc0[4 * q + 1] * s0[1]); w0.y = cvtpk(acc0[4 * q + 2] * s0[2], acc0[4 * q + 3] * s0[3]);
                w1.x = cvtpk(acc1[4 * q] * s1[0], acc1[4 * q + 1] * s1[1]); w1.y = cvtpk(acc1[4 * q + 2] * s1[2], acc1[4 * q + 3] * s1[3]);
                *(u32x2*)(orow + d0) = w0; *(u32x2*)(orow + 32 + d0) = w1;
            }
        }
    }
    __syncthreads();
}

template <int NMI> struct EpiResid {
    const bf16_t* H; bf16_t* O; int orow0; int nrows; int oc0, oc1;
    __device__ __forceinline__ void pre(int, int) {}
    __device__ __forceinline__ void pin() {}
    __device__ __forceinline__ void operator()(const f32x16 (&acc)[2][NMI], int wr, int wc, int r32, int hi, int = 0) const {
#pragma unroll
        for (int mi = 0; mi < NMI; ++mi) {
            const int tr = (2 * mi + wr) * 32 + r32;
            if (tr < nrows) {
#pragma unroll
                for (int ni = 0; ni < 2; ++ni) {
                    const size_t o = (size_t)(orow0 + tr) * DM + (ni ? oc1 : oc0) + wc * 32 + 16 * hi;
                    const u32x4 h0 = *(const u32x4*)(H + o), h1 = *(const u32x4*)(H + o + 8);
                    const f32x16& a = acc[ni][mi];
                    u32x4 w0, w1;
                    w0.x = cvtpk(DN_ALPHA * bflo(h0.x) + a[0], DN_ALPHA * bfhi(h0.x) + a[1]); w0.y = cvtpk(DN_ALPHA * bflo(h0.y) + a[2], DN_ALPHA * bfhi(h0.y) + a[3]);
                    w0.z = cvtpk(DN_ALPHA * bflo(h0.z) + a[4], DN_ALPHA * bfhi(h0.z) + a[5]); w0.w = cvtpk(DN_ALPHA * bflo(h0.w) + a[6], DN_ALPHA * bfhi(h0.w) + a[7]);
                    w1.x = cvtpk(DN_ALPHA * bflo(h1.x) + a[8], DN_ALPHA * bfhi(h1.x) + a[9]); w1.y = cvtpk(DN_ALPHA * bflo(h1.y) + a[10], DN_ALPHA * bfhi(h1.y) + a[11]);
                    w1.z = cvtpk(DN_ALPHA * bflo(h1.z) + a[12], DN_ALPHA * bfhi(h1.z) + a[13]); w1.w = cvtpk(DN_ALPHA * bflo(h1.w) + a[14], DN_ALPHA * bfhi(h1.w) + a[15]);
                    *(u32x4*)(O + o) = w0; *(u32x4*)(O + o + 8) = w1;
                }
            }
        }
    }
};

constexpr int RX_STRIDE = 4112;
constexpr int RT_XN = 0, RT_PART = 0, RT_LG = 32 * RX_STRIDE, RT_ST = RT_LG + 8192, RT_HIST = RT_ST + 256, RT_BASE = RT_HIST + 256, RT_END = RT_BASE + 256;
static_assert(RT_END <= LDS_BYTES - 64, "router LDS");
__device__ __forceinline__ void split_bf16x8(const float (&x)[8], bf16x8& h, bf16x8& l) {
    u32x4 hw, lw;
    hw.x = cvtpk(x[0], x[1]); hw.y = cvtpk(x[2], x[3]); hw.z = cvtpk(x[4], x[5]); hw.w = cvtpk(x[6], x[7]);
    lw.x = cvtpk(x[0] - bflo(hw.x), x[1] - bfhi(hw.x)); lw.y = cvtpk(x[2] - bflo(hw.y), x[3] - bfhi(hw.y));
    lw.z = cvtpk(x[4] - bflo(hw.z), x[5] - bfhi(hw.z)); lw.w = cvtpk(x[6] - bflo(hw.w), x[7] - bfhi(hw.w));
    h = *reinterpret_cast<bf16x8*>(&hw); l = *reinterpret_cast<bf16x8*>(&lw);
}
__device__ __forceinline__ void router_preformat(PP p, int bx, int G) {
    const int tid = tid_here();
    for (int idx = bx * NTHREADS + tid; idx < DEPTH * 128 * 64; idx += G * NTHREADS) {
        const int lane = idx & 63, ksg = (idx >> 6) & 127, layer = idx >> 13, r32 = lane & 31, k0 = ksg * 16 + (lane >> 5) * 8;
        const float* rw = p->router_w + (size_t)layer * DM * NEXP;
        float w0[8], w1[8];
#pragma unroll
        for (int j = 0; j < 8; ++j) { w0[j] = rw[(size_t)(k0 + j) * NEXP + r32]; w1[j] = rw[(size_t)(k0 + j) * NEXP + 32 + r32]; }
        bf16x8 wh0, wl0, wh1, wl1; split_bf16x8(w0, wh0, wl0); split_bf16x8(w1, wh1, wl1);
        u32x4* dst = (u32x4*)(p->ws + WS_RWF + (size_t)layer * RWF_LAYER) + (size_t)(ksg * 4) * 64 + lane;
        dst[0] = __builtin_bit_cast(u32x4, wh0); dst[64] = __builtin_bit_cast(u32x4, wl0); dst[128] = __builtin_bit_cast(u32x4, wh1); dst[192] = __builtin_bit_cast(u32x4, wl1);
    }
}
__device__ __forceinline__ void router_item(unsigned char* lds_in, PP p, int layer, int item, int M) {
    unsigned char* lds = lds_here(lds_in);
    const int tid = tid_here(), lane = tid & 63, wid = tid >> 6, r32 = lane & 31, hi = lane >> 5;
    const bf16_t* S1 = (const bf16_t*)(p->ws + WS_S1);
    bf16_t* H1 = (bf16_t*)(p->ws + WS_H1);
    float* part = (float*)(lds + RT_PART);
    float* lgs = (float*)(lds + RT_LG);
    int* hist = (int*)(lds + RT_HIST); int* basev = (int*)(lds + RT_BASE);
    const float* g1 = p->ln1_g + layer * DM; const float* b1 = p->ln1_b + layer * DM;
    if (tid < 64) hist[tid] = 0;
    f32x16 d0, d1;
    {
        u32x4 raw[4][4];
#pragma unroll
        for (int rr = 0; rr < 4; ++rr) {
            const int row = item * 32 + wid * 4 + rr, rowc = row < M ? row : M - 1;
#pragma unroll
            for (int i = 0; i < 4; ++i) raw[rr][i] = *(const u32x4*)(S1 + (size_t)rowc * DM + i * 512 + lane * 8);
        }
        float mu[4], rs[4];
#pragma unroll
        for (int rr = 0; rr < 4; ++rr) {
            float s = 0.f;
#pragma unroll
            for (int i = 0; i < 4; ++i) s += (bflo(raw[rr][i].x) + bfhi(raw[rr][i].x)) + (bflo(raw[rr][i].y) + bfhi(raw[rr][i].y)) + (bflo(raw[rr][i].z) + bfhi(raw[rr][i].z)) + (bflo(raw[rr][i].w) + bfhi(raw[rr][i].w));
            mu[rr] = wave_sum(s) * (1.f / DM);
            float q = 0.f;
#pragma unroll
            for (int i = 0; i < 4; ++i) {
                const unsigned ww[4] = {raw[rr][i].x, raw[rr][i].y, raw[rr][i].z, raw[rr][i].w};
#pragma unroll
                for (int e = 0; e < 4; ++e) { const float da = bflo(ww[e]) - mu[rr], db = bfhi(ww[e]) - mu[rr]; q += da * da + db * db; }
            }
            rs[rr] = rsqrtf(wave_sum(q) * (1.f / DM) + LN_EPS);
        }
#pragma unroll
        for (int r = 0; r < 16; ++r) { d0[r] = 0.f; d1[r] = 0.f; }
        const u32x4* wf = (const u32x4*)(p->ws + WS_RWF + (size_t)layer * RWF_LAYER);
#pragma unroll
        for (int h = 0; h < 2; ++h) {
#pragma unroll
            for (int ii = 0; ii < 2; ++ii) {
                const int i = 2 * h + ii;
                const f32x4 ga = *(const f32x4*)(g1 + i * 512 + lane * 8), gb = *(const f32x4*)(g1 + i * 512 + lane * 8 + 4);
                const f32x4 ba = *(const f32x4*)(b1 + i * 512 + lane * 8), bb = *(const f32x4*)(b1 + i * 512 + lane * 8 + 4);
#pragma unroll
                for (int rr = 0; rr < 4; ++rr) {
                    const int lr = wid * 4 + rr, row = item * 32 + lr;
                    const u32x4 a = raw[rr][i];
                    float x[8];
                    x[0] = (bflo(a.x) - mu[rr]) * rs[rr] * ga[0] + ba[0]; x[1] = (bfhi(a.x) - mu[rr]) * rs[rr] * ga[1] + ba[1];
                    x[2] = (bflo(a.y) - mu[rr]) * rs[rr] * ga[2] + ba[2]; x[3] = (bfhi(a.y) - mu[rr]) * rs[rr] * ga[3] + ba[3];
                    x[4] = (bflo(a.z) - mu[rr]) * rs[rr] * gb[0] + bb[0]; x[5] = (bfhi(a.z) - mu[rr]) * rs[rr] * gb[1] + bb[1];
                    x[6] = (bflo(a.w) - mu[rr]) * rs[rr] * gb[2] + bb[2]; x[7] = (bfhi(a.w) - mu[rr]) * rs[rr] * gb[3] + bb[3];
                    if (row < M) {
                        u32x4 hw; hw.x = cvtpk(x[0], x[1]); hw.y = cvtpk(x[2], x[3]); hw.z = cvtpk(x[4], x[5]); hw.w = cvtpk(x[6], x[7]);
                        *(u32x4*)(H1 + (size_t)row * DM + i * 512 + lane * 8) = hw;
                        u32x2 qw; qw.x = pk4_fp8(x[0], x[1], x[2], x[3]); qw.y = pk4_fp8(x[4], x[5], x[6], x[7]);
                        *(u32x2*)(p->ws + WS_H1Q + (size_t)row * DM + i * 512 + lane * 8) = qw;
                    }
                    float* xd = (float*)(lds + RT_XN + lr * RX_STRIDE) + ii * 512 + lane * 8;
                    *(f32x4*)xd = (f32x4){x[0], x[1], x[2], x[3]}; *(f32x4*)(xd + 4) = (f32x4){x[4], x[5], x[6], x[7]};
                }
            }
            __syncthreads();
#pragma unroll
            for (int ks = 0; ks < 8; ++ks) {
                const float* xs = (const float*)(lds + RT_XN + r32 * RX_STRIDE) + wid * 128 + ks * 16 + hi * 8;
                const f32x4 xa = *(const f32x4*)xs, xb = *(const f32x4*)(xs + 4);
                const float x[8] = {xa[0], xa[1], xa[2], xa[3], xb[0], xb[1], xb[2], xb[3]};
                bf16x8 xh, xl; split_bf16x8(x, xh, xl);
                const u32x4* wp = wf + (size_t)((h * 64 + wid * 8 + ks) * 4) * 64 + lane;
                const u32x4 q0 = wp[0], q1 = wp[64], q2 = wp[128], q3 = wp[192];
                const bf16x8 wh0 = __builtin_bit_cast(bf16x8, q0), wl0 = __builtin_bit_cast(bf16x8, q1), wh1 = __builtin_bit_cast(bf16x8, q2), wl1 = __builtin_bit_cast(bf16x8, q3);
                d0 = __builtin_amdgcn_mfma_f32_32x32x16_bf16(xh, wh0, d0, 0, 0, 0); d1 = __builtin_amdgcn_mfma_f32_32x32x16_bf16(xh, wh1, d1, 0, 0, 0);
                d0 = __builtin_amdgcn_mfma_f32_32x32x16_bf16(xh, wl0, d0, 0, 0, 0); d1 = __builtin_amdgcn_mfma_f32_32x32x16_bf16(xh, wl1, d1, 0, 0, 0);
                d0 = __builtin_amdgcn_mfma_f32_32x32x16_bf16(xl, wh0, d0, 0, 0, 0); d1 = __builtin_amdgcn_mfma_f32_32x32x16_bf16(xl, wh1, d1, 0, 0, 0);
            }
            __syncthreads();
        }
#pragma unroll
        for (int r = 0; r < 16; ++r) { part[(wid * 32 + crow(r, hi)) * 64 + r32] = d0[r]; part[(wid * 32 + crow(r, hi)) * 64 + 32 + r32] = d1[r]; }
    }
    __syncthreads();
    {
        f32x4 sum = *(const f32x4*)(part + tid * 4);
#pragma unroll
        for (int w = 1; w < 8; ++w) { const f32x4 t = *(const f32x4*)(part + w * 2048 + tid * 4); sum[0] += t[0]; sum[1] += t[1]; sum[2] += t[2]; sum[3] += t[3]; }
        *(f32x4*)(lgs + tid * 4) = sum;
    }
    __syncthreads();
    float lg[4];
#pragma unroll
    for (int rr = 0; rr < 4; ++rr) lg[rr] = lgs[(wid * 4 + rr) * 64 + lane];
    const float bias = p->router_bias[layer * NEXP + lane];
    int my_e[4], my_rank[4]; float my_g[4];
    for (int rr = 0; rr < 4; ++rr) {
        const int row = item * 32 + wid * 4 + rr;
        const float score = 1.f / (1.f + __expf(-lg[rr]));
        float sel = score + bias;
        int e_k = 0; float s_k = 0.f; float ssum = 0.f;
        for (int k = 0; k < TOPK; ++k) {
            const float m = wave_max(sel);
            const unsigned long long bal = __ballot(sel == m);
            const int idx = __ffsll((long long)bal) - 1;
            const float sc = __shfl(score, idx, 64);
            ssum += sc;
            if (lane == k) { e_k = idx; s_k = sc; }
            if (lane == idx) sel = -3.0e38f;
        }
        my_e[rr] = e_k; my_g[rr] = s_k / ssum * ROUTED_SCALE; my_rank[rr] = 0;
        if (lane < TOPK && row < M) my_rank[rr] = atomicAdd(&hist[e_k], 1);
    }
    __syncthreads();
    int* cnt = (int*)(p->ws + WS_CTL + CTL_CNT) + layer * CNT_LAYER;
    if (tid < 64) basev[tid] = atomicAdd(&cnt[tid * CNT_STRIDE], hist[tid]);
    __syncthreads();
    int* asg_e = (int*)(p->ws + WS_ASGE); int* asg_s = (int*)(p->ws + WS_ASGS);
    int* tokl = (int*)(p->ws + WS_TOKL); float* gatel = (float*)(p->ws + WS_GATEL);
    for (int rr = 0; rr < 4; ++rr) {
        const int row = item * 32 + wid * 4 + rr;
        if (lane < TOPK && row < M) {
            const int e = my_e[rr], slot = basev[e] + my_rank[rr];
            asg_e[row * 8 + lane] = e; asg_s[row * 8 + lane] = slot;
            tokl[(size_t)e * TALL + slot] = row; gatel[(size_t)e * TALL + slot] = my_g[rr];
        }
    }
    __syncthreads();
}

constexpr int MS_BASE = G_LDS_END;
constexpr int MS_CNT = MS_BASE, MS_OFF = MS_BASE + 66 * 4, MS_TP = MS_BASE + 132 * 4, MS_END = MS_BASE + 200 * 4;
__device__ __forceinline__ void moe_tables(unsigned char* lds, PP p, int layer, int M, int tmrows = TM) {
    int* c = (int*)(lds + MS_CNT); int* o = (int*)(lds + MS_OFF); int* tp = (int*)(lds + MS_TP);
    const int tid = tid_here();
    if (tid < 64) {
        const int* cnt = (const int*)(p->ws + WS_CTL + CTL_CNT) + layer * CNT_LAYER;
        const int n = __hip_atomic_load(&cnt[tid * CNT_STRIDE], __ATOMIC_RELAXED, __HIP_MEMORY_SCOPE_AGENT);
        const int nt = (n + tmrows - 1) / tmrows;
        int so = n, st = nt;
#pragma unroll
        for (int d = 1; d < 64; d <<= 1) { const int a = __shfl_up(so, d, 64), b2 = __shfl_up(st, d, 64); if (tid >= d) { so += a; st += b2; } }
        c[tid] = n; o[tid] = so - n; tp[tid] = st - nt;
        if (tid == 63) { c[64] = M; o[64] = SH_BASE; tp[64] = st; tp[65] = st; }
    }
    __syncthreads();
}
__device__ __forceinline__ void moe_decode(const unsigned char* lds, int id, int ntn, int& e, int& nt, int& m) {
    const int* tp = (const int*)(lds + MS_TP);
    int lo = 0;
#pragma unroll
    for (int step = 32; step >= 1; step >>= 1) { const int cand = lo + step; if (cand <= 63 && tp[cand] * ntn <= id) lo = cand; }
    e = __builtin_amdgcn_readfirstlane(lo); const int rem = id - __builtin_amdgcn_readfirstlane(tp[e]) * ntn, nm = __builtin_amdgcn_readfirstlane(tp[e + 1] - tp[e]);
    nt = __builtin_amdgcn_readfirstlane(rem / nm); m = __builtin_amdgcn_readfirstlane(rem % nm);
}

template <int NMI> struct EpiSwiglu {
    bf16_t* O; int orow0; int nrows; int oc;
    __device__ __forceinline__ void pre(int, int) {}
    __device__ __forceinline__ void pin() {}
    __device__ __forceinline__ void operator()(const f32x16 (&acc)[2][NMI], int wr, int wc, int r32, int hi, int pass = 0) const {
#pragma unroll
        for (int mi = 0; mi < NMI; ++mi) {
            const int tr = (2 * mi + wr) * 32 + r32;
            if (tr < nrows) {
                float v[16];
#pragma unroll
                for (int r = 0; r < 16; ++r) { const float gte = acc[0][mi][r]; v[r] = gte / (1.f + __expf(-gte)) * acc[1][mi][r]; }
                u32x4 w0, w1;
                w0.x = cvtpk(v[0], v[1]); w0.y = cvtpk(v[2], v[3]); w0.z = cvtpk(v[4], v[5]); w0.w = cvtpk(v[6], v[7]);
                w1.x = cvtpk(v[8], v[9]); w1.y = cvtpk(v[10], v[11]); w1.z = cvtpk(v[12], v[13]); w1.w = cvtpk(v[14], v[15]);
                bf16_t* q = O + (size_t)(orow0 + tr) * DEXP + oc + pass * 128 + wc * 32 + 16 * hi;
                *(u32x4*)q = w0; *(u32x4*)(q + 8) = w1;
            }
        }
    }
};
template <int NMI> struct EpiScaleStore {
    bf16_t* O; int orow0; int nrows; int oc0, oc1; const float* gate;
    float gpre[NMI];
    __device__ __forceinline__ void pre(int wr, int r32) {
#pragma unroll
        for (int mi = 0; mi < NMI; ++mi) gpre[mi] = gate ? gate[(2 * mi + wr) * 32 + r32] : 1.f;
    }
    __device__ __forceinline__ void pin() {
#pragma unroll
        for (int mi = 0; mi < NMI; ++mi) asm volatile("" : "+v"(gpre[mi]));
    }
    __device__ __forceinline__ void operator()(const f32x16 (&acc)[2][NMI], int wr, int wc, int r32, int hi, int pass = 0) const {
#pragma unroll
        for (int mi = 0; mi < NMI; ++mi) {
            const int tr = (2 * mi + wr) * 32 + r32;
            if (tr < nrows) {
                const float gsc = gpre[mi];
#pragma unroll
                for (int ni = 0; ni < 2; ++ni) {
                    const f32x16& a = acc[ni][mi];
                    u32x4 w0, w1;
                    w0.x = cvtpk(a[0] * gsc, a[1] * gsc); w0.y = cvtpk(a[2] * gsc, a[3] * gsc); w0.z = cvtpk(a[4] * gsc, a[5] * gsc); w0.w = cvtpk(a[6] * gsc, a[7] * gsc);
                    w1.x = cvtpk(a[8] * gsc, a[9] * gsc); w1.y = cvtpk(a[10] * gsc, a[11] * gsc); w1.z = cvtpk(a[12] * gsc, a[13] * gsc); w1.w = cvtpk(a[14] * gsc, a[15] * gsc);
                    bf16_t* q = O + (size_t)(orow0 + tr) * DM + (ni ? oc1 : oc0) + pass * 256 + wc * 32 + 16 * hi;
                    *(u32x4*)q = w0; *(u32x4*)(q + 8) = w1;
                }
            }
        }
    }
};

__device__ __forceinline__ void moe_gemm1_item(unsigned char* lds_in, PP p, int layer, int id) {
    unsigned char* lds = lds_here(lds_in);
    int e, nt, m; moe_decode(lds, id, 4, e, nt, m);
    const int* c = (const int*)(lds + MS_CNT); const int* o = (const int*)(lds + MS_OFF);
    const int cnt = __builtin_amdgcn_readfirstlane(c[e]), nvalid = (cnt - m * TM) < TM ? (cnt - m * TM) : TM;
    const int oe = __builtin_amdgcn_readfirstlane(o[e]);
    int* rows = (int*)(lds + G_ROWS);
    { const int t_ = tid_here();
      if (t_ < TM) {
        const int slot = m * TM + (t_ < nvalid ? t_ : nvalid - 1);
        rows[t_] = ((const int*)(p->ws + WS_TOKL))[(size_t)e * TALL + slot];
      } }
    __syncthreads();
    const float* W = p->exp_w13 + ((size_t)layer * 64 + e) * DM * 1024;
    GemmOp g{(const bf16_t*)(p->ws + WS_H1), DM, W, 1024, nt * 128, 512 + nt * 128, DM, 128};
    EpiSwiglu<3> ep{(bf16_t*)(p->ws + WS_ACT), oe + m * TM, nvalid, nt * 128};
    gemm_tile<1>(lds, g, ep);
}
__device__ __forceinline__ void moe_gemm2_item(unsigned char* lds_in, PP p, int layer, int id) {
    unsigned char* lds = lds_here(lds_in);
    int e, nt, m; moe_decode(lds, id, 4, e, nt, m); nt *= 2;
    const int* c = (const int*)(lds + MS_CNT); const int* o = (const int*)(lds + MS_OFF);
    const int cnt = __builtin_amdgcn_readfirstlane(c[e]), nvalid = (cnt - m * TM) < TM ? (cnt - m * TM) : TM;
    const int pos0 = __builtin_amdgcn_readfirstlane(o[e]) + m * TM;
    int* rows = (int*)(lds + G_ROWS);
    { const int t_ = tid_here(); if (t_ < TM) rows[t_] = pos0 + (t_ < nvalid ? t_ : nvalid - 1); }
    __syncthreads();
    const float* W = p->exp_w2 + ((size_t)layer * 64 + e) * DEXP * DM;
    GemmOp g{(const bf16_t*)(p->ws + WS_ACT), DEXP, W, DM, nt * 256, nt * 256 + 128, DEXP, 256};
    EpiScaleStore<3> ep{(bf16_t*)(p->ws + WS_Y), pos0, nvalid, nt * 256, nt * 256 + 128, (const float*)(p->ws + WS_GATEL) + (size_t)e * TALL + m * TM, {}};
    gemm_tile<2>(lds, g, ep);
}


constexpr int ST_ROWB = 528;
__device__ __forceinline__ void stage_put(unsigned char* lds, const f32x16& a, float sc, int row, int col) {
    u32x4 w0, w1;
    w0.x = cvtpk(a[0] * sc, a[1] * sc); w0.y = cvtpk(a[2] * sc, a[3] * sc); w0.z = cvtpk(a[4] * sc, a[5] * sc); w0.w = cvtpk(a[6] * sc, a[7] * sc);
    w1.x = cvtpk(a[8] * sc, a[9] * sc); w1.y = cvtpk(a[10] * sc, a[11] * sc); w1.z = cvtpk(a[12] * sc, a[13] * sc); w1.w = cvtpk(a[14] * sc, a[15] * sc);
    *(u32x4*)(lds + row * ST_ROWB + col * 2) = w0; *(u32x4*)(lds + row * ST_ROWB + col * 2 + 16) = w1;
}
struct EpiStoreBf16S {
    unsigned char* lds; bf16_t* O; int ldo; int orow0; int nrows; int oc0;
    __device__ __forceinline__ void pre(int, int) {}
    __device__ __forceinline__ void pin() {}
    __device__ __forceinline__ void operator()(const f32x16 (&acc)[2][4], int wr, int wc, int r32, int hi, int = 0) const {
#pragma unroll
        for (int mi = 0; mi < 4; ++mi)
#pragma unroll
            for (int ni = 0; ni < 2; ++ni) stage_put(lds, acc[ni][mi], 1.f, (2 * mi + wr) * 32 + r32, ni * 128 + wc * 32 + 16 * hi);
        __syncthreads();
        const int tid = tid_here();
#pragma unroll 4
        for (int i = 0; i < 16; ++i) {
            const int c = i * 512 + tid, row = c >> 5, ch = c & 31;
            if (row < nrows) *(u32x4*)(O + (size_t)(orow0 + row) * ldo + oc0 + ch * 8) = *(const u32x4*)(lds + row * ST_ROWB + ch * 16);
        }
    }
};

struct EpiConvS {
    unsigned char* lds; bf16_t* Q; const float* cw; int u0; int oc0;
    __device__ __forceinline__ void pre(int, int) {}
    __device__ __forceinline__ void pin() {}
    __device__ __forceinline__ void operator()(const f32x16 (&acc)[2][4], int wr, int wc, int r32, int hi, int = 0) const {
#pragma unroll
        for (int mi = 0; mi < 4; ++mi)
#pragma unroll
            for (int ni = 0; ni < 2; ++ni) stage_put(lds, acc[ni][mi], 1.f, (2 * mi + wr) * 32 + r32, ni * 128 + wc * 32 + 16 * hi);
        __syncthreads();
        const int tid = tid_here();
#pragma nounroll
        for (int i = 0; i < 16; ++i) {
            const int c = i * 512 + tid, row = c >> 5, ch = c & 31, u = u0 + row;
            if (row >= 3 && u < NB * LSEQ) {
                const int b = u / LSEQ, l = u - b * LSEQ, col = oc0 + ch * 8;
                float a8[8];
#pragma unroll
                for (int e = 0; e < 8; ++e) a8[e] = 0.f;
#pragma unroll
                for (int t = 0; t < 4; ++t) {
                    if (l - 3 + t >= 0) {
                        const u32x4 x = *(const u32x4*)(lds + (row - 3 + t) * ST_ROWB + ch * 16);
                        const f32x4 w0 = *(const f32x4*)(cw + t * 1536 + col), w1 = *(const f32x4*)(cw + t * 1536 + col + 4);
                        a8[0] += bflo(x.x) * w0[0]; a8[1] += bfhi(x.x) * w0[1]; a8[2] += bflo(x.y) * w0[2]; a8[3] += bfhi(x.y) * w0[3];
                        a8[4] += bflo(x.z) * w1[0]; a8[5] += bfhi(x.z) * w1[1]; a8[6] += bflo(x.w) * w1[2]; a8[7] += bfhi(x.w) * w1[3];
                    }
                }
                const float sc = col < 768 ? 0.08838834764831845f : 1.f;
#pragma unroll
                for (int e = 0; e < 8; ++e) a8[e] = siluf_(a8[e]) * sc;
                u32x4 w; w.x = cvtpk(a8[0], a8[1]); w.y = cvtpk(a8[2], a8[3]); w.z = cvtpk(a8[4], a8[5]); w.w = cvtpk(a8[6], a8[7]);
                *(u32x4*)(Q + (size_t)row_of(b, l) * 1536 + col) = w;
            }
        }
    }
};
struct EpiResidS {
    unsigned char* lds; const bf16_t* H; bf16_t* O; int orow0; int nrows; int oc0;
    __device__ __forceinline__ void pre(int, int) {}
    __device__ __forceinline__ void pin() {}
    __device__ __forceinline__ void operator()(const f32x16 (&acc)[2][4], int wr, int wc, int r32, int hi, int = 0) const {
#pragma unroll
        for (int mi = 0; mi < 4; ++mi)
#pragma unroll
            for (int ni = 0; ni < 2; ++ni) stage_put(lds, acc[ni][mi], 1.f, (2 * mi + wr) * 32 + r32, ni * 128 + wc * 32 + 16 * hi);
        __syncthreads();
        const int tid = tid_here();
#pragma unroll 4
        for (int i = 0; i < 16; ++i) {
            const int c = i * 512 + tid, row = c >> 5, ch = c & 31;
            if (row < nrows) {
                const size_t o = (size_t)(orow0 + row) * DM + oc0 + ch * 8;
                const u32x4 a = *(const u32x4*)(lds + row * ST_ROWB + ch * 16), h = *(const u32x4*)(H + o);
                u32x4 w;
                w.x = cvtpk(DN_ALPHA * bflo(h.x) + bflo(a.x), DN_ALPHA * bfhi(h.x) + bfhi(a.x)); w.y = cvtpk(DN_ALPHA * bflo(h.y) + bflo(a.y), DN_ALPHA * bfhi(h.y) + bfhi(a.y));
                w.z = cvtpk(DN_ALPHA * bflo(h.z) + bflo(a.z), DN_ALPHA * bfhi(h.z) + bfhi(a.z)); w.w = cvtpk(DN_ALPHA * bflo(h.w) + bflo(a.w), DN_ALPHA * bfhi(h.w) + bfhi(a.w));
                *(u32x4*)(O + o) = w;
            }
        }
    }
};

__device__ __forceinline__ void outproj_meta_item(unsigned char* lds_in, PP p, int layer, int item) {
    unsigned char* lds = lds_here(lds_in);
    const int tid = tid_here(), lane = tid & 63, wid = tid >> 6, r32 = lane & 31, hi = lane >> 5;
    const int row0 = TREAL + (item & 1) * 32, col0 = (item >> 1) * 32;
    const bf16_t* X = (const bf16_t*)(p->ws + WS_CAT) + (size_t)(row0 + r32) * DM + wid * 256 + hi * 8;
    const bf16_t* W = (const bf16_t*)(p->ws + WS_WT) + (size_t)layer * WT_LAYER + WT_OUT + (size_t)(col0 + r32) * DM + wid * 256 + hi * 8;
    f32x16 d;
#pragma unroll
    for (int r = 0; r < 16; ++r) d[r] = 0.f;
#pragma unroll
    for (int ks = 0; ks < 16; ++ks) {
        const bf16x8 a = *(const bf16x8*)(X + ks * 16), b = *(const bf16x8*)(W + ks * 16);
        d = __builtin_amdgcn_mfma_f32_32x32x16_bf16(a, b, d, 0, 0, 0);
    }
    float* part = (float*)lds;
#pragma unroll
    for (int r = 0; r < 16; ++r) part[(wid * 32 + crow(r, hi)) * 32 + r32] = d[r];
    __syncthreads();
    {
        const int row = tid >> 4, c2 = (tid & 15) * 2;
        float s0 = 0.f, s1 = 0.f;
#pragma unroll
        for (int w = 0; w < 8; ++w) { const f32x2 t = *(const f32x2*)(part + (w * 32 + row) * 32 + c2); s0 += t[0]; s1 += t[1]; }
        const size_t o = (size_t)(row0 + row) * DM + col0 + c2;
        const unsigned h = *(const unsigned*)((const bf16_t*)(p->ws + WS_HB) + o);
        *(unsigned*)((bf16_t*)(p->ws + WS_S1) + o) = cvtpk(DN_ALPHA * bflo(h) + s0, DN_ALPHA * bfhi(h) + s1);
    }
    __syncthreads();
}

constexpr float YQ_SCALE = 8.f;
struct EpiScaleStoreQ8 {
    unsigned char* lds; unsigned char* O; int orow0; int nrows; int oc0; const float* gate;
    float gpre[4];
    __device__ __forceinline__ void pre(int wr, int r32) {
#pragma unroll
        for (int mi = 0; mi < 4; ++mi) gpre[mi] = (gate ? gate[(2 * mi + wr) * 32 + r32] : 1.f) * YQ_SCALE;
    }
    __device__ __forceinline__ void pin() {}
    __device__ __forceinline__ void operator()(const f32x16 (&acc)[2][4], int wr, int wc, int r32, int hi, int = 0) const {
#pragma unroll
        for (int mi = 0; mi < 4; ++mi)
#pragma unroll
            for (int ni = 0; ni < 2; ++ni) {
                const f32x16& a = acc[ni][mi]; const float sc = gpre[mi];
                u32x4 w; w.x = pk4_fp8(a[0] * sc, a[1] * sc, a[2] * sc, a[3] * sc); w.y = pk4_fp8(a[4] * sc, a[5] * sc, a[6] * sc, a[7] * sc);
                w.z = pk4_fp8(a[8] * sc, a[9] * sc, a[10] * sc, a[11] * sc); w.w = pk4_fp8(a[12] * sc, a[13] * sc, a[14] * sc, a[15] * sc);
                *(u32x4*)(lds + ((2 * mi + wr) * 32 + r32) * 272 + ni * 128 + wc * 32 + 16 * hi) = w;
            }
        __syncthreads();
        const int tid = tid_here();
#pragma unroll 4
        for (int i = 0; i < 8; ++i) {
            const int c = i * 512 + tid, row = c >> 4, ch = c & 15;
            if (row < nrows) *(u32x4*)(O + (size_t)(orow0 + row) * DM + oc0 + ch * 16) = *(const u32x4*)(lds + row * 272 + ch * 16);
        }
    }
};
struct EpiScaleStoreS {
    unsigned char* lds; bf16_t* O; int orow0; int nrows; int oc0; const float* gate;
    float gpre[4];
    __device__ __forceinline__ void pre(int wr, int r32) {
#pragma unroll
        for (int mi = 0; mi < 4; ++mi) gpre[mi] = gate ? gate[(2 * mi + wr) * 32 + r32] : 1.f;
    }
    __device__ __forceinline__ void pin() {}
    __device__ __forceinline__ void operator()(const f32x16 (&acc)[2][4], int wr, int wc, int r32, int hi, int = 0) const {
#pragma unroll
        for (int mi = 0; mi < 4; ++mi)
#pragma unroll
            for (int ni = 0; ni < 2; ++ni) stage_put(lds, acc[ni][mi], gpre[mi], (2 * mi + wr) * 32 + r32, ni * 128 + wc * 32 + 16 * hi);
        __syncthreads();
        const int tid = tid_here();
#pragma unroll 4
        for (int i = 0; i < 16; ++i) {
            const int c = i * 512 + tid, row = c >> 5, ch = c & 31;
            if (row < nrows) *(u32x4*)(O + (size_t)(orow0 + row) * DM + oc0 + ch * 8) = *(const u32x4*)(lds + row * ST_ROWB + ch * 16);
        }
    }
};

#define GEMMQ_DISPATCH(nv, g, ep) do { if ((nv) > 128) gemm_tile_q<1, 4>(lds, g, ep); else if ((nv) > 64) gemm_tile_q<1, 2>(lds, g, ep); else gemm_tile_q<1, 1>(lds, g, ep); } while (0)
#ifndef G2_NPASS
#define G2_NPASS 1
#endif
template <int NMI> struct EpiSwigluQ {
    unsigned char* O; int orow0; int nrows; int oc;
    __device__ __forceinline__ void pre(int, int) {}
    __device__ __forceinline__ void pin() {}
    __device__ __forceinline__ void operator()(const f32x16 (&acc)[2][NMI], int wr, int wc, int r32, int hi, int = 0) const {
#pragma unroll
        for (int mi = 0; mi < NMI; ++mi) {
            const int tr = (2 * mi + wr) * 32 + r32;
            if (tr < nrows) {
                float v[16];
#pragma unroll
                for (int r = 0; r < 16; ++r) { const float gte = acc[0][mi][r]; v[r] = gte / (1.f + __expf(-gte)) * acc[1][mi][r]; }
                u32x4 w; w.x = pk4_fp8(v[0], v[1], v[2], v[3]); w.y = pk4_fp8(v[4], v[5], v[6], v[7]); w.z = pk4_fp8(v[8], v[9], v[10], v[11]); w.w = pk4_fp8(v[12], v[13], v[14], v[15]);
                *(u32x4*)(O + (size_t)(orow0 + tr) * DEXP + oc + wc * 32 + 16 * hi) = w;
            }
        }
    }
};
__device__ __forceinline__ void moeq_gemm1_item(unsigned char* lds_in, PP p, int layer, int id) {
    unsigned char* lds = lds_here(lds_in);
    int e, nt, m; moe_decode(lds, id, 4, e, nt, m);
    const int* c = (const int*)(lds + MS_CNT); const int* o = (const int*)(lds + MS_OFF);
    const int cnt = __builtin_amdgcn_readfirstlane(c[e]), nvalid = (cnt - m * TMB) < TMB ? (cnt - m * TMB) : TMB;
    const int oe = __builtin_amdgcn_readfirstlane(o[e]);
    int* rows = (int*)(lds + BF_ROWS);
    { const int t_ = tid_here();
      if (t_ < TMB) { const int slot = m * TMB + (t_ < nvalid ? t_ : nvalid - 1); rows[t_] = ((const int*)(p->ws + WS_TOKL))[(size_t)e * TALL + slot]; } }
    __syncthreads();
    GemmOpQ g{p->ws + WS_H1Q, DM, p->ws + WS_W13Q + layer * W13Q_LAYER + (size_t)e * 1024 * DM, DM, nt * 128, 512 + nt * 128, DM, 0, nvalid};
    EpiSwigluQ<4> ep{p->ws + WS_ACTQ, oe + m * TMB, nvalid, nt * 128};
    GEMMQ_DISPATCH(nvalid, g, ep);
}
__device__ __forceinline__ void moeq_gemm2_item(unsigned char* lds_in, PP p, int layer, int id) {
    unsigned char* lds = lds_here(lds_in);
    int e, nt, m; moe_decode(lds, id, 8 / G2_NPASS, e, nt, m); nt *= G2_NPASS;
    const int* c = (const int*)(lds + MS_CNT); const int* o = (const int*)(lds + MS_OFF);
    const int cnt = __builtin_amdgcn_readfirstlane(c[e]), nvalid = (cnt - m * TMB) < TMB ? (cnt - m * TMB) : TMB;
    const int pos0 = __builtin_amdgcn_readfirstlane(o[e]) + m * TMB;
    int* rows = (int*)(lds + BF_ROWS);
    { const int t_ = tid_here(); if (t_ < TMB) rows[t_] = pos0 + (t_ < nvalid ? t_ : nvalid - 1); }
    __syncthreads();
    GemmOpQ g{p->ws + WS_ACTQ, DEXP, p->ws + WS_W2Q + layer * W2Q_LAYER + (size_t)e * DM * DEXP, DEXP, nt * 256, nt * 256 + 128, DEXP, 256, nvalid};
    EpiScaleStoreQ8 ep{lds, p->ws + WS_Y, pos0, nvalid, nt * 256, (const float*)(p->ws + WS_GATEL) + (size_t)e * TALL + m * TMB, {}};
    GEMMQ_DISPATCH(nvalid, g, ep);
}
constexpr int XB_N13 = NEXP * 16 * 8, XB_N2 = NEXP * 4 * 16, XB_TOTAL = XB_N13 + XB_N2;
constexpr int XB_LDS = 0, XB_IDW = 128 * 132;
struct XBlock { const float* src; int ldsrc; unsigned char* dst; int K; };
__device__ __forceinline__ XBlock xblock_of(PP p, int layer, int id) {
    XBlock x;
    if (id < XB_N13) { const int e = id >> 7, r = id & 127, kb = r >> 3, nb = r & 7;
        x.src = p->exp_w13 + ((size_t)layer * NEXP + e) * DM * 1024 + (size_t)(kb * 128) * 1024 + nb * 128; x.ldsrc = 1024;
        x.dst = p->ws + WS_W13Q + layer * W13Q_LAYER + (size_t)e * 1024 * DM + (size_t)(nb * 128) * DM + kb * 128; x.K = DM; }
    else { const int q = id - XB_N13, e = q >> 6, r = q & 63, kb = r >> 4, nb = r & 15;
        x.src = p->exp_w2 + ((size_t)layer * NEXP + e) * DEXP * DM + (size_t)(kb * 128) * DM + nb * 128; x.ldsrc = DM;
        x.dst = p->ws + WS_W2Q + layer * W2Q_LAYER + (size_t)e * DM * DEXP + (size_t)(nb * 128) * DEXP + kb * 128; x.K = DEXP; }
    return x;
}
#define XB_LOAD(V, X) do { _Pragma("unroll") for (int u = 0; u < 2; ++u) { const int blk_ = u * 512 + tid, k4_ = blk_ >> 5, n4_ = blk_ & 31; \
        _Pragma("unroll") for (int j = 0; j < 4; ++j) V[u][j] = __builtin_nontemporal_load((const f32x4*)((X).src + (size_t)(k4_ * 4 + j) * (X).ldsrc + n4_ * 4)); } } while (0)
#define XB_STORE(V, X) do { \
        _Pragma("unroll") for (int u = 0; u < 2; ++u) { const int blk_ = u * 512 + tid, k4_ = blk_ >> 5, n4_ = blk_ & 31; \
            _Pragma("unroll") for (int i = 0; i < 4; ++i) *(unsigned*)(lds + XB_LDS + (n4_ * 4 + i) * 132 + k4_ * 4) = pk4_fp8(V[u][0][i] * 64.f, V[u][1][i] * 64.f, V[u][2][i] * 64.f, V[u][3][i] * 64.f); } \
        __syncthreads(); \
        { const int n_ = tid >> 2, seg_ = tid & 3; const unsigned* r_ = (const unsigned*)(lds + XB_LDS + n_ * 132 + seg_ * 32); \
          u32x4 w0_, w1_; w0_.x = r_[0]; w0_.y = r_[1]; w0_.z = r_[2]; w0_.w = r_[3]; w1_.x = r_[4]; w1_.y = r_[5]; w1_.z = r_[6]; w1_.w = r_[7]; \
          unsigned char* d_ = (X).dst + (size_t)n_ * (X).K + seg_ * 32; *(u32x4*)d_ = w0_; *(u32x4*)(d_ + 16) = w1_; } \
        __syncthreads(); } while (0)
constexpr int XB_CHUNK = 4;
__device__ __forceinline__ int xb_grab(unsigned char* lds, unsigned* qword, int tid) {
    volatile int* w = (volatile int*)(lds + XB_IDW);
    if (tid == 0) *w = (int)__hip_atomic_fetch_add(qword, (unsigned)XB_CHUNK, __ATOMIC_RELAXED, __HIP_MEMORY_SCOPE_AGENT);
    __syncthreads();
    return __builtin_amdgcn_readfirstlane(*w);
}
__device__ __forceinline__ void convert_experts_queue(unsigned char* lds_in, PP p, int layer) {
    unsigned char* lds = lds_here(lds_in);
    const int tid = tid_here();
    unsigned* qword = (unsigned*)(p->ws + WS_CTL + CTL_CNT) + CNT_QWORD + 64 * layer;
    static_assert(XB_TOTAL % XB_CHUNK == 0, "whole chunks");
    int cur = xb_grab(lds, qword, tid);
    if (cur < XB_TOTAL) {
        f32x4 va[2][4], vb[2][4];
        XBlock xa = xblock_of(p, layer, cur), xb_;
        XB_LOAD(va, xa);
        for (;;) {
            int nxt_reg = 0;
            if (tid == 0) nxt_reg = (int)__hip_atomic_fetch_add(qword, (unsigned)XB_CHUNK, __ATOMIC_RELAXED, __HIP_MEMORY_SCOPE_AGENT);
            xb_ = xblock_of(p, layer, cur + 1); XB_LOAD(vb, xb_);
            XB_STORE(va, xa);
            xa = xblock_of(p, layer, cur + 2); XB_LOAD(va, xa);
            XB_STORE(vb, xb_);
            xb_ = xblock_of(p, layer, cur + 3); XB_LOAD(vb, xb_);
            XB_STORE(va, xa);
            volatile int* w = (volatile int*)(lds + XB_IDW);
            if (tid == 0) *w = nxt_reg;
            __syncthreads();
            const int nxt = __builtin_amdgcn_readfirstlane(*w);
            const bool more = nxt < XB_TOTAL;
            if (more) { xa = xblock_of(p, layer, nxt); XB_LOAD(va, xa); }
            XB_STORE(vb, xb_);
            if (!more) break;
            cur = nxt;
        }
    }
    __syncthreads();
}

__device__ __forceinline__ void shared_gemm1_item(unsigned char* lds_in, PP p, int layer, int id, int M) {
    unsigned char* lds = lds_here(lds_in);
    const int mt = id >> 2, nt = id & 3, tid = tid_here();
    int* rows = (int*)(lds + BF_ROWS);
    if (tid < TMB) { const int r = mt * TMB + tid; rows[tid] = r < M ? r : M - 1; }
    __syncthreads();
    GemmOpQ g{p->ws + WS_H1Q, DM, p->ws + WS_SHQ + (size_t)layer * SHQ_LAYER, DM, nt * 128, 512 + nt * 128, DM, 0, M - mt * TMB};
    EpiSwigluQ<4> ep{p->ws + WS_ACTQ, SH_BASE + mt * TMB, M - mt * TMB, nt * 128};
    gemm_tile_q<1, 4>(lds, g, ep);
}
__device__ __forceinline__ void shared_gemm2_item(unsigned char* lds_in, PP p, int layer, int id, int M) {
    unsigned char* lds = lds_here(lds_in);
    const int mt = id / (8 / G2_NPASS), nt = (id % (8 / G2_NPASS)) * G2_NPASS, tid = tid_here();
    int* rows = (int*)(lds + BF_ROWS);
    if (tid < TMB) { const int r = mt * TMB + tid; rows[tid] = SH_BASE + (r < M ? r : M - 1); }
    __syncthreads();
    GemmOpQ g{p->ws + WS_ACTQ, DEXP, p->ws + WS_SHQ + (size_t)layer * SHQ_LAYER + (size_t)1024 * DM, DEXP, nt * 256, nt * 256 + 128, DEXP, 256, M - mt * TMB};
    EpiScaleStoreQ8 ep{lds, p->ws + WS_Y, SH_BASE + mt * TMB, M - mt * TMB, nt * 256, nullptr, {}};
    gemm_tile_q<1, 4>(lds, g, ep);
}
__device__ __forceinline__ void convert_shared_q(unsigned char* lds_in, PP p, int bx, int G) {
    unsigned char* lds = lds_here(lds_in);
    const int tid = tid_here();
    constexpr int NB13 = 16 * 8, NB2 = 4 * 16;
    for (int id = bx; id < DEPTH * (NB13 + NB2); id += G) {
        const int layer = id / (NB13 + NB2), r = id % (NB13 + NB2);
        XBlock x;
        if (r < NB13) { const int kb = r >> 3, nb = r & 7; x.src = p->sh_w13 + (size_t)layer * DM * 1024 + (size_t)(kb * 128) * 1024 + nb * 128; x.ldsrc = 1024;
            x.dst = p->ws + WS_SHQ + (size_t)layer * SHQ_LAYER + (size_t)(nb * 128) * DM + kb * 128; x.K = DM; }
        else { const int q = r - NB13, kb = q >> 4, nb = q & 15; x.src = p->sh_w2 + (size_t)layer * DEXP * DM + (size_t)(kb * 128) * DM + nb * 128; x.ldsrc = DM;
            x.dst = p->ws + WS_SHQ + (size_t)layer * SHQ_LAYER + (size_t)1024 * DM + (size_t)(nb * 128) * DEXP + kb * 128; x.K = DEXP; }
        f32x4 va[2][4];
        XB_LOAD(va, x); XB_STORE(va, x);
    }
}

constexpr int TM2 = 128;
__device__ __forceinline__ void moeq_gemm2r_item(unsigned char* lds_in, PP p, int layer, int id, int nsh, int M) {
    unsigned char* lds = lds_here(lds_in);
    int* rows = (int*)(lds + R_ROWS);
    const int t_ = tid_here();
    Gemm2Op g;
    g.Y = (bf16_t*)(p->ws + WS_Y); g.X = p->ws + WS_ACTQ; g.dump = (bf16_t*)(p->ws + WS_DUMP);
    if (id < nsh) {
        const int r0 = id * TM2, nv = (M - r0) < TM2 ? (M - r0) : TM2;
        if (t_ < TM2) rows[t_] = SH_BASE + r0 + (t_ < nv ? t_ : nv - 1);
        g.Wt = p->ws + WS_SHQ + (size_t)layer * SHQ_LAYER + (size_t)1024 * DM; g.gate = nullptr; g.yrow0 = SH_BASE + r0; g.nrows = nv;
    } else {
        int e, nt, m; moe_decode(lds, id - nsh, 1, e, nt, m);
        const int* c = (const int*)(lds + MS_CNT); const int* o = (const int*)(lds + MS_OFF);
        const int cnt = __builtin_amdgcn_readfirstlane(c[e]), nv = (cnt - m * TM2) < TM2 ? (cnt - m * TM2) : TM2;
        const int pos0 = __builtin_amdgcn_readfirstlane(o[e]) + m * TM2;
        if (t_ < TM2) rows[t_] = pos0 + (t_ < nv ? t_ : nv - 1);
        g.Wt = p->ws + WS_W2Q + layer * W2Q_LAYER + (size_t)e * DM * DEXP; g.gate = (const float*)(p->ws + WS_GATEL) + (size_t)e * TALL + m * TM2; g.yrow0 = pos0; g.nrows = nv;
    }
    __syncthreads();
    gemm2_resident(lds, g);
}

__device__ __forceinline__ void phase_combine(unsigned char* lds, PP p, int layer, int M, int bx, int G) {
    const int tid = tid_here(), lane = tid & 63, gw = bx * 8 + (tid >> 6), nw = G * 8;
    const int* o = (const int*)(lds + MS_OFF);
    const bf16_t* H1 = (const bf16_t*)(p->ws + WS_H1); const unsigned char* Y = p->ws + WS_Y;
    const int* asg_e = (const int*)(p->ws + WS_ASGE); const int* asg_s = (const int*)(p->ws + WS_ASGS);
    bf16_t* hb = (bf16_t*)(p->ws + WS_HB);
    for (int row = gw; row < M; row += nw) {
        float v[32];
        load_row32_bf16(H1 + (size_t)row * DM, lane, v);
#pragma unroll
        for (int i = 0; i < 32; ++i) v[i] *= DN_ALPHA;
        {
            typedef int i32x4 __attribute__((ext_vector_type(4)));
            const i32x4 e0 = *(const i32x4*)(asg_e + row * 8), e1 = *(const i32x4*)(asg_e + row * 8 + 4);
            const i32x4 s0 = *(const i32x4*)(asg_s + row * 8), s1 = *(const i32x4*)(asg_s + row * 8 + 4);
            int pos[9];
#pragma unroll
            for (int k = 0; k < 4; ++k) { pos[k] = o[e0[k]] + s0[k]; pos[4 + k] = o[e1[k]] + s1[k]; }
            pos[8] = SH_BASE + row;
            constexpr float YI = 1.f / YQ_SCALE;
#pragma unroll
            for (int k0 = 0; k0 < 9; k0 += 3) {
                asm volatile("" ::: "memory");
                u32x2 yv[3][4];
#pragma unroll
                for (int k = 0; k < 3; ++k)
#pragma unroll
                    for (int i = 0; i < 4; ++i) yv[k][i] = *(const u32x2*)(Y + (size_t)pos[k0 + k] * DM + i * 512 + lane * 8);
#pragma unroll
                for (int k = 0; k < 3; ++k)
#pragma unroll
                    for (int i = 0; i < 4; ++i) {
                        const f32x2 a = __builtin_amdgcn_cvt_pk_f32_fp8((int)yv[k][i].x, false), b = __builtin_amdgcn_cvt_pk_f32_fp8((int)yv[k][i].x, true);
                        const f32x2 c = __builtin_amdgcn_cvt_pk_f32_fp8((int)yv[k][i].y, false), d = __builtin_amdgcn_cvt_pk_f32_fp8((int)yv[k][i].y, true);
                        v[i * 8 + 0] += a[0] * YI; v[i * 8 + 1] += a[1] * YI; v[i * 8 + 2] += b[0] * YI; v[i * 8 + 3] += b[1] * YI;
                        v[i * 8 + 4] += c[0] * YI; v[i * 8 + 5] += c[1] * YI; v[i * 8 + 6] += d[0] * YI; v[i * 8 + 7] += d[1] * YI;
                    }
            }
        }
        ln_row32(v, p->ln2_g + layer * DM, p->ln2_b + layer * DM, lane);
        if (layer == DEPTH - 1) {
#pragma unroll
            for (int i = 0; i < 4; ++i) {
                float* dst = p->out + (size_t)row * DM + i * 512 + lane * 8;
                *(f32x4*)dst = (f32x4){v[i * 8], v[i * 8 + 1], v[i * 8 + 2], v[i * 8 + 3]};
                *(f32x4*)(dst + 4) = (f32x4){v[i * 8 + 4], v[i * 8 + 5], v[i * 8 + 6], v[i * 8 + 7]};
            }
        } else {
            store_row32_bf16(hb + (size_t)row * DM, lane, v);
            row_gates(lds, p, layer + 1, row, lane, v);
        }
    }
}

#define XB_TMO      128
#define XB_XCNT(j)  (256  + 64 * (j))
#define XB_XSUB(j)  (1280 + 64 * (j))
#define XB_XGEN(j)  (2304 + 64 * (j))
#define XB_TOP      3328
#define XB_TOPGEN   3392
#define XCD_BAR_WORDS 3456
#define XB_SPIN_CAP (1u << 18)

__device__ __forceinline__ unsigned xb_ld(unsigned* p)              { return __hip_atomic_load(p, __ATOMIC_RELAXED, __HIP_MEMORY_SCOPE_AGENT); }
__device__ __forceinline__ unsigned xb_add(unsigned* p, unsigned v) { return __hip_atomic_fetch_add(p, v, __ATOMIC_RELAXED, __HIP_MEMORY_SCOPE_AGENT); }
__device__ __forceinline__ unsigned xb_xcc_id() { return (unsigned)__builtin_amdgcn_s_getreg((3 << 11) | 20) & 0xFu; }
#define XB_SPIN(cond, bar) do { unsigned _sp = 0; while (cond) { __builtin_amdgcn_s_sleep(1); \
    if ((++_sp & 255u) == 0u) { if (xb_ld(&(bar)[XB_TMO])) break; if (_sp > XB_SPIN_CAP) { atomicAdd(&(bar)[XB_TMO], 1u); break; } } } } while (0)

struct XcdBarrier { unsigned* bar; unsigned x; volatile LAS unsigned* st; };

__device__ __forceinline__ XcdBarrier xcd_barrier_post(unsigned* bar, volatile LAS unsigned* st) {
    XcdBarrier b; b.bar = bar; b.x = xb_xcc_id(); b.st = st;
    if (threadIdx.x == 0) (void)xb_add(&bar[XB_XCNT(b.x)], 1u);
    return b;
}
__device__ __forceinline__ void xcd_barrier_complete(unsigned* bar, unsigned x, unsigned& nloc, unsigned& nx) {
    const unsigned G = gridDim.x * gridDim.y * gridDim.z;
    unsigned sum, cnt, mine, sp = 0u;
    for (;;) {
        sum = 0u; cnt = 0u; mine = 0u;
#pragma unroll
        for (unsigned j = 0; j < 16; ++j) { const unsigned c = xb_ld(&bar[XB_XCNT(j)]); sum += c; cnt += (c > 0u) ? 1u : 0u; mine = (j == x) ? c : mine; }
        if (sum == G) break;
        __builtin_amdgcn_s_sleep(1);
        if ((++sp & 255u) == 0u) { if (xb_ld(&bar[XB_TMO])) break; if (sp > XB_SPIN_CAP) { atomicAdd(&bar[XB_TMO], 1u); break; } }
    }
    nloc = mine > 0u ? mine : 1u; nx = cnt > 0u ? cnt : 1u;
}
__device__ __forceinline__ void xcd_barrier(const XcdBarrier& b) {
    asm volatile("s_waitcnt vmcnt(0)" ::: "memory");
    __syncthreads();
    if (threadIdx.x == 0) {
        unsigned* bar = b.bar;
        __builtin_amdgcn_s_waitcnt(0);
        unsigned nloc = b.st[0], nx = b.st[1];
        if (nloc == 0u) { xcd_barrier_complete(bar, b.x, nloc, nx); b.st[0] = nloc; b.st[1] = nx; }
        const unsigned old = xb_add(&bar[XB_XSUB(b.x)], 1u);
        const unsigned gen = old / nloc;
        if (old + 1u == (gen + 1u) * nloc) {
            __builtin_amdgcn_fence(__ATOMIC_RELEASE, "agent");
            asm volatile("s_waitcnt vmcnt(0)" ::: "memory");
            const unsigned og = xb_add(&bar[XB_TOP], 1u);
            const unsigned tg = og / nx;
            if (og + 1u == (tg + 1u) * nx) xb_add(&bar[XB_TOPGEN], 1u);
            else XB_SPIN(xb_ld(&bar[XB_TOPGEN]) == tg, bar);
            __builtin_amdgcn_fence(__ATOMIC_ACQUIRE, "agent");
            xb_add(&bar[XB_XGEN(b.x)], 1u);
            asm volatile("s_waitcnt vmcnt(0)" ::: "memory");
        } else {
            XB_SPIN(xb_ld(&bar[XB_XGEN(b.x)]) == gen, bar);
            __builtin_amdgcn_fence(__ATOMIC_ACQUIRE, "agent");
            asm volatile("s_waitcnt vmcnt(0)" ::: "memory");
        }
    }
    __syncthreads();
}

constexpr int NPHASES = 1 + 8 * DEPTH;
constexpr int XBW_OFF = LDS_BYTES - 16;

__global__ void __launch_bounds__(NTHREADS, 2) fwd_kernel(Params p_by_value) {
    extern __shared__ __attribute__((aligned(16))) unsigned char lds0[];
    const int tid0 = threadIdx.x, G0 = gridDim.x, bx0 = blockIdx.x;
    const int vcu0 = (G0 % 8 == 0) ? (bx0 % 8) * (G0 / 8) + bx0 / 8 : bx0;
    PP p = get_params();
    const int lo = p->ph_lo, hi = p->ph_hi;
    if (tid0 == 0) *(uint4*)(lds0 + XBW_OFF) = make_uint4(0u, 0u, 0u, 0u);
    __syncthreads();
    XcdBarrier bar; bar.bar = (unsigned*)(p->ws + WS_CTL); bar.x = 0; bar.st = (volatile LAS unsigned*)(LAS unsigned char*)(lds0 + XBW_OFF);
    if (hi - lo > 1) bar = xcd_barrier_post((unsigned*)(p->ws + WS_CTL), (volatile LAS unsigned*)(LAS unsigned char*)(lds0 + XBW_OFF));
#ifndef PHMASK
#define PHMASK 0x1FF
#endif
#define IN(k) (lo <= (k) && (k) < hi)
#define PHASE_IDS() unsigned char* lds = lds_here(lds0); const int G = sgpr_here(G0), bx = sgpr_here(bx0), vcu = sgpr_here(vcu0), tid = tid_here(); (void)G; (void)bx; (void)vcu; (void)tid
#define EN(b) (((PHMASK) >> (b)) & 1)
#ifndef REPMASK
#define REPMASK 0
#endif
#ifndef REPLAYER
#define REPLAYER -1
#endif
#define REPEAT(k) for (int rep_ = 0; rep_ <= ((((REPMASK) >> (k)) & 1) && (REPLAYER < 0 || layer == REPLAYER) ? 1 : 0); ++rep_)
#define REPBAR() do { if (rep_) xcd_barrier(bar); } while (0)
#ifndef MXMASK
#define MXMASK 0x3F
#endif
#define MXEN(b) (((MXMASK) >> (b)) & 1)
#ifdef DBG_PHN
#define PH_T0 ((volatile unsigned long long*)(lds0 + LDS_BYTES - 32))
#define PH_BEGIN(k) do { if ((k) == DBG_PHN && layer == DBG_PHL && tid_here() == 0) *PH_T0 = __builtin_amdgcn_s_memtime(); } while (0)
#define PH_MID(k) do { if ((k) == DBG_PHN && layer == DBG_PHL && tid_here() == 0) { const unsigned long long t_ = __builtin_amdgcn_s_memtime() - *PH_T0; atomicAdd(&dbg_acc[0], t_); atomicAdd(&dbg_acc[3], 1ull); atomicMax(&dbg_acc[2], t_); atomicMax(&dbg_acc[4], 1000000000ull - t_); } } while (0)
#define PH_END(k) do { if ((k) == DBG_PHN && layer == DBG_PHL && tid_here() == 0 && blockIdx.x == 0) dbg_acc[1] = __builtin_amdgcn_s_memtime() - *PH_T0; } while (0)
#else
#define PH_BEGIN(k)
#define PH_MID(k)
#define PH_END(k)
#endif
#define SEAM(k) do { if (IN((k) + 1)) xcd_barrier(bar); } while (0)
#ifdef DBG_P2MIX
#define PH_MIDS(n) do { if ((n) != 2) PH_MID(n); } while (0)
#else
#define PH_MIDS(n) PH_MID(n)
#endif
#define SEAMN(n) do { PH_MIDS(n); if (IN(pb + (n) + 1)) xcd_barrier(bar); PH_END(n); } while (0)

    if (EN(8) && IN(0)) for (int rep0_ = 0; rep0_ <= (((REPMASK) >> 8) & 1); ++rep0_) { p = get_params(); PHASE_IDS(); if (rep0_) xcd_barrier(bar); phase_ln_in(lds, p, bx, G); __syncthreads(); phase_convert(lds, p, bx, G); __syncthreads(); convert_shared_q(lds, p, bx, G); router_preformat(p, bx, G); if (rep0_ == (((REPMASK) >> 8) & 1)) SEAM(0); }


    for (int layer = 0; layer < DEPTH; ++layer) {
        const int pb = 1 + 8 * layer;
        const int M = (layer == DEPTH - 1) ? TREAL : TALL;
        if (EN(0) && IN(pb + 0)) REPEAT(0) { p = get_params(); PHASE_IDS(); REPBAR(); PH_BEGIN(0);
            int* rows = (int*)(lds + BF_ROWS);
            for (int id = vcu; id < 759; id += G) {
                int mt, nt;
#if defined(EXP_ORDER) && EXP_ORDER == 1
                mt = id % 33; nt = id / 33;
#elif defined(EXP_ORDER) && EXP_ORDER == 2
                nt = id % 23; mt = id / 23;
#elif defined(EXP_ORDER) && EXP_ORDER == 3
                if (id < 736) { const int grp = id / 92, r = id % 92; nt = r >> 2; mt = grp * 4 + (r & 3); } else { mt = 32; nt = id - 736; }
#else
                if (id < 736) { const int grp = id / 184, r = id % 184; nt = r >> 3; mt = grp * 8 + (r & 7); } else { mt = 32; nt = id - 736; }
#endif
#ifdef FUSE_CONV
                if (nt < 6) {
                    const int u0 = 253 * mt - 3;
                    if (tid < TMB) { int u = u0 + tid; u = u < 0 ? 0 : (u > NB * LSEQ - 1 ? NB * LSEQ - 1 : u); const int b_ = u / LSEQ; rows[tid] = row_of(b_, u - b_ * LSEQ); }
                    __syncthreads();
                    GemmOpBf g{(const bf16_t*)(p->ws + WS_HB), DM, (const bf16_t*)(p->ws + WS_WT) + (size_t)layer * WT_LAYER + WT_IN, DM, nt * 256, nt * 256 + 128, DM};
                    EpiConvS e{lds, (bf16_t*)(p->ws + WS_QKC), p->conv_qk + (size_t)layer * 4 * 1536, u0, nt * 256};
                    gemm_tile_bf(lds, g, e);
                    continue;
                }
#endif
                if (tid < TMB) { const int r = mt * TMB + tid; rows[tid] = r < TALL ? r : TALL - 1; }
                __syncthreads();
                GemmOpBf g{(const bf16_t*)(p->ws + WS_HB), DM, (const bf16_t*)(p->ws + WS_WT) + (size_t)layer * WT_LAYER + WT_IN, DM, nt * 256, nt * 256 + 128, DM};
                EpiStoreBf16S e{lds, (bf16_t*)(p->ws + WS_PROJ), PROJ_W, mt * TMB, TALL - mt * TMB, nt * 256};
                gemm_tile_bf(lds, g, e);
            }
            SEAMN(0);
        }
#ifndef FUSE_CONV
        if (EN(1) && IN(pb + 1)) REPEAT(1) { p = get_params(); PHASE_IDS(); REPBAR(); PH_BEGIN(1); phase_conv(p, layer, bx, G); SEAMN(1); }
#endif
        if (EN(2) && IN(pb + 2)) REPEAT(2) { p = get_params(); PHASE_IDS(); REPBAR(); PH_BEGIN(2);
#ifdef REP_P2_FULL
            if (rep_) { if (bx == 0 && tid == 0) __hip_atomic_store((unsigned*)(p->ws + WS_CTL + CTL_CNT) + CNT_QWORD + 64 * layer, 0u, __ATOMIC_RELAXED, __HIP_MEMORY_SCOPE_AGENT); xcd_barrier(bar); }
#endif
#if defined(USE_FP8_EXPERTS) && CONV_A_BUDGET > 0
            if ((bx >> 3) & 1) convert_experts_queue(lds, p, layer, CONV_A_BUDGET);
#endif
            int r = 0;
            for (int base = 0; base < 704; base += G, ++r) {
                const int id = base + ((r & 1) ? (G - 1 - bx) : bx);
                if (id < 704) {
#ifdef DBG_MIX
                    const unsigned long long tm0 = __builtin_amdgcn_s_memtime(); int ityp = 0;
#endif
                    if (id < 384) {
                        const int j = 7 - id / 48, rem = id % 48, mode = rem / 24, bh = rem % 24;
#ifdef DBG_MIX
                        ityp = (j == 7) ? (mode == 0 ? 1 : 2) : 0;
#endif
                        if (MXEN(0) && mode == 0) mixer_item<0>(lds, p, layer, bh / 6, bh % 6, j); else if (MXEN(1)) mixer_item<1>(lds, p, layer, bh / 6, bh % 6, j);
                    } else if (id < 656) {
                        const int q = id - 384, g = q & 3, rb = q >> 2;
#ifdef DBG_MIX
                        ityp = 3;
#endif
                        if (MXEN(2)) pool_item(lds, p, layer, rb / 17, rb % 17, g);
                    } else {
                        const int q = id - 656, mode = q / 24, bh = q % 24;
#ifdef DBG_MIX
                        ityp = 4 + mode;
#endif
                        if (MXEN(3) && mode == 0) mixer_meta_item<0>(lds, p, layer, bh / 6, bh % 6); else if (MXEN(4)) mixer_meta_item<1>(lds, p, layer, bh / 6, bh % 6);
                    }
#ifdef DBG_MIX
                    if (tid == 0 && ityp == DBG_MIX) { atomicAdd(&dbg_acc[2], __builtin_amdgcn_s_memtime() - tm0); atomicAdd(&dbg_acc[3], 1ull); }
#endif
                }
            }
#ifdef DBG_P2MIX
            PH_MID(2);
#endif
#ifdef USE_FP8_EXPERTS
            convert_experts_queue(lds, p, layer);
#endif
            SEAMN(2);
        }
        if (EN(3) && IN(pb + 3)) REPEAT(3) { p = get_params(); PHASE_IDS(); REPBAR(); PH_BEGIN(3);
            int* rows = (int*)(lds + BF_ROWS);
            const int ntile = (TREAL / TMB) * 8;
            if (M > TREAL) for (int it = G - 1 - bx; it < 128; it += G) outproj_meta_item(lds, p, layer, it);
            for (int id = vcu; id < ntile; id += G) {
                const int mt = id >> 3, nt = id & 7;
                if (tid < TMB) { const int r = mt * TMB + tid; rows[tid] = r < M ? r : M - 1; }
                __syncthreads();
                GemmOpBf g{(const bf16_t*)(p->ws + WS_CAT), DM, (const bf16_t*)(p->ws + WS_WT) + (size_t)layer * WT_LAYER + WT_OUT, DM, nt * 256, nt * 256 + 128, DM};
                EpiResidS e{lds, (const bf16_t*)(p->ws + WS_HB), (bf16_t*)(p->ws + WS_S1), mt * TMB, M - mt * TMB, nt * 256};
                gemm_tile_bf(lds, g, e);
            }
#ifdef TAIL_CONVERT
            if (layer + 1 < DEPTH && vcu >= ntile - ((ntile - 1) / G) * G) convert_experts_queue(lds, p, layer + 1, TAILC_P3);
#endif
            SEAMN(3);
        }
        if (EN(4) && IN(pb + 4)) REPEAT(4) { p = get_params(); PHASE_IDS(); REPBAR(); PH_BEGIN(4);
#ifdef REP_P4_RESET
            if (rep_) { if (bx == 0 && tid < 64) ((int*)(p->ws + WS_CTL + CTL_CNT) + layer * CNT_LAYER)[tid * CNT_STRIDE] = 0; __threadfence(); xcd_barrier(bar); }
#endif
            const int nit = (M + 31) >> 5;
            for (int id = bx; id < nit; id += G) router_item(lds, p, layer, id, M);
#ifdef TAIL_CONVERT
            if (layer + 1 < DEPTH && bx >= nit - ((nit - 1) / G) * G) convert_experts_queue(lds, p, layer + 1, TAILC_P4);
#endif
            SEAMN(4);
        }
        if (EN(5) && IN(pb + 5)) REPEAT(5) { p = get_params(); PHASE_IDS(); REPBAR(); PH_BEGIN(5);
#ifdef USE_FP8_EXPERTS
            moe_tables(lds, p, layer, M, TMB);
            const int nsh = ((M + TMB - 1) / TMB) * 4, nit = nsh + ((const int*)(lds + MS_TP))[65] * 4;
#ifdef EXP_ROUND_SYNC
            for (int id = vcu, rnd = 0; rnd * G < nit; id += G, ++rnd) { if (id < nit) { if (id < nsh) shared_gemm1_item(lds, p, layer, id, M); else moeq_gemm1_item(lds, p, layer, id - nsh); } if ((rnd + 1) * G < nit) xcd_barrier(bar); }
#else
            for (int id = vcu; id < nit; id += G) { if (id < nsh) shared_gemm1_item(lds, p, layer, id, M); else moeq_gemm1_item(lds, p, layer, id - nsh); }
#endif
#if defined(TAIL_CONVERT) && TAILC_P5 > 0
            if (layer + 1 < DEPTH && vcu >= nit - ((nit - 1) / G) * G) convert_experts_queue(lds, p, layer + 1, TAILC_P5);
#endif
#else
            moe_tables(lds, p, layer, M);
            const int nsh = ((M + TMB - 1) / TMB) * 4, nit = nsh + ((const int*)(lds + MS_TP))[65] * 4;
            for (int id = vcu; id < nit; id += G) { if (id < nsh) shared_gemm1_item(lds, p, layer, id, M); else moe_gemm1_item(lds, p, layer, id - nsh); }
#endif
            SEAMN(5);
        }
        if (EN(6) && IN(pb + 6)) REPEAT(6) { p = get_params(); PHASE_IDS(); REPBAR(); PH_BEGIN(6);
#ifdef USE_FP8_EXPERTS
            moe_tables(lds, p, layer, M, TMB);
            const int nsh = ((M + TMB - 1) / TMB) * (8 / G2_NPASS), nit = nsh + ((const int*)(lds + MS_TP))[65] * (8 / G2_NPASS);
            for (int id = vcu; id < nit; id += G) { if (id < nsh) shared_gemm2_item(lds, p, layer, id, M); else moeq_gemm2_item(lds, p, layer, id - nsh); }
#if defined(TAIL_CONVERT) && TAILC_P6 > 0
            if (layer + 1 < DEPTH && vcu >= nit - ((nit - 1) / G) * G) convert_experts_queue(lds, p, layer + 1, TAILC_P6);
#endif
#else
            moe_tables(lds, p, layer, M);
            const int nsh = ((M + TMB - 1) / TMB) * 8, nit = nsh + ((const int*)(lds + MS_TP))[65] * 4;
            for (int id = vcu; id < nit; id += G) { if (id < nsh) shared_gemm2_item(lds, p, layer, id, M); else moe_gemm2_item(lds, p, layer, id - nsh); }
#endif
            SEAMN(6);
        }
        if (EN(7) && IN(pb + 7)) REPEAT(7) { p = get_params(); PHASE_IDS(); REPBAR(); PH_BEGIN(7);
            moe_tables(lds, p, layer, M);
            if (layer + 1 < DEPTH) stage_gate_weights(lds, p, layer + 1);
            phase_combine(lds, p, layer, M, bx, G);
            __syncthreads();
            SEAMN(7);
        }
    }
#ifdef DBG_ANY
    {
        xcd_barrier(bar);
        p = get_params();
        const float frac = DBG_SEL == 8 ? (float)((double)(1000000000ull - dbg_acc[4]) / DBG_UNIT) : DBG_SEL == 7 ? (float)((double)dbg_acc[2] / DBG_UNIT) : DBG_SEL == 6 ? (float)((double)dbg_acc[0] / (double)dbg_acc[3] / DBG_UNIT) : DBG_SEL == 5 ? (float)((double)dbg_acc[1] / DBG_UNIT) : DBG_SEL == 4 ? (float)((double)dbg_acc[2] / (double)dbg_acc[0] * 0.05) : DBG_SEL == 3 ? (float)((double)dbg_acc[2] / (double)dbg_acc[3] / DBG_UNIT) : (float)((double)dbg_acc[DBG_SEL] / (double)dbg_acc[2]);
        const float cdbg = sqrtf(floorf(frac * 10.f + 0.5f));
        for (size_t i = (size_t)blockIdx.x * NTHREADS + tid_here(); i < (size_t)TREAL * DM / 4; i += (size_t)gridDim.x * NTHREADS) ((f32x4*)p->out)[i] = (f32x4){cdbg, cdbg, cdbg, cdbg};
    }
#endif
#undef IN
#undef SEAM
}

#ifndef N_LAUNCH_MODE
#define N_LAUNCH_MODE 1
#endif
extern "C" void kernel_launch(void* const* d_in, const int* in_sizes, int n_in, void* d_out, int out_size, void* d_ws, size_t ws_size, hipStream_t stream) {
    static int grid = 0;
    if (grid == 0) {
        if (n_in != 23 || ws_size < WS_END) { fprintf(stderr, "kernel_launch: unexpected n_in %d or ws %zu < %zu\n", n_in, ws_size, (size_t)WS_END); grid = -1; return; }
        int dev = 0, cus = 0, per_cu = 0;
        if (hipGetDevice(&dev) != hipSuccess || hipDeviceGetAttribute(&cus, hipDeviceAttributeMultiprocessorCount, dev) != hipSuccess) { grid = -1; return; }
        if (hipFuncSetAttribute((const void*)fwd_kernel, hipFuncAttributeMaxDynamicSharedMemorySize, LDS_BYTES) != hipSuccess) { fprintf(stderr, "kernel_launch: hipFuncSetAttribute failed\n"); grid = -1; return; }
        if (hipOccupancyMaxActiveBlocksPerMultiprocessor(&per_cu, (const void*)fwd_kernel, NTHREADS, LDS_BYTES) != hipSuccess || per_cu < 1)
            fprintf(stderr, "kernel_launch: occupancy query reports %d blocks per CU\n", per_cu);
        (void)hipGetLastError();
        grid = cus;
    }
    if (grid < 0) return;
    if (hipMemsetAsync((char*)d_ws + WS_CTL, 0, CTL_BYTES, stream) != hipSuccess) return;
    Params p{};
    const float* const* in = (const float* const*)d_in;
    p.x = in[0]; p.meta = in[1]; p.ln_in_g = in[2]; p.ln_in_b = in[3]; p.w_in = in[4]; p.b_igate = in[5]; p.b_fgate = in[6]; p.conv_qk = in[7];
    p.ml_norm_g = in[8]; p.sb_norm_g = in[9]; p.pool_w = in[10]; p.pool_scale = in[11]; p.w_out = in[12]; p.ln1_g = in[13]; p.ln1_b = in[14];
    p.router_w = in[15]; p.router_bias = in[16]; p.exp_w13 = in[17]; p.exp_w2 = in[18]; p.sh_w13 = in[19]; p.sh_w2 = in[20]; p.ln2_g = in[21]; p.ln2_b = in[22];
    p.out = (float*)d_out; p.ws = (unsigned char*)d_ws;
#if N_LAUNCH_MODE == 1
    p.ph_lo = 0; p.ph_hi = NPHASES;
    hipLaunchKernelGGL(fwd_kernel, dim3(grid), dim3(NTHREADS), LDS_BYTES, stream, p);
#else
    for (int ph = 0; ph < NPHASES; ++ph) {
        p.ph_lo = ph; p.ph_hi = ph + 1;
        hipLaunchKernelGGL(fwd_kernel, dim3(grid), dim3(NTHREADS), LDS_BYTES, stream, p);
    }
#endif
    const hipError_t le = hipPeekAtLastError();
    if (le != hipSuccess) fprintf(stderr, "kernel_launch: launch failed: %s\n", hipGetErrorName(le));
}
```

```cpp
#define USE_FP8_EXPERTS 1
#define FUSE_CONV 1
#ifndef CONV_A_BUDGET
#define CONV_A_BUDGET 0
#endif
#include <hip/hip_runtime.h>
#include <stdint.h>
#include <stdio.h>

constexpr int DM = 2048, NB = 4, SEQ = 2048, NMETA = 16, LSEQ = SEQ + NMETA, DEPTH = 2;
constexpr int TREAL = NB * SEQ;
constexpr int TALL = TREAL + NB * NMETA;
constexpr int HD = 128, NH = 6;
constexpr int N_IN = 5900;
constexpr int PROJ_W = 5888;
constexpr int PC_MLQK = 0, PC_MLV = 1536, PC_MLO = 2304, PC_SBQ = 3072, PC_SBK = 3840, PC_SBV = 4608, PC_POOL = 5376;
constexpr int NEXP = 64, TOPK = 8, DEXP = 512;
constexpr float ROUTED_SCALE = 2.5f;
constexpr float DN_ALPHA = 1.41421356237309515f;
constexpr float LN_EPS = 1e-5f, RMS_EPS = 1e-6f;
constexpr int SH_BASE = TALL * TOPK;
constexpr int PROWS = SH_BASE + TALL;

typedef unsigned short bf16_t;
typedef short bf16x8 __attribute__((ext_vector_type(8)));
typedef short s16x4 __attribute__((ext_vector_type(4)));
typedef float f32x16 __attribute__((ext_vector_type(16)));
typedef float f32x4 __attribute__((ext_vector_type(4)));
typedef float f32x2 __attribute__((ext_vector_type(2)));
typedef unsigned u32x4 __attribute__((ext_vector_type(4)));
typedef unsigned u32x2 __attribute__((ext_vector_type(2)));
#define LAS __attribute__((address_space(3)))

constexpr int NTHREADS = 512;
constexpr int LDS_BYTES = 144 * 1024;

__device__ __forceinline__ unsigned cvtpk(float lo, float hi) {
    unsigned r; asm volatile("v_cvt_pk_bf16_f32 %0, %1, %2" : "=v"(r) : "v"(lo), "v"(hi)); return r;
}
__device__ __forceinline__ float bf2f(bf16_t v) { return __uint_as_float(((unsigned)v) << 16); }
__device__ __forceinline__ float bflo(unsigned w) { return __uint_as_float(w << 16); }
__device__ __forceinline__ float bfhi(unsigned w) { return __uint_as_float(w & 0xffff0000u); }
__device__ __forceinline__ bf16_t f2bf(float f) { return (bf16_t)(cvtpk(f, 0.f) & 0xffffu); }
__device__ __forceinline__ unsigned pk4_fp8(float a, float b, float c, float d) { int w = __builtin_amdgcn_cvt_pk_fp8_f32(a, b, 0, false); w = __builtin_amdgcn_cvt_pk_fp8_f32(c, d, w, true); return (unsigned)w; }
__device__ __forceinline__ float fp8_round(float x, float s) { int w = __builtin_amdgcn_cvt_pk_fp8_f32(x * s, 0.f, 0, false); return __builtin_amdgcn_cvt_f32_fp8(w, 0) / s; }
__device__ __forceinline__ int crow(int r, int hi) { return (r & 3) + 8 * (r >> 2) + 4 * hi; }
template <int CTRL> __device__ __forceinline__ float dpp_mov(float v) {
    return __builtin_bit_cast(float, __builtin_amdgcn_update_dpp(0, __builtin_bit_cast(int, v), CTRL, 0xf, 0xf, true));
}
__device__ __forceinline__ float rdlane(float v, int l) { return __builtin_bit_cast(float, __builtin_amdgcn_readlane(__builtin_bit_cast(int, v), l)); }
__device__ __forceinline__ float wave_sum(float v) {
    v += dpp_mov<0xB1>(v); v += dpp_mov<0x4E>(v); v += dpp_mov<0x141>(v); v += dpp_mov<0x140>(v);
    return (rdlane(v, 0) + rdlane(v, 16)) + (rdlane(v, 32) + rdlane(v, 48));
}
__device__ __forceinline__ float wave_max(float v) {
    v = fmaxf(v, dpp_mov<0xB1>(v)); v = fmaxf(v, dpp_mov<0x4E>(v)); v = fmaxf(v, dpp_mov<0x141>(v)); v = fmaxf(v, dpp_mov<0x140>(v));
    return fmaxf(fmaxf(rdlane(v, 0), rdlane(v, 16)), fmaxf(rdlane(v, 32), rdlane(v, 48)));
}
template <int CTRL, int ROWMASK> __device__ __forceinline__ float dpp_shift(float ident, float v) {
    return __builtin_bit_cast(float, __builtin_amdgcn_update_dpp(__builtin_bit_cast(int, ident), __builtin_bit_cast(int, v), CTRL, ROWMASK, 0xf, false));
}
__device__ __forceinline__ float wave_scan_sum(float x) {
    x += dpp_shift<0x111, 0xf>(0.f, x); x += dpp_shift<0x112, 0xf>(0.f, x); x += dpp_shift<0x114, 0xf>(0.f, x); x += dpp_shift<0x118, 0xf>(0.f, x);
    x += dpp_shift<0x142, 0xa>(0.f, x); x += dpp_shift<0x143, 0xc>(0.f, x);
    return x;
}
__device__ __forceinline__ float wave_scan_max(float x) {
    constexpr float NI = -3.0e38f;
    x = fmaxf(x, dpp_shift<0x111, 0xf>(NI, x)); x = fmaxf(x, dpp_shift<0x112, 0xf>(NI, x)); x = fmaxf(x, dpp_shift<0x114, 0xf>(NI, x)); x = fmaxf(x, dpp_shift<0x118, 0xf>(NI, x));
    x = fmaxf(x, dpp_shift<0x142, 0xa>(NI, x)); x = fmaxf(x, dpp_shift<0x143, 0xc>(NI, x));
    return x;
}
__device__ __forceinline__ float sigmoidf_(float x) { return 1.f / (1.f + __expf(-x)); }
__device__ __forceinline__ float siluf_(float x) { return x / (1.f + __expf(-x)); }
__device__ __forceinline__ float logsigmoidf_(float x) { return fminf(x, 0.f) - __logf(1.f + __expf(-fabsf(x))); }

#if defined(DBG_TIMING) || defined(DBG_TIMING_BF) || defined(DBG_MIX) || defined(DBG_TQ) || defined(DBG_PHN)
#define DBG_ANY 1
__device__ unsigned long long dbg_acc[8];
#ifndef DBG_BLOCK
#define DBG_BLOCK 0
#endif
#ifndef DBG_WAVE
#define DBG_WAVE 0
#endif
#endif
__device__ __forceinline__ int tid_here() { int t = threadIdx.x; asm volatile("" : "+v"(t)); return t; }
__device__ __forceinline__ int sgpr_here(int x) { asm volatile("" : "+s"(x)); return x; }
__device__ __forceinline__ unsigned char* lds_here(unsigned char* l) { LAS unsigned char* q = (LAS unsigned char*)l; asm volatile("" : "+s"(q)); return (unsigned char*)q; }

__device__ __forceinline__ int row_of(int b, int l) { return l < NMETA ? TREAL + b * NMETA + l : b * SEQ + (l - NMETA); }

constexpr size_t al256(size_t x) { return (x + 255) / 256 * 256; }
constexpr size_t WS_CTL = 0;
constexpr size_t CTL_BYTES = 64 * 1024;
constexpr size_t CTL_CNT = 32 * 1024;
constexpr int CNT_STRIDE = 32, CNT_LAYER = 64 * CNT_STRIDE, CNT_QWORD = DEPTH * CNT_LAYER;
constexpr size_t WS_HB = al256(WS_CTL + CTL_BYTES);
constexpr size_t WS_PROJ = al256(WS_HB + (size_t)TALL * DM * 2);
constexpr size_t WS_GATES = al256(WS_PROJ + (size_t)TALL * PROJ_W * 2);
constexpr size_t WS_QKC = al256(WS_GATES + (size_t)TALL * 12 * 4);
constexpr size_t WS_CAT = al256(WS_QKC + (size_t)TALL * 1536 * 2);
constexpr size_t WS_S1 = al256(WS_CAT + (size_t)TALL * DM * 2);
constexpr size_t WS_H1 = al256(WS_S1 + (size_t)TALL * DM * 2);
constexpr size_t WS_ASGE = al256(WS_H1 + (size_t)TALL * DM * 2);
constexpr size_t WS_ASGS = al256(WS_ASGE + (size_t)TALL * 8 * 4);
constexpr size_t WS_TOKL = al256(WS_ASGS + (size_t)TALL * 8 * 4);
constexpr size_t WS_GATEL = al256(WS_TOKL + (size_t)NEXP * TALL * 4);
constexpr size_t WS_ACT = al256(WS_GATEL + (size_t)NEXP * TALL * 4);
constexpr size_t WS_Y = al256(WS_ACT + (size_t)PROWS * DEXP * 2);
constexpr size_t WT_IN = 0, WT_OUT = (size_t)PROJ_W * DM, WT_SH13 = WT_OUT + (size_t)DM * DM, WT_SH2 = WT_SH13 + (size_t)1024 * DM, WT_POOL = WT_SH2 + (size_t)DM * DEXP, WT_LAYER = WT_POOL + (size_t)4 * 128 * 128;
constexpr size_t WS_WT = al256(WS_Y + (size_t)PROWS * DM * 2);
constexpr size_t WS_W13Q = al256(WS_WT + (size_t)DEPTH * WT_LAYER * 2);
constexpr size_t W13Q_LAYER = (size_t)NEXP * 1024 * DM, W2Q_LAYER = (size_t)NEXP * DM * DEXP;
constexpr size_t WS_W2Q = al256(WS_W13Q + DEPTH * W13Q_LAYER);
constexpr size_t WS_H1Q = al256(WS_W2Q + DEPTH * W2Q_LAYER);
constexpr size_t WS_ACTQ = al256(WS_H1Q + (size_t)TALL * DM);
constexpr size_t WS_SHQ = al256(WS_ACTQ + (size_t)PROWS * DEXP);
constexpr size_t SHQ_LAYER = (size_t)1024 * DM + (size_t)DM * DEXP;
constexpr size_t WS_DUMP = al256(WS_SHQ + (size_t)DEPTH * SHQ_LAYER);
constexpr size_t RWF_LAYER = (size_t)128 * 4 * 64 * 16;
constexpr size_t WS_RWF = al256(WS_DUMP + 65536);
constexpr size_t WS_END = al256(WS_RWF + DEPTH * RWF_LAYER);

struct Params {
    const float* x; const float* meta; const float* ln_in_g; const float* ln_in_b;
    const float* w_in; const float* b_igate; const float* b_fgate; const float* conv_qk;
    const float* ml_norm_g; const float* sb_norm_g; const float* pool_w; const float* pool_scale;
    const float* w_out; const float* ln1_g; const float* ln1_b; const float* router_w; const float* router_bias;
    const float* exp_w13; const float* exp_w2; const float* sh_w13; const float* sh_w2;
    const float* ln2_g; const float* ln2_b;
    float* out; unsigned char* ws;
    int ph_lo, ph_hi;
};
typedef const Params __attribute__((address_space(4)))* PP;
__device__ __forceinline__ PP get_params() {
    PP k = (PP)__builtin_amdgcn_kernarg_segment_ptr();
    asm volatile("" : "+s"(k));
    return k;
}

constexpr int TM = 192;
constexpr int A_SLOT = 24576;
constexpr int G_AS = 0, G_BS = 3 * A_SLOT, G_ROWS = G_BS + 65536;
constexpr int G_LDS_END = G_ROWS + 1024;

__device__ __forceinline__ int swz_f(int n) { return ((n >> 2) & 7) ^ ((n >> 1) & 1); }

struct GemmOp {
    const bf16_t* X; int ldx;
    const float* W; int ldb;
    int cb0, cb1;
    int K;
    int cstep;
};

#define BSET_WAIT(N, S) asm volatile("s_waitcnt vmcnt(" #N ") lgkmcnt(0)" : "+v"(S[0]), "+v"(S[1]), "+v"(S[2]), "+v"(S[3]), "+v"(S[4]), "+v"(S[5]), "+v"(S[6]), "+v"(S[7]) :: "memory")

template <int NPASS, class Epi>
__device__ __forceinline__ void gemm_tile(unsigned char* lds_in, const GemmOp& g, Epi& epi) {
    unsigned char* lds = lds_here(lds_in);
    const int tid = tid_here(), lane = tid & 63, wid = __builtin_amdgcn_readfirstlane(tid >> 6), wr = wid >> 2, wc = wid & 3, r32 = lane & 31, hi = lane >> 5;
    const int* rows = (const int*)(lds + G_ROWS);
    const int a_r = wid * 8 + (lane >> 3);
    unsigned a_off[3];
#pragma unroll
    for (int j = 0; j < 3; ++j) a_off[j] = (unsigned)rows[a_r + 64 * j] * (unsigned)g.ldx + (((lane & 7) ^ swz_f(a_r)) << 3);
    const int a_lds = wid * 1024;
    const int kg = wid, nq = lane;
    const int blk = nq >> 3, gq = nq & 7;
    const int b_col = ((blk & 1) ? g.cb1 : g.cb0) + (blk >> 1) * 32 + gq * 4;
    const int b_n0 = blk * 32 + 8 * (gq & 3) + 4 * (gq >> 2);
    const int wa0 = G_BS + b_n0 * 128 + ((kg ^ swz_f(b_n0)) << 4);
    const int wa2 = G_BS + (b_n0 + 2) * 128 + ((kg ^ swz_f(b_n0 + 2)) << 4);
    const unsigned long long wa_ = (unsigned long long)g.W;
    const char* Wu = (const char*)(((unsigned long long)(unsigned)__builtin_amdgcn_readfirstlane((int)(wa_ >> 32)) << 32) | (unsigned)__builtin_amdgcn_readfirstlane((int)wa_));
    const int ldbu = __builtin_amdgcn_readfirstlane(g.ldb);
    unsigned b_voff = (unsigned)((kg * 8 * ldbu + b_col) * 4);
    const size_t ldb4 = (size_t)ldbu * 4;
    const int lanec = (hi ^ swz_f(r32)) << 4;
    int ard[4], brd[4];
#pragma unroll
    for (int ks = 0; ks < 4; ++ks) { ard[ks] = G_AS + (wr * 32 + r32) * 128 + ((ks << 5) ^ lanec); brd[ks] = G_BS + (wc * 64 + r32) * 128 + ((ks << 5) ^ lanec); }

    f32x16 acc[2][3];

    f32x4 s0[8], s1[8];
    const int nk = g.K >> 6;
#define G_DMA_A(kt, slot_off) do { \
        _Pragma("unroll") for (int j = 0; j < 3; ++j) __builtin_amdgcn_global_load_lds((const unsigned*)(g.X + a_off[j] + (kt) * 64), \
            (unsigned*)(lds + G_AS + (slot_off) + a_lds + j * 8192), 16, 0, 0); } while (0)
#define G_LOADB(S, kt) do { const char* wb_ = Wu + (size_t)(kt) * 64 * ldb4; \
        _Pragma("unroll") for (int j = 0; j < 8; ++j) asm volatile("global_load_dwordx4 %0, %1, %2" : "=v"(S[j]) : "v"(b_voff), "s"(wb_ + j * ldb4) : "memory"); } while (0)
#define G_WRITEB(S, buf) do { u32x4 w_; \
        w_.x = cvtpk(S[0][0], S[1][0]); w_.y = cvtpk(S[2][0], S[3][0]); w_.z = cvtpk(S[4][0], S[5][0]); w_.w = cvtpk(S[6][0], S[7][0]); *(u32x4*)(lds + wa0 + (buf) * 32768) = w_; \
        w_.x = cvtpk(S[0][1], S[1][1]); w_.y = cvtpk(S[2][1], S[3][1]); w_.z = cvtpk(S[4][1], S[5][1]); w_.w = cvtpk(S[6][1], S[7][1]); *(u32x4*)(lds + wa0 + (buf) * 32768 + 128) = w_; \
        w_.x = cvtpk(S[0][2], S[1][2]); w_.y = cvtpk(S[2][2], S[3][2]); w_.z = cvtpk(S[4][2], S[5][2]); w_.w = cvtpk(S[6][2], S[7][2]); *(u32x4*)(lds + wa2 + (buf) * 32768) = w_; \
        w_.x = cvtpk(S[0][3], S[1][3]); w_.y = cvtpk(S[2][3], S[3][3]); w_.z = cvtpk(S[4][3], S[5][3]); w_.w = cvtpk(S[6][3], S[7][3]); *(u32x4*)(lds + wa2 + (buf) * 32768 + 128) = w_; } while (0)
#define G_FRAGS(F, acur_, buf, ks) do { \
        _Pragma("unroll") for (int mi = 0; mi < 3; ++mi) F[mi] = *(const bf16x8*)(lds + ard[ks] + (acur_) + mi * 8192); \
        _Pragma("unroll") for (int ni = 0; ni < 2; ++ni) F[3 + ni] = *(const bf16x8*)(lds + brd[ks] + (buf) * 32768 + ni * 4096); } while (0)
#define G_MMA(F) do { \
        _Pragma("unroll") for (int ni = 0; ni < 2; ++ni) \
        _Pragma("unroll") for (int mi = 0; mi < 3; ++mi) acc[ni][mi] = __builtin_amdgcn_mfma_f32_32x32x16_bf16(F[3 + ni], F[mi], acc[ni][mi], 0, 0, 0); } while (0)
#define SB0() __builtin_amdgcn_sched_barrier(0)
#define G_MMA1(F, q) do { const int ni_ = (q) / 3, mi_ = (q) % 3; \
        acc[ni_][mi_] = __builtin_amdgcn_mfma_f32_32x32x16_bf16(F[3 + ni_], F[mi_], acc[ni_][mi_], 0, 0, 0); } while (0)
#define G_MMA2(F, pr) do { G_MMA1(F, 2 * (pr)); G_MMA1(F, 2 * (pr) + 1); } while (0)
#define G_WPIECE(S, buf, i, WA, OFF) do { u32x4 w_; \
        w_.x = cvtpk(S[0][i], S[1][i]); w_.y = cvtpk(S[2][i], S[3][i]); w_.z = cvtpk(S[4][i], S[5][i]); w_.w = cvtpk(S[6][i], S[7][i]); *(u32x4*)(lds + WA + (buf) * 32768 + OFF) = w_; } while (0)
#define G_DMA1(kt, slot_off, j) __builtin_amdgcn_global_load_lds((const unsigned*)(g.X + a_off[j] + (kt) * 64), (unsigned*)(lds + G_AS + (slot_off) + a_lds + (j) * 8192), 16, 0, 0)
#define G_LOAD1(S, kt, j) asm volatile("global_load_dwordx4 %0, %1, %2" : "=v"(S[j]) : "v"(b_voff), "s"(Wu + ((size_t)(kt) * 64 + (j)) * ldb4) : "memory")
#define SETWAIT(N, S) asm volatile("s_waitcnt vmcnt(" #N ")" : "+v"(S[0]), "+v"(S[1]), "+v"(S[2]), "+v"(S[3]), "+v"(S[4]), "+v"(S[5]), "+v"(S[6]), "+v"(S[7]) :: "memory")
#define G_STEP(kt, SW, TOPW, BARW, DO_WRITE, DO_DMA, DO_LOAD, HAS_NEXT) do { \
        if (DO_WRITE) { SETWAIT(TOPW, SW); } \
        G_FRAGS(f1, a_cur, (kt) & 1, 1); SB0(); \
        if (DO_WRITE) G_WPIECE(SW, ((kt) + 1) & 1, 0, wa0, 0);   SB0(); G_MMA2(f0, 0); SB0(); \
        if (DO_WRITE) G_WPIECE(SW, ((kt) + 1) & 1, 1, wa0, 128); SB0(); G_MMA2(f0, 1); SB0(); \
        if (DO_WRITE) G_WPIECE(SW, ((kt) + 1) & 1, 2, wa2, 0);   SB0(); G_MMA2(f0, 2); SB0(); \
        if (DO_WRITE) G_WPIECE(SW, ((kt) + 1) & 1, 3, wa2, 128); SB0(); \
        G_FRAGS(f0, a_cur, (kt) & 1, 2); SB0(); \
        if (DO_DMA) G_DMA1((kt) + 2, a_nn, 0); SB0(); G_MMA2(f1, 0); SB0(); \
        if (DO_DMA) G_DMA1((kt) + 2, a_nn, 1); if (DO_LOAD) { G_LOAD1(SW, (kt) + 3, 0); G_LOAD1(SW, (kt) + 3, 1); } SB0(); G_MMA2(f1, 1); SB0(); \
        if (DO_DMA) G_DMA1((kt) + 2, a_nn, 2); if (DO_LOAD) { G_LOAD1(SW, (kt) + 3, 2); G_LOAD1(SW, (kt) + 3, 3); } SB0(); G_MMA2(f1, 2); SB0(); \
        G_FRAGS(f1, a_cur, (kt) & 1, 3); SB0(); \
        if (DO_LOAD) { G_LOAD1(SW, (kt) + 3, 4); G_LOAD1(SW, (kt) + 3, 5); } SB0(); G_MMA2(f0, 0); SB0(); \
        if (DO_LOAD) { G_LOAD1(SW, (kt) + 3, 6); G_LOAD1(SW, (kt) + 3, 7); } SB0(); G_MMA2(f0, 1); SB0(); \
        G_MMA2(f0, 2); SB0(); \
        a_cur = a_cur + A_SLOT; a_cur = a_cur >= 3 * A_SLOT ? 0 : a_cur; a_nn = a_nn + A_SLOT; a_nn = a_nn >= 3 * A_SLOT ? 0 : a_nn; \
        if (HAS_NEXT) { DBG_T0(); asm volatile("s_waitcnt vmcnt(" #BARW ") lgkmcnt(0)" ::: "memory"); DBG_T1(); \
            __builtin_amdgcn_s_barrier(); DBG_T2(); \
            G_FRAGS(f0, a_cur, ((kt) + 1) & 1, 0); SB0(); } \
        G_MMA2(f1, 0); G_MMA2(f1, 1); G_MMA2(f1, 2); SB0(); } while (0)

#ifdef DBG_TIMING
    unsigned long long dt0_ = 0, dt1_ = 0, dwait_ = 0, dbar_ = 0; const unsigned long long dstart_ = __builtin_amdgcn_s_memtime();
#define DBG_T0() dt0_ = __builtin_amdgcn_s_memtime()
#define DBG_T1() do { dt1_ = __builtin_amdgcn_s_memtime(); dwait_ += dt1_ - dt0_; } while (0)
#define DBG_T2() do { dbar_ += __builtin_amdgcn_s_memtime() - dt1_; } while (0)
#else
#define DBG_T0()
#define DBG_T1()
#define DBG_T2()
#endif
    G_DMA_A(0, 0); __builtin_amdgcn_sched_barrier(0);
    G_LOADB(s0, 0); __builtin_amdgcn_sched_barrier(0);
    G_DMA_A(1, A_SLOT); __builtin_amdgcn_sched_barrier(0);
    G_LOADB(s1, 1); __builtin_amdgcn_sched_barrier(0);
#pragma unroll
    for (int pass = 0; pass < NPASS; ++pass) {
#pragma unroll
    for (int ni = 0; ni < 2; ++ni)
#pragma unroll
        for (int mi = 0; mi < 3; ++mi)
#pragma unroll
            for (int r = 0; r < 16; ++r) acc[ni][mi][r] = 0.f;
    int a_cur = 0, a_nn = 2 * A_SLOT;
    BSET_WAIT(11, s0);
    G_WRITEB(s0, 0); __builtin_amdgcn_sched_barrier(0);
    G_LOADB(s0, 2); __builtin_amdgcn_sched_barrier(0);
    asm volatile("s_waitcnt lgkmcnt(0)" ::: "memory");
    __builtin_amdgcn_s_barrier();
    bf16x8 f0[5], f1[5];
    G_FRAGS(f0, 0, 0, 0); SB0();
    int kt = 0;
    G_STEP(kt, s1, 8, 17, true, true, true, true); ++kt;
    for (; kt <= nk - 5; kt += 2) { G_STEP(kt, s0, 11, 17, true, true, true, true); G_STEP(kt + 1, s1, 11, 17, true, true, true, true); }
    G_STEP(kt, s0, 11, 9, true, true, false, true); ++kt;
    G_STEP(kt, s1, 3, 0, true, false, false, true); ++kt;
    G_STEP(kt, s0, 0, 0, false, false, false, false);
    {
      const int t2 = tid_here(), l2 = t2 & 63, w2 = __builtin_amdgcn_readfirstlane(t2 >> 6);
      epi.pre(w2 >> 2, l2 & 31);
      if (pass + 1 < NPASS) {
          asm volatile("s_waitcnt vmcnt(0) lgkmcnt(0)" ::: "memory"); epi.pin();
          __builtin_amdgcn_s_barrier();
          b_voff += (unsigned)(g.cstep * 4);
          G_DMA_A(0, 0); __builtin_amdgcn_sched_barrier(0);
          G_LOADB(s0, 0); __builtin_amdgcn_sched_barrier(0);
          G_DMA_A(1, A_SLOT); __builtin_amdgcn_sched_barrier(0);
          G_LOADB(s1, 1); __builtin_amdgcn_sched_barrier(0);
      }
      epi(acc, w2 >> 2, w2 & 3, l2 & 31, l2 >> 5, pass); }
    }
#ifdef DBG_TIMING
    { const unsigned long long dtot_ = __builtin_amdgcn_s_memtime() - dstart_;
      if (blockIdx.x == DBG_BLOCK && tid == DBG_WAVE * 64) { unsigned long long* d = (unsigned long long*)(lds + 0) ; (void)d;
        atomicAdd(&dbg_acc[0], dwait_); atomicAdd(&dbg_acc[1], dbar_); atomicAdd(&dbg_acc[2], dtot_); atomicAdd(&dbg_acc[3], (unsigned long long)nk); } }
#endif
#undef DBG_T0
#undef DBG_T1
#undef DBG_T2
#undef G_DMA_A
#undef G_LOADB
#undef G_WRITEB
#undef G_FRAGS
#undef G_MMA
#undef G_STEP
#undef SETWAIT
#undef G_MMA1
#undef G_MMA2
#undef G_WPIECE
#undef G_DMA1
#undef G_LOAD1
    __syncthreads();
}

template <int NMI> struct EpiStoreBf16 {
    bf16_t* O; int ldo; int orow0; int nrows; int oc0, oc1;
    __device__ __forceinline__ void pre(int, int) {}
    __device__ __forceinline__ void pin() {}
    __device__ __forceinline__ void operator()(const f32x16 (&acc)[2][NMI], int wr, int wc, int r32, int hi, int = 0) const {
#pragma unroll
        for (int mi = 0; mi < NMI; ++mi) {
            const int tr = (2 * mi + wr) * 32 + r32;
            if (tr < nrows) {
#pragma unroll
                for (int ni = 0; ni < 2; ++ni) {
                    bf16_t* p = O + (size_t)(orow0 + tr) * ldo + (ni ? oc1 : oc0) + wc * 32 + 16 * hi;
                    u32x4 w0, w1; const f32x16& a = acc[ni][mi];
                    w0.x = cvtpk(a[0], a[1]); w0.y = cvtpk(a[2], a[3]); w0.z = cvtpk(a[4], a[5]); w0.w = cvtpk(a[6], a[7]);
                    w1.x = cvtpk(a[8], a[9]); w1.y = cvtpk(a[10], a[11]); w1.z = cvtpk(a[12], a[13]); w1.w = cvtpk(a[14], a[15]);
                    *(u32x4*)p = w0; *(u32x4*)(p + 8) = w1;
                }
            }
        }
    }
};


constexpr int TMB = 256;
#ifdef EXP_DMA2X
#define EXP_DMA2 true
#define VMW(n) VMW2_##n
#define VMW2_8 16
#define VMW2_4 8
#define VMW2_0 0
#else
#define EXP_DMA2 false
#define VMW(n) n
#endif
#define XSTR(x) STR(x)
#define STR(x) #x
constexpr int BF_AS = 0, BF_BS = 65536, BF_ROWS = 131072, BF_SLOT = 16384;
struct GemmOpBf { const bf16_t* X; int ldx; const bf16_t* Wt; int ldw; int cb0, cb1; int K; };

template <class Epi>
__device__ __forceinline__ void gemm_tile_bf(unsigned char* lds_in, const GemmOpBf& g, const Epi& epi) {
    unsigned char* lds = lds_here(lds_in);
    const int tid = tid_here(), lane = tid & 63, wid = __builtin_amdgcn_readfirstlane(tid >> 6), wr = wid >> 2, wc = wid & 3, r32 = lane & 31, hi = lane >> 5;
    const int* rows = (const int*)(lds + BF_ROWS);
    unsigned a_off[2], b_off[2];
#pragma unroll
    for (int jj = 0; jj < 2; ++jj) {
        const int r = jj * 128 + wid * 16 + (lane >> 2);
        const int cpos = ((lane & 3) ^ ((r >> 2) & 3)) << 3;
        a_off[jj] = (unsigned)rows[r] * (unsigned)g.ldx + cpos;
        const int rho = r & 31, gcol = (((r >> 5) & 1) ? g.cb1 : g.cb0) + (r >> 6) * 32 + 16 * ((rho >> 2) & 1) + (rho & 3) + 4 * (rho >> 3);
        b_off[jj] = (unsigned)gcol * (unsigned)g.ldw + cpos;
    }
    const int p_lds = wid * 1024;
    const int lanec = (hi ^ ((r32 >> 2) & 3)) << 4;
    const int ard = BF_AS + (wr * 32 + r32) * 64, brd = BF_BS + (wc * 64 + r32) * 64;
    const int co0 = lanec, co1 = 32 ^ lanec;

    f32x16 acc[2][4];
#pragma unroll
    for (int ni = 0; ni < 2; ++ni)
#pragma unroll
        for (int mi = 0; mi < 4; ++mi)
#pragma unroll
            for (int r = 0; r < 16; ++r) acc[ni][mi][r] = 0.f;
    const int nk = g.K >> 5;
#define BF_DMA(kt, slot, which) do { BF_DMA_1(kt, slot, which); if (EXP_DMA2) BF_DMA_1(kt, slot, which); } while (0)
#define BF_DMA_1(kt, slot, which) do { \
        if ((which) < 2) __builtin_amdgcn_global_load_lds((const unsigned*)(g.X + a_off[(which) & 1] + (kt) * 32), (unsigned*)(lds + BF_AS + (slot) * BF_SLOT + p_lds + ((which) & 1) * 8192), 16, 0, 0); \
        else __builtin_amdgcn_global_load_lds((const unsigned*)(g.Wt + b_off[(which) & 1] + (kt) * 32), (unsigned*)(lds + BF_BS + (slot) * BF_SLOT + p_lds + ((which) & 1) * 8192), 16, 0, 0); } while (0)
#define BF_FRAGS(F, slot, co) do { \
        _Pragma("unroll") for (int mi = 0; mi < 4; ++mi) F[mi] = *(const bf16x8*)(lds + ard + (slot) * BF_SLOT + mi * 4096 + (co)); \
        _Pragma("unroll") for (int ni = 0; ni < 2; ++ni) F[4 + ni] = *(const bf16x8*)(lds + brd + (slot) * BF_SLOT + ni * 2048 + (co)); } while (0)
#define BF_MMA1(F, q) do { const int ni_ = (q) >> 2, mi_ = (q) & 3; \
        acc[ni_][mi_] = __builtin_amdgcn_mfma_f32_32x32x16_bf16(F[4 + ni_], F[mi_], acc[ni_][mi_], 0, 0, 0); } while (0)
#define BF_MMA2(F, pr) do { BF_MMA1(F, 2 * (pr)); BF_MMA1(F, 2 * (pr) + 1); } while (0)
#define SB0() __builtin_amdgcn_sched_barrier(0)
#define BF_STEP(kt, slot, WAITN, DO_ISSUE, HAS_NEXT) do { \
        BF_FRAGS(f1, slot, co1); SB0(); \
        BF_MMA2(f0, 0); BF_MMA2(f0, 1); BF_MMA2(f0, 2); BF_MMA2(f0, 3); SB0(); \
        if (HAS_NEXT) { BDBG_T0(); asm volatile("s_waitcnt vmcnt(" XSTR(VMW(WAITN)) ")" ::: "memory"); BDBG_T1(); \
            __builtin_amdgcn_s_barrier(); BDBG_T2(); \
            BF_FRAGS(f0, ((slot) + 1) & 3, co0); SB0(); } \
        if (DO_ISSUE) BF_DMA((kt) + 3, ((slot) + 3) & 3, 0); SB0(); BF_MMA2(f1, 0); SB0(); \
        if (DO_ISSUE) BF_DMA((kt) + 3, ((slot) + 3) & 3, 2); SB0(); BF_MMA2(f1, 1); SB0(); \
        if (DO_ISSUE) BF_DMA((kt) + 3, ((slot) + 3) & 3, 1); SB0(); BF_MMA2(f1, 2); SB0(); \
        if (DO_ISSUE) BF_DMA((kt) + 3, ((slot) + 3) & 3, 3); SB0(); BF_MMA2(f1, 3); SB0(); } while (0)

#ifdef DBG_TIMING_BF
    unsigned long long dt0_ = 0, dt1_ = 0, dwait_ = 0, dbar_ = 0; const unsigned long long dstart_ = __builtin_amdgcn_s_memtime(); const unsigned long long drt_ = __builtin_amdgcn_s_memrealtime();
#define BDBG_T0() dt0_ = __builtin_amdgcn_s_memtime()
#define BDBG_T1() do { dt1_ = __builtin_amdgcn_s_memtime(); dwait_ += dt1_ - dt0_; } while (0)
#define BDBG_T2() do { dbar_ += __builtin_amdgcn_s_memtime() - dt1_; } while (0)
#else
#define BDBG_T0()
#define BDBG_T1()
#define BDBG_T2()
#endif
#pragma unroll
    for (int t = 0; t < 3; ++t) { BF_DMA(t, t, 0); BF_DMA(t, t, 2); BF_DMA(t, t, 1); BF_DMA(t, t, 3); }
    SB0();
    asm volatile("s_waitcnt vmcnt(" XSTR(VMW(8)) ")" ::: "memory");
    __builtin_amdgcn_s_barrier();
    bf16x8 f0[6], f1[6];
    BF_FRAGS(f0, 0, co0); SB0();
    int kt = 0;
    for (; kt < nk - 4; kt += 4) {
        BF_STEP(kt, 0, 4, true, true); BF_STEP(kt + 1, 1, 4, true, true); BF_STEP(kt + 2, 2, 4, true, true); BF_STEP(kt + 3, 3, 4, true, true);
    }
    BF_STEP(kt, 0, 4, true, true); BF_STEP(kt + 1, 1, 4, false, true); BF_STEP(kt + 2, 2, 0, false, true); BF_STEP(kt + 3, 3, 0, false, false);
#ifdef DBG_TIMING_BF
    { const unsigned long long dtot_ = __builtin_amdgcn_s_memtime() - dstart_; const unsigned long long drtot_ = __builtin_amdgcn_s_memrealtime() - drt_;
      if (tid == DBG_WAVE * 64) { atomicAdd(&dbg_acc[0], DBG_SEL == 4 ? drtot_ : dwait_); atomicAdd(&dbg_acc[1], dbar_); atomicAdd(&dbg_acc[2], dtot_); atomicAdd(&dbg_acc[3], (unsigned long long)nk); if (DBG_SEL == 5) atomicMax(&dbg_acc[1], dtot_ / (unsigned long long)nk); } }
#endif
#undef BDBG_T0
#undef BDBG_T1
#undef BDBG_T2
#undef BF_DMA
#undef BF_DMA_1
#undef BF_FRAGS
#undef BF_MMA1
#undef BF_MMA2
#undef BF_STEP
    __syncthreads();
    {
      const int t2 = tid_here(), l2 = t2 & 63, w2 = __builtin_amdgcn_readfirstlane(t2 >> 6);
      epi(acc, w2 >> 2, w2 & 3, l2 & 31, l2 >> 5); }
    __syncthreads();
}

typedef int i32x8 __attribute__((ext_vector_type(8)));
struct GemmOpQ { const unsigned char* X; int ldx; const unsigned char* Wt; int ldw; int cb0, cb1; int K; int cstep; int nrows; };
constexpr int WQ_SCALE_BYTE = 0x79;

template <int NPASS, int NMIU, class Epi>
__device__ __forceinline__ void gemm_tile_q(unsigned char* lds_in, const GemmOpQ& g, Epi& epi) {
    unsigned char* lds = lds_here(lds_in);
#ifdef DBG_TQ
    const unsigned long long dq0_ = __builtin_amdgcn_s_memtime(); unsigned long long dq1_ = 0;
#endif
    const int tid = tid_here(), lane = tid & 63, wid = __builtin_amdgcn_readfirstlane(tid >> 6), wr = wid >> 2, wc = wid & 3, r32 = lane & 31, hi = lane >> 5;
    const int* rows = (const int*)(lds + BF_ROWS);
    unsigned a_off[2], b_off[2];
#pragma unroll
    for (int jj = 0; jj < 2; ++jj) {
        const int r = jj * 128 + wid * 16 + (lane >> 2);
        const int cpos = ((lane & 3) ^ ((r >> 2) & 3)) << 4;
        a_off[jj] = (unsigned)rows[r] * (unsigned)g.ldx + cpos;
        const int rho = r & 31, gcol = (((r >> 5) & 1) ? g.cb1 : g.cb0) + (r >> 6) * 32 + 16 * ((rho >> 2) & 1) + (rho & 3) + 4 * (rho >> 3);
        b_off[jj] = (unsigned)gcol * (unsigned)g.ldw + cpos;
    }
    const int p_lds = wid * 1024;
    const int c0 = ((2 * hi) ^ ((r32 >> 2) & 3)) << 4;
    const int ard = BF_AS + (wr * 32 + r32) * 64, brd = BF_BS + (wc * 64 + r32) * 64;
    constexpr int nmi = NMIU;

    f32x16 acc[2][4];
    const int nk = g.K >> 6;
#define Q_DMA(kt, slot, which) do { \
        if ((which) < 2) __builtin_amdgcn_global_load_lds((const unsigned*)(g.X + a_off[(which) & 1] + (kt) * 64), (unsigned*)(lds + BF_AS + (slot) * BF_SLOT + p_lds + ((which) & 1) * 8192), 16, 0, 0); \
        else __builtin_amdgcn_global_load_lds((const unsigned*)(g.Wt + b_off[(which) & 1] + (kt) * 64), (unsigned*)(lds + BF_BS + (slot) * BF_SLOT + p_lds + ((which) & 1) * 8192), 16, 0, 0); } while (0)
#define Q_FRAG(dst, base) do { typedef int i32x4_ __attribute__((ext_vector_type(4))); \
        const i32x4_ lo_ = *(const i32x4_*)(lds + (base) + c0), hi_ = *(const i32x4_*)(lds + (base) + (c0 ^ 16)); \
        dst = __builtin_shufflevector(lo_, hi_, 0, 1, 2, 3, 4, 5, 6, 7); } while (0)
#define Q_MMA(ni, mi) acc[ni][mi] = __builtin_amdgcn_mfma_scale_f32_32x32x64_f8f6f4(fw[ni], fx[mi], acc[ni][mi], 0, 0, 0, WQ_SCALE_BYTE * 0x01010101, 0, 0x7f7f7f7f)
#define Q_MMAX(FWv, FXv, ni, mi, j) acc[ni][mi] = __builtin_amdgcn_mfma_scale_f32_32x32x64_f8f6f4(FWv[ni], FXv[j], acc[ni][mi], 0, 0, 0, WQ_SCALE_BYTE * 0x01010101, 0, 0x7f7f7f7f)
#define Q_STEP(kt, slot, WAITN, DO_ISSUE, HAS_NEXT, FW, FXA, FWN, FXAN) do { \
        i32x8 fxb[2]; \
        Q_FRAG(FXA[0], ard + (slot) * BF_SLOT); if (nmi > 1) Q_FRAG(FXA[1], ard + (slot) * BF_SLOT + 4096); \
        if (nmi > 2) Q_FRAG(fxb[0], ard + (slot) * BF_SLOT + 8192); \
        if (nmi > 3) Q_FRAG(fxb[1], ard + (slot) * BF_SLOT + 12288); SB0(); \
        if (nmi > 0) { Q_MMAX(FW, FXA, 0, 0, 0); Q_MMAX(FW, FXA, 1, 0, 0); } if (nmi > 1) { Q_MMAX(FW, FXA, 0, 1, 1); Q_MMAX(FW, FXA, 1, 1, 1); } SB0(); \
        if (HAS_NEXT) { asm volatile("s_waitcnt vmcnt(" #WAITN ")" ::: "memory"); \
            __builtin_amdgcn_s_barrier(); \
            if (nmi > 0) { Q_FRAG(FWN[0], brd + (((slot) + 1) & 3) * BF_SLOT); Q_FRAG(FWN[1], brd + (((slot) + 1) & 3) * BF_SLOT + 2048); } SB0(); } \
        if (DO_ISSUE) Q_DMA((kt) + 3, ((slot) + 3) & 3, 0); SB0(); if (nmi > 2) Q_MMAX(FW, fxb, 0, 2, 0); SB0(); \
        if (DO_ISSUE) Q_DMA((kt) + 3, ((slot) + 3) & 3, 2); SB0(); if (nmi > 2) Q_MMAX(FW, fxb, 1, 2, 0); SB0(); \
        if (DO_ISSUE) Q_DMA((kt) + 3, ((slot) + 3) & 3, 1); SB0(); if (nmi > 3) Q_MMAX(FW, fxb, 0, 3, 1); SB0(); \
        if (DO_ISSUE) Q_DMA((kt) + 3, ((slot) + 3) & 3, 3); SB0(); if (nmi > 3) Q_MMAX(FW, fxb, 1, 3, 1); SB0(); } while (0)

#pragma unroll
    for (int t = 0; t < 3; ++t) { Q_DMA(t, t, 0); Q_DMA(t, t, 2); Q_DMA(t, t, 1); Q_DMA(t, t, 3); }
    SB0();
#pragma unroll
    for (int pass = 0; pass < NPASS; ++pass) {
#pragma unroll
    for (int ni = 0; ni < 2; ++ni)
#pragma unroll
        for (int mi = 0; mi < 4; ++mi)
#pragma unroll
            for (int r = 0; r < 16; ++r) acc[ni][mi][r] = 0.f;
    asm volatile("s_waitcnt vmcnt(8)" ::: "memory");
    __builtin_amdgcn_s_barrier();
    i32x8 fw0[2], fx0[2], fw1[2], fx1[2];
    if (nmi > 0) { Q_FRAG(fw0[0], brd); Q_FRAG(fw0[1], brd + 2048); } SB0();
    int kt = 0;
    for (; kt < nk - 4; kt += 4) {
        Q_STEP(kt, 0, 4, true, true, fw0, fx0, fw1, fx1); Q_STEP(kt + 1, 1, 4, true, true, fw1, fx1, fw0, fx0);
        Q_STEP(kt + 2, 2, 4, true, true, fw0, fx0, fw1, fx1); Q_STEP(kt + 3, 3, 4, true, true, fw1, fx1, fw0, fx0);
    }
    Q_STEP(kt, 0, 4, true, true, fw0, fx0, fw1, fx1); Q_STEP(kt + 1, 1, 4, false, true, fw1, fx1, fw0, fx0);
    Q_STEP(kt + 2, 2, 0, false, true, fw0, fx0, fw1, fx1); Q_STEP(kt + 3, 3, 0, false, false, fw1, fx1, fw0, fx0);
#ifdef DBG_TQ
    dq1_ = __builtin_amdgcn_s_memtime();
#endif
#pragma unroll
    for (int ni = 0; ni < 2; ++ni)
#pragma unroll
        for (int mi = 0; mi < 4; ++mi) asm volatile("" : "+v"(acc[ni][mi]));
    { const int t2 = tid_here(), l2 = t2 & 63, w2 = __builtin_amdgcn_readfirstlane(t2 >> 6);
      if (pass == 0) epi.pre(w2 >> 2, l2 & 31);
      if (NPASS == 1) __syncthreads();
      if (pass + 1 < NPASS) {
          asm volatile("s_waitcnt vmcnt(0) lgkmcnt(0)" ::: "memory"); epi.pin();
          __builtin_amdgcn_s_barrier();
          b_off[0] += (unsigned)g.cstep * (unsigned)g.ldw; b_off[1] += (unsigned)g.cstep * (unsigned)g.ldw;
          _Pragma("unroll") for (int t = 0; t < 3; ++t) { Q_DMA(t, t, 0); Q_DMA(t, t, 2); Q_DMA(t, t, 1); Q_DMA(t, t, 3); }
          SB0();
      }
      epi(acc, w2 >> 2, w2 & 3, l2 & 31, l2 >> 5, pass); }
    }
#undef Q_DMA
#undef Q_FRAG
#undef Q_MMA
#undef Q_MMAX
#undef Q_STEP
    __syncthreads();
#ifdef DBG_TQ
    if (g.K == DBG_TQ && tid_here() == 0) { const unsigned long long dq2_ = __builtin_amdgcn_s_memtime(); atomicAdd(&dbg_acc[0], dq1_ - dq0_); atomicAdd(&dbg_acc[2], dq2_ - dq0_); atomicAdd(&dbg_acc[3], 1ull); }
#endif
}

constexpr int R_AS = 0, R_BS = 65536, R_ROWS = 131072;
struct Gemm2Op { const unsigned char* X; const unsigned char* Wt; bf16_t* Y; const float* gate; int yrow0; int nrows; bf16_t* dump; };

__device__ __forceinline__ void gemm2_resident(unsigned char* lds_in, const Gemm2Op& g) {
    unsigned char* lds = lds_here(lds_in);
    const int tid = tid_here(), lane = tid & 63, wid = __builtin_amdgcn_readfirstlane(tid >> 6), wr = wid >> 2, wc = wid & 3, r32 = lane & 31, hi = lane >> 5;
    const int* rows = (const int*)(lds + R_ROWS);
    const int xr = wid * 16 + (lane >> 2);
    const unsigned x_off = (unsigned)rows[xr] * (unsigned)DEXP + ((((lane & 3) ^ ((xr >> 2) & 3))) << 4);
    unsigned b_off[2];
#pragma unroll
    for (int jj = 0; jj < 2; ++jj) {
        const int r = jj * 128 + wid * 16 + (lane >> 2);
        const int cpos = ((lane & 3) ^ ((r >> 2) & 3)) << 4;
        const int rho = r & 31, gcol = ((r >> 5) & 1) * 128 + (r >> 6) * 32 + 16 * ((rho >> 2) & 1) + (rho & 3) + 4 * (rho >> 3);
        b_off[jj] = (unsigned)gcol * (unsigned)DEXP + cpos;
    }
    const int p_lds = wid * 1024;
    const int c0 = ((2 * hi) ^ ((r32 >> 2) & 3)) << 4;
    const int ard = R_AS + (wr * 64 + r32) * 64, brd = R_BS + (wc * 64 + r32) * 64;
    float gsc[2];
#pragma unroll
    for (int mi = 0; mi < 2; ++mi) gsc[mi] = g.gate ? g.gate[wr * 64 + mi * 32 + r32] : 1.f;
    asm volatile("s_waitcnt vmcnt(0)" : "+v"(gsc[0]), "+v"(gsc[1]) :: "memory");

#define R_DMAX(ks) __builtin_amdgcn_global_load_lds((const unsigned*)(g.X + x_off + (ks) * 64), (unsigned*)(lds + R_AS + (ks) * 8192 + p_lds), 16, 0, 0)
#define R_DMAW(s, slot, jj) __builtin_amdgcn_global_load_lds((const unsigned*)(g.Wt + (size_t)((s) >> 3) * 256 * DEXP + b_off[jj] + ((s) & 7) * 64), (unsigned*)(lds + R_BS + (slot) * BF_SLOT + p_lds + (jj) * 8192), 16, 0, 0)
#define R_FRAG(dst, base) do { typedef int i32x4_ __attribute__((ext_vector_type(4))); \
        const i32x4_ lo_ = *(const i32x4_*)(lds + (base) + c0), hi_ = *(const i32x4_*)(lds + (base) + (c0 ^ 16)); \
        dst = __builtin_shufflevector(lo_, hi_, 0, 1, 2, 3, 4, 5, 6, 7); } while (0)
#define R_MMA(ni, mi) acc[ni][mi] = __builtin_amdgcn_mfma_scale_f32_32x32x64_f8f6f4(fw[ni], fx[mi], acc[ni][mi], 0, 0, 0, WQ_SCALE_BYTE * 0x01010101, 0, 0x7f7f7f7f)
#define R_STEP(s, ks, WAITN, DO_ISSUE) do { \
        asm volatile("s_waitcnt vmcnt(" #WAITN ")" ::: "memory"); \
        __builtin_amdgcn_s_barrier(); \
        i32x8 fx[2], fw[2]; \
        R_FRAG(fw[0], brd + ((ks) & 3) * BF_SLOT); R_FRAG(fw[1], brd + ((ks) & 3) * BF_SLOT + 2048); \
        R_FRAG(fx[0], ard + (ks) * 8192); R_FRAG(fx[1], ard + (ks) * 8192 + 2048); SB0(); \
        if (DO_ISSUE) R_DMAW((s) + 3, ((ks) + 3) & 3, 0); SB0(); R_MMA(0, 0); R_MMA(1, 0); SB0(); \
        if (DO_ISSUE) R_DMAW((s) + 3, ((ks) + 3) & 3, 1); SB0(); R_MMA(0, 1); R_MMA(1, 1); SB0(); } while (0)
#define R_STORE(nt) do { \
        _Pragma("unroll") for (int ni = 0; ni < 2; ++ni) _Pragma("unroll") for (int mi = 0; mi < 2; ++mi) asm volatile("" : "+v"(acc[ni][mi])); \
        _Pragma("unroll") for (int mi = 0; mi < 2; ++mi) { const int tr = wr * 64 + mi * 32 + r32; \
            _Pragma("unroll") for (int ni = 0; ni < 2; ++ni) { const f32x16& a = acc[ni][mi]; const float sc = gsc[mi]; u32x4 w0, w1; \
                w0.x = cvtpk(a[0] * sc, a[1] * sc); w0.y = cvtpk(a[2] * sc, a[3] * sc); w0.z = cvtpk(a[4] * sc, a[5] * sc); w0.w = cvtpk(a[6] * sc, a[7] * sc); \
                w1.x = cvtpk(a[8] * sc, a[9] * sc); w1.y = cvtpk(a[10] * sc, a[11] * sc); w1.z = cvtpk(a[12] * sc, a[13] * sc); w1.w = cvtpk(a[14] * sc, a[15] * sc); \
                bf16_t* q = tr < g.nrows ? g.Y + (size_t)(g.yrow0 + tr) * DM + (nt) * 256 + ni * 128 + wc * 32 + 16 * hi : g.dump + tid * 16;     \
                *(u32x4*)q = w0; *(u32x4*)(q + 8) = w1; } } } while (0)

#pragma unroll
    for (int ks = 0; ks < 8; ++ks) R_DMAX(ks);
#pragma unroll
    for (int t = 0; t < 3; ++t) { R_DMAW(t, t, 0); R_DMAW(t, t, 1); }
    SB0();
    f32x16 acc[2][2];
#define R_ZERO() do { _Pragma("unroll") for (int ni = 0; ni < 2; ++ni) _Pragma("unroll") for (int mi = 0; mi < 2; ++mi) _Pragma("unroll") for (int r = 0; r < 16; ++r) acc[ni][mi][r] = 0.f; } while (0)
    R_ZERO();
    R_STEP(0, 0, 4, true); R_STEP(1, 1, 4, true); R_STEP(2, 2, 4, true); R_STEP(3, 3, 4, true);
    R_STEP(4, 4, 4, true); R_STEP(5, 5, 4, true); R_STEP(6, 6, 4, true); R_STEP(7, 7, 4, true);
    R_STORE(0);
#pragma nounroll
    for (int nt = 1; nt < 7; ++nt) {
        const int s0 = nt * 8;
        R_ZERO();
        R_STEP(s0 + 0, 0, 12, true); R_STEP(s0 + 1, 1, 12, true); R_STEP(s0 + 2, 2, 12, true); R_STEP(s0 + 3, 3, 4, true);
        R_STEP(s0 + 4, 4, 4, true); R_STEP(s0 + 5, 5, 4, true); R_STEP(s0 + 6, 6, 4, true); R_STEP(s0 + 7, 7, 4, true);
        R_STORE(nt);
    }
    R_ZERO();
    R_STEP(56, 0, 12, true); R_STEP(57, 1, 12, true); R_STEP(58, 2, 12, true); R_STEP(59, 3, 4, true);
    R_STEP(60, 4, 4, true); R_STEP(61, 5, 4, false); R_STEP(62, 6, 2, false); R_STEP(63, 7, 0, false);
    R_STORE(7);
#undef R_DMAX
#undef R_DMAW
#undef R_FRAG
#undef R_MMA
#undef R_STEP
#undef R_STORE
#undef R_ZERO
    __syncthreads();
}

__device__ __forceinline__ void load_row32_f32(const float* src, int lane, float (&v)[32]) {
#pragma unroll
    for (int i = 0; i < 4; ++i) {
        const f32x4 a = *(const f32x4*)(src + i * 512 + lane * 8), b = *(const f32x4*)(src + i * 512 + lane * 8 + 4);
        v[i * 8 + 0] = a[0]; v[i * 8 + 1] = a[1]; v[i * 8 + 2] = a[2]; v[i * 8 + 3] = a[3];
        v[i * 8 + 4] = b[0]; v[i * 8 + 5] = b[1]; v[i * 8 + 6] = b[2]; v[i * 8 + 7] = b[3];
    }
}
__device__ __forceinline__ void load_row32_bf16(const bf16_t* src, int lane, float (&v)[32]) {
#pragma unroll
    for (int i = 0; i < 4; ++i) {
        const u32x4 a = *(const u32x4*)(src + i * 512 + lane * 8);
        v[i * 8 + 0] = bflo(a.x); v[i * 8 + 1] = bfhi(a.x); v[i * 8 + 2] = bflo(a.y); v[i * 8 + 3] = bfhi(a.y);
        v[i * 8 + 4] = bflo(a.z); v[i * 8 + 5] = bfhi(a.z); v[i * 8 + 6] = bflo(a.w); v[i * 8 + 7] = bfhi(a.w);
    }
}
__device__ __forceinline__ void ln_row32(float (&v)[32], const float* g, const float* bb, int lane) {
    float s = 0.f;
#pragma unroll
    for (int i = 0; i < 32; ++i) s += v[i];
    const float mu = wave_sum(s) * (1.f / DM);
    float q = 0.f;
#pragma unroll
    for (int i = 0; i < 32; ++i) { const float d = v[i] - mu; q += d * d; }
    const float rstd = rsqrtf(wave_sum(q) * (1.f / DM) + LN_EPS);
#pragma unroll
    for (int i = 0; i < 4; ++i) {
        const f32x4 g0 = *(const f32x4*)(g + i * 512 + lane * 8), g1 = *(const f32x4*)(g + i * 512 + lane * 8 + 4);
        const f32x4 b0 = *(const f32x4*)(bb + i * 512 + lane * 8), b1 = *(const f32x4*)(bb + i * 512 + lane * 8 + 4);
#pragma unroll
        for (int e = 0; e < 4; ++e) {
            v[i * 8 + e] = (v[i * 8 + e] - mu) * rstd * g0[e] + b0[e];
            v[i * 8 + 4 + e] = (v[i * 8 + 4 + e] - mu) * rstd * g1[e] + b1[e];
        }
    }
}
__device__ __forceinline__ void store_row32_bf16(bf16_t* dst, int lane, const float (&v)[32]) {
#pragma unroll
    for (int i = 0; i < 4; ++i) {
        u32x4 w; w.x = cvtpk(v[i * 8 + 0], v[i * 8 + 1]); w.y = cvtpk(v[i * 8 + 2], v[i * 8 + 3]); w.z = cvtpk(v[i * 8 + 4], v[i * 8 + 5]); w.w = cvtpk(v[i * 8 + 6], v[i * 8 + 7]);
        *(u32x4*)(dst + i * 512 + lane * 8) = w;
    }
}


constexpr int WG_LDS = 0;
__device__ __forceinline__ void stage_gate_weights(unsigned char* lds, PP p, int layer) {
    float* Wg = (float*)(lds + WG_LDS);
    const float* w = p->w_in + (size_t)layer * DM * N_IN + 3072;
    const int tid = tid_here();
    for (int i = tid; i < DM * 3; i += NTHREADS) {
        const int k = i / 3, c = (i % 3) * 4;
        const f32x4 a = *(const f32x4*)(w + (size_t)k * N_IN + c);
        Wg[(c + 0) * DM + k] = a[0]; Wg[(c + 1) * DM + k] = a[1]; Wg[(c + 2) * DM + k] = a[2]; Wg[(c + 3) * DM + k] = a[3];
    }
    __syncthreads();
}
__device__ __forceinline__ void row_gates(const unsigned char* lds, PP p, int layer, int row, int lane, const float (&v)[32]) {
    const float* Wg = (const float*)(lds + WG_LDS);
    float g = 0.f;
#pragma nounroll
    for (int c = 0; c < 12; ++c) {
        float a = 0.f;
#pragma unroll
        for (int i = 0; i < 4; ++i) {
            const f32x4 w0 = *(const f32x4*)(Wg + c * DM + i * 512 + lane * 8), w1 = *(const f32x4*)(Wg + c * DM + i * 512 + lane * 8 + 4);
            a += v[i * 8 + 0] * w0[0] + v[i * 8 + 1] * w0[1] + v[i * 8 + 2] * w0[2] + v[i * 8 + 3] * w0[3]
               + v[i * 8 + 4] * w1[0] + v[i * 8 + 5] * w1[1] + v[i * 8 + 6] * w1[2] + v[i * 8 + 7] * w1[3];
        }
        a = wave_sum(a);
        g = (lane == c) ? a : g;
    }
    if (lane < 12) {
        if (lane < 6) g += p->b_igate[layer * 6 + lane];
        else g = logsigmoidf_(g + p->b_fgate[layer * 6 + lane - 6]);
        ((float*)(p->ws + WS_GATES))[(size_t)row * 12 + lane] = g;
    }
}

__device__ __forceinline__ void phase_ln_in(unsigned char* lds, PP p, int bx, int G) {
    stage_gate_weights(lds, p, 0);
    const int tid = tid_here(), lane = tid & 63, gw = bx * 8 + (tid >> 6), nw = G * 8;
    bf16_t* hb = (bf16_t*)(p->ws + WS_HB);
    for (int row = gw; row < TALL; row += nw) {
        const float* src = row < TREAL ? p->x + (size_t)row * DM : p->meta + (size_t)((row - TREAL) & 15) * DM;
        float v[32];
        load_row32_f32(src, lane, v);
        ln_row32(v, p->ln_in_g, p->ln_in_b, lane);
        store_row32_bf16(hb + (size_t)row * DM, lane, v);
        row_gates(lds, p, 0, row, lane, v);
    }
}

__device__ __forceinline__ void gates_item(unsigned char* lds_in, PP p, int layer, int item) {
    unsigned char* lds = lds_here(lds_in);
    const int tid = tid_here(), lane = tid & 63, wid = tid >> 6;
    float* Wg = (float*)lds;
    const float* w = p->w_in + (size_t)layer * DM * N_IN + 3072;
    for (int i = tid; i < DM * 3; i += NTHREADS) { const int k = i / 3, c = i % 3; *(f32x4*)(Wg + k * 12 + c * 4) = *(const f32x4*)(w + (size_t)k * N_IN + c * 4); }
    __syncthreads();
    const bf16_t* hb = (const bf16_t*)(p->ws + WS_HB);
    float* gates = (float*)(p->ws + WS_GATES);
    for (int rr = 0; rr < 4; ++rr) {
        const int row = item * 32 + wid * 4 + rr;
        if (row < TALL) {
            float acc[12];
#pragma unroll
            for (int c = 0; c < 12; ++c) acc[c] = 0.f;
            const bf16_t* xr = hb + (size_t)row * DM;
            for (int i = 0; i < 32; ++i) {
                const int k = i * 64 + lane;
                const float xv = bf2f(xr[k]);
                const f32x4 w0 = *(const f32x4*)(Wg + k * 12), w1 = *(const f32x4*)(Wg + k * 12 + 4), w2 = *(const f32x4*)(Wg + k * 12 + 8);
#pragma unroll
                for (int e = 0; e < 4; ++e) { acc[e] += xv * w0[e]; acc[4 + e] += xv * w1[e]; acc[8 + e] += xv * w2[e]; }
            }
#pragma unroll
            for (int c = 0; c < 12; ++c) acc[c] = wave_sum(acc[c]);
            if (lane < 12) {
                float v = 0.f;
#pragma unroll
                for (int c = 0; c < 12; ++c) v = (lane == c) ? acc[c] : v;
                if (lane < 6) v += p->b_igate[layer * 6 + lane];
                else v = logsigmoidf_(v + p->b_fgate[layer * 6 + lane - 6]);
                gates[(size_t)row * 12 + lane] = v;
            }
        }
    }
    __syncthreads();
}

__device__ __forceinline__ void phase_conv(PP p, int layer, int bx, int G) {
    const bf16_t* proj = (const bf16_t*)(p->ws + WS_PROJ);
    bf16_t* qkc = (bf16_t*)(p->ws + WS_QKC);
    const float* cw = p->conv_qk + (size_t)layer * 4 * 1536;
    const int total = TALL * 192;
    for (int idx = bx * NTHREADS + tid_here(); idx < total; idx += G * NTHREADS) {
        const int row = idx / 192, c0 = (idx % 192) * 8;
        int b, l;
        if (row < TREAL) { b = row >> 11; l = NMETA + (row & 2047); } else { b = (row - TREAL) >> 4; l = (row - TREAL) & 15; }
        float acc[8];
#pragma unroll
        for (int e = 0; e < 8; ++e) acc[e] = 0.f;
#pragma unroll
        for (int i = 0; i < 4; ++i) {
            const int ls = l - 3 + i;
            if (ls >= 0) {
                const u32x4 a = *(const u32x4*)(proj + (size_t)row_of(b, ls) * PROJ_W + PC_MLQK + c0);
                const f32x4 w0 = *(const f32x4*)(cw + i * 1536 + c0), w1 = *(const f32x4*)(cw + i * 1536 + c0 + 4);
                acc[0] += bflo(a.x) * w0[0]; acc[1] += bfhi(a.x) * w0[1]; acc[2] += bflo(a.y) * w0[2]; acc[3] += bfhi(a.y) * w0[3];
                acc[4] += bflo(a.z) * w1[0]; acc[5] += bfhi(a.z) * w1[1]; acc[6] += bflo(a.w) * w1[2]; acc[7] += bfhi(a.w) * w1[3];
            }
        }
        const float sc = c0 < 768 ? 0.08838834764831845f : 1.f;
#pragma unroll
        for (int e = 0; e < 8; ++e) acc[e] = siluf_(acc[e]) * sc;
        u32x4 w; w.x = cvtpk(acc[0], acc[1]); w.y = cvtpk(acc[2], acc[3]); w.z = cvtpk(acc[4], acc[5]); w.w = cvtpk(acc[6], acc[7]);
        *(u32x4*)(qkc + (size_t)row * 1536 + c0) = w;
    }
}

template <int NB>
__device__ __forceinline__ void transpose_strip(unsigned char* lds_in, const float* src, int ldsrc, int scol0, int k0, bf16_t* dst, int K, int n0) {
    unsigned char* lds = lds_here(lds_in);
    const int tid = tid_here();
    bf16_t* T = (bf16_t*)(lds + 100352);
    {
        const int k = tid >> 3, c8 = (tid & 7) * 8;
        f32x4 a[NB], b[NB];
#pragma unroll
        for (int q = 0; q < NB; ++q) { a[q] = *(const f32x4*)(src + (size_t)(k0 + k) * ldsrc + scol0 + q * 64 + c8); b[q] = *(const f32x4*)(src + (size_t)(k0 + k) * ldsrc + scol0 + q * 64 + c8 + 4); }
#pragma unroll
        for (int q = 0; q < NB; ++q) {
            bf16_t* Tq = T + (q * 64 + c8) * 66 + k;
            Tq[0 * 66] = f2bf(a[q][0]); Tq[1 * 66] = f2bf(a[q][1]); Tq[2 * 66] = f2bf(a[q][2]); Tq[3 * 66] = f2bf(a[q][3]);
            Tq[4 * 66] = f2bf(b[q][0]); Tq[5 * 66] = f2bf(b[q][1]); Tq[6 * 66] = f2bf(b[q][2]); Tq[7 * 66] = f2bf(b[q][3]);
        }
    }
    __syncthreads();
    {
        const int n = tid >> 3, k8 = (tid & 7) * 8;
#pragma unroll
        for (int q = 0; q < NB; ++q) {
            const unsigned* r = (const unsigned*)(T + (q * 64 + n) * 66 + k8);
            u32x4 w; w.x = r[0]; w.y = r[1]; w.z = r[2]; w.w = r[3];
            *(u32x4*)(dst + (size_t)(n0 + q * 64 + n) * K + k0 + k8) = w;
        }
    }
    __syncthreads();
}
__device__ __forceinline__ void phase_convert(unsigned char* lds, PP p, int bx, int G) {
    bf16_t* wt = (bf16_t*)(p->ws + WS_WT);
    constexpr int N_IN_S = 32 * 23, N_OUT_S = 32 * 8, N_S13_S = 32 * 4, N_S2_S = 8 * 8, N_PL_S = 8, PER_LAYER = N_IN_S + N_OUT_S + N_S13_S + N_S2_S + N_PL_S;
    for (int id = bx; id < DEPTH * PER_LAYER; id += G) {
        const int layer = id / PER_LAYER; int r = id % PER_LAYER;
        bf16_t* base = wt + (size_t)layer * WT_LAYER;
        if (r < N_IN_S) { const int nb = r >> 5, kb = r & 31, n0 = nb * 256; transpose_strip<4>(lds, p->w_in + (size_t)layer * DM * N_IN, N_IN, n0 < 3072 ? n0 : n0 + 12, kb * 64, base + WT_IN, DM, n0); continue; }
        r -= N_IN_S;
        if (r < N_OUT_S) { const int nb = r >> 5, kb = r & 31; transpose_strip<4>(lds, p->w_out + (size_t)layer * DM * DM, DM, nb * 256, kb * 64, base + WT_OUT, DM, nb * 256); continue; }
        r -= N_OUT_S;
        if (r < N_S13_S) { const int nb = r >> 5, kb = r & 31; transpose_strip<4>(lds, p->sh_w13 + (size_t)layer * DM * 1024, 1024, nb * 256, kb * 64, base + WT_SH13, DM, nb * 256); continue; }
        r -= N_S13_S;
        if (r < N_S2_S) { const int nb = r >> 3, kb = r & 7; transpose_strip<4>(lds, p->sh_w2 + (size_t)layer * DEXP * DM, DM, nb * 256, kb * 64, base + WT_SH2, DEXP, nb * 256); continue; }
        r -= N_S2_S;
        { const int g = r >> 1, kb = r & 1;
          transpose_strip<2>(lds, p->pool_w + ((size_t)layer * 4 + g) * 128 * 128, 128, 0, kb * 64, base + WT_POOL + (size_t)g * 128 * 128, 128, 0); }
    }
}

#define KSWZ(row, colB) ((row) * 256 + ((colB) ^ (((row) & 7) << 4)))
#define SBAR() __builtin_amdgcn_sched_barrier(0)
constexpr int MX_V = 0, MX_K = 16384, MX_BUF = 32768, MX_C = 65536, MX_MQ = MX_C + 2112 * 4, MX_EM = MX_MQ + 1024, MX_WS = MX_EM + 1024, MX_Q = 77824, MX_END = MX_Q + 65536;

__device__ __forceinline__ int v_st(int k, int c) { const int kk = (k & ~0xC) | ((k & 4) << 1) | ((k & 8) >> 1); return ((kk >> 3) * 4 + (c >> 5)) * 512 + ((kk & 7) * 32 + (c & 31)) * 2; }
__device__ __forceinline__ int v_rd_base(int lane) { return ((lane & 3) << 3) | (((lane >> 2) & 3) << 6) | (((lane >> 4) & 1) << 5) | (((lane >> 5) & 1) << 8); }
constexpr int v_rd_off(int d0, int ks, int half) { return d0 * 512 + ks * 4096 + half * 2048; }
template <int OFF> __device__ __forceinline__ s16x4 tr_read(int vb) {
    s16x4 r; asm volatile("ds_read_b64_tr_b16 %0, %1 offset:%2" : "=&v"(r) : "v"(vb), "i"(OFF) : "memory"); return r;
}
template <int D0> __device__ __forceinline__ void pv_one(f32x16& od, int vb, bf16x8 pa0, bf16x8 pa1, bf16x8 pa2, bf16x8 pa3) {
    const s16x4 l0 = tr_read<v_rd_off(D0, 0, 0)>(vb), h0 = tr_read<v_rd_off(D0, 0, 1)>(vb), l1 = tr_read<v_rd_off(D0, 1, 0)>(vb), h1 = tr_read<v_rd_off(D0, 1, 1)>(vb);
    const s16x4 l2 = tr_read<v_rd_off(D0, 2, 0)>(vb), h2 = tr_read<v_rd_off(D0, 2, 1)>(vb), l3 = tr_read<v_rd_off(D0, 3, 0)>(vb), h3 = tr_read<v_rd_off(D0, 3, 1)>(vb);
    asm volatile("s_waitcnt lgkmcnt(0)" ::: "memory"); SBAR();
#define PK(L, H) (bf16x8){L[0], L[1], L[2], L[3], H[0], H[1], H[2], H[3]}
    __builtin_amdgcn_s_setprio(1);
    od = __builtin_amdgcn_mfma_f32_32x32x16_bf16(pa0, PK(l0, h0), od, 0, 0, 0);
    od = __builtin_amdgcn_mfma_f32_32x32x16_bf16(pa1, PK(l1, h1), od, 0, 0, 0);
    od = __builtin_amdgcn_mfma_f32_32x32x16_bf16(pa2, PK(l2, h2), od, 0, 0, 0);
    od = __builtin_amdgcn_mfma_f32_32x32x16_bf16(pa3, PK(l3, h3), od, 0, 0, 0);
    __builtin_amdgcn_s_setprio(0);
#undef PK
}
__device__ __forceinline__ void qkt(f32x16& p0, f32x16& p1, const unsigned char* Ks, const unsigned char* Qw, int r32, int hi) {
#pragma unroll
    for (int r = 0; r < 16; ++r) { p0[r] = 0.f; p1[r] = 0.f; }
#pragma unroll
    for (int d0 = 0; d0 < 8; ++d0) {
        const int cb = (d0 * 16 + hi * 8) * 2;
        const bf16x8 b0 = *(const bf16x8*)(Ks + KSWZ(r32, cb));
        const bf16x8 b1 = *(const bf16x8*)(Ks + KSWZ(32 + r32, cb));
        const bf16x8 q = *(const bf16x8*)(Qw + KSWZ(r32, cb));
        p0 = __builtin_amdgcn_mfma_f32_32x32x16_bf16(b0, q, p0, 0, 0, 0);
        p1 = __builtin_amdgcn_mfma_f32_32x32x16_bf16(b1, q, p1, 0, 0, 0);
    }
}
__device__ __forceinline__ float swap_sum(float v) {
    auto rr = __builtin_amdgcn_permlane32_swap(__float_as_uint(v), __float_as_uint(v), false, false);
    return __uint_as_float(rr[0]) + __uint_as_float(rr[1]);
}

#ifndef MIXER_INLINE
#define MIXER_INLINE __forceinline__
#endif
struct MixSrc { const bf16_t* Q; int ldq; const bf16_t* K; int ldk; const bf16_t* V; int ldv; };

template <int MODE>
__device__ MIXER_INLINE void mixer_item(unsigned char* lds_in, PP p, int layer, int b, int h, int j) {
    unsigned char* lds = lds_here(lds_in);
    const int tid = tid_here(), wid = tid >> 6, lane = tid & 63, r32 = lane & 31, hi = lane >> 5;
    const bf16_t* proj = (const bf16_t*)(p->ws + WS_PROJ);
    const bf16_t* qkc = (const bf16_t*)(p->ws + WS_QKC);
    const float* gates = (const float*)(p->ws + WS_GATES);
    bf16_t* cat = (bf16_t*)(p->ws + WS_CAT);
    MixSrc S;
    if (MODE == 0) { S.Q = proj + PC_SBQ + h * HD; S.ldq = PROJ_W; S.K = proj + PC_SBK + h * HD; S.ldk = PROJ_W; S.V = proj + PC_SBV + h * HD; S.ldv = PROJ_W; }
    else { S.Q = qkc + h * HD; S.ldq = 1536; S.K = qkc + 768 + h * HD; S.ldk = 1536; S.V = proj + PC_MLV + h * HD; S.ldv = PROJ_W; }
    unsigned char* V_lds = lds + MX_V; unsigned char* K_lds = lds + MX_K;
    float* carr = (float*)(lds + MX_C); float* mqa = (float*)(lds + MX_MQ); float* ema = (float*)(lds + MX_EM);
    float* wsc = (float*)(lds + MX_WS) + wid * 64;

    const int s0 = 256 * j;
    const int qrow = b * SEQ + s0 + wid * 32 + r32;
    const int lq = NMETA + s0 + wid * 32 + r32;
    unsigned char* Qw = lds + MX_Q + wid * 32 * 256;
#pragma unroll
    for (int d0 = 0; d0 < 8; ++d0) *(bf16x8*)(Qw + KSWZ(r32, (d0 * 16 + hi * 8) * 2)) = *(const bf16x8*)(S.Q + (size_t)qrow * S.ldq + d0 * 16 + hi * 8);

    float mq = 0.f;
    if (MODE == 1) {
        const int Lend = NMETA + s0 + 256;
        if (wid == 0) {
            float csum = 0.f, cmax = -3.0e38f;
            for (int base0 = 0; base0 < Lend; base0 += 512) {
                float lfv[8], liv[8];
#pragma unroll
                for (int u = 0; u < 8; ++u) {
                    const int l = base0 + u * 64 + lane; const bool ok = l < Lend;
                    const int row = row_of(b, ok ? l : 0);
                    lfv[u] = ok ? gates[(size_t)row * 12 + 6 + h] : 0.f;
                    liv[u] = ok ? gates[(size_t)row * 12 + h] : 0.f;
                }
#pragma unroll
                for (int u = 0; u < 8; ++u) {
                    const int l = base0 + u * 64 + lane; const bool ok = l < Lend;
                    const float cB = csum + wave_scan_sum(lfv[u]);
                    const float c = ok ? liv[u] - cB : -3.0e38f;
                    const float pm = fmaxf(cmax, wave_scan_max(c));
                    if (ok) {
                        carr[l] = c;
                        if (l >= Lend - 256) { const float m0 = fmaxf(pm, 0.f); mqa[l - (Lend - 256)] = m0; ema[l - (Lend - 256)] = __expf(-(cB + m0)); }
                    }
                    csum = rdlane(cB, 63); cmax = rdlane(pm, 63);
                }
            }
        }
        __syncthreads();
        mq = mqa[wid * 32 + r32];
    }

    const int ntiles = 4 * j + 5;
    const int last_tile = 1 + (s0 + 32 * wid + 31 - (MODE == 0 ? 1 : 0)) / 64;
    const int sr = tid >> 4, sc = (tid & 15) * 8;
    const int vst0 = v_st(sr, sc), vst1 = v_st(32 + sr, sc);
    const int vb0 = (int)(uintptr_t)(LAS unsigned char*)V_lds + v_rd_base(lane);
    bf16x8 vs0, vs1, ks0, ks1;
#define SLOAD(it) do { int r0_, r1_; \
        if ((it) == 0) { r0_ = TREAL + b * NMETA + (sr < NMETA ? sr : NMETA - 1); r1_ = TREAL + b * NMETA + NMETA - 1; } \
        else { r0_ = b * SEQ + 64 * ((it) - 1) + sr; r1_ = r0_ + 32; } \
        vs0 = *(const bf16x8*)(S.V + (size_t)r0_ * S.ldv + sc); vs1 = *(const bf16x8*)(S.V + (size_t)r1_ * S.ldv + sc); \
        ks0 = *(const bf16x8*)(S.K + (size_t)r0_ * S.ldk + sc); ks1 = *(const bf16x8*)(S.K + (size_t)r1_ * S.ldk + sc); } while (0)
#define SWRITE(bo) do { *(bf16x8*)(V_lds + (bo) + vst0) = vs0; *(bf16x8*)(V_lds + (bo) + vst1) = vs1; \
        *(bf16x8*)(K_lds + (bo) + KSWZ(sr, sc * 2)) = ks0; *(bf16x8*)(K_lds + (bo) + KSWZ(32 + sr, sc * 2)) = ks1; } while (0)

    f32x16 o[4];
#pragma unroll
    for (int d = 0; d < 4; ++d)
#pragma unroll
        for (int r = 0; r < 16; ++r) o[d][r] = 0.f;
    float R = (MODE == 0) ? 1.f : 0.f, den = 0.f;

    SLOAD(ntiles - 1);
    SWRITE(((ntiles - 1) & 1) * MX_BUF);
    if (ntiles > 1) SLOAD(ntiles - 2);
    for (int it = ntiles - 1; it >= 0; --it) {
        const int bo = (it & 1) * MX_BUF;
        __syncthreads();
        if (MODE == 0 && it < ntiles - 1) {
            const volatile int* fl = (const volatile int*)(lds + MX_MQ) + ((it + 1) & 1) * 8;
            const int any = fl[0] | fl[1] | fl[2] | fl[3] | fl[4] | fl[5] | fl[6] | fl[7];
            if (__builtin_amdgcn_readfirstlane(any) == 0) break;
        }
        if (it > 0) { SWRITE(MX_BUF - bo); if (it > 1) SLOAD(it - 2); }
        if (it <= last_tile) {
            f32x16 p0, p1;
            qkt(p0, p1, K_lds + bo, Qw, r32, hi);
            const int lbase = it == 0 ? 0 : NMETA + 64 * (it - 1);
            int kmax = lq - lbase + (MODE == 1 ? 1 : 0);
            const int nvalid = it == 0 ? NMETA : 64;
            kmax = kmax < nvalid ? kmax : nvalid;
            if (MODE == 0) {
                constexpr float SC = 0.08838834764831845f * 1.4426950408889634f;
                float x[32];
#pragma unroll
                for (int r = 0; r < 16; ++r) {
                    const float z0 = crow(r, hi) < kmax ? fminf(p0[r] * SC, 60.f) : -1.0e30f;
                    const float z1 = 32 + crow(r, hi) < kmax ? fminf(p1[r] * SC, 60.f) : -1.0e30f;
                    const float e0 = __builtin_amdgcn_exp2f(z0), e1 = __builtin_amdgcn_exp2f(z1);
                    const float k0 = __builtin_amdgcn_rcpf(1.f + e0), k1 = __builtin_amdgcn_rcpf(1.f + e1);
                    x[r] = k0; x[16 + r] = k1; p0[r] = e0 * k0; p1[r] = e1 * k1;
                }
                float run = R;
                float sown[8];
#pragma unroll
                for (int q = 7; q >= 0; --q) {
                    const float g = (x[4 * q] * x[4 * q + 1]) * (x[4 * q + 2] * x[4 * q + 3]);
                    auto rr = __builtin_amdgcn_permlane32_swap(__float_as_uint(g), __float_as_uint(g), false, false);
                    const float lo_q = __uint_as_float(rr[0]), up_q = __uint_as_float(rr[1]);
                    const float s_up = run; run *= up_q;
                    const float s_lo = run; run *= lo_q;
                    sown[q] = hi ? s_up : s_lo;
                }
                R = run;
#pragma unroll
                for (int q = 0; q < 8; ++q) {
                    const float E3 = sown[q], E2 = E3 * x[4 * q + 3], E1 = E2 * x[4 * q + 2], E0 = E1 * x[4 * q + 1];
                    if (q < 4) { p0[4 * q] *= E0; p0[4 * q + 1] *= E1; p0[4 * q + 2] *= E2; p0[4 * q + 3] *= E3; }
                    else { p1[4 * (q - 4)] *= E0; p1[4 * (q - 4) + 1] *= E1; p1[4 * (q - 4) + 2] *= E2; p1[4 * (q - 4) + 3] *= E3; }
                }
            } else {
#pragma unroll
                for (int q = 0; q < 8; ++q) {
                    const f32x4 c4 = *(const f32x4*)(carr + lbase + 8 * q + 4 * hi);
#pragma unroll
                    for (int i = 0; i < 4; ++i) {
                        const int kk = 8 * q + 4 * hi + i;
                        const float w = kk < kmax ? __expf(c4[i] - mq) : 0.f;
                        if (q < 4) { p0[4 * q + i] *= w; den += p0[4 * q + i]; } else { p1[4 * (q - 4) + i] *= w; den += p1[4 * (q - 4) + i]; }
                    }
                }
            }
            bf16x8 pa0, pa1, pa2, pa3;
#define PK4(P, BASE, OUT) do { unsigned a0 = cvtpk(P[BASE + 0], P[BASE + 1]), a1 = cvtpk(P[BASE + 2], P[BASE + 3]); \
        unsigned b0 = cvtpk(P[BASE + 4], P[BASE + 5]), b1 = cvtpk(P[BASE + 6], P[BASE + 7]); \
        auto r0 = __builtin_amdgcn_permlane32_swap(a0, b0, false, false); auto r1 = __builtin_amdgcn_permlane32_swap(a1, b1, false, false); \
        u32x4 w = {r0[0], r1[0], r0[1], r1[1]}; OUT = *reinterpret_cast<bf16x8*>(&w); } while (0)
            PK4(p0, 0, pa0); PK4(p0, 8, pa1); PK4(p1, 0, pa2); PK4(p1, 8, pa3);
#undef PK4
            pv_one<0>(o[0], vb0 + bo, pa0, pa1, pa2, pa3); pv_one<1>(o[1], vb0 + bo, pa0, pa1, pa2, pa3);
            pv_one<2>(o[2], vb0 + bo, pa0, pa1, pa2, pa3); pv_one<3>(o[3], vb0 + bo, pa0, pa1, pa2, pa3);
        }
        if (MODE == 0) {
            const bool alive = (it > last_tile) || (__ballot(R > 0.f) != 0ull);
            if (lane == 0) ((volatile int*)(lds + MX_MQ))[(it & 1) * 8 + wid] = alive ? 1 : 0;
        }
    }
#undef SLOAD
#undef SWRITE
    float rden[16];
    if (MODE == 1) {
        den = swap_sum(den);
        if (hi == 0) wsc[r32] = den;
        asm volatile("s_waitcnt lgkmcnt(0)" ::: "memory");
#pragma unroll
        for (int r = 0; r < 16; ++r) { const int qi = crow(r, hi); rden[r] = 1.f / fmaxf(fabsf(wsc[qi]), ema[wid * 32 + qi]); }
#pragma unroll
        for (int d = 0; d < 4; ++d)
#pragma unroll
            for (int r = 0; r < 16; ++r) o[d][r] *= rden[r];
    }
    float ss[16];
#pragma unroll
    for (int r = 0; r < 16; ++r) ss[r] = o[0][r] * o[0][r] + o[1][r] * o[1][r] + o[2][r] * o[2][r] + o[3][r] * o[3][r];
#pragma unroll
    for (int off = 1; off < 32; off <<= 1)
#pragma unroll
        for (int r = 0; r < 16; ++r) ss[r] += __shfl_xor(ss[r], off, 64);
    const float* ng = (MODE == 0 ? p->sb_norm_g : p->ml_norm_g) + layer * 768 + h * HD;
    const int ccol = (MODE == 0 ? 768 : 0) + h * HD;
    float gv[4];
#pragma unroll
    for (int d = 0; d < 4; ++d) gv[d] = ng[d * 32 + r32];
#pragma unroll
    for (int r = 0; r < 16; ++r) {
        const float rn = rsqrtf(ss[r] * (1.f / HD) + RMS_EPS);
        const int orow = b * SEQ + s0 + wid * 32 + crow(r, hi);
#pragma unroll
        for (int d = 0; d < 4; ++d) {
            float v = o[d][r] * rn * gv[d];
            if (MODE == 1) v *= sigmoidf_(bf2f(proj[(size_t)orow * PROJ_W + PC_MLO + h * HD + d * 32 + r32]));
            cat[(size_t)orow * DM + ccol + d * 32 + r32] = f2bf(v);
        }
    }
    __syncthreads();
}

template <int MODE>
__device__ __forceinline__ void mixer_meta_item(unsigned char* lds_in, PP p, int layer, int b, int h) {
    unsigned char* lds = lds_here(lds_in);
    const int tid = tid_here();
    const bf16_t* proj = (const bf16_t*)(p->ws + WS_PROJ);
    const bf16_t* qkc = (const bf16_t*)(p->ws + WS_QKC);
    const float* gates = (const float*)(p->ws + WS_GATES);
    bf16_t* cat = (bf16_t*)(p->ws + WS_CAT);
    MixSrc S;
    if (MODE == 0) { S.Q = proj + PC_SBQ + h * HD; S.ldq = PROJ_W; S.K = proj + PC_SBK + h * HD; S.ldk = PROJ_W; S.V = proj + PC_SBV + h * HD; S.ldv = PROJ_W; }
    else { S.Q = qkc + h * HD; S.ldq = 1536; S.K = qkc + 768 + h * HD; S.ldk = 1536; S.V = proj + PC_MLV + h * HD; S.ldv = PROJ_W; }
    float* Ss = (float*)lds; float* As = Ss + 256; float* dn = As + 256;
    const int row0 = TREAL + b * NMETA;
    if (tid < 256) {
        const int qi = tid >> 4, ki = tid & 15;
        const bf16_t* q = S.Q + (size_t)(row0 + qi) * S.ldq; const bf16_t* k = S.K + (size_t)(row0 + ki) * S.ldk;
        float s = 0.f;
        for (int d = 0; d < HD; ++d) s += bf2f(q[d]) * bf2f(k[d]);
        Ss[qi * 16 + ki] = s;
    }
    __syncthreads();
    if (tid < 16) {
        const int qi = tid;
        if (MODE == 0) {
            float R = 0.f;
            for (int jj = 15; jj >= 0; --jj) {
                float a = 0.f;
                if (jj < qi) {
                    const float z = Ss[qi * 16 + jj] * 0.08838834764831845f;
                    const float lk = -(fmaxf(z, 0.f) + __logf(1.f + __expf(-fabsf(z))));
                    a = __expf(z + lk + R); R += lk;
                }
                As[qi * 16 + jj] = a;
            }
            dn[qi] = 1.f;
        } else {
            float cB = 0.f, pm = -3.0e38f, cs[16];
            float cBq = 0.f;
            for (int jj = 0; jj < 16; ++jj) {
                cB += gates[(size_t)(row0 + jj) * 12 + 6 + h];
                cs[jj] = gates[(size_t)(row0 + jj) * 12 + h] - cB;
                if (jj <= qi) { pm = fmaxf(pm, cs[jj]); cBq = cB; }
            }
            const float m0 = fmaxf(pm, 0.f);
            float den = 0.f;
            for (int jj = 0; jj < 16; ++jj) {
                float a = 0.f;
                if (jj <= qi) { a = __expf(cs[jj] - m0) * Ss[qi * 16 + jj]; den += a; }
                As[qi * 16 + jj] = a;
            }
            dn[qi] = 1.f / fmaxf(fabsf(den), __expf(-(cBq + m0)));
        }
    }
    __syncthreads();
    {
        const int qi = tid >> 5, d4 = (tid & 31) * 4;
        float o[4] = {0.f, 0.f, 0.f, 0.f};
        for (int jj = 0; jj < 16; ++jj) {
            const float a = As[qi * 16 + jj];
            const u32x2 v = *(const u32x2*)(S.V + (size_t)(row0 + jj) * S.ldv + d4);
            o[0] += a * bflo(v.x); o[1] += a * bfhi(v.x); o[2] += a * bflo(v.y); o[3] += a * bfhi(v.y);
        }
        const float dd = dn[qi];
        float ss = 0.f;
#pragma unroll
        for (int e = 0; e < 4; ++e) { o[e] *= dd; ss += o[e] * o[e]; }
#pragma unroll
        for (int off = 1; off < 32; off <<= 1) ss += __shfl_xor(ss, off, 64);
        const float rn = rsqrtf(ss * (1.f / HD) + RMS_EPS);
        const float* ng = (MODE == 0 ? p->sb_norm_g : p->ml_norm_g) + layer * 768 + h * HD;
        const int ccol = (MODE == 0 ? 768 : 0) + h * HD;
        const int orow = row0 + qi;
#pragma unroll
        for (int e = 0; e < 4; ++e) {
            float v = o[e] * rn * ng[d4 + e];
            if (MODE == 1) v *= sigmoidf_(bf2f(proj[(size_t)orow * PROJ_W + PC_MLO + h * HD + d4 + e]));
            cat[(size_t)orow * DM + ccol + d4 + e] = f2bf(v);
        }
    }
    __syncthreads();
}

constexpr int PL_U = 0, PL_P = 36864, PL_W = PL_P + 32768;
__device__ __forceinline__ void pool_item(unsigned char* lds_in, PP p, int layer, int b, int pb, int g) {
    unsigned char* lds = lds_here(lds_in);
    const int tid = tid_here(), lane = tid & 63, wid = tid >> 6, r32 = lane & 31, hi = lane >> 5;
    const bf16_t* proj = (const bf16_t*)(p->ws + WS_PROJ);
    bf16_t* cat = (bf16_t*)(p->ws + WS_CAT);
    const bf16_t* wt = (const bf16_t*)(p->ws + WS_WT) + (size_t)layer * WT_LAYER + WT_POOL + (size_t)g * 128 * 128;
    const int win = 2 << g;
    const int l0 = pb * 128, nl = (LSEQ - l0) < 128 ? (LSEQ - l0) : 128;
    for (int idx = tid; idx < 143 * 16; idx += NTHREADS) {
        const int li = idx >> 4, ch = idx & 15, l = l0 - 15 + li;
        u32x4 v = {0u, 0u, 0u, 0u};
        if (l >= 0 && l < LSEQ) v = *(const u32x4*)(proj + (size_t)row_of(b, l) * PROJ_W + PC_POOL + g * 128 + ch * 8);
        *(u32x4*)(lds + PL_U + li * 256 + ch * 16) = v;
    }
    for (int idx = tid; idx < 128 * 16; idx += NTHREADS) {
        const int d = idx >> 4, ch = idx & 15;
        *(u32x4*)(lds + PL_W + KSWZ(d, ch * 16)) = *(const u32x4*)(wt + (size_t)d * 128 + ch * 8);
    }
    __syncthreads();
    {
        const int c = tid & 127, chn = tid >> 7;
        const bf16_t* U = (const bf16_t*)(lds + PL_U);
        const int i0 = chn * 32;
        float sum = 0.f;
        for (int t = 1; t < win; ++t) sum += bf2f(U[(15 + i0 - t) * 128 + c]);
        for (int i = 0; i < 32; ++i) {
            const int l = l0 + i0 + i;
            const float u = bf2f(U[(15 + i0 + i) * 128 + c]);
            sum += u;
            const int cnt = (l + 1) < win ? (l + 1) : win;
            const float pv = sum / (float)cnt - u;
            sum -= bf2f(U[(15 + i0 + i - win + 1) * 128 + c]);
            *(bf16_t*)(lds + PL_P + KSWZ(i0 + i, c * 2)) = f2bf(pv);
        }
    }
    __syncthreads();
    {
        const int rt = wid >> 1, ch2 = wid & 1;
        f32x16 acc0, acc1;
#pragma unroll
        for (int r = 0; r < 16; ++r) { acc0[r] = 0.f; acc1[r] = 0.f; }
#pragma unroll
        for (int ks = 0; ks < 8; ++ks) {
            const int cb = (ks * 16 + hi * 8) * 2;
            const bf16x8 pf = *(const bf16x8*)(lds + PL_P + KSWZ(rt * 32 + r32, cb));
            const bf16x8 w0 = *(const bf16x8*)(lds + PL_W + KSWZ(ch2 * 64 + r32, cb));
            const bf16x8 w1 = *(const bf16x8*)(lds + PL_W + KSWZ(ch2 * 64 + 32 + r32, cb));
            acc0 = __builtin_amdgcn_mfma_f32_32x32x16_bf16(w0, pf, acc0, 0, 0, 0);
            acc1 = __builtin_amdgcn_mfma_f32_32x32x16_bf16(w1, pf, acc1, 0, 0, 0);
        }
        const int li = rt * 32 + r32;
        if (li < nl) {
            bf16_t* orow = cat + (size_t)row_of(b, l0 + li) * DM + 1536 + g * 128 + ch2 * 64;
            const float* sc = p->pool_scale + layer * 512 + g * 128 + ch2 * 64;
#pragma unroll
            for (int q = 0; q < 4; ++q) {
                const int d0 = 8 * q + 4 * hi;
                const f32x4 s0 = *(const f32x4*)(sc + d0), s1 = *(const f32x4*)(sc + 32 + d0);
                u32x2 w0, w1;
                w0.x = cvtpk(acc0[4 * q] * s0[0], acc0[4 * q + 1] * s0[1]); w0.y = cvtpk(acc0[4 * q + 2] * s0[2], acc0[4 * q + 3] * s0[3]);
                w1.x = cvtpk(acc1[4 * q] * s1[0], acc1[4 * q + 1] * s1[1]); w1.y = cvtpk(acc1[4 * q + 2] * s1[2], acc1[4 * q + 3] * s1[3]);
                *(u32x2*)(orow + d0) = w0; *(u32x2*)(orow + 32 + d0) = w1;
            }
        }
    }
    __syncthreads();
}

template <int NMI> struct EpiResid {
    const bf16_t* H; bf16_t* O; int orow0; int nrows; int oc0, oc1;
    __device__ __forceinline__ void pre(int, int) {}
    __device__ __forceinline__ void pin() {}
    __device__ __forceinline__ void operator()(const f32x16 (&acc)[2][NMI], int wr, int wc, int r32, int hi, int = 0) const {
#pragma unroll
        for (int mi = 0; mi < NMI; ++mi) {
            const int tr = (2 * mi + wr) * 32 + r32;
            if (tr < nrows) {
#pragma unroll
                for (int ni = 0; ni < 2; ++ni) {
                    const size_t o = (size_t)(orow0 + tr) * DM + (ni ? oc1 : oc0) + wc * 32 + 16 * hi;
                    const u32x4 h0 = *(const u32x4*)(H + o), h1 = *(const u32x4*)(H + o + 8);
                    const f32x16& a = acc[ni][mi];
                    u32x4 w0, w1;
                    w0.x = cvtpk(DN_ALPHA * bflo(h0.x) + a[0], DN_ALPHA * bfhi(h0.x) + a[1]); w0.y = cvtpk(DN_ALPHA * bflo(h0.y) + a[2], DN_ALPHA * bfhi(h0.y) + a[3]);
                    w0.z = cvtpk(DN_ALPHA * bflo(h0.z) + a[4], DN_ALPHA * bfhi(h0.z) + a[5]); w0.w = cvtpk(DN_ALPHA * bflo(h0.w) + a[6], DN_ALPHA * bfhi(h0.w) + a[7]);
                    w1.x = cvtpk(DN_ALPHA * bflo(h1.x) + a[8], DN_ALPHA * bfhi(h1.x) + a[9]); w1.y = cvtpk(DN_ALPHA * bflo(h1.y) + a[10], DN_ALPHA * bfhi(h1.y) + a[11]);
                    w1.z = cvtpk(DN_ALPHA * bflo(h1.z) + a[12], DN_ALPHA * bfhi(h1.z) + a[13]); w1.w = cvtpk(DN_ALPHA * bflo(h1.w) + a[14], DN_ALPHA * bfhi(h1.w) + a[15]);
                    *(u32x4*)(O + o) = w0; *(u32x4*)(O + o + 8) = w1;
                }
            }
        }
    }
};

#ifndef RDUP_NA
#define RDUP_NA 1
#endif
#ifndef RDUP_NB
#define RDUP_NB 1
#endif
#ifndef RDUP_NC
#define RDUP_NC 1
#endif
#ifndef RDUP_ND
#define RDUP_ND 1
#endif
#ifndef RDUP_NE
#define RDUP_NE 1
#endif
__device__ __forceinline__ int rdup_n(int n) { if (n > 1) asm volatile("" : "+s"(n)); return n; }
#define RDUP_LOOP(X) for (int q##X##_ = 0, n##X##_ = rdup_n(RDUP_N##X); q##X##_ < n##X##_; ++q##X##_)
#define RDUP_LAST(X) (q##X##_ == n##X##_ - 1)
constexpr int RX_STRIDE = 4112;
constexpr int RT_XN = 0, RT_PART = 0, RT_LG = 32 * RX_STRIDE, RT_ST = RT_LG + 8192, RT_HIST = RT_ST + 256, RT_BASE = RT_HIST + 256, RT_END = RT_BASE + 256;
static_assert(RT_END <= LDS_BYTES - 64, "router LDS");
__device__ __forceinline__ void split_bf16x8(const float (&x)[8], bf16x8& h, bf16x8& l) {
    u32x4 hw, lw;
    hw.x = cvtpk(x[0], x[1]); hw.y = cvtpk(x[2], x[3]); hw.z = cvtpk(x[4], x[5]); hw.w = cvtpk(x[6], x[7]);
    lw.x = cvtpk(x[0] - bflo(hw.x), x[1] - bfhi(hw.x)); lw.y = cvtpk(x[2] - bflo(hw.y), x[3] - bfhi(hw.y));
    lw.z = cvtpk(x[4] - bflo(hw.z), x[5] - bfhi(hw.z)); lw.w = cvtpk(x[6] - bflo(hw.w), x[7] - bfhi(hw.w));
    h = *reinterpret_cast<bf16x8*>(&hw); l = *reinterpret_cast<bf16x8*>(&lw);
}
__device__ __forceinline__ void router_preformat(PP p, int bx, int G) {
    const int tid = tid_here();
    for (int idx = bx * NTHREADS + tid; idx < DEPTH * 128 * 64; idx += G * NTHREADS) {
        const int lane = idx & 63, ksg = (idx >> 6) & 127, layer = idx >> 13, r32 = lane & 31, k0 = ksg * 16 + (lane >> 5) * 8;
        const float* rw = p->router_w + (size_t)layer * DM * NEXP;
        float w0[8], w1[8];
#pragma unroll
        for (int j = 0; j < 8; ++j) { w0[j] = rw[(size_t)(k0 + j) * NEXP + r32]; w1[j] = rw[(size_t)(k0 + j) * NEXP + 32 + r32]; }
        bf16x8 wh0, wl0, wh1, wl1; split_bf16x8(w0, wh0, wl0); split_bf16x8(w1, wh1, wl1);
        u32x4* dst = (u32x4*)(p->ws + WS_RWF + (size_t)layer * RWF_LAYER) + (size_t)(ksg * 4) * 64 + lane;
        dst[0] = __builtin_bit_cast(u32x4, wh0); dst[64] = __builtin_bit_cast(u32x4, wl0); dst[128] = __builtin_bit_cast(u32x4, wh1); dst[192] = __builtin_bit_cast(u32x4, wl1);
    }
}
__device__ __forceinline__ void router_item(unsigned char* lds_in, PP p, int layer, int item, int M) {
    unsigned char* lds = lds_here(lds_in);
    const int tid = tid_here(), lane = tid & 63, wid = tid >> 6, r32 = lane & 31, hi = lane >> 5;
    const bf16_t* S1 = (const bf16_t*)(p->ws + WS_S1);
    bf16_t* H1 = (bf16_t*)(p->ws + WS_H1);
    float* part = (float*)(lds + RT_PART);
    float* lgs = (float*)(lds + RT_LG);
    int* hist = (int*)(lds + RT_HIST); int* basev = (int*)(lds + RT_BASE);
    const float* g1 = p->ln1_g + layer * DM; const float* b1 = p->ln1_b + layer * DM;
    if (tid < 64) hist[tid] = 0;
    f32x16 d0, d1;
    {
        u32x4 raw[4][4];
        float mu[4], rs[4];
        RDUP_LOOP(A) {
#pragma unroll
        for (int rr = 0; rr < 4; ++rr) {
            const int row = item * 32 + wid * 4 + rr, rowc = row < M ? row : M - 1;
#pragma unroll
            for (int i = 0; i < 4; ++i) raw[rr][i] = *(const u32x4*)(S1 + (size_t)rowc * DM + i * 512 + lane * 8);
        }
#pragma unroll
        for (int rr = 0; rr < 4; ++rr) {
            float s = 0.f;
#pragma unroll
            for (int i = 0; i < 4; ++i) s += (bflo(raw[rr][i].x) + bfhi(raw[rr][i].x)) + (bflo(raw[rr][i].y) + bfhi(raw[rr][i].y)) + (bflo(raw[rr][i].z) + bfhi(raw[rr][i].z)) + (bflo(raw[rr][i].w) + bfhi(raw[rr][i].w));
            mu[rr] = wave_sum(s) * (1.f / DM);
            float q = 0.f;
#pragma unroll
            for (int i = 0; i < 4; ++i) {
                const unsigned ww[4] = {raw[rr][i].x, raw[rr][i].y, raw[rr][i].z, raw[rr][i].w};
#pragma unroll
                for (int e = 0; e < 4; ++e) { const float da = bflo(ww[e]) - mu[rr], db = bfhi(ww[e]) - mu[rr]; q += da * da + db * db; }
            }
            rs[rr] = rsqrtf(wave_sum(q) * (1.f / DM) + LN_EPS);
        }
        }
        RDUP_LOOP(B) {
#pragma unroll
        for (int r = 0; r < 16; ++r) { d0[r] = 0.f; d1[r] = 0.f; }
        const u32x4* wf = (const u32x4*)(p->ws + WS_RWF + (size_t)layer * RWF_LAYER);
#pragma unroll
        for (int h = 0; h < 2; ++h) {
            RDUP_LOOP(D)
#pragma unroll
            for (int ii = 0; ii < 2; ++ii) {
                const int i = 2 * h + ii;
                const f32x4 ga = *(const f32x4*)(g1 + i * 512 + lane * 8), gb = *(const f32x4*)(g1 + i * 512 + lane * 8 + 4);
                const f32x4 ba = *(const f32x4*)(b1 + i * 512 + lane * 8), bb = *(const f32x4*)(b1 + i * 512 + lane * 8 + 4);
#pragma unroll
                for (int rr = 0; rr < 4; ++rr) {
                    const int lr = wid * 4 + rr, row = item * 32 + lr;
                    const u32x4 a = raw[rr][i];
                    float x[8];
                    x[0] = (bflo(a.x) - mu[rr]) * rs[rr] * ga[0] + ba[0]; x[1] = (bfhi(a.x) - mu[rr]) * rs[rr] * ga[1] + ba[1];
                    x[2] = (bflo(a.y) - mu[rr]) * rs[rr] * ga[2] + ba[2]; x[3] = (bfhi(a.y) - mu[rr]) * rs[rr] * ga[3] + ba[3];
                    x[4] = (bflo(a.z) - mu[rr]) * rs[rr] * gb[0] + bb[0]; x[5] = (bfhi(a.z) - mu[rr]) * rs[rr] * gb[1] + bb[1];
                    x[6] = (bflo(a.w) - mu[rr]) * rs[rr] * gb[2] + bb[2]; x[7] = (bfhi(a.w) - mu[rr]) * rs[rr] * gb[3] + bb[3];
                    if (row < M) {
                        u32x4 hw; hw.x = cvtpk(x[0], x[1]); hw.y = cvtpk(x[2], x[3]); hw.z = cvtpk(x[4], x[5]); hw.w = cvtpk(x[6], x[7]);
                        *(u32x4*)(H1 + (size_t)row * DM + i * 512 + lane * 8) = hw;
                        u32x2 qw; qw.x = pk4_fp8(x[0], x[1], x[2], x[3]); qw.y = pk4_fp8(x[4], x[5], x[6], x[7]);
                        *(u32x2*)(p->ws + WS_H1Q + (size_t)row * DM + i * 512 + lane * 8) = qw;
                    }
                    float* xd = (float*)(lds + RT_XN + lr * RX_STRIDE) + ii * 512 + lane * 8;
                    *(f32x4*)xd = (f32x4){x[0], x[1], x[2], x[3]}; *(f32x4*)(xd + 4) = (f32x4){x[4], x[5], x[6], x[7]};
                }
            }
            __syncthreads();
            RDUP_LOOP(E) {
#if RDUP_NE > 1
            const f32x16 sv0 = d0, sv1 = d1;
#endif
#pragma unroll
            for (int ks = 0; ks < 8; ++ks) {
                const float* xs = (const float*)(lds + RT_XN + r32 * RX_STRIDE) + wid * 128 + ks * 16 + hi * 8;
                const f32x4 xa = *(const f32x4*)xs, xb = *(const f32x4*)(xs + 4);
                const float x[8] = {xa[0], xa[1], xa[2], xa[3], xb[0], xb[1], xb[2], xb[3]};
                bf16x8 xh, xl; split_bf16x8(x, xh, xl);
                const u32x4* wp = wf + (size_t)((h * 64 + wid * 8 + ks) * 4) * 64 + lane;
                const u32x4 q0 = wp[0], q1 = wp[64], q2 = wp[128], q3 = wp[192];
                const bf16x8 wh0 = __builtin_bit_cast(bf16x8, q0), wl0 = __builtin_bit_cast(bf16x8, q1), wh1 = __builtin_bit_cast(bf16x8, q2), wl1 = __builtin_bit_cast(bf16x8, q3);
                d0 = __builtin_amdgcn_mfma_f32_32x32x16_bf16(xh, wh0, d0, 0, 0, 0); d1 = __builtin_amdgcn_mfma_f32_32x32x16_bf16(xh, wh1, d1, 0, 0, 0);
                d0 = __builtin_amdgcn_mfma_f32_32x32x16_bf16(xh, wl0, d0, 0, 0, 0); d1 = __builtin_amdgcn_mfma_f32_32x32x16_bf16(xh, wl1, d1, 0, 0, 0);
                d0 = __builtin_amdgcn_mfma_f32_32x32x16_bf16(xl, wh0, d0, 0, 0, 0); d1 = __builtin_amdgcn_mfma_f32_32x32x16_bf16(xl, wh1, d1, 0, 0, 0);
            }
#if RDUP_NE > 1
            if (!RDUP_LAST(E)) { d0 = sv0; d1 = sv1; }
#endif
            }
            __syncthreads();
        }
        }
#pragma unroll
        for (int r = 0; r < 16; ++r) { part[(wid * 32 + crow(r, hi)) * 64 + r32] = d0[r]; part[(wid * 32 + crow(r, hi)) * 64 + 32 + r32] = d1[r]; }
    }
    __syncthreads();
    {
        f32x4 sum = *(const f32x4*)(part + tid * 4);
#pragma unroll
        for (int w = 1; w < 8; ++w) { const f32x4 t = *(const f32x4*)(part + w * 2048 + tid * 4); sum[0] += t[0]; sum[1] += t[1]; sum[2] += t[2]; sum[3] += t[3]; }
        *(f32x4*)(lgs + tid * 4) = sum;
    }
    __syncthreads();
    float lg[4];
#pragma unroll
    for (int rr = 0; rr < 4; ++rr) lg[rr] = lgs[(wid * 4 + rr) * 64 + lane];
    const float bias = p->router_bias[layer * NEXP + lane];
    int my_e[4], my_rank[4]; float my_g[4];
    RDUP_LOOP(C)
    for (int rr = 0; rr < 4; ++rr) {
        const int row = item * 32 + wid * 4 + rr;
        const float score = 1.f / (1.f + __expf(-lg[rr]));
        float sel = score + bias;
        int e_k = 0; float s_k = 0.f; float ssum = 0.f;
        for (int k = 0; k < TOPK; ++k) {
            const float m = wave_max(sel);
            const unsigned long long bal = __ballot(sel == m);
            const int idx = __ffsll((long long)bal) - 1;
            const float sc = rdlane(score, __builtin_amdgcn_readfirstlane(idx));
            ssum += sc;
            if (lane == k) { e_k = idx; s_k = sc; }
            if (lane == idx) sel = -3.0e38f;
        }
        my_e[rr] = e_k; my_g[rr] = s_k / ssum * ROUTED_SCALE; my_rank[rr] = 0;
        if (RDUP_LAST(C) && lane < TOPK && row < M) my_rank[rr] = atomicAdd(&hist[e_k], 1);
    }
    __syncthreads();
    int* cnt = (int*)(p->ws + WS_CTL + CTL_CNT) + layer * CNT_LAYER;
    if (tid < 64) basev[tid] = atomicAdd(&cnt[tid * CNT_STRIDE], hist[tid]);
#ifdef PROBE_ATOM2
    if (tid < 64) basev[64 + tid] = atomicAdd(&cnt[DEPTH * CNT_LAYER + 4096 + layer * CNT_LAYER + tid * CNT_STRIDE], hist[tid]);
#endif
    __syncthreads();
    int* asg_e = (int*)(p->ws + WS_ASGE); int* asg_s = (int*)(p->ws + WS_ASGS);
    int* tokl = (int*)(p->ws + WS_TOKL); float* gatel = (float*)(p->ws + WS_GATEL);
    for (int rr = 0; rr < 4; ++rr) {
        const int row = item * 32 + wid * 4 + rr;
        if (lane < TOPK && row < M) {
            const int e = my_e[rr], slot = basev[e] + my_rank[rr];
            asg_e[row * 8 + lane] = e; asg_s[row * 8 + lane] = slot;
            tokl[(size_t)e * TALL + slot] = row; gatel[(size_t)e * TALL + slot] = my_g[rr];
        }
    }
    __syncthreads();
}

constexpr int MS_BASE = G_LDS_END;
constexpr int MS_CNT = MS_BASE, MS_OFF = MS_BASE + 66 * 4, MS_TP = MS_BASE + 132 * 4, MS_END = MS_BASE + 200 * 4;
__device__ __forceinline__ void moe_tables(unsigned char* lds, PP p, int layer, int M, int tmrows = TM) {
    int* c = (int*)(lds + MS_CNT); int* o = (int*)(lds + MS_OFF); int* tp = (int*)(lds + MS_TP);
    const int tid = tid_here();
    if (tid < 64) {
        const int* cnt = (const int*)(p->ws + WS_CTL + CTL_CNT) + layer * CNT_LAYER;
        const int n = __hip_atomic_load(&cnt[tid * CNT_STRIDE], __ATOMIC_RELAXED, __HIP_MEMORY_SCOPE_AGENT);
        const int nt = (n + tmrows - 1) / tmrows;
        int so = n, st = nt;
#pragma unroll
        for (int d = 1; d < 64; d <<= 1) { const int a = __shfl_up(so, d, 64), b2 = __shfl_up(st, d, 64); if (tid >= d) { so += a; st += b2; } }
        c[tid] = n; o[tid] = so - n; tp[tid] = st - nt;
        if (tid == 63) { c[64] = M; o[64] = SH_BASE; tp[64] = st; tp[65] = st; }
    }
    __syncthreads();
}
__device__ __forceinline__ void moe_decode(const unsigned char* lds, int id, int ntn, int& e, int& nt, int& m) {
    const int* tp = (const int*)(lds + MS_TP);
    int lo = 0;
#pragma unroll
    for (int step = 32; step >= 1; step >>= 1) { const int cand = lo + step; if (cand <= 63 && tp[cand] * ntn <= id) lo = cand; }
    e = __builtin_amdgcn_readfirstlane(lo); const int rem = id - __builtin_amdgcn_readfirstlane(tp[e]) * ntn, nm = __builtin_amdgcn_readfirstlane(tp[e + 1] - tp[e]);
    nt = __builtin_amdgcn_readfirstlane(rem / nm); m = __builtin_amdgcn_readfirstlane(rem % nm);
}

template <int NMI> struct EpiSwiglu {
    bf16_t* O; int orow0; int nrows; int oc;
    __device__ __forceinline__ void pre(int, int) {}
    __device__ __forceinline__ void pin() {}
    __device__ __forceinline__ void operator()(const f32x16 (&acc)[2][NMI], int wr, int wc, int r32, int hi, int pass = 0) const {
#pragma unroll
        for (int mi = 0; mi < NMI; ++mi) {
            const int tr = (2 * mi + wr) * 32 + r32;
            if (tr < nrows) {
                float v[16];
#pragma unroll
                for (int r = 0; r < 16; ++r) { const float gte = acc[0][mi][r]; v[r] = gte / (1.f + __expf(-gte)) * acc[1][mi][r]; }
                u32x4 w0, w1;
                w0.x = cvtpk(v[0], v[1]); w0.y = cvtpk(v[2], v[3]); w0.z = cvtpk(v[4], v[5]); w0.w = cvtpk(v[6], v[7]);
                w1.x = cvtpk(v[8], v[9]); w1.y = cvtpk(v[10], v[11]); w1.z = cvtpk(v[12], v[13]); w1.w = cvtpk(v[14], v[15]);
                bf16_t* q = O + (size_t)(orow0 + tr) * DEXP + oc + pass * 128 + wc * 32 + 16 * hi;
                *(u32x4*)q = w0; *(u32x4*)(q + 8) = w1;
            }
        }
    }
};
template <int NMI> struct EpiScaleStore {
    bf16_t* O; int orow0; int nrows; int oc0, oc1; const float* gate;
    float gpre[NMI];
    __device__ __forceinline__ void pre(int wr, int r32) {
#pragma unroll
        for (int mi = 0; mi < NMI; ++mi) gpre[mi] = gate ? gate[(2 * mi + wr) * 32 + r32] : 1.f;
    }
    __device__ __forceinline__ void pin() {
#pragma unroll
        for (int mi = 0; mi < NMI; ++mi) asm volatile("" : "+v"(gpre[mi]));
    }
    __device__ __forceinline__ void operator()(const f32x16 (&acc)[2][NMI], int wr, int wc, int r32, int hi, int pass = 0) const {
#pragma unroll
        for (int mi = 0; mi < NMI; ++mi) {
            const int tr = (2 * mi + wr) * 32 + r32;
            if (tr < nrows) {
                const float gsc = gpre[mi];
#pragma unroll
                for (int ni = 0; ni < 2; ++ni) {
                    const f32x16& a = acc[ni][mi];
                    u32x4 w0, w1;
                    w0.x = cvtpk(a[0] * gsc, a[1] * gsc); w0.y = cvtpk(a[2] * gsc, a[3] * gsc); w0.z = cvtpk(a[4] * gsc, a[5] * gsc); w0.w = cvtpk(a[6] * gsc, a[7] * gsc);
                    w1.x = cvtpk(a[8] * gsc, a[9] * gsc); w1.y = cvtpk(a[10] * gsc, a[11] * gsc); w1.z = cvtpk(a[12] * gsc, a[13] * gsc); w1.w = cvtpk(a[14] * gsc, a[15] * gsc);
                    bf16_t* q = O + (size_t)(orow0 + tr) * DM + (ni ? oc1 : oc0) + pass * 256 + wc * 32 + 16 * hi;
                    *(u32x4*)q = w0; *(u32x4*)(q + 8) = w1;
                }
            }
        }
    }
};

__device__ __forceinline__ void moe_gemm1_item(unsigned char* lds_in, PP p, int layer, int id) {
    unsigned char* lds = lds_here(lds_in);
    int e, nt, m; moe_decode(lds, id, 4, e, nt, m);
    const int* c = (const int*)(lds + MS_CNT); const int* o = (const int*)(lds + MS_OFF);
    const int cnt = __builtin_amdgcn_readfirstlane(c[e]), nvalid = (cnt - m * TM) < TM ? (cnt - m * TM) : TM;
    const int oe = __builtin_amdgcn_readfirstlane(o[e]);
    int* rows = (int*)(lds + G_ROWS);
    { const int t_ = tid_here();
      if (t_ < TM) {
        const int slot = m * TM + (t_ < nvalid ? t_ : nvalid - 1);
        rows[t_] = ((const int*)(p->ws + WS_TOKL))[(size_t)e * TALL + slot];
      } }
    __syncthreads();
    const float* W = p->exp_w13 + ((size_t)layer * 64 + e) * DM * 1024;
    GemmOp g{(const bf16_t*)(p->ws + WS_H1), DM, W, 1024, nt * 128, 512 + nt * 128, DM, 128};
    EpiSwiglu<3> ep{(bf16_t*)(p->ws + WS_ACT), oe + m * TM, nvalid, nt * 128};
    gemm_tile<1>(lds, g, ep);
}
__device__ __forceinline__ void moe_gemm2_item(unsigned char* lds_in, PP p, int layer, int id) {
    unsigned char* lds = lds_here(lds_in);
    int e, nt, m; moe_decode(lds, id, 4, e, nt, m); nt *= 2;
    const int* c = (const int*)(lds + MS_CNT); const int* o = (const int*)(lds + MS_OFF);
    const int cnt = __builtin_amdgcn_readfirstlane(c[e]), nvalid = (cnt - m * TM) < TM ? (cnt - m * TM) : TM;
    const int pos0 = __builtin_amdgcn_readfirstlane(o[e]) + m * TM;
    int* rows = (int*)(lds + G_ROWS);
    { const int t_ = tid_here(); if (t_ < TM) rows[t_] = pos0 + (t_ < nvalid ? t_ : nvalid - 1); }
    __syncthreads();
    const float* W = p->exp_w2 + ((size_t)layer * 64 + e) * DEXP * DM;
    GemmOp g{(const bf16_t*)(p->ws + WS_ACT), DEXP, W, DM, nt * 256, nt * 256 + 128, DEXP, 256};
    EpiScaleStore<3> ep{(bf16_t*)(p->ws + WS_Y), pos0, nvalid, nt * 256, nt * 256 + 128, (const float*)(p->ws + WS_GATEL) + (size_t)e * TALL + m * TM, {}};
    gemm_tile<2>(lds, g, ep);
}


constexpr int ST_ROWB = 528;
__device__ __forceinline__ void stage_put(unsigned char* lds, const f32x16& a, float sc, int row, int col) {
    u32x4 w0, w1;
    w0.x = cvtpk(a[0] * sc, a[1] * sc); w0.y = cvtpk(a[2] * sc, a[3] * sc); w0.z = cvtpk(a[4] * sc, a[5] * sc); w0.w = cvtpk(a[6] * sc, a[7] * sc);
    w1.x = cvtpk(a[8] * sc, a[9] * sc); w1.y = cvtpk(a[10] * sc, a[11] * sc); w1.z = cvtpk(a[12] * sc, a[13] * sc); w1.w = cvtpk(a[14] * sc, a[15] * sc);
    *(u32x4*)(lds + row * ST_ROWB + col * 2) = w0; *(u32x4*)(lds + row * ST_ROWB + col * 2 + 16) = w1;
}
struct EpiStoreBf16S {
    unsigned char* lds; bf16_t* O; int ldo; int orow0; int nrows; int oc0;
    __device__ __forceinline__ void pre(int, int) {}
    __device__ __forceinline__ void pin() {}
    __device__ __forceinline__ void operator()(const f32x16 (&acc)[2][4], int wr, int wc, int r32, int hi, int = 0) const {
#pragma unroll
        for (int mi = 0; mi < 4; ++mi)
#pragma unroll
            for (int ni = 0; ni < 2; ++ni) stage_put(lds, acc[ni][mi], 1.f, (2 * mi + wr) * 32 + r32, ni * 128 + wc * 32 + 16 * hi);
        __syncthreads();
        const int tid = tid_here();
#pragma unroll 4
        for (int i = 0; i < 16; ++i) {
            const int c = i * 512 + tid, row = c >> 5, ch = c & 31;
            if (row < nrows) *(u32x4*)(O + (size_t)(orow0 + row) * ldo + oc0 + ch * 8) = *(const u32x4*)(lds + row * ST_ROWB + ch * 16);
        }
    }
};

struct EpiConvS {
    unsigned char* lds; bf16_t* Q; const float* cw; int u0; int oc0;
    __device__ __forceinline__ void pre(int, int) {}
    __device__ __forceinline__ void pin() {}
    __device__ __forceinline__ void operator()(const f32x16 (&acc)[2][4], int wr, int wc, int r32, int hi, int = 0) const {
#pragma unroll
        for (int mi = 0; mi < 4; ++mi)
#pragma unroll
            for (int ni = 0; ni < 2; ++ni) stage_put(lds, acc[ni][mi], 1.f, (2 * mi + wr) * 32 + r32, ni * 128 + wc * 32 + 16 * hi);
        __syncthreads();
        const int tid = tid_here();
#pragma nounroll
        for (int i = 0; i < 16; ++i) {
            const int c = i * 512 + tid, row = c >> 5, ch = c & 31, u = u0 + row;
            if (row >= 3 && u < NB * LSEQ) {
                const int b = u / LSEQ, l = u - b * LSEQ, col = oc0 + ch * 8;
                float a8[8];
#pragma unroll
                for (int e = 0; e < 8; ++e) a8[e] = 0.f;
#pragma unroll
                for (int t = 0; t < 4; ++t) {
                    if (l - 3 + t >= 0) {
                        const u32x4 x = *(const u32x4*)(lds + (row - 3 + t) * ST_ROWB + ch * 16);
                        const f32x4 w0 = *(const f32x4*)(cw + t * 1536 + col), w1 = *(const f32x4*)(cw + t * 1536 + col + 4);
                        a8[0] += bflo(x.x) * w0[0]; a8[1] += bfhi(x.x) * w0[1]; a8[2] += bflo(x.y) * w0[2]; a8[3] += bfhi(x.y) * w0[3];
                        a8[4] += bflo(x.z) * w1[0]; a8[5] += bfhi(x.z) * w1[1]; a8[6] += bflo(x.w) * w1[2]; a8[7] += bfhi(x.w) * w1[3];
                    }
                }
                const float sc = col < 768 ? 0.08838834764831845f : 1.f;
#pragma unroll
                for (int e = 0; e < 8; ++e) a8[e] = siluf_(a8[e]) * sc;
                u32x4 w; w.x = cvtpk(a8[0], a8[1]); w.y = cvtpk(a8[2], a8[3]); w.z = cvtpk(a8[4], a8[5]); w.w = cvtpk(a8[6], a8[7]);
                *(u32x4*)(Q + (size_t)row_of(b, l) * 1536 + col) = w;
            }
        }
    }
};
struct EpiResidS {
    unsigned char* lds; const bf16_t* H; bf16_t* O; int orow0; int nrows; int oc0;
    __device__ __forceinline__ void pre(int, int) {}
    __device__ __forceinline__ void pin() {}
    __device__ __forceinline__ void operator()(const f32x16 (&acc)[2][4], int wr, int wc, int r32, int hi, int = 0) const {
#pragma unroll
        for (int mi = 0; mi < 4; ++mi)
#pragma unroll
            for (int ni = 0; ni < 2; ++ni) stage_put(lds, acc[ni][mi], 1.f, (2 * mi + wr) * 32 + r32, ni * 128 + wc * 32 + 16 * hi);
        const int tid = tid_here();
#pragma unroll
        for (int half = 0; half < 2; ++half) {
            u32x4 hv[8];
#pragma unroll
            for (int i = 0; i < 8; ++i) {
                const int c = (half * 8 + i) * 512 + tid, row = c >> 5, ch = c & 31, rowc = row < nrows ? row : nrows - 1;
                hv[i] = *(const u32x4*)(H + (size_t)(orow0 + rowc) * DM + oc0 + ch * 8);
            }
            if (half == 0) __syncthreads();
#pragma unroll
            for (int i = 0; i < 8; ++i) {
                const int c = (half * 8 + i) * 512 + tid, row = c >> 5, ch = c & 31;
                if (row < nrows) {
                    const u32x4 a = *(const u32x4*)(lds + row * ST_ROWB + ch * 16), h = hv[i];
                    u32x4 w;
                    w.x = cvtpk(DN_ALPHA * bflo(h.x) + bflo(a.x), DN_ALPHA * bfhi(h.x) + bfhi(a.x)); w.y = cvtpk(DN_ALPHA * bflo(h.y) + bflo(a.y), DN_ALPHA * bfhi(h.y) + bfhi(a.y));
                    w.z = cvtpk(DN_ALPHA * bflo(h.z) + bflo(a.z), DN_ALPHA * bfhi(h.z) + bfhi(a.z)); w.w = cvtpk(DN_ALPHA * bflo(h.w) + bflo(a.w), DN_ALPHA * bfhi(h.w) + bfhi(a.w));
                    *(u32x4*)(O + (size_t)(orow0 + row) * DM + oc0 + ch * 8) = w;
                }
            }
        }
    }
};

__device__ __forceinline__ void outproj_meta_item(unsigned char* lds_in, PP p, int layer, int item) {
    unsigned char* lds = lds_here(lds_in);
    const int tid = tid_here(), lane = tid & 63, wid = tid >> 6, r32 = lane & 31, hi = lane >> 5;
    const int row0 = TREAL + (item & 1) * 32, col0 = (item >> 1) * 32;
    const bf16_t* X = (const bf16_t*)(p->ws + WS_CAT) + (size_t)(row0 + r32) * DM + wid * 256 + hi * 8;
    const bf16_t* W = (const bf16_t*)(p->ws + WS_WT) + (size_t)layer * WT_LAYER + WT_OUT + (size_t)(col0 + r32) * DM + wid * 256 + hi * 8;
    f32x16 d;
#pragma unroll
    for (int r = 0; r < 16; ++r) d[r] = 0.f;
#pragma unroll
    for (int ks = 0; ks < 16; ++ks) {
        const bf16x8 a = *(const bf16x8*)(X + ks * 16), b = *(const bf16x8*)(W + ks * 16);
        d = __builtin_amdgcn_mfma_f32_32x32x16_bf16(a, b, d, 0, 0, 0);
    }
    float* part = (float*)lds;
#pragma unroll
    for (int r = 0; r < 16; ++r) part[(wid * 32 + crow(r, hi)) * 32 + r32] = d[r];
    __syncthreads();
    {
        const int row = tid >> 4, c2 = (tid & 15) * 2;
        float s0 = 0.f, s1 = 0.f;
#pragma unroll
        for (int w = 0; w < 8; ++w) { const f32x2 t = *(const f32x2*)(part + (w * 32 + row) * 32 + c2); s0 += t[0]; s1 += t[1]; }
        const size_t o = (size_t)(row0 + row) * DM + col0 + c2;
        const unsigned h = *(const unsigned*)((const bf16_t*)(p->ws + WS_HB) + o);
        *(unsigned*)((bf16_t*)(p->ws + WS_S1) + o) = cvtpk(DN_ALPHA * bflo(h) + s0, DN_ALPHA * bfhi(h) + s1);
    }
    __syncthreads();
}

constexpr float YQ_SCALE = 8.f;
struct EpiScaleStoreQ8 {
    unsigned char* lds; unsigned char* O; int orow0; int nrows; int oc0; int goff;
    float gpre[4];
    __device__ __forceinline__ void pre(int wr, int r32) {
#pragma unroll
        for (int mi = 0; mi < 4; ++mi) gpre[mi] = (goff >= 0 ? *(const float*)(lds + goff + ((2 * mi + wr) * 32 + r32) * 4) : 1.f) * YQ_SCALE;
    }
    __device__ __forceinline__ void pin() {}
    __device__ __forceinline__ void operator()(const f32x16 (&acc)[2][4], int wr, int wc, int r32, int hi, int = 0) const {
#pragma unroll
        for (int mi = 0; mi < 4; ++mi)
#pragma unroll
            for (int ni = 0; ni < 2; ++ni) {
                const f32x16& a = acc[ni][mi]; const float sc = gpre[mi];
                u32x4 w; w.x = pk4_fp8(a[0] * sc, a[1] * sc, a[2] * sc, a[3] * sc); w.y = pk4_fp8(a[4] * sc, a[5] * sc, a[6] * sc, a[7] * sc);
                w.z = pk4_fp8(a[8] * sc, a[9] * sc, a[10] * sc, a[11] * sc); w.w = pk4_fp8(a[12] * sc, a[13] * sc, a[14] * sc, a[15] * sc);
                *(u32x4*)(lds + ((2 * mi + wr) * 32 + r32) * 272 + ni * 128 + wc * 32 + 16 * hi) = w;
            }
        __syncthreads();
        const int tid = tid_here();
#pragma unroll 4
        for (int i = 0; i < 8; ++i) {
            const int c = i * 512 + tid, row = c >> 4, ch = c & 15;
            if (row < nrows) *(u32x4*)(O + (size_t)(orow0 + row) * DM + oc0 + ch * 16) = *(const u32x4*)(lds + row * 272 + ch * 16);
        }
    }
};
struct EpiScaleStoreS {
    unsigned char* lds; bf16_t* O; int orow0; int nrows; int oc0; const float* gate;
    float gpre[4];
    __device__ __forceinline__ void pre(int wr, int r32) {
#pragma unroll
        for (int mi = 0; mi < 4; ++mi) gpre[mi] = gate ? gate[(2 * mi + wr) * 32 + r32] : 1.f;
    }
    __device__ __forceinline__ void pin() {}
    __device__ __forceinline__ void operator()(const f32x16 (&acc)[2][4], int wr, int wc, int r32, int hi, int = 0) const {
#pragma unroll
        for (int mi = 0; mi < 4; ++mi)
#pragma unroll
            for (int ni = 0; ni < 2; ++ni) stage_put(lds, acc[ni][mi], gpre[mi], (2 * mi + wr) * 32 + r32, ni * 128 + wc * 32 + 16 * hi);
        __syncthreads();
        const int tid = tid_here();
#pragma unroll 4
        for (int i = 0; i < 16; ++i) {
            const int c = i * 512 + tid, row = c >> 5, ch = c & 31;
            if (row < nrows) *(u32x4*)(O + (size_t)(orow0 + row) * DM + oc0 + ch * 8) = *(const u32x4*)(lds + row * ST_ROWB + ch * 16);
        }
    }
};

#define GEMMQ_DISPATCH(nv, g, ep) do { if ((nv) > 128) gemm_tile_q<1, 4>(lds, g, ep); else if ((nv) > 64) gemm_tile_q<1, 2>(lds, g, ep); else gemm_tile_q<1, 1>(lds, g, ep); } while (0)
#ifndef G2_NPASS
#define G2_NPASS 1
#endif
template <int NMI> struct EpiSwigluQ {
    unsigned char* O; int orow0; int nrows; int oc;
    __device__ __forceinline__ void pre(int, int) {}
    __device__ __forceinline__ void pin() {}
    __device__ __forceinline__ void operator()(const f32x16 (&acc)[2][NMI], int wr, int wc, int r32, int hi, int = 0) const {
#pragma unroll
        for (int mi = 0; mi < NMI; ++mi) {
            const int tr = (2 * mi + wr) * 32 + r32;
            if (tr < nrows) {
                float v[16];
#pragma unroll
                for (int r = 0; r < 16; ++r) { const float gte = acc[0][mi][r]; v[r] = gte / (1.f + __expf(-gte)) * acc[1][mi][r]; }
                u32x4 w; w.x = pk4_fp8(v[0], v[1], v[2], v[3]); w.y = pk4_fp8(v[4], v[5], v[6], v[7]); w.z = pk4_fp8(v[8], v[9], v[10], v[11]); w.w = pk4_fp8(v[12], v[13], v[14], v[15]);
                *(u32x4*)(O + (size_t)(orow0 + tr) * DEXP + oc + wc * 32 + 16 * hi) = w;
            }
        }
    }
};
__device__ __forceinline__ void moeq_gemm1_item(unsigned char* lds_in, PP p, int layer, int id) {
    unsigned char* lds = lds_here(lds_in);
    int e, nt, m; moe_decode(lds, id, 4, e, nt, m);
    const int* c = (const int*)(lds + MS_CNT); const int* o = (const int*)(lds + MS_OFF);
    const int cnt = __builtin_amdgcn_readfirstlane(c[e]), nvalid = (cnt - m * TMB) < TMB ? (cnt - m * TMB) : TMB;
    const int oe = __builtin_amdgcn_readfirstlane(o[e]);
    int* rows = (int*)(lds + BF_ROWS);
    { const int t_ = tid_here();
      if (t_ < TMB) { const int slot = m * TMB + (t_ < nvalid ? t_ : nvalid - 1); rows[t_] = ((const int*)(p->ws + WS_TOKL))[(size_t)e * TALL + slot]; } }
    __syncthreads();
    GemmOpQ g{p->ws + WS_H1Q, DM, p->ws + WS_W13Q + layer * W13Q_LAYER + (size_t)e * 1024 * DM, DM, nt * 128, 512 + nt * 128, DM, 0, nvalid};
    EpiSwigluQ<4> ep{p->ws + WS_ACTQ, oe + m * TMB, nvalid, nt * 128};
    GEMMQ_DISPATCH(nvalid, g, ep);
}
__device__ __forceinline__ void moeq_gemm2_item(unsigned char* lds_in, PP p, int layer, int id) {
    unsigned char* lds = lds_here(lds_in);
    int e, nt, m; moe_decode(lds, id, 8 / G2_NPASS, e, nt, m); nt *= G2_NPASS;
    const int* c = (const int*)(lds + MS_CNT); const int* o = (const int*)(lds + MS_OFF);
    const int cnt = __builtin_amdgcn_readfirstlane(c[e]), nvalid = (cnt - m * TMB) < TMB ? (cnt - m * TMB) : TMB;
    const int pos0 = __builtin_amdgcn_readfirstlane(o[e]) + m * TMB;
    int* rows = (int*)(lds + BF_ROWS);
    { const int t_ = tid_here(); if (t_ < TMB) { const int s_ = t_ < nvalid ? t_ : nvalid - 1; rows[t_] = pos0 + s_;
        ((float*)(lds + BF_ROWS + 1024))[t_] = ((const float*)(p->ws + WS_GATEL))[(size_t)e * TALL + m * TMB + s_]; } }
    __syncthreads();
    GemmOpQ g{p->ws + WS_ACTQ, DEXP, p->ws + WS_W2Q + layer * W2Q_LAYER + (size_t)e * DM * DEXP, DEXP, nt * 256, nt * 256 + 128, DEXP, 256, nvalid};
    EpiScaleStoreQ8 ep{lds, p->ws + WS_Y, pos0, nvalid, nt * 256, BF_ROWS + 1024, {}};
    GEMMQ_DISPATCH(nvalid, g, ep);
}
constexpr int XB_N13 = NEXP * 16 * 8, XB_N2 = NEXP * 4 * 16, XB_TOTAL = XB_N13 + XB_N2;
constexpr int XB_LDS = 0, XB_IDW = 128 * 132;
struct XBlock { const float* src; int ldsrc; unsigned char* dst; int K; };
__device__ __forceinline__ XBlock xblock_of(PP p, int layer, int id) {
    XBlock x;
    if (id < XB_N13) { const int e = id >> 7, r = id & 127, kb = r >> 3, nb = r & 7;
        x.src = p->exp_w13 + ((size_t)layer * NEXP + e) * DM * 1024 + (size_t)(kb * 128) * 1024 + nb * 128; x.ldsrc = 1024;
        x.dst = p->ws + WS_W13Q + layer * W13Q_LAYER + (size_t)e * 1024 * DM + (size_t)(nb * 128) * DM + kb * 128; x.K = DM; }
    else { const int q = id - XB_N13, e = q >> 6, r = q & 63, kb = r >> 4, nb = r & 15;
        x.src = p->exp_w2 + ((size_t)layer * NEXP + e) * DEXP * DM + (size_t)(kb * 128) * DM + nb * 128; x.ldsrc = DM;
        x.dst = p->ws + WS_W2Q + layer * W2Q_LAYER + (size_t)e * DM * DEXP + (size_t)(nb * 128) * DEXP + kb * 128; x.K = DEXP; }
    return x;
}
#define XB_LOAD(V, X) do { _Pragma("unroll") for (int u = 0; u < 2; ++u) { const int blk_ = u * 512 + tid, k4_ = blk_ >> 5, n4_ = blk_ & 31; \
        _Pragma("unroll") for (int j = 0; j < 4; ++j) V[u][j] = __builtin_nontemporal_load((const f32x4*)((X).src + (size_t)(k4_ * 4 + j) * (X).ldsrc + n4_ * 4)); } } while (0)
#define XB_STORE(V, X) do { \
        _Pragma("unroll") for (int u = 0; u < 2; ++u) { const int blk_ = u * 512 + tid, k4_ = blk_ >> 5, n4_ = blk_ & 31; \
            _Pragma("unroll") for (int i = 0; i < 4; ++i) *(unsigned*)(lds + XB_LDS + (n4_ * 4 + i) * 132 + k4_ * 4) = pk4_fp8(V[u][0][i] * 64.f, V[u][1][i] * 64.f, V[u][2][i] * 64.f, V[u][3][i] * 64.f); } \
        __syncthreads(); \
        { const int n_ = tid >> 2, seg_ = tid & 3; const unsigned* r_ = (const unsigned*)(lds + XB_LDS + n_ * 132 + seg_ * 32); \
          u32x4 w0_, w1_; w0_.x = r_[0]; w0_.y = r_[1]; w0_.z = r_[2]; w0_.w = r_[3]; w1_.x = r_[4]; w1_.y = r_[5]; w1_.z = r_[6]; w1_.w = r_[7]; \
          unsigned char* d_ = (X).dst + (size_t)n_ * (X).K + seg_ * 32; *(u32x4*)d_ = w0_; *(u32x4*)(d_ + 16) = w1_; } \
        __syncthreads(); } while (0)
constexpr int XB_CHUNK = 4;
__device__ __forceinline__ int xb_grab(unsigned char* lds, unsigned* qword, int tid) {
    volatile int* w = (volatile int*)(lds + XB_IDW);
    if (tid == 0) *w = (int)__hip_atomic_fetch_add(qword, (unsigned)XB_CHUNK, __ATOMIC_RELAXED, __HIP_MEMORY_SCOPE_AGENT);
    __syncthreads();
    return __builtin_amdgcn_readfirstlane(*w);
}
__device__ __forceinline__ void convert_experts_queue(unsigned char* lds_in, PP p, int layer) {
    unsigned char* lds = lds_here(lds_in);
    const int tid = tid_here();
    unsigned* qword = (unsigned*)(p->ws + WS_CTL + CTL_CNT) + CNT_QWORD + 64 * layer;
    static_assert(XB_TOTAL % XB_CHUNK == 0, "whole chunks");
    int cur = xb_grab(lds, qword, tid);
    if (cur < XB_TOTAL) {
        f32x4 va[2][4], vb[2][4];
        XBlock xa = xblock_of(p, layer, cur), xb_;
        XB_LOAD(va, xa);
        for (;;) {
            int nxt_reg = 0;
            if (tid == 0) nxt_reg = (int)__hip_atomic_fetch_add(qword, (unsigned)XB_CHUNK, __ATOMIC_RELAXED, __HIP_MEMORY_SCOPE_AGENT);
            xb_ = xblock_of(p, layer, cur + 1); XB_LOAD(vb, xb_);
            XB_STORE(va, xa);
            xa = xblock_of(p, layer, cur + 2); XB_LOAD(va, xa);
            XB_STORE(vb, xb_);
            xb_ = xblock_of(p, layer, cur + 3); XB_LOAD(vb, xb_);
            XB_STORE(va, xa);
            volatile int* w = (volatile int*)(lds + XB_IDW);
            if (tid == 0) *w = nxt_reg;
            __syncthreads();
            const int nxt = __builtin_amdgcn_readfirstlane(*w);
            const bool more = nxt < XB_TOTAL;
            if (more) { xa = xblock_of(p, layer, nxt); XB_LOAD(va, xa); }
            XB_STORE(vb, xb_);
            if (!more) break;
            cur = nxt;
        }
    }
    __syncthreads();
}

__device__ __forceinline__ void shared_gemm1_item(unsigned char* lds_in, PP p, int layer, int id, int M) {
    unsigned char* lds = lds_here(lds_in);
    const int mt = id >> 2, nt = id & 3, tid = tid_here();
    int* rows = (int*)(lds + BF_ROWS);
    if (tid < TMB) { const int r = mt * TMB + tid; rows[tid] = r < M ? r : M - 1; }
    __syncthreads();
    GemmOpQ g{p->ws + WS_H1Q, DM, p->ws + WS_SHQ + (size_t)layer * SHQ_LAYER, DM, nt * 128, 512 + nt * 128, DM, 0, M - mt * TMB};
    EpiSwigluQ<4> ep{p->ws + WS_ACTQ, SH_BASE + mt * TMB, M - mt * TMB, nt * 128};
    gemm_tile_q<1, 4>(lds, g, ep);
}
__device__ __forceinline__ void shared_gemm2_item(unsigned char* lds_in, PP p, int layer, int id, int M) {
    unsigned char* lds = lds_here(lds_in);
    const int mt = id / (8 / G2_NPASS), nt = (id % (8 / G2_NPASS)) * G2_NPASS, tid = tid_here();
    int* rows = (int*)(lds + BF_ROWS);
    if (tid < TMB) { const int r = mt * TMB + tid; rows[tid] = SH_BASE + (r < M ? r : M - 1); }
    __syncthreads();
    GemmOpQ g{p->ws + WS_ACTQ, DEXP, p->ws + WS_SHQ + (size_t)layer * SHQ_LAYER + (size_t)1024 * DM, DEXP, nt * 256, nt * 256 + 128, DEXP, 256, M - mt * TMB};
    EpiScaleStoreQ8 ep{lds, p->ws + WS_Y, SH_BASE + mt * TMB, M - mt * TMB, nt * 256, -1, {}};
    gemm_tile_q<1, 4>(lds, g, ep);
}
__device__ __forceinline__ void convert_shared_q(unsigned char* lds_in, PP p, int bx, int G) {
    unsigned char* lds = lds_here(lds_in);
    const int tid = tid_here();
    constexpr int NB13 = 16 * 8, NB2 = 4 * 16;
    for (int id = bx; id < DEPTH * (NB13 + NB2); id += G) {
        const int layer = id / (NB13 + NB2), r = id % (NB13 + NB2);
        XBlock x;
        if (r < NB13) { const int kb = r >> 3, nb = r & 7; x.src = p->sh_w13 + (size_t)layer * DM * 1024 + (size_t)(kb * 128) * 1024 + nb * 128; x.ldsrc = 1024;
            x.dst = p->ws + WS_SHQ + (size_t)layer * SHQ_LAYER + (size_t)(nb * 128) * DM + kb * 128; x.K = DM; }
        else { const int q = r - NB13, kb = q >> 4, nb = q & 15; x.src = p->sh_w2 + (size_t)layer * DEXP * DM + (size_t)(kb * 128) * DM + nb * 128; x.ldsrc = DM;
            x.dst = p->ws + WS_SHQ + (size_t)layer * SHQ_LAYER + (size_t)1024 * DM + (size_t)(nb * 128) * DEXP + kb * 128; x.K = DEXP; }
        f32x4 va[2][4];
        XB_LOAD(va, x); XB_STORE(va, x);
    }
}

constexpr int TM2 = 128;
__device__ __forceinline__ void moeq_gemm2r_item(unsigned char* lds_in, PP p, int layer, int id, int nsh, int M) {
    unsigned char* lds = lds_here(lds_in);
    int* rows = (int*)(lds + R_ROWS);
    const int t_ = tid_here();
    Gemm2Op g;
    g.Y = (bf16_t*)(p->ws + WS_Y); g.X = p->ws + WS_ACTQ; g.dump = (bf16_t*)(p->ws + WS_DUMP);
    if (id < nsh) {
        const int r0 = id * TM2, nv = (M - r0) < TM2 ? (M - r0) : TM2;
        if (t_ < TM2) rows[t_] = SH_BASE + r0 + (t_ < nv ? t_ : nv - 1);
        g.Wt = p->ws + WS_SHQ + (size_t)layer * SHQ_LAYER + (size_t)1024 * DM; g.gate = nullptr; g.yrow0 = SH_BASE + r0; g.nrows = nv;
    } else {
        int e, nt, m; moe_decode(lds, id - nsh, 1, e, nt, m);
        const int* c = (const int*)(lds + MS_CNT); const int* o = (const int*)(lds + MS_OFF);
        const int cnt = __builtin_amdgcn_readfirstlane(c[e]), nv = (cnt - m * TM2) < TM2 ? (cnt - m * TM2) : TM2;
        const int pos0 = __builtin_amdgcn_readfirstlane(o[e]) + m * TM2;
        if (t_ < TM2) rows[t_] = pos0 + (t_ < nv ? t_ : nv - 1);
        g.Wt = p->ws + WS_W2Q + layer * W2Q_LAYER + (size_t)e * DM * DEXP; g.gate = (const float*)(p->ws + WS_GATEL) + (size_t)e * TALL + m * TM2; g.yrow0 = pos0; g.nrows = nv;
    }
    __syncthreads();
    gemm2_resident(lds, g);
}

__device__ __forceinline__ void phase_combine(unsigned char* lds, PP p, int layer, int M, int bx, int G) {
    const int tid = tid_here(), lane = tid & 63, gw = bx * 8 + (tid >> 6), nw = G * 8;
    const int* o = (const int*)(lds + MS_OFF);
    const bf16_t* H1 = (const bf16_t*)(p->ws + WS_H1); const unsigned char* Y = p->ws + WS_Y;
    const int* asg_e = (const int*)(p->ws + WS_ASGE); const int* asg_s = (const int*)(p->ws + WS_ASGS);
    bf16_t* hb = (bf16_t*)(p->ws + WS_HB);
    for (int row = gw; row < M; row += nw) {
        float v[32];
        load_row32_bf16(H1 + (size_t)row * DM, lane, v);
#pragma unroll
        for (int i = 0; i < 32; ++i) v[i] *= DN_ALPHA;
        {
            typedef int i32x4 __attribute__((ext_vector_type(4)));
            const i32x4 e0 = *(const i32x4*)(asg_e + row * 8), e1 = *(const i32x4*)(asg_e + row * 8 + 4);
            const i32x4 s0 = *(const i32x4*)(asg_s + row * 8), s1 = *(const i32x4*)(asg_s + row * 8 + 4);
            int pos[9];
#pragma unroll
            for (int k = 0; k < 4; ++k) { pos[k] = o[e0[k]] + s0[k]; pos[4 + k] = o[e1[k]] + s1[k]; }
            pos[8] = SH_BASE + row;
            constexpr float YI = 1.f / YQ_SCALE;
#pragma unroll
            for (int k0 = 0; k0 < 9; k0 += 3) {
                asm volatile("" ::: "memory");
                u32x2 yv[3][4];
#pragma unroll
                for (int k = 0; k < 3; ++k)
#pragma unroll
                    for (int i = 0; i < 4; ++i) yv[k][i] = *(const u32x2*)(Y + (size_t)pos[k0 + k] * DM + i * 512 + lane * 8);
#pragma unroll
                for (int k = 0; k < 3; ++k)
#pragma unroll
                    for (int i = 0; i < 4; ++i) {
                        const f32x2 a = __builtin_amdgcn_cvt_pk_f32_fp8((int)yv[k][i].x, false), b = __builtin_amdgcn_cvt_pk_f32_fp8((int)yv[k][i].x, true);
                        const f32x2 c = __builtin_amdgcn_cvt_pk_f32_fp8((int)yv[k][i].y, false), d = __builtin_amdgcn_cvt_pk_f32_fp8((int)yv[k][i].y, true);
                        v[i * 8 + 0] += a[0] * YI; v[i * 8 + 1] += a[1] * YI; v[i * 8 + 2] += b[0] * YI; v[i * 8 + 3] += b[1] * YI;
                        v[i * 8 + 4] += c[0] * YI; v[i * 8 + 5] += c[1] * YI; v[i * 8 + 6] += d[0] * YI; v[i * 8 + 7] += d[1] * YI;
                    }
            }
        }
        ln_row32(v, p->ln2_g + layer * DM, p->ln2_b + layer * DM, lane);
        if (layer == DEPTH - 1) {
#pragma unroll
            for (int i = 0; i < 4; ++i) {
                float* dst = p->out + (size_t)row * DM + i * 512 + lane * 8;
                *(f32x4*)dst = (f32x4){v[i * 8], v[i * 8 + 1], v[i * 8 + 2], v[i * 8 + 3]};
                *(f32x4*)(dst + 4) = (f32x4){v[i * 8 + 4], v[i * 8 + 5], v[i * 8 + 6], v[i * 8 + 7]};
            }
        } else {
            store_row32_bf16(hb + (size_t)row * DM, lane, v);
            row_gates(lds, p, layer + 1, row, lane, v);
        }
    }
}

#define XB_TMO      128
#define XB_XCNT(j)  (256  + 64 * (j))
#define XB_XSUB(j)  (1280 + 64 * (j))
#define XB_XGEN(j)  (2304 + 64 * (j))
#define XB_TOP      3328
#define XB_TOPGEN   3392
#define XCD_BAR_WORDS 3456
#define XB_SPIN_CAP (1u << 18)

__device__ __forceinline__ unsigned xb_ld(unsigned* p)              { return __hip_atomic_load(p, __ATOMIC_RELAXED, __HIP_MEMORY_SCOPE_AGENT); }
__device__ __forceinline__ unsigned xb_add(unsigned* p, unsigned v) { return __hip_atomic_fetch_add(p, v, __ATOMIC_RELAXED, __HIP_MEMORY_SCOPE_AGENT); }
__device__ __forceinline__ unsigned xb_xcc_id() { return (unsigned)__builtin_amdgcn_s_getreg((3 << 11) | 20) & 0xFu; }
#define XB_SPIN(cond, bar) do { unsigned _sp = 0; while (cond) { __builtin_amdgcn_s_sleep(1); \
    if ((++_sp & 255u) == 0u) { if (xb_ld(&(bar)[XB_TMO])) break; if (_sp > XB_SPIN_CAP) { atomicAdd(&(bar)[XB_TMO], 1u); break; } } } } while (0)

struct XcdBarrier { unsigned* bar; unsigned x; volatile LAS unsigned* st; };

__device__ __forceinline__ XcdBarrier xcd_barrier_post(unsigned* bar, volatile LAS unsigned* st) {
    XcdBarrier b; b.bar = bar; b.x = xb_xcc_id(); b.st = st;
    if (threadIdx.x == 0) (void)xb_add(&bar[XB_XCNT(b.x)], 1u);
    return b;
}
__device__ __forceinline__ void xcd_barrier_complete(unsigned* bar, unsigned x, unsigned& nloc, unsigned& nx) {
    const unsigned G = gridDim.x * gridDim.y * gridDim.z;
    unsigned sum, cnt, mine, sp = 0u;
    for (;;) {
        sum = 0u; cnt = 0u; mine = 0u;
#pragma unroll
        for (unsigned j = 0; j < 16; ++j) { const unsigned c = xb_ld(&bar[XB_XCNT(j)]); sum += c; cnt += (c > 0u) ? 1u : 0u; mine = (j == x) ? c : mine; }
        if (sum == G) break;
        __builtin_amdgcn_s_sleep(1);
        if ((++sp & 255u) == 0u) { if (xb_ld(&bar[XB_TMO])) break; if (sp > XB_SPIN_CAP) { atomicAdd(&bar[XB_TMO], 1u); break; } }
    }
    nloc = mine > 0u ? mine : 1u; nx = cnt > 0u ? cnt : 1u;
}
__device__ __forceinline__ void xcd_barrier(const XcdBarrier& b) {
    asm volatile("s_waitcnt vmcnt(0)" ::: "memory");
    __syncthreads();
    if (threadIdx.x == 0) {
        unsigned* bar = b.bar;
        __builtin_amdgcn_s_waitcnt(0);
        unsigned nloc = b.st[0], nx = b.st[1];
        if (nloc == 0u) { xcd_barrier_complete(bar, b.x, nloc, nx); b.st[0] = nloc; b.st[1] = nx; }
        const unsigned old = xb_add(&bar[XB_XSUB(b.x)], 1u);
        const unsigned gen = old / nloc;
        if (old + 1u == (gen + 1u) * nloc) {
            __builtin_amdgcn_fence(__ATOMIC_RELEASE, "agent");
            asm volatile("s_waitcnt vmcnt(0)" ::: "memory");
            const unsigned og = xb_add(&bar[XB_TOP], 1u);
            const unsigned tg = og / nx;
            if (og + 1u == (tg + 1u) * nx) xb_add(&bar[XB_TOPGEN], 1u);
            else XB_SPIN(xb_ld(&bar[XB_TOPGEN]) == tg, bar);
            __builtin_amdgcn_fence(__ATOMIC_ACQUIRE, "agent");
            xb_add(&bar[XB_XGEN(b.x)], 1u);
            asm volatile("s_waitcnt vmcnt(0)" ::: "memory");
        } else {
            XB_SPIN(xb_ld(&bar[XB_XGEN(b.x)]) == gen, bar);
            __builtin_amdgcn_fence(__ATOMIC_ACQUIRE, "agent");
            asm volatile("s_waitcnt vmcnt(0)" ::: "memory");
        }
    }
    __syncthreads();
}

constexpr int NPHASES = 1 + 8 * DEPTH;
constexpr int XBW_OFF = LDS_BYTES - 16;

__global__ void __launch_bounds__(NTHREADS, 2) fwd_kernel(Params p_by_value) {
    extern __shared__ __attribute__((aligned(16))) unsigned char lds0[];
    const int tid0 = threadIdx.x, G0 = gridDim.x, bx0 = blockIdx.x;
    const int vcu0 = (G0 % 8 == 0) ? (bx0 % 8) * (G0 / 8) + bx0 / 8 : bx0;
    PP p = get_params();
    const int lo = p->ph_lo, hi = p->ph_hi;
    if (tid0 == 0) *(uint4*)(lds0 + XBW_OFF) = make_uint4(0u, 0u, 0u, 0u);
    __syncthreads();
    XcdBarrier bar; bar.bar = (unsigned*)(p->ws + WS_CTL); bar.x = 0; bar.st = (volatile LAS unsigned*)(LAS unsigned char*)(lds0 + XBW_OFF);
    if (hi - lo > 1) bar = xcd_barrier_post((unsigned*)(p->ws + WS_CTL), (volatile LAS unsigned*)(LAS unsigned char*)(lds0 + XBW_OFF));
#ifndef PHMASK
#define PHMASK 0x1FF
#endif
#define IN(k) (lo <= (k) && (k) < hi)
#define PHASE_IDS() unsigned char* lds = lds_here(lds0); const int G = sgpr_here(G0), bx = sgpr_here(bx0), vcu = sgpr_here(vcu0), tid = tid_here(); (void)G; (void)bx; (void)vcu; (void)tid
#define EN(b) (((PHMASK) >> (b)) & 1)
#ifndef REPMASK
#define REPMASK 0
#endif
#ifndef REPLAYER
#define REPLAYER -1
#endif
#define REPEAT(k) for (int rep_ = 0; rep_ <= ((((REPMASK) >> (k)) & 1) && (REPLAYER < 0 || layer == REPLAYER) ? 1 : 0); ++rep_)
#define REPBAR() do { if (rep_) xcd_barrier(bar); } while (0)
#ifndef MXMASK
#define MXMASK 0x3F
#endif
#define MXEN(b) (((MXMASK) >> (b)) & 1)
#ifndef MXDUP
#define MXDUP -1
#endif
#ifdef DBG_PHN
#define PH_T0 ((volatile unsigned long long*)(lds0 + LDS_BYTES - 32))
#define PH_BEGIN(k) do { if ((k) == DBG_PHN && layer == DBG_PHL && tid_here() == 0) *PH_T0 = __builtin_amdgcn_s_memtime(); } while (0)
#define PH_MID(k) do { if ((k) == DBG_PHN && layer == DBG_PHL && tid_here() == 0) { const unsigned long long t_ = __builtin_amdgcn_s_memtime() - *PH_T0; atomicAdd(&dbg_acc[0], t_); atomicAdd(&dbg_acc[3], 1ull); atomicMax(&dbg_acc[2], t_); atomicMax(&dbg_acc[4], 1000000000ull - t_); } } while (0)
#define PH_END(k) do { if ((k) == DBG_PHN && layer == DBG_PHL && tid_here() == 0 && blockIdx.x == 0) dbg_acc[1] = __builtin_amdgcn_s_memtime() - *PH_T0; } while (0)
#elif defined(SPIN_PHN)
#define PH_T0 ((volatile unsigned long long*)(lds0 + LDS_BYTES - 32))
#define PH_BEGIN(k) do { if ((k) == SPIN_PHN && layer == SPIN_PHL && blockIdx.x == 0 && tid_here() == 0) *PH_T0 = __builtin_amdgcn_s_memtime(); } while (0)
#define PH_MID(k)
#define PH_END(k) do { if ((k) == SPIN_PHN && layer == SPIN_PHL && blockIdx.x == 0) { __syncthreads(); const unsigned long long t1_ = __builtin_amdgcn_s_memtime(), T_ = t1_ - *PH_T0; \
        while (__builtin_amdgcn_s_memtime() < t1_ + (unsigned long long)(SPIN_K) * T_) __builtin_amdgcn_s_sleep(8); __syncthreads(); } } while (0)
#else
#define PH_BEGIN(k)
#define PH_MID(k)
#define PH_END(k)
#endif
#define SEAM(k) do { if (IN((k) + 1)) xcd_barrier(bar); } while (0)
#ifdef DBG_P2MIX
#define PH_MIDS(n) do { if ((n) != 2) PH_MID(n); } while (0)
#else
#define PH_MIDS(n) PH_MID(n)
#endif
#define SEAMN(n) do { PH_MIDS(n); if (IN(pb + (n) + 1)) xcd_barrier(bar); PH_END(n); } while (0)

#if defined(SPIN_PHN) && SPIN_PHN >= 8
    if (blockIdx.x == 0 && tid_here() == 0) *PH_T0 = __builtin_amdgcn_s_memtime();
#endif
    if (EN(8) && IN(0)) for (int rep0_ = 0; rep0_ <= (((REPMASK) >> 8) & 1); ++rep0_) { p = get_params(); PHASE_IDS(); if (rep0_) xcd_barrier(bar); phase_ln_in(lds, p, bx, G); __syncthreads(); phase_convert(lds, p, bx, G); __syncthreads(); convert_shared_q(lds, p, bx, G); router_preformat(p, bx, G); if (rep0_ == (((REPMASK) >> 8) & 1)) SEAM(0); }


#if defined(SPIN_PHN) && SPIN_PHN == 8
    if (blockIdx.x == 0) { __syncthreads(); const unsigned long long t1_ = __builtin_amdgcn_s_memtime(), T_ = t1_ - *PH_T0;
        while (__builtin_amdgcn_s_memtime() < t1_ + (unsigned long long)(SPIN_K) * T_) __builtin_amdgcn_s_sleep(8); __syncthreads(); }
#endif
    for (int layer = 0; layer < DEPTH; ++layer) {
        const int pb = 1 + 8 * layer;
        const int M = (layer == DEPTH - 1) ? TREAL : TALL;
        if (EN(0) && IN(pb + 0)) REPEAT(0) { p = get_params(); PHASE_IDS(); REPBAR(); PH_BEGIN(0);
            int* rows = (int*)(lds + BF_ROWS);
            for (int id = vcu; id < 759; id += G) {
                int mt, nt;
#if defined(EXP_ORDER) && EXP_ORDER == 1
                mt = id % 33; nt = id / 33;
#elif defined(EXP_ORDER) && EXP_ORDER == 2
                nt = id % 23; mt = id / 23;
#elif defined(EXP_ORDER) && EXP_ORDER == 3
                if (id < 736) { const int grp = id / 92, r = id % 92; nt = r >> 2; mt = grp * 4 + (r & 3); } else { mt = 32; nt = id - 736; }
#else
                if (id < 736) { const int grp = id / 184, r = id % 184; nt = r >> 3; mt = grp * 8 + (r & 7); } else { mt = 32; nt = id - 736; }
#endif
#ifdef FUSE_CONV
                if (nt < 6) {
                    const int u0 = 253 * mt - 3;
                    if (tid < TMB) { int u = u0 + tid; u = u < 0 ? 0 : (u > NB * LSEQ - 1 ? NB * LSEQ - 1 : u); const int b_ = u / LSEQ; rows[tid] = row_of(b_, u - b_ * LSEQ); }
                    __syncthreads();
                    GemmOpBf g{(const bf16_t*)(p->ws + WS_HB), DM, (const bf16_t*)(p->ws + WS_WT) + (size_t)layer * WT_LAYER + WT_IN, DM, nt * 256, nt * 256 + 128, DM};
                    EpiConvS e{lds, (bf16_t*)(p->ws + WS_QKC), p->conv_qk + (size_t)layer * 4 * 1536, u0, nt * 256};
                    gemm_tile_bf(lds, g, e);
                    continue;
                }
#endif
                if (tid < TMB) { const int r = mt * TMB + tid; rows[tid] = r < TALL ? r : TALL - 1; }
                __syncthreads();
                GemmOpBf g{(const bf16_t*)(p->ws + WS_HB), DM, (const bf16_t*)(p->ws + WS_WT) + (size_t)layer * WT_LAYER + WT_IN, DM, nt * 256, nt * 256 + 128, DM};
                EpiStoreBf16S e{lds, (bf16_t*)(p->ws + WS_PROJ), PROJ_W, mt * TMB, TALL - mt * TMB, nt * 256};
                gemm_tile_bf(lds, g, e);
            }
            SEAMN(0);
        }
#ifndef FUSE_CONV
        if (EN(1) && IN(pb + 1)) REPEAT(1) { p = get_params(); PHASE_IDS(); REPBAR(); PH_BEGIN(1); phase_conv(p, layer, bx, G); SEAMN(1); }
#endif
        if (EN(2) && IN(pb + 2)) REPEAT(2) { p = get_params(); PHASE_IDS(); REPBAR(); PH_BEGIN(2);
#ifdef REP_P2_FULL
            if (rep_) { if (bx == 0 && tid == 0) __hip_atomic_store((unsigned*)(p->ws + WS_CTL + CTL_CNT) + CNT_QWORD + 64 * layer, 0u, __ATOMIC_RELAXED, __HIP_MEMORY_SCOPE_AGENT); xcd_barrier(bar); }
#endif
#if defined(USE_FP8_EXPERTS) && CONV_A_BUDGET > 0
            if ((bx >> 3) & 1) convert_experts_queue(lds, p, layer, CONV_A_BUDGET);
#endif
            int r = 0;
            for (int base = 0; base < 704; base += G, ++r) {
                const int id = base + ((r & 1) ? (G - 1 - bx) : bx);
                if (id < 704) {
#ifdef DBG_MIX
                    const unsigned long long tm0 = __builtin_amdgcn_s_memtime(); int ityp = 0;
#endif
                    if (id < 384) {
                        const int j = 7 - id / 48, rem = id % 48, mode = rem / 24, bh = rem % 24;
#ifdef DBG_MIX
                        ityp = (j == 7) ? (mode == 0 ? 1 : 2) : 0;
#endif
                        for (int dq_ = 0, dn_ = rdup_n((MXDUP == 0 && mode == 0) || (MXDUP == 1 && mode == 1) ? 2 : 1); dq_ < dn_; ++dq_)
                        if (MXEN(0) && mode == 0) mixer_item<0>(lds, p, layer, bh / 6, bh % 6, j); else if (MXEN(1)) mixer_item<1>(lds, p, layer, bh / 6, bh % 6, j);
                    } else if (id < 656) {
                        const int q = id - 384, g = q & 3, rb = q >> 2;
#ifdef DBG_MIX
                        ityp = 3;
#endif
                        for (int dq_ = 0, dn_ = rdup_n(MXDUP == 2 ? 2 : 1); dq_ < dn_; ++dq_)
                        if (MXEN(2)) pool_item(lds, p, layer, rb / 17, rb % 17, g);
                    } else {
                        const int q = id - 656, mode = q / 24, bh = q % 24;
#ifdef DBG_MIX
                        ityp = 4 + mode;
#endif
                        if (MXEN(3) && mode == 0) mixer_meta_item<0>(lds, p, layer, bh / 6, bh % 6); else if (MXEN(4)) mixer_meta_item<1>(lds, p, layer, bh / 6, bh % 6);
                    }
#ifdef DBG_MIX
                    if (tid == 0 && ityp == DBG_MIX) { atomicAdd(&dbg_acc[2], __builtin_amdgcn_s_memtime() - tm0); atomicAdd(&dbg_acc[3], 1ull); }
#endif
                }
            }
#ifdef DBG_P2MIX
            PH_MID(2);
#endif
#ifdef USE_FP8_EXPERTS
            convert_experts_queue(lds, p, layer);
#endif
            SEAMN(2);
        }
        if (EN(3) && IN(pb + 3)) REPEAT(3) { p = get_params(); PHASE_IDS(); REPBAR(); PH_BEGIN(3);
            int* rows = (int*)(lds + BF_ROWS);
            const int ntile = (TREAL / TMB) * 8;
            if (M > TREAL) for (int it = G - 1 - bx; it < 128; it += G) outproj_meta_item(lds, p, layer, it);
            for (int id = vcu; id < ntile; id += G) {
                const int mt = id >> 3, nt = id & 7;
                if (tid < TMB) { const int r = mt * TMB + tid; rows[tid] = r < M ? r : M - 1; }
                __syncthreads();
                GemmOpBf g{(const bf16_t*)(p->ws + WS_CAT), DM, (const bf16_t*)(p->ws + WS_WT) + (size_t)layer * WT_LAYER + WT_OUT, DM, nt * 256, nt * 256 + 128, DM};
                EpiResidS e{lds, (const bf16_t*)(p->ws + WS_HB), (bf16_t*)(p->ws + WS_S1), mt * TMB, M - mt * TMB, nt * 256};
                gemm_tile_bf(lds, g, e);
            }
#ifdef TAIL_CONVERT
            if (layer + 1 < DEPTH && vcu >= ntile - ((ntile - 1) / G) * G) convert_experts_queue(lds, p, layer + 1, TAILC_P3);
#endif
            SEAMN(3);
        }
        if (EN(4) && IN(pb + 4)) REPEAT(4) { p = get_params(); PHASE_IDS(); REPBAR(); PH_BEGIN(4);
#ifdef REP_P4_RESET
            if (rep_) { if (bx == 0 && tid < 64) ((int*)(p->ws + WS_CTL + CTL_CNT) + layer * CNT_LAYER)[tid * CNT_STRIDE] = 0; __threadfence(); xcd_barrier(bar); }
#endif
            const int nit = (M + 31) >> 5;
            for (int id = bx; id < nit; id += G) router_item(lds, p, layer, id, M);
#ifdef TAIL_CONVERT
            if (layer + 1 < DEPTH && bx >= nit - ((nit - 1) / G) * G) convert_experts_queue(lds, p, layer + 1, TAILC_P4);
#endif
            SEAMN(4);
        }
        if (EN(5) && IN(pb + 5)) REPEAT(5) { p = get_params(); PHASE_IDS(); REPBAR(); PH_BEGIN(5);
#ifdef USE_FP8_EXPERTS
            moe_tables(lds, p, layer, M, TMB);
            const int nsh = ((M + TMB - 1) / TMB) * 4, nit = nsh + ((const int*)(lds + MS_TP))[65] * 4;
#ifdef EXP_ROUND_SYNC
            for (int id = vcu, rnd = 0; rnd * G < nit; id += G, ++rnd) { if (id < nit) { if (id < nsh) shared_gemm1_item(lds, p, layer, id, M); else moeq_gemm1_item(lds, p, layer, id - nsh); } if ((rnd + 1) * G < nit) xcd_barrier(bar); }
#else
            for (int id = vcu; id < nit; id += G) { if (id < nsh) shared_gemm1_item(lds, p, layer, id, M); else moeq_gemm1_item(lds, p, layer, id - nsh); }
#endif
#if defined(TAIL_CONVERT) && TAILC_P5 > 0
            if (layer + 1 < DEPTH && vcu >= nit - ((nit - 1) / G) * G) convert_experts_queue(lds, p, layer + 1, TAILC_P5);
#endif
#else
            moe_tables(lds, p, layer, M);
            const int nsh = ((M + TMB - 1) / TMB) * 4, nit = nsh + ((const int*)(lds + MS_TP))[65] * 4;
            for (int id = vcu; id < nit; id += G) { if (id < nsh) shared_gemm1_item(lds, p, layer, id, M); else moe_gemm1_item(lds, p, layer, id - nsh); }
#endif
            SEAMN(5);
        }
        if (EN(6) && IN(pb + 6)) REPEAT(6) { p = get_params(); PHASE_IDS(); REPBAR(); PH_BEGIN(6);
#ifdef USE_FP8_EXPERTS
            moe_tables(lds, p, layer, M, TMB);
            const int nsh = ((M + TMB - 1) / TMB) * (8 / G2_NPASS), nit = nsh + ((const int*)(lds + MS_TP))[65] * (8 / G2_NPASS);
            for (int id = vcu; id < nit; id += G) { if (id < nsh) shared_gemm2_item(lds, p, layer, id, M); else moeq_gemm2_item(lds, p, layer, id - nsh); }
#if defined(TAIL_CONVERT) && TAILC_P6 > 0
            if (layer + 1 < DEPTH && vcu >= nit - ((nit - 1) / G) * G) convert_experts_queue(lds, p, layer + 1, TAILC_P6);
#endif
#else
            moe_tables(lds, p, layer, M);
            const int nsh = ((M + TMB - 1) / TMB) * 8, nit = nsh + ((const int*)(lds + MS_TP))[65] * 4;
            for (int id = vcu; id < nit; id += G) { if (id < nsh) shared_gemm2_item(lds, p, layer, id, M); else moe_gemm2_item(lds, p, layer, id - nsh); }
#endif
            SEAMN(6);
        }
        if (EN(7) && IN(pb + 7)) REPEAT(7) { p = get_params(); PHASE_IDS(); REPBAR(); PH_BEGIN(7);
            moe_tables(lds, p, layer, M);
            if (layer + 1 < DEPTH) stage_gate_weights(lds, p, layer + 1);
            phase_combine(lds, p, layer, M, bx, G);
            __syncthreads();
            SEAMN(7);
        }
    }
#if defined(SPIN_PHN) && SPIN_PHN == 9
    if (blockIdx.x == 0) { __syncthreads(); const unsigned long long t1_ = __builtin_amdgcn_s_memtime(), T_ = t1_ - *PH_T0;
        while (__builtin_amdgcn_s_memtime() < t1_ + (unsigned long long)(SPIN_K) * T_) __builtin_amdgcn_s_sleep(8); __syncthreads(); }
#endif
#ifdef DBG_ANY
    {
        xcd_barrier(bar);
        p = get_params();
        const float frac = DBG_SEL == 8 ? (float)((double)(1000000000ull - dbg_acc[4]) / DBG_UNIT) : DBG_SEL == 7 ? (float)((double)dbg_acc[2] / DBG_UNIT) : DBG_SEL == 6 ? (float)((double)dbg_acc[0] / (double)dbg_acc[3] / DBG_UNIT) : DBG_SEL == 5 ? (float)((double)dbg_acc[1] / DBG_UNIT) : DBG_SEL == 4 ? (float)((double)dbg_acc[2] / (double)dbg_acc[0] * 0.05) : DBG_SEL == 3 ? (float)((double)dbg_acc[2] / (double)dbg_acc[3] / DBG_UNIT) : (float)((double)dbg_acc[DBG_SEL] / (double)dbg_acc[2]);
        const float cdbg = sqrtf(floorf(frac * 10.f + 0.5f));
        for (size_t i = (size_t)blockIdx.x * NTHREADS + tid_here(); i < (size_t)TREAL * DM / 4; i += (size_t)gridDim.x * NTHREADS) ((f32x4*)p->out)[i] = (f32x4){cdbg, cdbg, cdbg, cdbg};
    }
#endif
#undef IN
#undef SEAM
}

#ifndef N_LAUNCH_MODE
#define N_LAUNCH_MODE 1
#endif
extern "C" void kernel_launch(void* const* d_in, const int* in_sizes, int n_in, void* d_out, int out_size, void* d_ws, size_t ws_size, hipStream_t stream) {
    static int grid = 0;
    if (grid == 0) {
        if (n_in != 23 || ws_size < WS_END) { fprintf(stderr, "kernel_launch: unexpected n_in %d or ws %zu < %zu\n", n_in, ws_size, (size_t)WS_END); grid = -1; return; }
        int dev = 0, cus = 0, per_cu = 0;
        if (hipGetDevice(&dev) != hipSuccess || hipDeviceGetAttribute(&cus, hipDeviceAttributeMultiprocessorCount, dev) != hipSuccess) { grid = -1; return; }
        if (hipFuncSetAttribute((const void*)fwd_kernel, hipFuncAttributeMaxDynamicSharedMemorySize, LDS_BYTES) != hipSuccess) { fprintf(stderr, "kernel_launch: hipFuncSetAttribute failed\n"); grid = -1; return; }
        if (hipOccupancyMaxActiveBlocksPerMultiprocessor(&per_cu, (const void*)fwd_kernel, NTHREADS, LDS_BYTES) != hipSuccess || per_cu < 1)
            fprintf(stderr, "kernel_launch: occupancy query reports %d blocks per CU\n", per_cu);
        (void)hipGetLastError();
        grid = cus;
    }
    if (grid < 0) return;
    if (hipMemsetAsync((char*)d_ws + WS_CTL, 0, CTL_BYTES, stream) != hipSuccess) return;
    Params p{};
    const float* const* in = (const float* const*)d_in;
    p.x = in[0]; p.meta = in[1]; p.ln_in_g = in[2]; p.ln_in_b = in[3]; p.w_in = in[4]; p.b_igate = in[5]; p.b_fgate = in[6]; p.conv_qk = in[7];
    p.ml_norm_g = in[8]; p.sb_norm_g = in[9]; p.pool_w = in[10]; p.pool_scale = in[11]; p.w_out = in[12]; p.ln1_g = in[13]; p.ln1_b = in[14];
    p.router_w = in[15]; p.router_bias = in[16]; p.exp_w13 = in[17]; p.exp_w2 = in[18]; p.sh_w13 = in[19]; p.sh_w2 = in[20]; p.ln2_g = in[21]; p.ln2_b = in[22];
    p.out = (float*)d_out; p.ws = (unsigned char*)d_ws;
#if N_LAUNCH_MODE == 1
    p.ph_lo = 0; p.ph_hi = NPHASES;
    hipLaunchKernelGGL(fwd_kernel, dim3(grid), dim3(NTHREADS), LDS_BYTES, stream, p);
#else
    for (int ph = 0; ph < NPHASES; ++ph) {
        p.ph_lo = ph; p.ph_hi = ph + 1;
        hipLaunchKernelGGL(fwd_kernel, dim3(grid), dim3(NTHREADS), LDS_BYTES, stream, p);
    }
#endif
    const hipError_t le = hipPeekAtLastError();
    if (le != hipSuccess) fprintf(stderr, "kernel_launch: launch failed: %s\n", hipGetErrorName(le));
}
```

```cpp
#define USE_FP8_EXPERTS 1
#define FUSE_CONV 1
#ifndef CONV_A_BUDGET
#define CONV_A_BUDGET 0
#endif
#include <hip/hip_runtime.h>
#include <stdint.h>
#include <stdio.h>

constexpr int DM = 2048, NB = 4, SEQ = 2048, NMETA = 16, LSEQ = SEQ + NMETA, DEPTH = 2;
constexpr int TREAL = NB * SEQ;
constexpr int TALL = TREAL + NB * NMETA;
constexpr int HD = 128, NH = 6;
constexpr int N_IN = 5900;
constexpr int PROJ_W = 5888;
constexpr int PC_MLQK = 0, PC_MLV = 1536, PC_MLO = 2304, PC_SBQ = 3072, PC_SBK = 3840, PC_SBV = 4608, PC_POOL = 5376;
constexpr int NEXP = 64, TOPK = 8, DEXP = 512;
constexpr float ROUTED_SCALE = 2.5f;
constexpr float DN_ALPHA = 1.41421356237309515f;
constexpr float LN_EPS = 1e-5f, RMS_EPS = 1e-6f;
constexpr int SH_BASE = TALL * TOPK;
constexpr int PROWS = SH_BASE + TALL;

typedef unsigned short bf16_t;
typedef short bf16x8 __attribute__((ext_vector_type(8)));
typedef short s16x4 __attribute__((ext_vector_type(4)));
typedef float f32x16 __attribute__((ext_vector_type(16)));
typedef float f32x4 __attribute__((ext_vector_type(4)));
typedef float f32x2 __attribute__((ext_vector_type(2)));
typedef unsigned u32x4 __attribute__((ext_vector_type(4)));
typedef unsigned u32x2 __attribute__((ext_vector_type(2)));
#define LAS __attribute__((address_space(3)))

constexpr int NTHREADS = 512;
constexpr int LDS_BYTES = 144 * 1024;

__device__ __forceinline__ unsigned cvtpk(float lo, float hi) {
    unsigned r; asm volatile("v_cvt_pk_bf16_f32 %0, %1, %2" : "=v"(r) : "v"(lo), "v"(hi)); return r;
}
__device__ __forceinline__ float bf2f(bf16_t v) { return __uint_as_float(((unsigned)v) << 16); }
__device__ __forceinline__ float bflo(unsigned w) { return __uint_as_float(w << 16); }
__device__ __forceinline__ float bfhi(unsigned w) { return __uint_as_float(w & 0xffff0000u); }
__device__ __forceinline__ bf16_t f2bf(float f) { return (bf16_t)(cvtpk(f, 0.f) & 0xffffu); }
__device__ __forceinline__ unsigned pk4_fp8(float a, float b, float c, float d) { int w = __builtin_amdgcn_cvt_pk_fp8_f32(a, b, 0, false); w = __builtin_amdgcn_cvt_pk_fp8_f32(c, d, w, true); return (unsigned)w; }
__device__ __forceinline__ float fp8_round(float x, float s) { int w = __builtin_amdgcn_cvt_pk_fp8_f32(x * s, 0.f, 0, false); return __builtin_amdgcn_cvt_f32_fp8(w, 0) / s; }
__device__ __forceinline__ int crow(int r, int hi) { return (r & 3) + 8 * (r >> 2) + 4 * hi; }
template <int CTRL> __device__ __forceinline__ float dpp_mov(float v) {
    return __builtin_bit_cast(float, __builtin_amdgcn_update_dpp(0, __builtin_bit_cast(int, v), CTRL, 0xf, 0xf, true));
}
__device__ __forceinline__ float rdlane(float v, int l) { return __builtin_bit_cast(float, __builtin_amdgcn_readlane(__builtin_bit_cast(int, v), l)); }
__device__ __forceinline__ float wave_sum(float v) {
    v += dpp_mov<0xB1>(v); v += dpp_mov<0x4E>(v); v += dpp_mov<0x141>(v); v += dpp_mov<0x140>(v);
    return (rdlane(v, 0) + rdlane(v, 16)) + (rdlane(v, 32) + rdlane(v, 48));
}
__device__ __forceinline__ float wave_max(float v) {
    v = fmaxf(v, dpp_mov<0xB1>(v)); v = fmaxf(v, dpp_mov<0x4E>(v)); v = fmaxf(v, dpp_mov<0x141>(v)); v = fmaxf(v, dpp_mov<0x140>(v));
    return fmaxf(fmaxf(rdlane(v, 0), rdlane(v, 16)), fmaxf(rdlane(v, 32), rdlane(v, 48)));
}
template <int CTRL, int ROWMASK> __device__ __forceinline__ float dpp_shift(float ident, float v) {
    return __builtin_bit_cast(float, __builtin_amdgcn_update_dpp(__builtin_bit_cast(int, ident), __builtin_bit_cast(int, v), CTRL, ROWMASK, 0xf, false));
}
__device__ __forceinline__ float wave_scan_sum(float x) {
    x += dpp_shift<0x111, 0xf>(0.f, x); x += dpp_shift<0x112, 0xf>(0.f, x); x += dpp_shift<0x114, 0xf>(0.f, x); x += dpp_shift<0x118, 0xf>(0.f, x);
    x += dpp_shift<0x142, 0xa>(0.f, x); x += dpp_shift<0x143, 0xc>(0.f, x);
    return x;
}
__device__ __forceinline__ float wave_scan_max(float x) {
    constexpr float NI = -3.0e38f;
    x = fmaxf(x, dpp_shift<0x111, 0xf>(NI, x)); x = fmaxf(x, dpp_shift<0x112, 0xf>(NI, x)); x = fmaxf(x, dpp_shift<0x114, 0xf>(NI, x)); x = fmaxf(x, dpp_shift<0x118, 0xf>(NI, x));
    x = fmaxf(x, dpp_shift<0x142, 0xa>(NI, x)); x = fmaxf(x, dpp_shift<0x143, 0xc>(NI, x));
    return x;
}
__device__ __forceinline__ float sigmoidf_(float x) { return 1.f / (1.f + __expf(-x)); }
__device__ __forceinline__ float siluf_(float x) { return x / (1.f + __expf(-x)); }
__device__ __forceinline__ float logsigmoidf_(float x) { return fminf(x, 0.f) - __logf(1.f + __expf(-fabsf(x))); }

#if defined(DBG_TIMING) || defined(DBG_TIMING_BF) || (defined(DBG_MIX) && !defined(SPIN_MIX)) || defined(DBG_TQ) || defined(DBG_PHN)
#define DBG_ANY 1
#endif
#if defined(DBG_ANY) || defined(SPIN_MIX)
__device__ unsigned long long dbg_acc[8];
#ifndef DBG_BLOCK
#define DBG_BLOCK 0
#endif
#ifndef DBG_WAVE
#define DBG_WAVE 0
#endif
#endif
__device__ __forceinline__ int tid_here() { int t = threadIdx.x; asm volatile("" : "+v"(t)); return t; }
__device__ __forceinline__ int sgpr_here(int x) { asm volatile("" : "+s"(x)); return x; }
__device__ __forceinline__ unsigned char* lds_here(unsigned char* l) { LAS unsigned char* q = (LAS unsigned char*)l; asm volatile("" : "+s"(q)); return (unsigned char*)q; }

__device__ __forceinline__ int row_of(int b, int l) { return l < NMETA ? TREAL + b * NMETA + l : b * SEQ + (l - NMETA); }

constexpr size_t al256(size_t x) { return (x + 255) / 256 * 256; }
constexpr size_t WS_CTL = 0;
constexpr size_t CTL_BYTES = 64 * 1024;
constexpr size_t CTL_CNT = 32 * 1024;
constexpr int CNT_STRIDE = 32, CNT_LAYER = 64 * CNT_STRIDE, CNT_QWORD = DEPTH * CNT_LAYER;
constexpr size_t WS_HB = al256(WS_CTL + CTL_BYTES);
constexpr size_t WS_PROJ = al256(WS_HB + (size_t)TALL * DM * 2);
constexpr size_t WS_GATES = al256(WS_PROJ + (size_t)TALL * PROJ_W * 2);
constexpr size_t WS_QKC = al256(WS_GATES + (size_t)TALL * 12 * 4);
constexpr size_t WS_CAT = al256(WS_QKC + (size_t)TALL * 1536 * 2);
constexpr size_t WS_S1 = al256(WS_CAT + (size_t)TALL * DM * 2);
constexpr size_t WS_H1 = al256(WS_S1 + (size_t)TALL * DM * 2);
constexpr size_t WS_ASGE = al256(WS_H1 + (size_t)TALL * DM * 2);
constexpr size_t WS_ASGS = al256(WS_ASGE + (size_t)TALL * 8 * 4);
constexpr size_t WS_TOKL = al256(WS_ASGS + (size_t)TALL * 8 * 4);
constexpr size_t WS_GATEL = al256(WS_TOKL + (size_t)NEXP * TALL * 4);
constexpr size_t WS_ACT = al256(WS_GATEL + (size_t)NEXP * TALL * 4);
constexpr size_t WS_Y = al256(WS_ACT + (size_t)PROWS * DEXP * 2);
constexpr size_t WT_IN = 0, WT_OUT = (size_t)PROJ_W * DM, WT_SH13 = WT_OUT + (size_t)DM * DM, WT_SH2 = WT_SH13 + (size_t)1024 * DM, WT_POOL = WT_SH2 + (size_t)DM * DEXP, WT_LAYER = WT_POOL + (size_t)4 * 128 * 128;
constexpr size_t WS_WT = al256(WS_Y + (size_t)PROWS * DM * 2);
constexpr size_t WS_W13Q = al256(WS_WT + (size_t)DEPTH * WT_LAYER * 2);
constexpr size_t W13Q_LAYER = (size_t)NEXP * 1024 * DM, W2Q_LAYER = (size_t)NEXP * DM * DEXP;
constexpr size_t WS_W2Q = al256(WS_W13Q + DEPTH * W13Q_LAYER);
constexpr size_t WS_H1Q = al256(WS_W2Q + DEPTH * W2Q_LAYER);
constexpr size_t WS_ACTQ = al256(WS_H1Q + (size_t)TALL * DM);
constexpr size_t WS_SHQ = al256(WS_ACTQ + (size_t)PROWS * DEXP);
constexpr size_t SHQ_LAYER = (size_t)1024 * DM + (size_t)DM * DEXP;
constexpr size_t WS_DUMP = al256(WS_SHQ + (size_t)DEPTH * SHQ_LAYER);
constexpr size_t RWF_LAYER = (size_t)128 * 4 * 64 * 16;
constexpr size_t WS_RWF = al256(WS_DUMP + 65536);
constexpr size_t WS_END = al256(WS_RWF + DEPTH * RWF_LAYER);

struct Params {
    const float* x; const float* meta; const float* ln_in_g; const float* ln_in_b;
    const float* w_in; const float* b_igate; const float* b_fgate; const float* conv_qk;
    const float* ml_norm_g; const float* sb_norm_g; const float* pool_w; const float* pool_scale;
    const float* w_out; const float* ln1_g; const float* ln1_b; const float* router_w; const float* router_bias;
    const float* exp_w13; const float* exp_w2; const float* sh_w13; const float* sh_w2;
    const float* ln2_g; const float* ln2_b;
    float* out; unsigned char* ws;
    int ph_lo, ph_hi;
};
typedef const Params __attribute__((address_space(4)))* PP;
__device__ __forceinline__ PP get_params() {
    PP k = (PP)__builtin_amdgcn_kernarg_segment_ptr();
    asm volatile("" : "+s"(k));
    return k;
}

constexpr int TM = 192;
constexpr int A_SLOT = 24576;
constexpr int G_AS = 0, G_BS = 3 * A_SLOT, G_ROWS = G_BS + 65536;
constexpr int G_LDS_END = G_ROWS + 1024;

__device__ __forceinline__ int swz_f(int n) { return ((n >> 2) & 7) ^ ((n >> 1) & 1); }

struct GemmOp {
    const bf16_t* X; int ldx;
    const float* W; int ldb;
    int cb0, cb1;
    int K;
    int cstep;
};

#define BSET_WAIT(N, S) asm volatile("s_waitcnt vmcnt(" #N ") lgkmcnt(0)" : "+v"(S[0]), "+v"(S[1]), "+v"(S[2]), "+v"(S[3]), "+v"(S[4]), "+v"(S[5]), "+v"(S[6]), "+v"(S[7]) :: "memory")

template <int NPASS, class Epi>
__device__ __forceinline__ void gemm_tile(unsigned char* lds_in, const GemmOp& g, Epi& epi) {
    unsigned char* lds = lds_here(lds_in);
    const int tid = tid_here(), lane = tid & 63, wid = __builtin_amdgcn_readfirstlane(tid >> 6), wr = wid >> 2, wc = wid & 3, r32 = lane & 31, hi = lane >> 5;
    const int* rows = (const int*)(lds + G_ROWS);
    const int a_r = wid * 8 + (lane >> 3);
    unsigned a_off[3];
#pragma unroll
    for (int j = 0; j < 3; ++j) a_off[j] = (unsigned)rows[a_r + 64 * j] * (unsigned)g.ldx + (((lane & 7) ^ swz_f(a_r)) << 3);
    const int a_lds = wid * 1024;
    const int kg = wid, nq = lane;
    const int blk = nq >> 3, gq = nq & 7;
    const int b_col = ((blk & 1) ? g.cb1 : g.cb0) + (blk >> 1) * 32 + gq * 4;
    const int b_n0 = blk * 32 + 8 * (gq & 3) + 4 * (gq >> 2);
    const int wa0 = G_BS + b_n0 * 128 + ((kg ^ swz_f(b_n0)) << 4);
    const int wa2 = G_BS + (b_n0 + 2) * 128 + ((kg ^ swz_f(b_n0 + 2)) << 4);
    const unsigned long long wa_ = (unsigned long long)g.W;
    const char* Wu = (const char*)(((unsigned long long)(unsigned)__builtin_amdgcn_readfirstlane((int)(wa_ >> 32)) << 32) | (unsigned)__builtin_amdgcn_readfirstlane((int)wa_));
    const int ldbu = __builtin_amdgcn_readfirstlane(g.ldb);
    unsigned b_voff = (unsigned)((kg * 8 * ldbu + b_col) * 4);
    const size_t ldb4 = (size_t)ldbu * 4;
    const int lanec = (hi ^ swz_f(r32)) << 4;
    int ard[4], brd[4];
#pragma unroll
    for (int ks = 0; ks < 4; ++ks) { ard[ks] = G_AS + (wr * 32 + r32) * 128 + ((ks << 5) ^ lanec); brd[ks] = G_BS + (wc * 64 + r32) * 128 + ((ks << 5) ^ lanec); }

    f32x16 acc[2][3];

    f32x4 s0[8], s1[8];
    const int nk = g.K >> 6;
#define G_DMA_A(kt, slot_off) do { \
        _Pragma("unroll") for (int j = 0; j < 3; ++j) __builtin_amdgcn_global_load_lds((const unsigned*)(g.X + a_off[j] + (kt) * 64), \
            (unsigned*)(lds + G_AS + (slot_off) + a_lds + j * 8192), 16, 0, 0); } while (0)
#define G_LOADB(S, kt) do { const char* wb_ = Wu + (size_t)(kt) * 64 * ldb4; \
        _Pragma("unroll") for (int j = 0; j < 8; ++j) asm volatile("global_load_dwordx4 %0, %1, %2" : "=v"(S[j]) : "v"(b_voff), "s"(wb_ + j * ldb4) : "memory"); } while (0)
#define G_WRITEB(S, buf) do { u32x4 w_; \
        w_.x = cvtpk(S[0][0], S[1][0]); w_.y = cvtpk(S[2][0], S[3][0]); w_.z = cvtpk(S[4][0], S[5][0]); w_.w = cvtpk(S[6][0], S[7][0]); *(u32x4*)(lds + wa0 + (buf) * 32768) = w_; \
        w_.x = cvtpk(S[0][1], S[1][1]); w_.y = cvtpk(S[2][1], S[3][1]); w_.z = cvtpk(S[4][1], S[5][1]); w_.w = cvtpk(S[6][1], S[7][1]); *(u32x4*)(lds + wa0 + (buf) * 32768 + 128) = w_; \
        w_.x = cvtpk(S[0][2], S[1][2]); w_.y = cvtpk(S[2][2], S[3][2]); w_.z = cvtpk(S[4][2], S[5][2]); w_.w = cvtpk(S[6][2], S[7][2]); *(u32x4*)(lds + wa2 + (buf) * 32768) = w_; \
        w_.x = cvtpk(S[0][3], S[1][3]); w_.y = cvtpk(S[2][3], S[3][3]); w_.z = cvtpk(S[4][3], S[5][3]); w_.w = cvtpk(S[6][3], S[7][3]); *(u32x4*)(lds + wa2 + (buf) * 32768 + 128) = w_; } while (0)
#define G_FRAGS(F, acur_, buf, ks) do { \
        _Pragma("unroll") for (int mi = 0; mi < 3; ++mi) F[mi] = *(const bf16x8*)(lds + ard[ks] + (acur_) + mi * 8192); \
        _Pragma("unroll") for (int ni = 0; ni < 2; ++ni) F[3 + ni] = *(const bf16x8*)(lds + brd[ks] + (buf) * 32768 + ni * 4096); } while (0)
#define G_MMA(F) do { \
        _Pragma("unroll") for (int ni = 0; ni < 2; ++ni) \
        _Pragma("unroll") for (int mi = 0; mi < 3; ++mi) acc[ni][mi] = __builtin_amdgcn_mfma_f32_32x32x16_bf16(F[3 + ni], F[mi], acc[ni][mi], 0, 0, 0); } while (0)
#define SB0() __builtin_amdgcn_sched_barrier(0)
#define G_MMA1(F, q) do { const int ni_ = (q) / 3, mi_ = (q) % 3; \
        acc[ni_][mi_] = __builtin_amdgcn_mfma_f32_32x32x16_bf16(F[3 + ni_], F[mi_], acc[ni_][mi_], 0, 0, 0); } while (0)
#define G_MMA2(F, pr) do { G_MMA1(F, 2 * (pr)); G_MMA1(F, 2 * (pr) + 1); } while (0)
#define G_WPIECE(S, buf, i, WA, OFF) do { u32x4 w_; \
        w_.x = cvtpk(S[0][i], S[1][i]); w_.y = cvtpk(S[2][i], S[3][i]); w_.z = cvtpk(S[4][i], S[5][i]); w_.w = cvtpk(S[6][i], S[7][i]); *(u32x4*)(lds + WA + (buf) * 32768 + OFF) = w_; } while (0)
#define G_DMA1(kt, slot_off, j) __builtin_amdgcn_global_load_lds((const unsigned*)(g.X + a_off[j] + (kt) * 64), (unsigned*)(lds + G_AS + (slot_off) + a_lds + (j) * 8192), 16, 0, 0)
#define G_LOAD1(S, kt, j) asm volatile("global_load_dwordx4 %0, %1, %2" : "=v"(S[j]) : "v"(b_voff), "s"(Wu + ((size_t)(kt) * 64 + (j)) * ldb4) : "memory")
#define SETWAIT(N, S) asm volatile("s_waitcnt vmcnt(" #N ")" : "+v"(S[0]), "+v"(S[1]), "+v"(S[2]), "+v"(S[3]), "+v"(S[4]), "+v"(S[5]), "+v"(S[6]), "+v"(S[7]) :: "memory")
#define G_STEP(kt, SW, TOPW, BARW, DO_WRITE, DO_DMA, DO_LOAD, HAS_NEXT) do { \
        if (DO_WRITE) { SETWAIT(TOPW, SW); } \
        G_FRAGS(f1, a_cur, (kt) & 1, 1); SB0(); \
        if (DO_WRITE) G_WPIECE(SW, ((kt) + 1) & 1, 0, wa0, 0);   SB0(); G_MMA2(f0, 0); SB0(); \
        if (DO_WRITE) G_WPIECE(SW, ((kt) + 1) & 1, 1, wa0, 128); SB0(); G_MMA2(f0, 1); SB0(); \
        if (DO_WRITE) G_WPIECE(SW, ((kt) + 1) & 1, 2, wa2, 0);   SB0(); G_MMA2(f0, 2); SB0(); \
        if (DO_WRITE) G_WPIECE(SW, ((kt) + 1) & 1, 3, wa2, 128); SB0(); \
        G_FRAGS(f0, a_cur, (kt) & 1, 2); SB0(); \
        if (DO_DMA) G_DMA1((kt) + 2, a_nn, 0); SB0(); G_MMA2(f1, 0); SB0(); \
        if (DO_DMA) G_DMA1((kt) + 2, a_nn, 1); if (DO_LOAD) { G_LOAD1(SW, (kt) + 3, 0); G_LOAD1(SW, (kt) + 3, 1); } SB0(); G_MMA2(f1, 1); SB0(); \
        if (DO_DMA) G_DMA1((kt) + 2, a_nn, 2); if (DO_LOAD) { G_LOAD1(SW, (kt) + 3, 2); G_LOAD1(SW, (kt) + 3, 3); } SB0(); G_MMA2(f1, 2); SB0(); \
        G_FRAGS(f1, a_cur, (kt) & 1, 3); SB0(); \
        if (DO_LOAD) { G_LOAD1(SW, (kt) + 3, 4); G_LOAD1(SW, (kt) + 3, 5); } SB0(); G_MMA2(f0, 0); SB0(); \
        if (DO_LOAD) { G_LOAD1(SW, (kt) + 3, 6); G_LOAD1(SW, (kt) + 3, 7); } SB0(); G_MMA2(f0, 1); SB0(); \
        G_MMA2(f0, 2); SB0(); \
        a_cur = a_cur + A_SLOT; a_cur = a_cur >= 3 * A_SLOT ? 0 : a_cur; a_nn = a_nn + A_SLOT; a_nn = a_nn >= 3 * A_SLOT ? 0 : a_nn; \
        if (HAS_NEXT) { DBG_T0(); asm volatile("s_waitcnt vmcnt(" #BARW ") lgkmcnt(0)" ::: "memory"); DBG_T1(); \
            __builtin_amdgcn_s_barrier(); DBG_T2(); \
            G_FRAGS(f0, a_cur, ((kt) + 1) & 1, 0); SB0(); } \
        G_MMA2(f1, 0); G_MMA2(f1, 1); G_MMA2(f1, 2); SB0(); } while (0)

#ifdef DBG_TIMING
    unsigned long long dt0_ = 0, dt1_ = 0, dwait_ = 0, dbar_ = 0; const unsigned long long dstart_ = __builtin_amdgcn_s_memtime();
#define DBG_T0() dt0_ = __builtin_amdgcn_s_memtime()
#define DBG_T1() do { dt1_ = __builtin_amdgcn_s_memtime(); dwait_ += dt1_ - dt0_; } while (0)
#define DBG_T2() do { dbar_ += __builtin_amdgcn_s_memtime() - dt1_; } while (0)
#else
#define DBG_T0()
#define DBG_T1()
#define DBG_T2()
#endif
    G_DMA_A(0, 0); __builtin_amdgcn_sched_barrier(0);
    G_LOADB(s0, 0); __builtin_amdgcn_sched_barrier(0);
    G_DMA_A(1, A_SLOT); __builtin_amdgcn_sched_barrier(0);
    G_LOADB(s1, 1); __builtin_amdgcn_sched_barrier(0);
#pragma unroll
    for (int pass = 0; pass < NPASS; ++pass) {
#pragma unroll
    for (int ni = 0; ni < 2; ++ni)
#pragma unroll
        for (int mi = 0; mi < 3; ++mi)
#pragma unroll
            for (int r = 0; r < 16; ++r) acc[ni][mi][r] = 0.f;
    int a_cur = 0, a_nn = 2 * A_SLOT;
    BSET_WAIT(11, s0);
    G_WRITEB(s0, 0); __builtin_amdgcn_sched_barrier(0);
    G_LOADB(s0, 2); __builtin_amdgcn_sched_barrier(0);
    asm volatile("s_waitcnt lgkmcnt(0)" ::: "memory");
    __builtin_amdgcn_s_barrier();
    bf16x8 f0[5], f1[5];
    G_FRAGS(f0, 0, 0, 0); SB0();
    int kt = 0;
    G_STEP(kt, s1, 8, 17, true, true, true, true); ++kt;
    for (; kt <= nk - 5; kt += 2) { G_STEP(kt, s0, 11, 17, true, true, true, true); G_STEP(kt + 1, s1, 11, 17, true, true, true, true); }
    G_STEP(kt, s0, 11, 9, true, true, false, true); ++kt;
    G_STEP(kt, s1, 3, 0, true, false, false, true); ++kt;
    G_STEP(kt, s0, 0, 0, false, false, false, false);
    {
      const int t2 = tid_here(), l2 = t2 & 63, w2 = __builtin_amdgcn_readfirstlane(t2 >> 6);
      epi.pre(w2 >> 2, l2 & 31);
      if (pass + 1 < NPASS) {
          asm volatile("s_waitcnt vmcnt(0) lgkmcnt(0)" ::: "memory"); epi.pin();
          __builtin_amdgcn_s_barrier();
          b_voff += (unsigned)(g.cstep * 4);
          G_DMA_A(0, 0); __builtin_amdgcn_sched_barrier(0);
          G_LOADB(s0, 0); __builtin_amdgcn_sched_barrier(0);
          G_DMA_A(1, A_SLOT); __builtin_amdgcn_sched_barrier(0);
          G_LOADB(s1, 1); __builtin_amdgcn_sched_barrier(0);
      }
      epi(acc, w2 >> 2, w2 & 3, l2 & 31, l2 >> 5, pass); }
    }
#ifdef DBG_TIMING
    { const unsigned long long dtot_ = __builtin_amdgcn_s_memtime() - dstart_;
      if (blockIdx.x == DBG_BLOCK && tid == DBG_WAVE * 64) { unsigned long long* d = (unsigned long long*)(lds + 0) ; (void)d;
        atomicAdd(&dbg_acc[0], dwait_); atomicAdd(&dbg_acc[1], dbar_); atomicAdd(&dbg_acc[2], dtot_); atomicAdd(&dbg_acc[3], (unsigned long long)nk); } }
#endif
#undef DBG_T0
#undef DBG_T1
#undef DBG_T2
#undef G_DMA_A
#undef G_LOADB
#undef G_WRITEB
#undef G_FRAGS
#undef G_MMA
#undef G_STEP
#undef SETWAIT
#undef G_MMA1
#undef G_MMA2
#undef G_WPIECE
#undef G_DMA1
#undef G_LOAD1
    __syncthreads();
}

template <int NMI> struct EpiStoreBf16 {
    bf16_t* O; int ldo; int orow0; int nrows; int oc0, oc1;
    __device__ __forceinline__ void pre(int, int) {}
    __device__ __forceinline__ void pin() {}
    __device__ __forceinline__ void operator()(const f32x16 (&acc)[2][NMI], int wr, int wc, int r32, int hi, int = 0) const {
#pragma unroll
        for (int mi = 0; mi < NMI; ++mi) {
            const int tr = (2 * mi + wr) * 32 + r32;
            if (tr < nrows) {
#pragma unroll
                for (int ni = 0; ni < 2; ++ni) {
                    bf16_t* p = O + (size_t)(orow0 + tr) * ldo + (ni ? oc1 : oc0) + wc * 32 + 16 * hi;
                    u32x4 w0, w1; const f32x16& a = acc[ni][mi];
                    w0.x = cvtpk(a[0], a[1]); w0.y = cvtpk(a[2], a[3]); w0.z = cvtpk(a[4], a[5]); w0.w = cvtpk(a[6], a[7]);
                    w1.x = cvtpk(a[8], a[9]); w1.y = cvtpk(a[10], a[11]); w1.z = cvtpk(a[12], a[13]); w1.w = cvtpk(a[14], a[15]);
                    *(u32x4*)p = w0; *(u32x4*)(p + 8) = w1;
                }
            }
        }
    }
};


constexpr int TMB = 256;
#ifdef EXP_DMA2X
#define EXP_DMA2 true
#define VMW(n) VMW2_##n
#define VMW2_8 16
#define VMW2_4 8
#define VMW2_0 0
#else
#define EXP_DMA2 false
#define VMW(n) n
#endif
#define XSTR(x) STR(x)
#define STR(x) #x
constexpr int BF_AS = 0, BF_BS = 65536, BF_ROWS = 131072, BF_SLOT = 16384;
struct GemmOpBf { const bf16_t* X; int ldx; const bf16_t* Wt; int ldw; int cb0, cb1; int K; };

template <class Epi>
__device__ __forceinline__ void gemm_tile_bf(unsigned char* lds_in, const GemmOpBf& g, const Epi& epi) {
    unsigned char* lds = lds_here(lds_in);
    const int tid = tid_here(), lane = tid & 63, wid = __builtin_amdgcn_readfirstlane(tid >> 6), wr = wid >> 2, wc = wid & 3, r32 = lane & 31, hi = lane >> 5;
    const int* rows = (const int*)(lds + BF_ROWS);
    unsigned a_off[2], b_off[2];
#pragma unroll
    for (int jj = 0; jj < 2; ++jj) {
        const int r = jj * 128 + wid * 16 + (lane >> 2);
        const int cpos = ((lane & 3) ^ ((r >> 2) & 3)) << 3;
        a_off[jj] = (unsigned)rows[r] * (unsigned)g.ldx + cpos;
        const int rho = r & 31, gcol = (((r >> 5) & 1) ? g.cb1 : g.cb0) + (r >> 6) * 32 + 16 * ((rho >> 2) & 1) + (rho & 3) + 4 * (rho >> 3);
        b_off[jj] = (unsigned)gcol * (unsigned)g.ldw + cpos;
    }
    const int p_lds = wid * 1024;
    const int lanec = (hi ^ ((r32 >> 2) & 3)) << 4;
    const int ard = BF_AS + (wr * 32 + r32) * 64, brd = BF_BS + (wc * 64 + r32) * 64;
    const int co0 = lanec, co1 = 32 ^ lanec;

    f32x16 acc[2][4];
#pragma unroll
    for (int ni = 0; ni < 2; ++ni)
#pragma unroll
        for (int mi = 0; mi < 4; ++mi)
#pragma unroll
            for (int r = 0; r < 16; ++r) acc[ni][mi][r] = 0.f;
    const int nk = g.K >> 5;
#define BF_DMA(kt, slot, which) do { BF_DMA_1(kt, slot, which); if (EXP_DMA2) BF_DMA_1(kt, slot, which); } while (0)
#define BF_DMA_1(kt, slot, which) do { \
        if ((which) < 2) __builtin_amdgcn_global_load_lds((const unsigned*)(g.X + a_off[(which) & 1] + (kt) * 32), (unsigned*)(lds + BF_AS + (slot) * BF_SLOT + p_lds + ((which) & 1) * 8192), 16, 0, 0); \
        else __builtin_amdgcn_global_load_lds((const unsigned*)(g.Wt + b_off[(which) & 1] + (kt) * 32), (unsigned*)(lds + BF_BS + (slot) * BF_SLOT + p_lds + ((which) & 1) * 8192), 16, 0, 0); } while (0)
#define BF_FRAGS(F, slot, co) do { \
        _Pragma("unroll") for (int mi = 0; mi < 4; ++mi) F[mi] = *(const bf16x8*)(lds + ard + (slot) * BF_SLOT + mi * 4096 + (co)); \
        _Pragma("unroll") for (int ni = 0; ni < 2; ++ni) F[4 + ni] = *(const bf16x8*)(lds + brd + (slot) * BF_SLOT + ni * 2048 + (co)); } while (0)
#define BF_MMA1(F, q) do { const int ni_ = (q) >> 2, mi_ = (q) & 3; \
        acc[ni_][mi_] = __builtin_amdgcn_mfma_f32_32x32x16_bf16(F[4 + ni_], F[mi_], acc[ni_][mi_], 0, 0, 0); } while (0)
#define BF_MMA2(F, pr) do { BF_MMA1(F, 2 * (pr)); BF_MMA1(F, 2 * (pr) + 1); } while (0)
#define SB0() __builtin_amdgcn_sched_barrier(0)
#define BF_STEP(kt, slot, WAITN, DO_ISSUE, HAS_NEXT) do { \
        BF_FRAGS(f1, slot, co1); SB0(); \
        BF_MMA2(f0, 0); BF_MMA2(f0, 1); BF_MMA2(f0, 2); BF_MMA2(f0, 3); SB0(); \
        if (HAS_NEXT) { BDBG_T0(); asm volatile("s_waitcnt vmcnt(" XSTR(VMW(WAITN)) ")" ::: "memory"); BDBG_T1(); \
            __builtin_amdgcn_s_barrier(); BDBG_T2(); \
            BF_FRAGS(f0, ((slot) + 1) & 3, co0); SB0(); } \
        if (DO_ISSUE) BF_DMA((kt) + 3, ((slot) + 3) & 3, 0); SB0(); BF_MMA2(f1, 0); SB0(); \
        if (DO_ISSUE) BF_DMA((kt) + 3, ((slot) + 3) & 3, 2); SB0(); BF_MMA2(f1, 1); SB0(); \
        if (DO_ISSUE) BF_DMA((kt) + 3, ((slot) + 3) & 3, 1); SB0(); BF_MMA2(f1, 2); SB0(); \
        if (DO_ISSUE) BF_DMA((kt) + 3, ((slot) + 3) & 3, 3); SB0(); BF_MMA2(f1, 3); SB0(); } while (0)

#ifdef DBG_TIMING_BF
    unsigned long long dt0_ = 0, dt1_ = 0, dwait_ = 0, dbar_ = 0; const unsigned long long dstart_ = __builtin_amdgcn_s_memtime(); const unsigned long long drt_ = __builtin_amdgcn_s_memrealtime();
#define BDBG_T0() dt0_ = __builtin_amdgcn_s_memtime()
#define BDBG_T1() do { dt1_ = __builtin_amdgcn_s_memtime(); dwait_ += dt1_ - dt0_; } while (0)
#define BDBG_T2() do { dbar_ += __builtin_amdgcn_s_memtime() - dt1_; } while (0)
#else
#define BDBG_T0()
#define BDBG_T1()
#define BDBG_T2()
#endif
#pragma unroll
    for (int t = 0; t < 3; ++t) { BF_DMA(t, t, 0); BF_DMA(t, t, 2); BF_DMA(t, t, 1); BF_DMA(t, t, 3); }
    SB0();
    asm volatile("s_waitcnt vmcnt(" XSTR(VMW(8)) ")" ::: "memory");
    __builtin_amdgcn_s_barrier();
    bf16x8 f0[6], f1[6];
    BF_FRAGS(f0, 0, co0); SB0();
    int kt = 0;
    for (; kt < nk - 4; kt += 4) {
        BF_STEP(kt, 0, 4, true, true); BF_STEP(kt + 1, 1, 4, true, true); BF_STEP(kt + 2, 2, 4, true, true); BF_STEP(kt + 3, 3, 4, true, true);
    }
    BF_STEP(kt, 0, 4, true, true); BF_STEP(kt + 1, 1, 4, false, true); BF_STEP(kt + 2, 2, 0, false, true); BF_STEP(kt + 3, 3, 0, false, false);
#ifdef DBG_TIMING_BF
    { const unsigned long long dtot_ = __builtin_amdgcn_s_memtime() - dstart_; const unsigned long long drtot_ = __builtin_amdgcn_s_memrealtime() - drt_;
      if (tid == DBG_WAVE * 64) { atomicAdd(&dbg_acc[0], DBG_SEL == 4 ? drtot_ : dwait_); atomicAdd(&dbg_acc[1], dbar_); atomicAdd(&dbg_acc[2], dtot_); atomicAdd(&dbg_acc[3], (unsigned long long)nk); if (DBG_SEL == 5) atomicMax(&dbg_acc[1], dtot_ / (unsigned long long)nk); } }
#endif
#undef BDBG_T0
#undef BDBG_T1
#undef BDBG_T2
#undef BF_DMA
#undef BF_DMA_1
#undef BF_FRAGS
#undef BF_MMA1
#undef BF_MMA2
#undef BF_STEP
    __syncthreads();
    {
      const int t2 = tid_here(), l2 = t2 & 63, w2 = __builtin_amdgcn_readfirstlane(t2 >> 6);
      epi(acc, w2 >> 2, w2 & 3, l2 & 31, l2 >> 5); }
    __syncthreads();
}

typedef int i32x8 __attribute__((ext_vector_type(8)));
struct GemmOpQ { const unsigned char* X; int ldx; const unsigned char* Wt; int ldw; int cb0, cb1; int K; int cstep; int nrows; };
constexpr int WQ_SCALE_BYTE = 0x79;

template <int NPASS, int NMIU, class Epi>
__device__ __forceinline__ void gemm_tile_q(unsigned char* lds_in, const GemmOpQ& g, Epi& epi) {
    unsigned char* lds = lds_here(lds_in);
#ifdef DBG_TQ
    const unsigned long long dq0_ = __builtin_amdgcn_s_memtime(); unsigned long long dq1_ = 0;
#endif
    const int tid = tid_here(), lane = tid & 63, wid = __builtin_amdgcn_readfirstlane(tid >> 6), wr = wid >> 2, wc = wid & 3, r32 = lane & 31, hi = lane >> 5;
    const int* rows = (const int*)(lds + BF_ROWS);
    unsigned a_off[2], b_off[2];
#pragma unroll
    for (int jj = 0; jj < 2; ++jj) {
        const int r = jj * 128 + wid * 16 + (lane >> 2);
        const int cpos = ((lane & 3) ^ ((r >> 2) & 3)) << 4;
        a_off[jj] = (unsigned)rows[r] * (unsigned)g.ldx + cpos;
        const int rho = r & 31, gcol = (((r >> 5) & 1) ? g.cb1 : g.cb0) + (r >> 6) * 32 + 16 * ((rho >> 2) & 1) + (rho & 3) + 4 * (rho >> 3);
        b_off[jj] = (unsigned)gcol * (unsigned)g.ldw + cpos;
    }
    const int p_lds = wid * 1024;
    const int c0 = ((2 * hi) ^ ((r32 >> 2) & 3)) << 4;
    const int ard = BF_AS + (wr * 32 + r32) * 64, brd = BF_BS + (wc * 64 + r32) * 64;
    constexpr int nmi = NMIU;

    f32x16 acc[2][4];
    const int nk = g.K >> 6;
#define Q_DMA(kt, slot, which) do { \
        if ((which) < 2) __builtin_amdgcn_global_load_lds((const unsigned*)(g.X + a_off[(which) & 1] + (kt) * 64), (unsigned*)(lds + BF_AS + (slot) * BF_SLOT + p_lds + ((which) & 1) * 8192), 16, 0, 0); \
        else __builtin_amdgcn_global_load_lds((const unsigned*)(g.Wt + b_off[(which) & 1] + (kt) * 64), (unsigned*)(lds + BF_BS + (slot) * BF_SLOT + p_lds + ((which) & 1) * 8192), 16, 0, 0); } while (0)
#define Q_FRAG(dst, base) do { typedef int i32x4_ __attribute__((ext_vector_type(4))); \
        const i32x4_ lo_ = *(const i32x4_*)(lds + (base) + c0), hi_ = *(const i32x4_*)(lds + (base) + (c0 ^ 16)); \
        dst = __builtin_shufflevector(lo_, hi_, 0, 1, 2, 3, 4, 5, 6, 7); } while (0)
#define Q_MMA(ni, mi) acc[ni][mi] = __builtin_amdgcn_mfma_scale_f32_32x32x64_f8f6f4(fw[ni], fx[mi], acc[ni][mi], 0, 0, 0, WQ_SCALE_BYTE * 0x01010101, 0, 0x7f7f7f7f)
#define Q_MMAX(FWv, FXv, ni, mi, j) acc[ni][mi] = __builtin_amdgcn_mfma_scale_f32_32x32x64_f8f6f4(FWv[ni], FXv[j], acc[ni][mi], 0, 0, 0, WQ_SCALE_BYTE * 0x01010101, 0, 0x7f7f7f7f)
#define Q_STEP(kt, slot, WAITN, DO_ISSUE, HAS_NEXT, FW, FXA, FWN, FXAN) do { \
        i32x8 fxb[2]; \
        Q_FRAG(FXA[0], ard + (slot) * BF_SLOT); if (nmi > 1) Q_FRAG(FXA[1], ard + (slot) * BF_SLOT + 4096); \
        if (nmi > 2) Q_FRAG(fxb[0], ard + (slot) * BF_SLOT + 8192); \
        if (nmi > 3) Q_FRAG(fxb[1], ard + (slot) * BF_SLOT + 12288); SB0(); \
        if (nmi > 0) { Q_MMAX(FW, FXA, 0, 0, 0); Q_MMAX(FW, FXA, 1, 0, 0); } if (nmi > 1) { Q_MMAX(FW, FXA, 0, 1, 1); Q_MMAX(FW, FXA, 1, 1, 1); } SB0(); \
        if (HAS_NEXT) { asm volatile("s_waitcnt vmcnt(" #WAITN ")" ::: "memory"); \
            __builtin_amdgcn_s_barrier(); \
            if (nmi > 0) { Q_FRAG(FWN[0], brd + (((slot) + 1) & 3) * BF_SLOT); Q_FRAG(FWN[1], brd + (((slot) + 1) & 3) * BF_SLOT + 2048); } SB0(); } \
        if (DO_ISSUE) Q_DMA((kt) + 3, ((slot) + 3) & 3, 0); SB0(); if (nmi > 2) Q_MMAX(FW, fxb, 0, 2, 0); SB0(); \
        if (DO_ISSUE) Q_DMA((kt) + 3, ((slot) + 3) & 3, 2); SB0(); if (nmi > 2) Q_MMAX(FW, fxb, 1, 2, 0); SB0(); \
        if (DO_ISSUE) Q_DMA((kt) + 3, ((slot) + 3) & 3, 1); SB0(); if (nmi > 3) Q_MMAX(FW, fxb, 0, 3, 1); SB0(); \
        if (DO_ISSUE) Q_DMA((kt) + 3, ((slot) + 3) & 3, 3); SB0(); if (nmi > 3) Q_MMAX(FW, fxb, 1, 3, 1); SB0(); } while (0)

#pragma unroll
    for (int t = 0; t < 3; ++t) { Q_DMA(t, t, 0); Q_DMA(t, t, 2); Q_DMA(t, t, 1); Q_DMA(t, t, 3); }
    SB0();
#pragma unroll
    for (int pass = 0; pass < NPASS; ++pass) {
#pragma unroll
    for (int ni = 0; ni < 2; ++ni)
#pragma unroll
        for (int mi = 0; mi < 4; ++mi)
#pragma unroll
            for (int r = 0; r < 16; ++r) acc[ni][mi][r] = 0.f;
    asm volatile("s_waitcnt vmcnt(8)" ::: "memory");
    __builtin_amdgcn_s_barrier();
    i32x8 fw0[2], fx0[2], fw1[2], fx1[2];
    if (nmi > 0) { Q_FRAG(fw0[0], brd); Q_FRAG(fw0[1], brd + 2048); } SB0();
    int kt = 0;
    for (; kt < nk - 4; kt += 4) {
        Q_STEP(kt, 0, 4, true, true, fw0, fx0, fw1, fx1); Q_STEP(kt + 1, 1, 4, true, true, fw1, fx1, fw0, fx0);
        Q_STEP(kt + 2, 2, 4, true, true, fw0, fx0, fw1, fx1); Q_STEP(kt + 3, 3, 4, true, true, fw1, fx1, fw0, fx0);
    }
    Q_STEP(kt, 0, 4, true, true, fw0, fx0, fw1, fx1); Q_STEP(kt + 1, 1, 4, false, true, fw1, fx1, fw0, fx0);
    Q_STEP(kt + 2, 2, 0, false, true, fw0, fx0, fw1, fx1); Q_STEP(kt + 3, 3, 0, false, false, fw1, fx1, fw0, fx0);
#ifdef DBG_TQ
    dq1_ = __builtin_amdgcn_s_memtime();
#endif
#pragma unroll
    for (int ni = 0; ni < 2; ++ni)
#pragma unroll
        for (int mi = 0; mi < 4; ++mi) asm volatile("" : "+v"(acc[ni][mi]));
    { const int t2 = tid_here(), l2 = t2 & 63, w2 = __builtin_amdgcn_readfirstlane(t2 >> 6);
      if (pass == 0) epi.pre(w2 >> 2, l2 & 31);
      if (NPASS == 1) __syncthreads();
      if (pass + 1 < NPASS) {
          asm volatile("s_waitcnt vmcnt(0) lgkmcnt(0)" ::: "memory"); epi.pin();
          __builtin_amdgcn_s_barrier();
          b_off[0] += (unsigned)g.cstep * (unsigned)g.ldw; b_off[1] += (unsigned)g.cstep * (unsigned)g.ldw;
          _Pragma("unroll") for (int t = 0; t < 3; ++t) { Q_DMA(t, t, 0); Q_DMA(t, t, 2); Q_DMA(t, t, 1); Q_DMA(t, t, 3); }
          SB0();
      }
      epi(acc, w2 >> 2, w2 & 3, l2 & 31, l2 >> 5, pass); }
    }
#undef Q_DMA
#undef Q_FRAG
#undef Q_MMA
#undef Q_MMAX
#undef Q_STEP
    __syncthreads();
#ifdef DBG_TQ
    if (g.K == DBG_TQ && tid_here() == 0) { const unsigned long long dq2_ = __builtin_amdgcn_s_memtime(); atomicAdd(&dbg_acc[0], dq1_ - dq0_); atomicAdd(&dbg_acc[2], dq2_ - dq0_); atomicAdd(&dbg_acc[3], 1ull); }
#endif
}

constexpr int R_AS = 0, R_BS = 65536, R_ROWS = 131072;
struct Gemm2Op { const unsigned char* X; const unsigned char* Wt; bf16_t* Y; const float* gate; int yrow0; int nrows; bf16_t* dump; };

__device__ __forceinline__ void gemm2_resident(unsigned char* lds_in, const Gemm2Op& g) {
    unsigned char* lds = lds_here(lds_in);
    const int tid = tid_here(), lane = tid & 63, wid = __builtin_amdgcn_readfirstlane(tid >> 6), wr = wid >> 2, wc = wid & 3, r32 = lane & 31, hi = lane >> 5;
    const int* rows = (const int*)(lds + R_ROWS);
    const int xr = wid * 16 + (lane >> 2);
    const unsigned x_off = (unsigned)rows[xr] * (unsigned)DEXP + ((((lane & 3) ^ ((xr >> 2) & 3))) << 4);
    unsigned b_off[2];
#pragma unroll
    for (int jj = 0; jj < 2; ++jj) {
        const int r = jj * 128 + wid * 16 + (lane >> 2);
        const int cpos = ((lane & 3) ^ ((r >> 2) & 3)) << 4;
        const int rho = r & 31, gcol = ((r >> 5) & 1) * 128 + (r >> 6) * 32 + 16 * ((rho >> 2) & 1) + (rho & 3) + 4 * (rho >> 3);
        b_off[jj] = (unsigned)gcol * (unsigned)DEXP + cpos;
    }
    const int p_lds = wid * 1024;
    const int c0 = ((2 * hi) ^ ((r32 >> 2) & 3)) << 4;
    const int ard = R_AS + (wr * 64 + r32) * 64, brd = R_BS + (wc * 64 + r32) * 64;
    float gsc[2];
#pragma unroll
    for (int mi = 0; mi < 2; ++mi) gsc[mi] = g.gate ? g.gate[wr * 64 + mi * 32 + r32] : 1.f;
    asm volatile("s_waitcnt vmcnt(0)" : "+v"(gsc[0]), "+v"(gsc[1]) :: "memory");

#define R_DMAX(ks) __builtin_amdgcn_global_load_lds((const unsigned*)(g.X + x_off + (ks) * 64), (unsigned*)(lds + R_AS + (ks) * 8192 + p_lds), 16, 0, 0)
#define R_DMAW(s, slot, jj) __builtin_amdgcn_global_load_lds((const unsigned*)(g.Wt + (size_t)((s) >> 3) * 256 * DEXP + b_off[jj] + ((s) & 7) * 64), (unsigned*)(lds + R_BS + (slot) * BF_SLOT + p_lds + (jj) * 8192), 16, 0, 0)
#define R_FRAG(dst, base) do { typedef int i32x4_ __attribute__((ext_vector_type(4))); \
        const i32x4_ lo_ = *(const i32x4_*)(lds + (base) + c0), hi_ = *(const i32x4_*)(lds + (base) + (c0 ^ 16)); \
        dst = __builtin_shufflevector(lo_, hi_, 0, 1, 2, 3, 4, 5, 6, 7); } while (0)
#define R_MMA(ni, mi) acc[ni][mi] = __builtin_amdgcn_mfma_scale_f32_32x32x64_f8f6f4(fw[ni], fx[mi], acc[ni][mi], 0, 0, 0, WQ_SCALE_BYTE * 0x01010101, 0, 0x7f7f7f7f)
#define R_STEP(s, ks, WAITN, DO_ISSUE) do { \
        asm volatile("s_waitcnt vmcnt(" #WAITN ")" ::: "memory"); \
        __builtin_amdgcn_s_barrier(); \
        i32x8 fx[2], fw[2]; \
        R_FRAG(fw[0], brd + ((ks) & 3) * BF_SLOT); R_FRAG(fw[1], brd + ((ks) & 3) * BF_SLOT + 2048); \
        R_FRAG(fx[0], ard + (ks) * 8192); R_FRAG(fx[1], ard + (ks) * 8192 + 2048); SB0(); \
        if (DO_ISSUE) R_DMAW((s) + 3, ((ks) + 3) & 3, 0); SB0(); R_MMA(0, 0); R_MMA(1, 0); SB0(); \
        if (DO_ISSUE) R_DMAW((s) + 3, ((ks) + 3) & 3, 1); SB0(); R_MMA(0, 1); R_MMA(1, 1); SB0(); } while (0)
#define R_STORE(nt) do { \
        _Pragma("unroll") for (int ni = 0; ni < 2; ++ni) _Pragma("unroll") for (int mi = 0; mi < 2; ++mi) asm volatile("" : "+v"(acc[ni][mi])); \
        _Pragma("unroll") for (int mi = 0; mi < 2; ++mi) { const int tr = wr * 64 + mi * 32 + r32; \
            _Pragma("unroll") for (int ni = 0; ni < 2; ++ni) { const f32x16& a = acc[ni][mi]; const float sc = gsc[mi]; u32x4 w0, w1; \
                w0.x = cvtpk(a[0] * sc, a[1] * sc); w0.y = cvtpk(a[2] * sc, a[3] * sc); w0.z = cvtpk(a[4] * sc, a[5] * sc); w0.w = cvtpk(a[6] * sc, a[7] * sc); \
                w1.x = cvtpk(a[8] * sc, a[9] * sc); w1.y = cvtpk(a[10] * sc, a[11] * sc); w1.z = cvtpk(a[12] * sc, a[13] * sc); w1.w = cvtpk(a[14] * sc, a[15] * sc); \
                bf16_t* q = tr < g.nrows ? g.Y + (size_t)(g.yrow0 + tr) * DM + (nt) * 256 + ni * 128 + wc * 32 + 16 * hi : g.dump + tid * 16;     \
                *(u32x4*)q = w0; *(u32x4*)(q + 8) = w1; } } } while (0)

#pragma unroll
    for (int ks = 0; ks < 8; ++ks) R_DMAX(ks);
#pragma unroll
    for (int t = 0; t < 3; ++t) { R_DMAW(t, t, 0); R_DMAW(t, t, 1); }
    SB0();
    f32x16 acc[2][2];
#define R_ZERO() do { _Pragma("unroll") for (int ni = 0; ni < 2; ++ni) _Pragma("unroll") for (int mi = 0; mi < 2; ++mi) _Pragma("unroll") for (int r = 0; r < 16; ++r) acc[ni][mi][r] = 0.f; } while (0)
    R_ZERO();
    R_STEP(0, 0, 4, true); R_STEP(1, 1, 4, true); R_STEP(2, 2, 4, true); R_STEP(3, 3, 4, true);
    R_STEP(4, 4, 4, true); R_STEP(5, 5, 4, true); R_STEP(6, 6, 4, true); R_STEP(7, 7, 4, true);
    R_STORE(0);
#pragma nounroll
    for (int nt = 1; nt < 7; ++nt) {
        const int s0 = nt * 8;
        R_ZERO();
        R_STEP(s0 + 0, 0, 12, true); R_STEP(s0 + 1, 1, 12, true); R_STEP(s0 + 2, 2, 12, true); R_STEP(s0 + 3, 3, 4, true);
        R_STEP(s0 + 4, 4, 4, true); R_STEP(s0 + 5, 5, 4, true); R_STEP(s0 + 6, 6, 4, true); R_STEP(s0 + 7, 7, 4, true);
        R_STORE(nt);
    }
    R_ZERO();
    R_STEP(56, 0, 12, true); R_STEP(57, 1, 12, true); R_STEP(58, 2, 12, true); R_STEP(59, 3, 4, true);
    R_STEP(60, 4, 4, true); R_STEP(61, 5, 4, false); R_STEP(62, 6, 2, false); R_STEP(63, 7, 0, false);
    R_STORE(7);
#undef R_DMAX
#undef R_DMAW
#undef R_FRAG
#undef R_MMA
#undef R_STEP
#undef R_STORE
#undef R_ZERO
    __syncthreads();
}

__device__ __forceinline__ void load_row32_f32(const float* src, int lane, float (&v)[32]) {
#pragma unroll
    for (int i = 0; i < 4; ++i) {
        const f32x4 a = *(const f32x4*)(src + i * 512 + lane * 8), b = *(const f32x4*)(src + i * 512 + lane * 8 + 4);
        v[i * 8 + 0] = a[0]; v[i * 8 + 1] = a[1]; v[i * 8 + 2] = a[2]; v[i * 8 + 3] = a[3];
        v[i * 8 + 4] = b[0]; v[i * 8 + 5] = b[1]; v[i * 8 + 6] = b[2]; v[i * 8 + 7] = b[3];
    }
}
__device__ __forceinline__ void load_row32_bf16(const bf16_t* src, int lane, float (&v)[32]) {
#pragma unroll
    for (int i = 0; i < 4; ++i) {
        const u32x4 a = *(const u32x4*)(src + i * 512 + lane * 8);
        v[i * 8 + 0] = bflo(a.x); v[i * 8 + 1] = bfhi(a.x); v[i * 8 + 2] = bflo(a.y); v[i * 8 + 3] = bfhi(a.y);
        v[i * 8 + 4] = bflo(a.z); v[i * 8 + 5] = bfhi(a.z); v[i * 8 + 6] = bflo(a.w); v[i * 8 + 7] = bfhi(a.w);
    }
}
__device__ __forceinline__ void ln_row32(float (&v)[32], const float* g, const float* bb, int lane) {
    float s = 0.f;
#pragma unroll
    for (int i = 0; i < 32; ++i) s += v[i];
    const float mu = wave_sum(s) * (1.f / DM);
    float q = 0.f;
#pragma unroll
    for (int i = 0; i < 32; ++i) { const float d = v[i] - mu; q += d * d; }
    const float rstd = rsqrtf(wave_sum(q) * (1.f / DM) + LN_EPS);
#pragma unroll
    for (int i = 0; i < 4; ++i) {
        const f32x4 g0 = *(const f32x4*)(g + i * 512 + lane * 8), g1 = *(const f32x4*)(g + i * 512 + lane * 8 + 4);
        const f32x4 b0 = *(const f32x4*)(bb + i * 512 + lane * 8), b1 = *(const f32x4*)(bb + i * 512 + lane * 8 + 4);
#pragma unroll
        for (int e = 0; e < 4; ++e) {
            v[i * 8 + e] = (v[i * 8 + e] - mu) * rstd * g0[e] + b0[e];
            v[i * 8 + 4 + e] = (v[i * 8 + 4 + e] - mu) * rstd * g1[e] + b1[e];
        }
    }
}
__device__ __forceinline__ void store_row32_bf16(bf16_t* dst, int lane, const float (&v)[32]) {
#pragma unroll
    for (int i = 0; i < 4; ++i) {
        u32x4 w; w.x = cvtpk(v[i * 8 + 0], v[i * 8 + 1]); w.y = cvtpk(v[i * 8 + 2], v[i * 8 + 3]); w.z = cvtpk(v[i * 8 + 4], v[i * 8 + 5]); w.w = cvtpk(v[i * 8 + 6], v[i * 8 + 7]);
        *(u32x4*)(dst + i * 512 + lane * 8) = w;
    }
}


constexpr int WG_LDS = 0;
__device__ __forceinline__ void stage_gate_weights(unsigned char* lds, PP p, int layer) {
    float* Wg = (float*)(lds + WG_LDS);
    const float* w = p->w_in + (size_t)layer * DM * N_IN + 3072;
    const int tid = tid_here();
    for (int i = tid; i < DM * 3; i += NTHREADS) {
        const int k = i / 3, c = (i % 3) * 4;
        const f32x4 a = *(const f32x4*)(w + (size_t)k * N_IN + c);
        Wg[(c + 0) * DM + k] = a[0]; Wg[(c + 1) * DM + k] = a[1]; Wg[(c + 2) * DM + k] = a[2]; Wg[(c + 3) * DM + k] = a[3];
    }
    __syncthreads();
}
__device__ __forceinline__ void row_gates(const unsigned char* lds, PP p, int layer, int row, int lane, const float (&v)[32]) {
    const float* Wg = (const float*)(lds + WG_LDS);
    float g = 0.f;
#pragma nounroll
    for (int c = 0; c < 12; ++c) {
        float a = 0.f;
#pragma unroll
        for (int i = 0; i < 4; ++i) {
            const f32x4 w0 = *(const f32x4*)(Wg + c * DM + i * 512 + lane * 8), w1 = *(const f32x4*)(Wg + c * DM + i * 512 + lane * 8 + 4);
            a += v[i * 8 + 0] * w0[0] + v[i * 8 + 1] * w0[1] + v[i * 8 + 2] * w0[2] + v[i * 8 + 3] * w0[3]
               + v[i * 8 + 4] * w1[0] + v[i * 8 + 5] * w1[1] + v[i * 8 + 6] * w1[2] + v[i * 8 + 7] * w1[3];
        }
        a = wave_sum(a);
        g = (lane == c) ? a : g;
    }
    if (lane < 12) {
        if (lane < 6) g += p->b_igate[layer * 6 + lane];
        else g = logsigmoidf_(g + p->b_fgate[layer * 6 + lane - 6]);
        ((float*)(p->ws + WS_GATES))[(size_t)row * 12 + lane] = g;
    }
}

__device__ __forceinline__ void phase_ln_in(unsigned char* lds, PP p, int bx, int G) {
    stage_gate_weights(lds, p, 0);
    const int tid = tid_here(), lane = tid & 63, gw = bx * 8 + (tid >> 6), nw = G * 8;
    bf16_t* hb = (bf16_t*)(p->ws + WS_HB);
    for (int row = gw; row < TALL; row += nw) {
        const float* src = row < TREAL ? p->x + (size_t)row * DM : p->meta + (size_t)((row - TREAL) & 15) * DM;
        float v[32];
        load_row32_f32(src, lane, v);
        ln_row32(v, p->ln_in_g, p->ln_in_b, lane);
        store_row32_bf16(hb + (size_t)row * DM, lane, v);
        row_gates(lds, p, 0, row, lane, v);
    }
}

__device__ __forceinline__ void gates_item(unsigned char* lds_in, PP p, int layer, int item) {
    unsigned char* lds = lds_here(lds_in);
    const int tid = tid_here(), lane = tid & 63, wid = tid >> 6;
    float* Wg = (float*)lds;
    const float* w = p->w_in + (size_t)layer * DM * N_IN + 3072;
    for (int i = tid; i < DM * 3; i += NTHREADS) { const int k = i / 3, c = i % 3; *(f32x4*)(Wg + k * 12 + c * 4) = *(const f32x4*)(w + (size_t)k * N_IN + c * 4); }
    __syncthreads();
    const bf16_t* hb = (const bf16_t*)(p->ws + WS_HB);
    float* gates = (float*)(p->ws + WS_GATES);
    for (int rr = 0; rr < 4; ++rr) {
        const int row = item * 32 + wid * 4 + rr;
        if (row < TALL) {
            float acc[12];
#pragma unroll
            for (int c = 0; c < 12; ++c) acc[c] = 0.f;
            const bf16_t* xr = hb + (size_t)row * DM;
            for (int i = 0; i < 32; ++i) {
                const int k = i * 64 + lane;
                const float xv = bf2f(xr[k]);
                const f32x4 w0 = *(const f32x4*)(Wg + k * 12), w1 = *(const f32x4*)(Wg + k * 12 + 4), w2 = *(const f32x4*)(Wg + k * 12 + 8);
#pragma unroll
                for (int e = 0; e < 4; ++e) { acc[e] += xv * w0[e]; acc[4 + e] += xv * w1[e]; acc[8 + e] += xv * w2[e]; }
            }
#pragma unroll
            for (int c = 0; c < 12; ++c) acc[c] = wave_sum(acc[c]);
            if (lane < 12) {
                float v = 0.f;
#pragma unroll
                for (int c = 0; c < 12; ++c) v = (lane == c) ? acc[c] : v;
                if (lane < 6) v += p->b_igate[layer * 6 + lane];
                else v = logsigmoidf_(v + p->b_fgate[layer * 6 + lane - 6]);
                gates[(size_t)row * 12 + lane] = v;
            }
        }
    }
    __syncthreads();
}

__device__ __forceinline__ void phase_conv(PP p, int layer, int bx, int G) {
    const bf16_t* proj = (const bf16_t*)(p->ws + WS_PROJ);
    bf16_t* qkc = (bf16_t*)(p->ws + WS_QKC);
    const float* cw = p->conv_qk + (size_t)layer * 4 * 1536;
    const int total = TALL * 192;
    for (int idx = bx * NTHREADS + tid_here(); idx < total; idx += G * NTHREADS) {
        const int row = idx / 192, c0 = (idx % 192) * 8;
        int b, l;
        if (row < TREAL) { b = row >> 11; l = NMETA + (row & 2047); } else { b = (row - TREAL) >> 4; l = (row - TREAL) & 15; }
        float acc[8];
#pragma unroll
        for (int e = 0; e < 8; ++e) acc[e] = 0.f;
#pragma unroll
        for (int i = 0; i < 4; ++i) {
            const int ls = l - 3 + i;
            if (ls >= 0) {
                const u32x4 a = *(const u32x4*)(proj + (size_t)row_of(b, ls) * PROJ_W + PC_MLQK + c0);
                const f32x4 w0 = *(const f32x4*)(cw + i * 1536 + c0), w1 = *(const f32x4*)(cw + i * 1536 + c0 + 4);
                acc[0] += bflo(a.x) * w0[0]; acc[1] += bfhi(a.x) * w0[1]; acc[2] += bflo(a.y) * w0[2]; acc[3] += bfhi(a.y) * w0[3];
                acc[4] += bflo(a.z) * w1[0]; acc[5] += bfhi(a.z) * w1[1]; acc[6] += bflo(a.w) * w1[2]; acc[7] += bfhi(a.w) * w1[3];
            }
        }
        const float sc = c0 < 768 ? 0.08838834764831845f : 1.f;
#pragma unroll
        for (int e = 0; e < 8; ++e) acc[e] = siluf_(acc[e]) * sc;
        u32x4 w; w.x = cvtpk(acc[0], acc[1]); w.y = cvtpk(acc[2], acc[3]); w.z = cvtpk(acc[4], acc[5]); w.w = cvtpk(acc[6], acc[7]);
        *(u32x4*)(qkc + (size_t)row * 1536 + c0) = w;
    }
}

template <int NB>
__device__ __forceinline__ void transpose_strip(unsigned char* lds_in, const float* src, int ldsrc, int scol0, int k0, bf16_t* dst, int K, int n0) {
    unsigned char* lds = lds_here(lds_in);
    const int tid = tid_here();
    bf16_t* T = (bf16_t*)(lds + 100352);
    {
        const int k = tid >> 3, c8 = (tid & 7) * 8;
        f32x4 a[NB], b[NB];
#pragma unroll
        for (int q = 0; q < NB; ++q) { a[q] = *(const f32x4*)(src + (size_t)(k0 + k) * ldsrc + scol0 + q * 64 + c8); b[q] = *(const f32x4*)(src + (size_t)(k0 + k) * ldsrc + scol0 + q * 64 + c8 + 4); }
#pragma unroll
        for (int q = 0; q < NB; ++q) {
            bf16_t* Tq = T + (q * 64 + c8) * 66 + k;
            Tq[0 * 66] = f2bf(a[q][0]); Tq[1 * 66] = f2bf(a[q][1]); Tq[2 * 66] = f2bf(a[q][2]); Tq[3 * 66] = f2bf(a[q][3]);
            Tq[4 * 66] = f2bf(b[q][0]); Tq[5 * 66] = f2bf(b[q][1]); Tq[6 * 66] = f2bf(b[q][2]); Tq[7 * 66] = f2bf(b[q][3]);
        }
    }
    __syncthreads();
    {
        const int n = tid >> 3, k8 = (tid & 7) * 8;
#pragma unroll
        for (int q = 0; q < NB; ++q) {
            const unsigned* r = (const unsigned*)(T + (q * 64 + n) * 66 + k8);
            u32x4 w; w.x = r[0]; w.y = r[1]; w.z = r[2]; w.w = r[3];
            *(u32x4*)(dst + (size_t)(n0 + q * 64 + n) * K + k0 + k8) = w;
        }
    }
    __syncthreads();
}
__device__ __forceinline__ void phase_convert(unsigned char* lds, PP p, int bx, int G) {
    bf16_t* wt = (bf16_t*)(p->ws + WS_WT);
    constexpr int N_IN_S = 32 * 23, N_OUT_S = 32 * 8, N_S13_S = 32 * 4, N_S2_S = 8 * 8, N_PL_S = 8, PER_LAYER = N_IN_S + N_OUT_S + N_S13_S + N_S2_S + N_PL_S;
    for (int id = bx; id < DEPTH * PER_LAYER; id += G) {
        const int layer = id / PER_LAYER; int r = id % PER_LAYER;
        bf16_t* base = wt + (size_t)layer * WT_LAYER;
        if (r < N_IN_S) { const int nb = r >> 5, kb = r & 31, n0 = nb * 256; transpose_strip<4>(lds, p->w_in + (size_t)layer * DM * N_IN, N_IN, n0 < 3072 ? n0 : n0 + 12, kb * 64, base + WT_IN, DM, n0); continue; }
        r -= N_IN_S;
        if (r < N_OUT_S) { const int nb = r >> 5, kb = r & 31; transpose_strip<4>(lds, p->w_out + (size_t)layer * DM * DM, DM, nb * 256, kb * 64, base + WT_OUT, DM, nb * 256); continue; }
        r -= N_OUT_S;
        if (r < N_S13_S) { const int nb = r >> 5, kb = r & 31; transpose_strip<4>(lds, p->sh_w13 + (size_t)layer * DM * 1024, 1024, nb * 256, kb * 64, base + WT_SH13, DM, nb * 256); continue; }
        r -= N_S13_S;
        if (r < N_S2_S) { const int nb = r >> 3, kb = r & 7; transpose_strip<4>(lds, p->sh_w2 + (size_t)layer * DEXP * DM, DM, nb * 256, kb * 64, base + WT_SH2, DEXP, nb * 256); continue; }
        r -= N_S2_S;
        { const int g = r >> 1, kb = r & 1;
          transpose_strip<2>(lds, p->pool_w + ((size_t)layer * 4 + g) * 128 * 128, 128, 0, kb * 64, base + WT_POOL + (size_t)g * 128 * 128, 128, 0); }
    }
}

#define KSWZ(row, colB) ((row) * 256 + ((colB) ^ (((row) & 7) << 4)))
#define SBAR() __builtin_amdgcn_sched_barrier(0)
constexpr int MX_V = 0, MX_K = 16384, MX_BUF = 32768, MX_C = 65536, MX_MQ = MX_C + 2112 * 4, MX_EM = MX_MQ + 1024, MX_WS = MX_EM + 1024, MX_Q = 77824, MX_END = MX_Q + 65536;

__device__ __forceinline__ int v_st(int k, int c) { const int kk = (k & ~0xC) | ((k & 4) << 1) | ((k & 8) >> 1); return ((kk >> 3) * 4 + (c >> 5)) * 512 + ((kk & 7) * 32 + (c & 31)) * 2; }
__device__ __forceinline__ int v_rd_base(int lane) { return ((lane & 3) << 3) | (((lane >> 2) & 3) << 6) | (((lane >> 4) & 1) << 5) | (((lane >> 5) & 1) << 8); }
constexpr int v_rd_off(int d0, int ks, int half) { return d0 * 512 + ks * 4096 + half * 2048; }
template <int OFF> __device__ __forceinline__ s16x4 tr_read(int vb) {
    s16x4 r; asm volatile("ds_read_b64_tr_b16 %0, %1 offset:%2" : "=&v"(r) : "v"(vb), "i"(OFF) : "memory"); return r;
}
template <int D0> __device__ __forceinline__ void pv_one(f32x16& od, int vb, bf16x8 pa0, bf16x8 pa1, bf16x8 pa2, bf16x8 pa3) {
    const s16x4 l0 = tr_read<v_rd_off(D0, 0, 0)>(vb), h0 = tr_read<v_rd_off(D0, 0, 1)>(vb), l1 = tr_read<v_rd_off(D0, 1, 0)>(vb), h1 = tr_read<v_rd_off(D0, 1, 1)>(vb);
    const s16x4 l2 = tr_read<v_rd_off(D0, 2, 0)>(vb), h2 = tr_read<v_rd_off(D0, 2, 1)>(vb), l3 = tr_read<v_rd_off(D0, 3, 0)>(vb), h3 = tr_read<v_rd_off(D0, 3, 1)>(vb);
    asm volatile("s_waitcnt lgkmcnt(0)" ::: "memory"); SBAR();
#define PK(L, H) (bf16x8){L[0], L[1], L[2], L[3], H[0], H[1], H[2], H[3]}
    __builtin_amdgcn_s_setprio(1);
    od = __builtin_amdgcn_mfma_f32_32x32x16_bf16(pa0, PK(l0, h0), od, 0, 0, 0);
    od = __builtin_amdgcn_mfma_f32_32x32x16_bf16(pa1, PK(l1, h1), od, 0, 0, 0);
    od = __builtin_amdgcn_mfma_f32_32x32x16_bf16(pa2, PK(l2, h2), od, 0, 0, 0);
    od = __builtin_amdgcn_mfma_f32_32x32x16_bf16(pa3, PK(l3, h3), od, 0, 0, 0);
    __builtin_amdgcn_s_setprio(0);
#undef PK
}
__device__ __forceinline__ void qkt(f32x16& p0, f32x16& p1, const unsigned char* Ks, const unsigned char* Qw, int r32, int hi) {
#pragma unroll
    for (int r = 0; r < 16; ++r) { p0[r] = 0.f; p1[r] = 0.f; }
#pragma unroll
    for (int d0 = 0; d0 < 8; ++d0) {
        const int cb = (d0 * 16 + hi * 8) * 2;
        const bf16x8 b0 = *(const bf16x8*)(Ks + KSWZ(r32, cb));
        const bf16x8 b1 = *(const bf16x8*)(Ks + KSWZ(32 + r32, cb));
        const bf16x8 q = *(const bf16x8*)(Qw + KSWZ(r32, cb));
        p0 = __builtin_amdgcn_mfma_f32_32x32x16_bf16(b0, q, p0, 0, 0, 0);
        p1 = __builtin_amdgcn_mfma_f32_32x32x16_bf16(b1, q, p1, 0, 0, 0);
    }
}
__device__ __forceinline__ float swap_sum(float v) {
    auto rr = __builtin_amdgcn_permlane32_swap(__float_as_uint(v), __float_as_uint(v), false, false);
    return __uint_as_float(rr[0]) + __uint_as_float(rr[1]);
}

#ifndef MIXER_INLINE
#define MIXER_INLINE __forceinline__
#endif
struct MixSrc { const bf16_t* Q; int ldq; const bf16_t* K; int ldk; const bf16_t* V; int ldv; };

template <int MODE>
__device__ MIXER_INLINE void mixer_item(unsigned char* lds_in, PP p, int layer, int b, int h, int j) {
    unsigned char* lds = lds_here(lds_in);
    const int tid = tid_here(), wid = tid >> 6, lane = tid & 63, r32 = lane & 31, hi = lane >> 5;
    const bf16_t* proj = (const bf16_t*)(p->ws + WS_PROJ);
    const bf16_t* qkc = (const bf16_t*)(p->ws + WS_QKC);
    const float* gates = (const float*)(p->ws + WS_GATES);
    bf16_t* cat = (bf16_t*)(p->ws + WS_CAT);
    MixSrc S;
    if (MODE == 0) { S.Q = proj + PC_SBQ + h * HD; S.ldq = PROJ_W; S.K = proj + PC_SBK + h * HD; S.ldk = PROJ_W; S.V = proj + PC_SBV + h * HD; S.ldv = PROJ_W; }
    else { S.Q = qkc + h * HD; S.ldq = 1536; S.K = qkc + 768 + h * HD; S.ldk = 1536; S.V = proj + PC_MLV + h * HD; S.ldv = PROJ_W; }
    unsigned char* V_lds = lds + MX_V; unsigned char* K_lds = lds + MX_K;
    float* carr = (float*)(lds + MX_C); float* mqa = (float*)(lds + MX_MQ); float* ema = (float*)(lds + MX_EM);
    float* wsc = (float*)(lds + MX_WS) + wid * 64;

    const int s0 = 256 * j;
    const int qrow = b * SEQ + s0 + wid * 32 + r32;
    const int lq = NMETA + s0 + wid * 32 + r32;
    unsigned char* Qw = lds + MX_Q + wid * 32 * 256;
#pragma unroll
    for (int d0 = 0; d0 < 8; ++d0) *(bf16x8*)(Qw + KSWZ(r32, (d0 * 16 + hi * 8) * 2)) = *(const bf16x8*)(S.Q + (size_t)qrow * S.ldq + d0 * 16 + hi * 8);

    float mq = 0.f;
    if (MODE == 1) {
        const int Lend = NMETA + s0 + 256;
        if (wid == 0) {
            float csum = 0.f, cmax = -3.0e38f;
            for (int base0 = 0; base0 < Lend; base0 += 512) {
                float lfv[8], liv[8];
#pragma unroll
                for (int u = 0; u < 8; ++u) {
                    const int l = base0 + u * 64 + lane; const bool ok = l < Lend;
                    const int row = row_of(b, ok ? l : 0);
                    lfv[u] = ok ? gates[(size_t)row * 12 + 6 + h] : 0.f;
                    liv[u] = ok ? gates[(size_t)row * 12 + h] : 0.f;
                }
#pragma unroll
                for (int u = 0; u < 8; ++u) {
                    const int l = base0 + u * 64 + lane; const bool ok = l < Lend;
                    const float cB = csum + wave_scan_sum(lfv[u]);
                    const float c = ok ? liv[u] - cB : -3.0e38f;
                    const float pm = fmaxf(cmax, wave_scan_max(c));
                    if (ok) {
                        carr[l] = c * 1.4426950408889634f;
                        if (l >= Lend - 256) { const float m0 = fmaxf(pm, 0.f); mqa[l - (Lend - 256)] = m0 * 1.4426950408889634f; ema[l - (Lend - 256)] = __expf(-(cB + m0)); }
                    }
                    csum = rdlane(cB, 63); cmax = rdlane(pm, 63);
                }
            }
        }
        __syncthreads();
        mq = mqa[wid * 32 + r32];
    }

    const int ntiles = 4 * j + 5;
    const int last_tile = 1 + (s0 + 32 * wid + 31 - (MODE == 0 ? 1 : 0)) / 64;
    const int sr = tid >> 4, sc = (tid & 15) * 8;
    const int vst0 = v_st(sr, sc), vst1 = v_st(32 + sr, sc);
    const int vb0 = (int)(uintptr_t)(LAS unsigned char*)V_lds + v_rd_base(lane);
    bf16x8 vs0, vs1, ks0, ks1;
#define SLOAD(it) do { int r0_, r1_; \
        if ((it) == 0) { r0_ = TREAL + b * NMETA + (sr < NMETA ? sr : NMETA - 1); r1_ = TREAL + b * NMETA + NMETA - 1; } \
        else { r0_ = b * SEQ + 64 * ((it) - 1) + sr; r1_ = r0_ + 32; } \
        vs0 = *(const bf16x8*)(S.V + (size_t)r0_ * S.ldv + sc); vs1 = *(const bf16x8*)(S.V + (size_t)r1_ * S.ldv + sc); \
        ks0 = *(const bf16x8*)(S.K + (size_t)r0_ * S.ldk + sc); ks1 = *(const bf16x8*)(S.K + (size_t)r1_ * S.ldk + sc); } while (0)
#define SWRITE(bo) do { *(bf16x8*)(V_lds + (bo) + vst0) = vs0; *(bf16x8*)(V_lds + (bo) + vst1) = vs1; \
        *(bf16x8*)(K_lds + (bo) + KSWZ(sr, sc * 2)) = ks0; *(bf16x8*)(K_lds + (bo) + KSWZ(32 + sr, sc * 2)) = ks1; } while (0)

    f32x16 o[4];
#pragma unroll
    for (int d = 0; d < 4; ++d)
#pragma unroll
        for (int r = 0; r < 16; ++r) o[d][r] = 0.f;
    float R = (MODE == 0) ? 1.f : 0.f, den = 0.f;

    SLOAD(ntiles - 1);
    SWRITE(((ntiles - 1) & 1) * MX_BUF);
    if (ntiles > 1) SLOAD(ntiles - 2);
    for (int it = ntiles - 1; it >= 0; --it) {
        const int bo = (it & 1) * MX_BUF;
        __syncthreads();
        if (MODE == 0 && it < ntiles - 1) {
            const volatile int* fl = (const volatile int*)(lds + MX_MQ) + ((it + 1) & 1) * 8;
            const int any = fl[0] | fl[1] | fl[2] | fl[3] | fl[4] | fl[5] | fl[6] | fl[7];
            if (__builtin_amdgcn_readfirstlane(any) == 0) break;
        }
        if (it > 0) { SWRITE(MX_BUF - bo); if (it > 1) SLOAD(it - 2); }
        if (it <= last_tile) {
            f32x16 p0, p1;
            qkt(p0, p1, K_lds + bo, Qw, r32, hi);
            const int lbase = it == 0 ? 0 : NMETA + 64 * (it - 1);
            int kmax = lq - lbase + (MODE == 1 ? 1 : 0);
            const int nvalid = it == 0 ? NMETA : 64;
            kmax = kmax < nvalid ? kmax : nvalid;
            if (MODE == 0) {
                constexpr float SC = 0.08838834764831845f * 1.4426950408889634f;
                float x[32];
#pragma unroll
                for (int r = 0; r < 16; ++r) {
                    const float z0 = crow(r, hi) < kmax ? fminf(p0[r] * SC, 60.f) : -1.0e30f;
                    const float z1 = 32 + crow(r, hi) < kmax ? fminf(p1[r] * SC, 60.f) : -1.0e30f;
                    const float e0 = __builtin_amdgcn_exp2f(z0), e1 = __builtin_amdgcn_exp2f(z1);
                    const float k0 = __builtin_amdgcn_rcpf(1.f + e0), k1 = __builtin_amdgcn_rcpf(1.f + e1);
                    x[r] = k0; x[16 + r] = k1; p0[r] = e0 * k0; p1[r] = e1 * k1;
                }
                float run = R;
                float sown[8];
#pragma unroll
                for (int q = 7; q >= 0; --q) {
                    const float g = (x[4 * q] * x[4 * q + 1]) * (x[4 * q + 2] * x[4 * q + 3]);
                    auto rr = __builtin_amdgcn_permlane32_swap(__float_as_uint(g), __float_as_uint(g), false, false);
                    const float lo_q = __uint_as_float(rr[0]), up_q = __uint_as_float(rr[1]);
                    const float s_up = run; run *= up_q;
                    const float s_lo = run; run *= lo_q;
                    sown[q] = hi ? s_up : s_lo;
                }
                R = run;
#pragma unroll
                for (int q = 0; q < 8; ++q) {
                    const float E3 = sown[q], E2 = E3 * x[4 * q + 3], E1 = E2 * x[4 * q + 2], E0 = E1 * x[4 * q + 1];
                    if (q < 4) { p0[4 * q] *= E0; p0[4 * q + 1] *= E1; p0[4 * q + 2] *= E2; p0[4 * q + 3] *= E3; }
                    else { p1[4 * (q - 4)] *= E0; p1[4 * (q - 4) + 1] *= E1; p1[4 * (q - 4) + 2] *= E2; p1[4 * (q - 4) + 3] *= E3; }
                }
            } else {
                if (it > 0 && NMETA + s0 + wid * 32 + 1 - lbase >= 64) {
#pragma unroll
                    for (int q = 0; q < 8; ++q) {
                        const f32x4 c4 = *(const f32x4*)(carr + lbase + 8 * q + 4 * hi);
#pragma unroll
                        for (int i = 0; i < 4; ++i) {
                            const float w = __builtin_amdgcn_exp2f(c4[i] - mq);
                            if (q < 4) { p0[4 * q + i] *= w; den += p0[4 * q + i]; } else { p1[4 * (q - 4) + i] *= w; den += p1[4 * (q - 4) + i]; }
                        }
                    }
                } else {
#pragma unroll
                    for (int q = 0; q < 8; ++q) {
                        const f32x4 c4 = *(const f32x4*)(carr + lbase + 8 * q + 4 * hi);
#pragma unroll
                        for (int i = 0; i < 4; ++i) {
                            const int kk = 8 * q + 4 * hi + i;
                            const float w = kk < kmax ? __builtin_amdgcn_exp2f(c4[i] - mq) : 0.f;
                            if (q < 4) { p0[4 * q + i] *= w; den += p0[4 * q + i]; } else { p1[4 * (q - 4) + i] *= w; den += p1[4 * (q - 4) + i]; }
                        }
                    }
                }
            }
            bf16x8 pa0, pa1, pa2, pa3;
#define PK4(P, BASE, OUT) do { unsigned a0 = cvtpk(P[BASE + 0], P[BASE + 1]), a1 = cvtpk(P[BASE + 2], P[BASE + 3]); \
        unsigned b0 = cvtpk(P[BASE + 4], P[BASE + 5]), b1 = cvtpk(P[BASE + 6], P[BASE + 7]); \
        auto r0 = __builtin_amdgcn_permlane32_swap(a0, b0, false, false); auto r1 = __builtin_amdgcn_permlane32_swap(a1, b1, false, false); \
        u32x4 w = {r0[0], r1[0], r0[1], r1[1]}; OUT = *reinterpret_cast<bf16x8*>(&w); } while (0)
            PK4(p0, 0, pa0); PK4(p0, 8, pa1); PK4(p1, 0, pa2); PK4(p1, 8, pa3);
#undef PK4
            pv_one<0>(o[0], vb0 + bo, pa0, pa1, pa2, pa3); pv_one<1>(o[1], vb0 + bo, pa0, pa1, pa2, pa3);
            pv_one<2>(o[2], vb0 + bo, pa0, pa1, pa2, pa3); pv_one<3>(o[3], vb0 + bo, pa0, pa1, pa2, pa3);
        }
        if (MODE == 0) {
            const bool alive = (it > last_tile) || (__ballot(R > 0.f) != 0ull);
            if (lane == 0) ((volatile int*)(lds + MX_MQ))[(it & 1) * 8 + wid] = alive ? 1 : 0;
        }
    }
#undef SLOAD
#undef SWRITE
    float rden[16];
    if (MODE == 1) {
        den = swap_sum(den);
        if (hi == 0) wsc[r32] = den;
        asm volatile("s_waitcnt lgkmcnt(0)" ::: "memory");
#pragma unroll
        for (int r = 0; r < 16; ++r) { const int qi = crow(r, hi); rden[r] = 1.f / fmaxf(fabsf(wsc[qi]), ema[wid * 32 + qi]); }
#pragma unroll
        for (int d = 0; d < 4; ++d)
#pragma unroll
            for (int r = 0; r < 16; ++r) o[d][r] *= rden[r];
    }
    float ss[16];
#pragma unroll
    for (int r = 0; r < 16; ++r) ss[r] = o[0][r] * o[0][r] + o[1][r] * o[1][r] + o[2][r] * o[2][r] + o[3][r] * o[3][r];
#pragma unroll
    for (int off = 1; off < 32; off <<= 1)
#pragma unroll
        for (int r = 0; r < 16; ++r) ss[r] += __shfl_xor(ss[r], off, 64);
    const float* ng = (MODE == 0 ? p->sb_norm_g : p->ml_norm_g) + layer * 768 + h * HD;
    const int ccol = (MODE == 0 ? 768 : 0) + h * HD;
    float gv[4];
#pragma unroll
    for (int d = 0; d < 4; ++d) gv[d] = ng[d * 32 + r32];
#pragma unroll
    for (int r = 0; r < 16; ++r) {
        const float rn = rsqrtf(ss[r] * (1.f / HD) + RMS_EPS);
        const int orow = b * SEQ + s0 + wid * 32 + crow(r, hi);
#pragma unroll
        for (int d = 0; d < 4; ++d) {
            float v = o[d][r] * rn * gv[d];
            if (MODE == 1) v *= sigmoidf_(bf2f(proj[(size_t)orow * PROJ_W + PC_MLO + h * HD + d * 32 + r32]));
            cat[(size_t)orow * DM + ccol + d * 32 + r32] = f2bf(v);
        }
    }
    __syncthreads();
}

template <int MODE>
__device__ __forceinline__ void mixer_meta_item(unsigned char* lds_in, PP p, int layer, int b, int h) {
    unsigned char* lds = lds_here(lds_in);
    const int tid = tid_here();
    const bf16_t* proj = (const bf16_t*)(p->ws + WS_PROJ);
    const bf16_t* qkc = (const bf16_t*)(p->ws + WS_QKC);
    const float* gates = (const float*)(p->ws + WS_GATES);
    bf16_t* cat = (bf16_t*)(p->ws + WS_CAT);
    MixSrc S;
    if (MODE == 0) { S.Q = proj + PC_SBQ + h * HD; S.ldq = PROJ_W; S.K = proj + PC_SBK + h * HD; S.ldk = PROJ_W; S.V = proj + PC_SBV + h * HD; S.ldv = PROJ_W; }
    else { S.Q = qkc + h * HD; S.ldq = 1536; S.K = qkc + 768 + h * HD; S.ldk = 1536; S.V = proj + PC_MLV + h * HD; S.ldv = PROJ_W; }
    float* Ss = (float*)lds; float* As = Ss + 256; float* dn = As + 256;
    const int row0 = TREAL + b * NMETA;
    if (tid < 256) {
        const int qi = tid >> 4, ki = tid & 15;
        const bf16_t* q = S.Q + (size_t)(row0 + qi) * S.ldq; const bf16_t* k = S.K + (size_t)(row0 + ki) * S.ldk;
        float s = 0.f;
        for (int d = 0; d < HD; ++d) s += bf2f(q[d]) * bf2f(k[d]);
        Ss[qi * 16 + ki] = s;
    }
    __syncthreads();
    if (tid < 16) {
        const int qi = tid;
        if (MODE == 0) {
            float R = 0.f;
            for (int jj = 15; jj >= 0; --jj) {
                float a = 0.f;
                if (jj < qi) {
                    const float z = Ss[qi * 16 + jj] * 0.08838834764831845f;
                    const float lk = -(fmaxf(z, 0.f) + __logf(1.f + __expf(-fabsf(z))));
                    a = __expf(z + lk + R); R += lk;
                }
                As[qi * 16 + jj] = a;
            }
            dn[qi] = 1.f;
        } else {
            float cB = 0.f, pm = -3.0e38f, cs[16];
            float cBq = 0.f;
            for (int jj = 0; jj < 16; ++jj) {
                cB += gates[(size_t)(row0 + jj) * 12 + 6 + h];
                cs[jj] = gates[(size_t)(row0 + jj) * 12 + h] - cB;
                if (jj <= qi) { pm = fmaxf(pm, cs[jj]); cBq = cB; }
            }
            const float m0 = fmaxf(pm, 0.f);
            float den = 0.f;
            for (int jj = 0; jj < 16; ++jj) {
                float a = 0.f;
                if (jj <= qi) { a = __expf(cs[jj] - m0) * Ss[qi * 16 + jj]; den += a; }
                As[qi * 16 + jj] = a;
            }
            dn[qi] = 1.f / fmaxf(fabsf(den), __expf(-(cBq + m0)));
        }
    }
    __syncthreads();
    {
        const int qi = tid >> 5, d4 = (tid & 31) * 4;
        float o[4] = {0.f, 0.f, 0.f, 0.f};
        for (int jj = 0; jj < 16; ++jj) {
            const float a = As[qi * 16 + jj];
            const u32x2 v = *(const u32x2*)(S.V + (size_t)(row0 + jj) * S.ldv + d4);
            o[0] += a * bflo(v.x); o[1] += a * bfhi(v.x); o[2] += a * bflo(v.y); o[3] += a * bfhi(v.y);
        }
        const float dd = dn[qi];
        float ss = 0.f;
#pragma unroll
        for (int e = 0; e < 4; ++e) { o[e] *= dd; ss += o[e] * o[e]; }
#pragma unroll
        for (int off = 1; off < 32; off <<= 1) ss += __shfl_xor(ss, off, 64);
        const float rn = rsqrtf(ss * (1.f / HD) + RMS_EPS);
        const float* ng = (MODE == 0 ? p->sb_norm_g : p->ml_norm_g) + layer * 768 + h * HD;
        const int ccol = (MODE == 0 ? 768 : 0) + h * HD;
        const int orow = row0 + qi;
#pragma unroll
        for (int e = 0; e < 4; ++e) {
            float v = o[e] * rn * ng[d4 + e];
            if (MODE == 1) v *= sigmoidf_(bf2f(proj[(size_t)orow * PROJ_W + PC_MLO + h * HD + d4 + e]));
            cat[(size_t)orow * DM + ccol + d4 + e] = f2bf(v);
        }
    }
    __syncthreads();
}

constexpr int PL_U = 0, PL_P = 36864, PL_W = PL_P + 32768;
__device__ __forceinline__ void pool_item(unsigned char* lds_in, PP p, int layer, int b, int pb, int g) {
    unsigned char* lds = lds_here(lds_in);
    const int tid = tid_here(), lane = tid & 63, wid = tid >> 6, r32 = lane & 31, hi = lane >> 5;
    const bf16_t* proj = (const bf16_t*)(p->ws + WS_PROJ);
    bf16_t* cat = (bf16_t*)(p->ws + WS_CAT);
    const bf16_t* wt = (const bf16_t*)(p->ws + WS_WT) + (size_t)layer * WT_LAYER + WT_POOL + (size_t)g * 128 * 128;
    const int win = 2 << g;
    const int l0 = pb * 128, nl = (LSEQ - l0) < 128 ? (LSEQ - l0) : 128;
    for (int idx = tid; idx < 143 * 16; idx += NTHREADS) {
        const int li = idx >> 4, ch = idx & 15, l = l0 - 15 + li;
        u32x4 v = {0u, 0u, 0u, 0u};
        if (l >= 0 && l < LSEQ) v = *(const u32x4*)(proj + (size_t)row_of(b, l) * PROJ_W + PC_POOL + g * 128 + ch * 8);
        *(u32x4*)(lds + PL_U + li * 256 + ch * 16) = v;
    }
    for (int idx = tid; idx < 128 * 16; idx += NTHREADS) {
        const int d = idx >> 4, ch = idx & 15;
        *(u32x4*)(lds + PL_W + KSWZ(d, ch * 16)) = *(const u32x4*)(wt + (size_t)d * 128 + ch * 8);
    }
    __syncthreads();
    {
        const int c = tid & 127, chn = tid >> 7;
        const bf16_t* U = (const bf16_t*)(lds + PL_U);
        const int i0 = chn * 32;
        float sum = 0.f;
        for (int t = 1; t < win; ++t) sum += bf2f(U[(15 + i0 - t) * 128 + c]);
        for (int i = 0; i < 32; ++i) {
            const int l = l0 + i0 + i;
            const float u = bf2f(U[(15 + i0 + i) * 128 + c]);
            sum += u;
            const int cnt = (l + 1) < win ? (l + 1) : win;
            const float pv = sum / (float)cnt - u;
            sum -= bf2f(U[(15 + i0 + i - win + 1) * 128 + c]);
            *(bf16_t*)(lds + PL_P + KSWZ(i0 + i, c * 2)) = f2bf(pv);
        }
    }
    __syncthreads();
    {
        const int rt = wid >> 1, ch2 = wid & 1;
        f32x16 acc0, acc1;
#pragma unroll
        for (int r = 0; r < 16; ++r) { acc0[r] = 0.f; acc1[r] = 0.f; }
#pragma unroll
        for (int ks = 0; ks < 8; ++ks) {
            const int cb = (ks * 16 + hi * 8) * 2;
            const bf16x8 pf = *(const bf16x8*)(lds + PL_P + KSWZ(rt * 32 + r32, cb));
            const bf16x8 w0 = *(const bf16x8*)(lds + PL_W + KSWZ(ch2 * 64 + r32, cb));
            const bf16x8 w1 = *(const bf16x8*)(lds + PL_W + KSWZ(ch2 * 64 + 32 + r32, cb));
            acc0 = __builtin_amdgcn_mfma_f32_32x32x16_bf16(w0, pf, acc0, 0, 0, 0);
            acc1 = __builtin_amdgcn_mfma_f32_32x32x16_bf16(w1, pf, acc1, 0, 0, 0);
        }
        const int li = rt * 32 + r32;
        if (li < nl) {
            bf16_t* orow = cat + (size_t)row_of(b, l0 + li) * DM + 1536 + g * 128 + ch2 * 64;
            const float* sc = p->pool_scale + layer * 512 + g * 128 + ch2 * 64;
#pragma unroll
            for (int q = 0; q < 4; ++q) {
                const int d0 = 8 * q + 4 * hi;
                const f32x4 s0 = *(const f32x4*)(sc + d0), s1 = *(const f32x4*)(sc + 32 + d0);
                u32x2 w0, w1;
                w0.x = cvtpk(acc0[4 * q] * s0[0], acc0[4 * q + 1] * s0[1]); w0.y = cvtpk(acc0[4 * q + 2] * s0[2], acc0[4 * q + 3] * s0[3]);
                w1.x = cvtpk(acc1[4 * q] * s1[0], acc1[4 * q + 1] * s1[1]); w1.y = cvtpk(acc1[4 * q + 2] * s1[2], acc1[4 * q + 3] * s1[3]);
                *(u32x2*)(orow + d0) = w0; *(u32x2*)(orow + 32 + d0) = w1;
            }
        }
    }
    __syncthreads();
}

template <int NMI> struct EpiResid {
    const bf16_t* H; bf16_t* O; int orow0; int nrows; int oc0, oc1;
    __device__ __forceinline__ void pre(int, int) {}
    __device__ __forceinline__ void pin() {}
    __device__ __forceinline__ void operator()(const f32x16 (&acc)[2][NMI], int wr, int wc, int r32, int hi, int = 0) const {
#pragma unroll
        for (int mi = 0; mi < NMI; ++mi) {
            const int tr = (2 * mi + wr) * 32 + r32;
            if (tr < nrows) {
#pragma unroll
                for (int ni = 0; ni < 2; ++ni) {
                    const size_t o = (size_t)(orow0 + tr) * DM + (ni ? oc1 : oc0) + wc * 32 + 16 * hi;
                    const u32x4 h0 = *(const u32x4*)(H + o), h1 = *(const u32x4*)(H + o + 8);
                    const f32x16& a = acc[ni][mi];
                    u32x4 w0, w1;
                    w0.x = cvtpk(DN_ALPHA * bflo(h0.x) + a[0], DN_ALPHA * bfhi(h0.x) + a[1]); w0.y = cvtpk(DN_ALPHA * bflo(h0.y) + a[2], DN_ALPHA * bfhi(h0.y) + a[3]);
                    w0.z = cvtpk(DN_ALPHA * bflo(h0.z) + a[4], DN_ALPHA * bfhi(h0.z) + a[5]); w0.w = cvtpk(DN_ALPHA * bflo(h0.w) + a[6], DN_ALPHA * bfhi(h0.w) + a[7]);
                    w1.x = cvtpk(DN_ALPHA * bflo(h1.x) + a[8], DN_ALPHA * bfhi(h1.x) + a[9]); w1.y = cvtpk(DN_ALPHA * bflo(h1.y) + a[10], DN_ALPHA * bfhi(h1.y) + a[11]);
                    w1.z = cvtpk(DN_ALPHA * bflo(h1.z) + a[12], DN_ALPHA * bfhi(h1.z) + a[13]); w1.w = cvtpk(DN_ALPHA * bflo(h1.w) + a[14], DN_ALPHA * bfhi(h1.w) + a[15]);
                    *(u32x4*)(O + o) = w0; *(u32x4*)(O + o + 8) = w1;
                }
            }
        }
    }
};

#ifndef RDUP_NA
#define RDUP_NA 1
#endif
#ifndef RDUP_NB
#define RDUP_NB 1
#endif
#ifndef RDUP_NC
#define RDUP_NC 1
#endif
#ifndef RDUP_ND
#define RDUP_ND 1
#endif
#ifndef RDUP_NE
#define RDUP_NE 1
#endif
__device__ __forceinline__ int rdup_n(int n) { if (n > 1) asm volatile("" : "+s"(n)); return n; }
#define RDUP_LOOP(X) for (int q##X##_ = 0, n##X##_ = rdup_n(RDUP_N##X); q##X##_ < n##X##_; ++q##X##_)
#define RDUP_LAST(X) (q##X##_ == n##X##_ - 1)
constexpr int RX_STRIDE = 4112;
constexpr int RT_XN = 0, RT_PART = 0, RT_LG = 32 * RX_STRIDE, RT_ST = RT_LG + 8192, RT_HIST = RT_ST + 256, RT_BASE = RT_HIST + 256, RT_END = RT_BASE + 256;
static_assert(RT_END <= LDS_BYTES - 64, "router LDS");
__device__ __forceinline__ void split_bf16x8(const float (&x)[8], bf16x8& h, bf16x8& l) {
    u32x4 hw, lw;
    hw.x = cvtpk(x[0], x[1]); hw.y = cvtpk(x[2], x[3]); hw.z = cvtpk(x[4], x[5]); hw.w = cvtpk(x[6], x[7]);
    lw.x = cvtpk(x[0] - bflo(hw.x), x[1] - bfhi(hw.x)); lw.y = cvtpk(x[2] - bflo(hw.y), x[3] - bfhi(hw.y));
    lw.z = cvtpk(x[4] - bflo(hw.z), x[5] - bfhi(hw.z)); lw.w = cvtpk(x[6] - bflo(hw.w), x[7] - bfhi(hw.w));
    h = *reinterpret_cast<bf16x8*>(&hw); l = *reinterpret_cast<bf16x8*>(&lw);
}
__device__ __forceinline__ void router_preformat(PP p, int bx, int G) {
    const int tid = tid_here();
    for (int idx = bx * NTHREADS + tid; idx < DEPTH * 128 * 64; idx += G * NTHREADS) {
        const int lane = idx & 63, ksg = (idx >> 6) & 127, layer = idx >> 13, r32 = lane & 31, k0 = ksg * 16 + (lane >> 5) * 8;
        const float* rw = p->router_w + (size_t)layer * DM * NEXP;
        float w0[8], w1[8];
#pragma unroll
        for (int j = 0; j < 8; ++j) { w0[j] = rw[(size_t)(k0 + j) * NEXP + r32]; w1[j] = rw[(size_t)(k0 + j) * NEXP + 32 + r32]; }
        bf16x8 wh0, wl0, wh1, wl1; split_bf16x8(w0, wh0, wl0); split_bf16x8(w1, wh1, wl1);
        u32x4* dst = (u32x4*)(p->ws + WS_RWF + (size_t)layer * RWF_LAYER) + (size_t)(ksg * 4) * 64 + lane;
        dst[0] = __builtin_bit_cast(u32x4, wh0); dst[64] = __builtin_bit_cast(u32x4, wl0); dst[128] = __builtin_bit_cast(u32x4, wh1); dst[192] = __builtin_bit_cast(u32x4, wl1);
    }
}
__device__ __forceinline__ void router_item(unsigned char* lds_in, PP p, int layer, int item, int M) {
    unsigned char* lds = lds_here(lds_in);
    const int tid = tid_here(), lane = tid & 63, wid = tid >> 6, r32 = lane & 31, hi = lane >> 5;
    const bf16_t* S1 = (const bf16_t*)(p->ws + WS_S1);
    bf16_t* H1 = (bf16_t*)(p->ws + WS_H1);
    float* part = (float*)(lds + RT_PART);
    float* lgs = (float*)(lds + RT_LG);
    int* hist = (int*)(lds + RT_HIST); int* basev = (int*)(lds + RT_BASE);
    const float* g1 = p->ln1_g + layer * DM; const float* b1 = p->ln1_b + layer * DM;
    if (tid < 64) hist[tid] = 0;
    f32x16 d0, d1;
    {
        u32x4 raw[4][4];
        float mu[4], rs[4];
        RDUP_LOOP(A) {
#pragma unroll
        for (int rr = 0; rr < 4; ++rr) {
            const int row = item * 32 + wid * 4 + rr, rowc = row < M ? row : M - 1;
#pragma unroll
            for (int i = 0; i < 4; ++i) raw[rr][i] = *(const u32x4*)(S1 + (size_t)rowc * DM + i * 512 + lane * 8);
        }
#pragma unroll
        for (int rr = 0; rr < 4; ++rr) {
            float s = 0.f;
#pragma unroll
            for (int i = 0; i < 4; ++i) s += (bflo(raw[rr][i].x) + bfhi(raw[rr][i].x)) + (bflo(raw[rr][i].y) + bfhi(raw[rr][i].y)) + (bflo(raw[rr][i].z) + bfhi(raw[rr][i].z)) + (bflo(raw[rr][i].w) + bfhi(raw[rr][i].w));
            mu[rr] = wave_sum(s) * (1.f / DM);
            float q = 0.f;
#pragma unroll
            for (int i = 0; i < 4; ++i) {
                const unsigned ww[4] = {raw[rr][i].x, raw[rr][i].y, raw[rr][i].z, raw[rr][i].w};
#pragma unroll
                for (int e = 0; e < 4; ++e) { const float da = bflo(ww[e]) - mu[rr], db = bfhi(ww[e]) - mu[rr]; q += da * da + db * db; }
            }
            rs[rr] = rsqrtf(wave_sum(q) * (1.f / DM) + LN_EPS);
        }
        }
        RDUP_LOOP(B) {
#pragma unroll
        for (int r = 0; r < 16; ++r) { d0[r] = 0.f; d1[r] = 0.f; }
        const u32x4* wf = (const u32x4*)(p->ws + WS_RWF + (size_t)layer * RWF_LAYER);
#pragma unroll
        for (int h = 0; h < 2; ++h) {
            RDUP_LOOP(D)
#pragma unroll
            for (int ii = 0; ii < 2; ++ii) {
                const int i = 2 * h + ii;
                const f32x4 ga = *(const f32x4*)(g1 + i * 512 + lane * 8), gb = *(const f32x4*)(g1 + i * 512 + lane * 8 + 4);
                const f32x4 ba = *(const f32x4*)(b1 + i * 512 + lane * 8), bb = *(const f32x4*)(b1 + i * 512 + lane * 8 + 4);
#pragma unroll
                for (int rr = 0; rr < 4; ++rr) {
                    const int lr = wid * 4 + rr, row = item * 32 + lr;
                    const u32x4 a = raw[rr][i];
                    float x[8];
                    x[0] = (bflo(a.x) - mu[rr]) * rs[rr] * ga[0] + ba[0]; x[1] = (bfhi(a.x) - mu[rr]) * rs[rr] * ga[1] + ba[1];
                    x[2] = (bflo(a.y) - mu[rr]) * rs[rr] * ga[2] + ba[2]; x[3] = (bfhi(a.y) - mu[rr]) * rs[rr] * ga[3] + ba[3];
                    x[4] = (bflo(a.z) - mu[rr]) * rs[rr] * gb[0] + bb[0]; x[5] = (bfhi(a.z) - mu[rr]) * rs[rr] * gb[1] + bb[1];
                    x[6] = (bflo(a.w) - mu[rr]) * rs[rr] * gb[2] + bb[2]; x[7] = (bfhi(a.w) - mu[rr]) * rs[rr] * gb[3] + bb[3];
                    if (row < M) {
                        u32x4 hw; hw.x = cvtpk(x[0], x[1]); hw.y = cvtpk(x[2], x[3]); hw.z = cvtpk(x[4], x[5]); hw.w = cvtpk(x[6], x[7]);
                        *(u32x4*)(H1 + (size_t)row * DM + i * 512 + lane * 8) = hw;
                        u32x2 qw; qw.x = pk4_fp8(x[0], x[1], x[2], x[3]); qw.y = pk4_fp8(x[4], x[5], x[6], x[7]);
                        *(u32x2*)(p->ws + WS_H1Q + (size_t)row * DM + i * 512 + lane * 8) = qw;
                    }
                    float* xd = (float*)(lds + RT_XN + lr * RX_STRIDE) + ii * 512 + lane * 8;
                    *(f32x4*)xd = (f32x4){x[0], x[1], x[2], x[3]}; *(f32x4*)(xd + 4) = (f32x4){x[4], x[5], x[6], x[7]};
                }
            }
            __syncthreads();
            RDUP_LOOP(E) {
#if RDUP_NE > 1
            const f32x16 sv0 = d0, sv1 = d1;
#endif
#pragma unroll
            for (int ks = 0; ks < 8; ++ks) {
                const float* xs = (const float*)(lds + RT_XN + r32 * RX_STRIDE) + wid * 128 + ks * 16 + hi * 8;
                const f32x4 xa = *(const f32x4*)xs, xb = *(const f32x4*)(xs + 4);
                const float x[8] = {xa[0], xa[1], xa[2], xa[3], xb[0], xb[1], xb[2], xb[3]};
                bf16x8 xh, xl; split_bf16x8(x, xh, xl);
                const u32x4* wp = wf + (size_t)((h * 64 + wid * 8 + ks) * 4) * 64 + lane;
                const u32x4 q0 = wp[0], q1 = wp[64], q2 = wp[128], q3 = wp[192];
                const bf16x8 wh0 = __builtin_bit_cast(bf16x8, q0), wl0 = __builtin_bit_cast(bf16x8, q1), wh1 = __builtin_bit_cast(bf16x8, q2), wl1 = __builtin_bit_cast(bf16x8, q3);
                d0 = __builtin_amdgcn_mfma_f32_32x32x16_bf16(xh, wh0, d0, 0, 0, 0); d1 = __builtin_amdgcn_mfma_f32_32x32x16_bf16(xh, wh1, d1, 0, 0, 0);
                d0 = __builtin_amdgcn_mfma_f32_32x32x16_bf16(xh, wl0, d0, 0, 0, 0); d1 = __builtin_amdgcn_mfma_f32_32x32x16_bf16(xh, wl1, d1, 0, 0, 0);
                d0 = __builtin_amdgcn_mfma_f32_32x32x16_bf16(xl, wh0, d0, 0, 0, 0); d1 = __builtin_amdgcn_mfma_f32_32x32x16_bf16(xl, wh1, d1, 0, 0, 0);
            }
#if RDUP_NE > 1
            if (!RDUP_LAST(E)) { d0 = sv0; d1 = sv1; }
#endif
            }
            __syncthreads();
        }
        }
#pragma unroll
        for (int r = 0; r < 16; ++r) { part[(wid * 32 + crow(r, hi)) * 64 + r32] = d0[r]; part[(wid * 32 + crow(r, hi)) * 64 + 32 + r32] = d1[r]; }
    }
    __syncthreads();
    {
        f32x4 sum = *(const f32x4*)(part + tid * 4);
#pragma unroll
        for (int w = 1; w < 8; ++w) { const f32x4 t = *(const f32x4*)(part + w * 2048 + tid * 4); sum[0] += t[0]; sum[1] += t[1]; sum[2] += t[2]; sum[3] += t[3]; }
        *(f32x4*)(lgs + tid * 4) = sum;
    }
    __syncthreads();
    float lg[4];
#pragma unroll
    for (int rr = 0; rr < 4; ++rr) lg[rr] = lgs[(wid * 4 + rr) * 64 + lane];
    const float bias = p->router_bias[layer * NEXP + lane];
    int my_e[4], my_rank[4]; float my_g[4];
    RDUP_LOOP(C)
    for (int rr = 0; rr < 4; ++rr) {
        const int row = item * 32 + wid * 4 + rr;
        const float score = 1.f / (1.f + __expf(-lg[rr]));
        float sel = score + bias;
        int e_k = 0; float s_k = 0.f; float ssum = 0.f;
        for (int k = 0; k < TOPK; ++k) {
            const float m = wave_max(sel);
            const unsigned long long bal = __ballot(sel == m);
            const int idx = __ffsll((long long)bal) - 1;
            const float sc = rdlane(score, __builtin_amdgcn_readfirstlane(idx));
            ssum += sc;
            if (lane == k) { e_k = idx; s_k = sc; }
            if (lane == idx) sel = -3.0e38f;
        }
        my_e[rr] = e_k; my_g[rr] = s_k / ssum * ROUTED_SCALE; my_rank[rr] = 0;
        if (RDUP_LAST(C) && lane < TOPK && row < M) my_rank[rr] = atomicAdd(&hist[e_k], 1);
    }
    __syncthreads();
    int* cnt = (int*)(p->ws + WS_CTL + CTL_CNT) + layer * CNT_LAYER;
    if (tid < 64) basev[tid] = atomicAdd(&cnt[tid * CNT_STRIDE], hist[tid]);
#ifdef PROBE_ATOM2
    if (tid < 64) basev[64 + tid] = atomicAdd(&cnt[DEPTH * CNT_LAYER + 4096 + layer * CNT_LAYER + tid * CNT_STRIDE], hist[tid]);
#endif
    __syncthreads();
    int* asg_e = (int*)(p->ws + WS_ASGE); int* asg_s = (int*)(p->ws + WS_ASGS);
    int* tokl = (int*)(p->ws + WS_TOKL); float* gatel = (float*)(p->ws + WS_GATEL);
    for (int rr = 0; rr < 4; ++rr) {
        const int row = item * 32 + wid * 4 + rr;
        if (lane < TOPK && row < M) {
            const int e = my_e[rr], slot = basev[e] + my_rank[rr];
            asg_e[row * 8 + lane] = e; asg_s[row * 8 + lane] = slot;
            tokl[(size_t)e * TALL + slot] = row; gatel[(size_t)e * TALL + slot] = my_g[rr];
        }
    }
    __syncthreads();
}

constexpr int MS_BASE = G_LDS_END;
constexpr int MS_CNT = MS_BASE, MS_OFF = MS_BASE + 66 * 4, MS_TP = MS_BASE + 132 * 4, MS_END = MS_BASE + 200 * 4;
__device__ __forceinline__ void moe_tables(unsigned char* lds, PP p, int layer, int M, int tmrows = TM) {
    int* c = (int*)(lds + MS_CNT); int* o = (int*)(lds + MS_OFF); int* tp = (int*)(lds + MS_TP);
    const int tid = tid_here();
    if (tid < 64) {
        const int* cnt = (const int*)(p->ws + WS_CTL + CTL_CNT) + layer * CNT_LAYER;
        const int n = __hip_atomic_load(&cnt[tid * CNT_STRIDE], __ATOMIC_RELAXED, __HIP_MEMORY_SCOPE_AGENT);
        const int nt = (n + tmrows - 1) / tmrows;
        int so = n, st = nt;
#pragma unroll
        for (int d = 1; d < 64; d <<= 1) { const int a = __shfl_up(so, d, 64), b2 = __shfl_up(st, d, 64); if (tid >= d) { so += a; st += b2; } }
        c[tid] = n; o[tid] = so - n; tp[tid] = st - nt;
        if (tid == 63) { c[64] = M; o[64] = SH_BASE; tp[64] = st; tp[65] = st; }
    }
    __syncthreads();
}
__device__ __forceinline__ void moe_decode(const unsigned char* lds, int id, int ntn, int& e, int& nt, int& m) {
    const int* tp = (const int*)(lds + MS_TP);
    int lo = 0;
#pragma unroll
    for (int step = 32; step >= 1; step >>= 1) { const int cand = lo + step; if (cand <= 63 && tp[cand] * ntn <= id) lo = cand; }
    e = __builtin_amdgcn_readfirstlane(lo); const int rem = id - __builtin_amdgcn_readfirstlane(tp[e]) * ntn, nm = __builtin_amdgcn_readfirstlane(tp[e + 1] - tp[e]);
    nt = __builtin_amdgcn_readfirstlane(rem / nm); m = __builtin_amdgcn_readfirstlane(rem % nm);
}

template <int NMI> struct EpiSwiglu {
    bf16_t* O; int orow0; int nrows; int oc;
    __device__ __forceinline__ void pre(int, int) {}
    __device__ __forceinline__ void pin() {}
    __device__ __forceinline__ void operator()(const f32x16 (&acc)[2][NMI], int wr, int wc, int r32, int hi, int pass = 0) const {
#pragma unroll
        for (int mi = 0; mi < NMI; ++mi) {
            const int tr = (2 * mi + wr) * 32 + r32;
            if (tr < nrows) {
                float v[16];
#pragma unroll
                for (int r = 0; r < 16; ++r) { const float gte = acc[0][mi][r]; v[r] = gte / (1.f + __expf(-gte)) * acc[1][mi][r]; }
                u32x4 w0, w1;
                w0.x = cvtpk(v[0], v[1]); w0.y = cvtpk(v[2], v[3]); w0.z = cvtpk(v[4], v[5]); w0.w = cvtpk(v[6], v[7]);
                w1.x = cvtpk(v[8], v[9]); w1.y = cvtpk(v[10], v[11]); w1.z = cvtpk(v[12], v[13]); w1.w = cvtpk(v[14], v[15]);
                bf16_t* q = O + (size_t)(orow0 + tr) * DEXP + oc + pass * 128 + wc * 32 + 16 * hi;
                *(u32x4*)q = w0; *(u32x4*)(q + 8) = w1;
            }
        }
    }
};
template <int NMI> struct EpiScaleStore {
    bf16_t* O; int orow0; int nrows; int oc0, oc1; const float* gate;
    float gpre[NMI];
    __device__ __forceinline__ void pre(int wr, int r32) {
#pragma unroll
        for (int mi = 0; mi < NMI; ++mi) gpre[mi] = gate ? gate[(2 * mi + wr) * 32 + r32] : 1.f;
    }
    __device__ __forceinline__ void pin() {
#pragma unroll
        for (int mi = 0; mi < NMI; ++mi) asm volatile("" : "+v"(gpre[mi]));
    }
    __device__ __forceinline__ void operator()(const f32x16 (&acc)[2][NMI], int wr, int wc, int r32, int hi, int pass = 0) const {
#pragma unroll
        for (int mi = 0; mi < NMI; ++mi) {
            const int tr = (2 * mi + wr) * 32 + r32;
            if (tr < nrows) {
                const float gsc = gpre[mi];
#pragma unroll
                for (int ni = 0; ni < 2; ++ni) {
                    const f32x16& a = acc[ni][mi];
                    u32x4 w0, w1;
                    w0.x = cvtpk(a[0] * gsc, a[1] * gsc); w0.y = cvtpk(a[2] * gsc, a[3] * gsc); w0.z = cvtpk(a[4] * gsc, a[5] * gsc); w0.w = cvtpk(a[6] * gsc, a[7] * gsc);
                    w1.x = cvtpk(a[8] * gsc, a[9] * gsc); w1.y = cvtpk(a[10] * gsc, a[11] * gsc); w1.z = cvtpk(a[12] * gsc, a[13] * gsc); w1.w = cvtpk(a[14] * gsc, a[15] * gsc);
                    bf16_t* q = O + (size_t)(orow0 + tr) * DM + (ni ? oc1 : oc0) + pass * 256 + wc * 32 + 16 * hi;
                    *(u32x4*)q = w0; *(u32x4*)(q + 8) = w1;
                }
            }
        }
    }
};

__device__ __forceinline__ void moe_gemm1_item(unsigned char* lds_in, PP p, int layer, int id) {
    unsigned char* lds = lds_here(lds_in);
    int e, nt, m; moe_decode(lds, id, 4, e, nt, m);
    const int* c = (const int*)(lds + MS_CNT); const int* o = (const int*)(lds + MS_OFF);
    const int cnt = __builtin_amdgcn_readfirstlane(c[e]), nvalid = (cnt - m * TM) < TM ? (cnt - m * TM) : TM;
    const int oe = __builtin_amdgcn_readfirstlane(o[e]);
    int* rows = (int*)(lds + G_ROWS);
    { const int t_ = tid_here();
      if (t_ < TM) {
        const int slot = m * TM + (t_ < nvalid ? t_ : nvalid - 1);
        rows[t_] = ((const int*)(p->ws + WS_TOKL))[(size_t)e * TALL + slot];
      } }
    __syncthreads();
    const float* W = p->exp_w13 + ((size_t)layer * 64 + e) * DM * 1024;
    GemmOp g{(const bf16_t*)(p->ws + WS_H1), DM, W, 1024, nt * 128, 512 + nt * 128, DM, 128};
    EpiSwiglu<3> ep{(bf16_t*)(p->ws + WS_ACT), oe + m * TM, nvalid, nt * 128};
    gemm_tile<1>(lds, g, ep);
}
__device__ __forceinline__ void moe_gemm2_item(unsigned char* lds_in, PP p, int layer, int id) {
    unsigned char* lds = lds_here(lds_in);
    int e, nt, m; moe_decode(lds, id, 4, e, nt, m); nt *= 2;
    const int* c = (const int*)(lds + MS_CNT); const int* o = (const int*)(lds + MS_OFF);
    const int cnt = __builtin_amdgcn_readfirstlane(c[e]), nvalid = (cnt - m * TM) < TM ? (cnt - m * TM) : TM;
    const int pos0 = __builtin_amdgcn_readfirstlane(o[e]) + m * TM;
    int* rows = (int*)(lds + G_ROWS);
    { const int t_ = tid_here(); if (t_ < TM) rows[t_] = pos0 + (t_ < nvalid ? t_ : nvalid - 1); }
    __syncthreads();
    const float* W = p->exp_w2 + ((size_t)layer * 64 + e) * DEXP * DM;
    GemmOp g{(const bf16_t*)(p->ws + WS_ACT), DEXP, W, DM, nt * 256, nt * 256 + 128, DEXP, 256};
    EpiScaleStore<3> ep{(bf16_t*)(p->ws + WS_Y), pos0, nvalid, nt * 256, nt * 256 + 128, (const float*)(p->ws + WS_GATEL) + (size_t)e * TALL + m * TM, {}};
    gemm_tile<2>(lds, g, ep);
}


constexpr int ST_ROWB = 528;
__device__ __forceinline__ void stage_put(unsigned char* lds, const f32x16& a, float sc, int row, int col) {
    u32x4 w0, w1;
    w0.x = cvtpk(a[0] * sc, a[1] * sc); w0.y = cvtpk(a[2] * sc, a[3] * sc); w0.z = cvtpk(a[4] * sc, a[5] * sc); w0.w = cvtpk(a[6] * sc, a[7] * sc);
    w1.x = cvtpk(a[8] * sc, a[9] * sc); w1.y = cvtpk(a[10] * sc, a[11] * sc); w1.z = cvtpk(a[12] * sc, a[13] * sc); w1.w = cvtpk(a[14] * sc, a[15] * sc);
    *(u32x4*)(lds + row * ST_ROWB + col * 2) = w0; *(u32x4*)(lds + row * ST_ROWB + col * 2 + 16) = w1;
}
struct EpiStoreBf16S {
    unsigned char* lds; bf16_t* O; int ldo; int orow0; int nrows; int oc0;
    __device__ __forceinline__ void pre(int, int) {}
    __device__ __forceinline__ void pin() {}
    __device__ __forceinline__ void operator()(const f32x16 (&acc)[2][4], int wr, int wc, int r32, int hi, int = 0) const {
#pragma unroll
        for (int mi = 0; mi < 4; ++mi)
#pragma unroll
            for (int ni = 0; ni < 2; ++ni) stage_put(lds, acc[ni][mi], 1.f, (2 * mi + wr) * 32 + r32, ni * 128 + wc * 32 + 16 * hi);
        __syncthreads();
        const int tid = tid_here();
#pragma unroll 4
        for (int i = 0; i < 16; ++i) {
            const int c = i * 512 + tid, row = c >> 5, ch = c & 31;
            if (row < nrows) *(u32x4*)(O + (size_t)(orow0 + row) * ldo + oc0 + ch * 8) = *(const u32x4*)(lds + row * ST_ROWB + ch * 16);
        }
    }
};

struct EpiConvS {
    unsigned char* lds; bf16_t* Q; const float* cw; int u0; int oc0;
    __device__ __forceinline__ void pre(int, int) {}
    __device__ __forceinline__ void pin() {}
    __device__ __forceinline__ void operator()(const f32x16 (&acc)[2][4], int wr, int wc, int r32, int hi, int = 0) const {
#pragma unroll
        for (int mi = 0; mi < 4; ++mi)
#pragma unroll
            for (int ni = 0; ni < 2; ++ni) stage_put(lds, acc[ni][mi], 1.f, (2 * mi + wr) * 32 + r32, ni * 128 + wc * 32 + 16 * hi);
        const int tid = tid_here();
        f32x4 cwv[4][2];
#pragma unroll
        for (int t = 0; t < 4; ++t) { cwv[t][0] = *(const f32x4*)(cw + t * 1536 + oc0 + (tid & 31) * 8); cwv[t][1] = *(const f32x4*)(cw + t * 1536 + oc0 + (tid & 31) * 8 + 4); }
        __syncthreads();
#pragma unroll 2
        for (int i = 0; i < 16; ++i) {
            const int c = i * 512 + tid, row = c >> 5, ch = c & 31, u = u0 + row;
            if (row >= 3 && u < NB * LSEQ) {
                const int b = u / LSEQ, l = u - b * LSEQ, col = oc0 + ch * 8;
                float a8[8];
#pragma unroll
                for (int e = 0; e < 8; ++e) a8[e] = 0.f;
#pragma unroll
                for (int t = 0; t < 4; ++t) {
                    if (l - 3 + t >= 0) {
                        const u32x4 x = *(const u32x4*)(lds + (row - 3 + t) * ST_ROWB + ch * 16);
                        const f32x4 w0 = cwv[t][0], w1 = cwv[t][1];
                        a8[0] += bflo(x.x) * w0[0]; a8[1] += bfhi(x.x) * w0[1]; a8[2] += bflo(x.y) * w0[2]; a8[3] += bfhi(x.y) * w0[3];
                        a8[4] += bflo(x.z) * w1[0]; a8[5] += bfhi(x.z) * w1[1]; a8[6] += bflo(x.w) * w1[2]; a8[7] += bfhi(x.w) * w1[3];
                    }
                }
                const float sc = col < 768 ? 0.08838834764831845f : 1.f;
#pragma unroll
                for (int e = 0; e < 8; ++e) a8[e] = siluf_(a8[e]) * sc;
                u32x4 w; w.x = cvtpk(a8[0], a8[1]); w.y = cvtpk(a8[2], a8[3]); w.z = cvtpk(a8[4], a8[5]); w.w = cvtpk(a8[6], a8[7]);
                *(u32x4*)(Q + (size_t)row_of(b, l) * 1536 + col) = w;
            }
        }
    }
};
struct EpiResidS {
    unsigned char* lds; const bf16_t* H; bf16_t* O; int orow0; int nrows; int oc0;
    __device__ __forceinline__ void pre(int, int) {}
    __device__ __forceinline__ void pin() {}
    __device__ __forceinline__ void operator()(const f32x16 (&acc)[2][4], int wr, int wc, int r32, int hi, int = 0) const {
#pragma unroll
        for (int mi = 0; mi < 4; ++mi)
#pragma unroll
            for (int ni = 0; ni < 2; ++ni) stage_put(lds, acc[ni][mi], 1.f, (2 * mi + wr) * 32 + r32, ni * 128 + wc * 32 + 16 * hi);
        const int tid = tid_here();
#pragma unroll
        for (int half = 0; half < 2; ++half) {
            u32x4 hv[8];
#pragma unroll
            for (int i = 0; i < 8; ++i) {
                const int c = (half * 8 + i) * 512 + tid, row = c >> 5, ch = c & 31, rowc = row < nrows ? row : nrows - 1;
                hv[i] = *(const u32x4*)(H + (size_t)(orow0 + rowc) * DM + oc0 + ch * 8);
            }
            if (half == 0) __syncthreads();
#pragma unroll
            for (int i = 0; i < 8; ++i) {
                const int c = (half * 8 + i) * 512 + tid, row = c >> 5, ch = c & 31;
                if (row < nrows) {
                    const u32x4 a = *(const u32x4*)(lds + row * ST_ROWB + ch * 16), h = hv[i];
                    u32x4 w;
                    w.x = cvtpk(DN_ALPHA * bflo(h.x) + bflo(a.x), DN_ALPHA * bfhi(h.x) + bfhi(a.x)); w.y = cvtpk(DN_ALPHA * bflo(h.y) + bflo(a.y), DN_ALPHA * bfhi(h.y) + bfhi(a.y));
                    w.z = cvtpk(DN_ALPHA * bflo(h.z) + bflo(a.z), DN_ALPHA * bfhi(h.z) + bfhi(a.z)); w.w = cvtpk(DN_ALPHA * bflo(h.w) + bflo(a.w), DN_ALPHA * bfhi(h.w) + bfhi(a.w));
                    *(u32x4*)(O + (size_t)(orow0 + row) * DM + oc0 + ch * 8) = w;
                }
            }
        }
    }
};

__device__ __forceinline__ void outproj_meta_item(unsigned char* lds_in, PP p, int layer, int item) {
    unsigned char* lds = lds_here(lds_in);
    const int tid = tid_here(), lane = tid & 63, wid = tid >> 6, r32 = lane & 31, hi = lane >> 5;
    const int row0 = TREAL + (item & 1) * 32, col0 = (item >> 1) * 32;
    const bf16_t* X = (const bf16_t*)(p->ws + WS_CAT) + (size_t)(row0 + r32) * DM + wid * 256 + hi * 8;
    const bf16_t* W = (const bf16_t*)(p->ws + WS_WT) + (size_t)layer * WT_LAYER + WT_OUT + (size_t)(col0 + r32) * DM + wid * 256 + hi * 8;
    f32x16 d;
#pragma unroll
    for (int r = 0; r < 16; ++r) d[r] = 0.f;
#pragma unroll
    for (int ks = 0; ks < 16; ++ks) {
        const bf16x8 a = *(const bf16x8*)(X + ks * 16), b = *(const bf16x8*)(W + ks * 16);
        d = __builtin_amdgcn_mfma_f32_32x32x16_bf16(a, b, d, 0, 0, 0);
    }
    float* part = (float*)lds;
#pragma unroll
    for (int r = 0; r < 16; ++r) part[(wid * 32 + crow(r, hi)) * 32 + r32] = d[r];
    __syncthreads();
    {
        const int row = tid >> 4, c2 = (tid & 15) * 2;
        float s0 = 0.f, s1 = 0.f;
#pragma unroll
        for (int w = 0; w < 8; ++w) { const f32x2 t = *(const f32x2*)(part + (w * 32 + row) * 32 + c2); s0 += t[0]; s1 += t[1]; }
        const size_t o = (size_t)(row0 + row) * DM + col0 + c2;
        const unsigned h = *(const unsigned*)((const bf16_t*)(p->ws + WS_HB) + o);
        *(unsigned*)((bf16_t*)(p->ws + WS_S1) + o) = cvtpk(DN_ALPHA * bflo(h) + s0, DN_ALPHA * bfhi(h) + s1);
    }
    __syncthreads();
}

constexpr float YQ_SCALE = 8.f;
struct EpiScaleStoreQ8 {
    unsigned char* lds; unsigned char* O; int orow0; int nrows; int oc0; int goff;
    float gpre[4];
    __device__ __forceinline__ void pre(int wr, int r32) {
#pragma unroll
        for (int mi = 0; mi < 4; ++mi) gpre[mi] = (goff >= 0 ? *(const float*)(lds + goff + ((2 * mi + wr) * 32 + r32) * 4) : 1.f) * YQ_SCALE;
    }
    __device__ __forceinline__ void pin() {}
    __device__ __forceinline__ void operator()(const f32x16 (&acc)[2][4], int wr, int wc, int r32, int hi, int = 0) const {
#pragma unroll
        for (int mi = 0; mi < 4; ++mi)
#pragma unroll
            for (int ni = 0; ni < 2; ++ni) {
                const f32x16& a = acc[ni][mi]; const float sc = gpre[mi];
                u32x4 w; w.x = pk4_fp8(a[0] * sc, a[1] * sc, a[2] * sc, a[3] * sc); w.y = pk4_fp8(a[4] * sc, a[5] * sc, a[6] * sc, a[7] * sc);
                w.z = pk4_fp8(a[8] * sc, a[9] * sc, a[10] * sc, a[11] * sc); w.w = pk4_fp8(a[12] * sc, a[13] * sc, a[14] * sc, a[15] * sc);
                *(u32x4*)(lds + ((2 * mi + wr) * 32 + r32) * 272 + ni * 128 + wc * 32 + 16 * hi) = w;
            }
        __syncthreads();
        const int tid = tid_here();
#pragma unroll 4
        for (int i = 0; i < 8; ++i) {
            const int c = i * 512 + tid, row = c >> 4, ch = c & 15;
            if (row < nrows) *(u32x4*)(O + (size_t)(orow0 + row) * DM + oc0 + ch * 16) = *(const u32x4*)(lds + row * 272 + ch * 16);
        }
    }
};
struct EpiScaleStoreS {
    unsigned char* lds; bf16_t* O; int orow0; int nrows; int oc0; const float* gate;
    float gpre[4];
    __device__ __forceinline__ void pre(int wr, int r32) {
#pragma unroll
        for (int mi = 0; mi < 4; ++mi) gpre[mi] = gate ? gate[(2 * mi + wr) * 32 + r32] : 1.f;
    }
    __device__ __forceinline__ void pin() {}
    __device__ __forceinline__ void operator()(const f32x16 (&acc)[2][4], int wr, int wc, int r32, int hi, int = 0) const {
#pragma unroll
        for (int mi = 0; mi < 4; ++mi)
#pragma unroll
            for (int ni = 0; ni < 2; ++ni) stage_put(lds, acc[ni][mi], gpre[mi], (2 * mi + wr) * 32 + r32, ni * 128 + wc * 32 + 16 * hi);
        __syncthreads();
        const int tid = tid_here();
#pragma unroll 4
        for (int i = 0; i < 16; ++i) {
            const int c = i * 512 + tid, row = c >> 5, ch = c & 31;
            if (row < nrows) *(u32x4*)(O + (size_t)(orow0 + row) * DM + oc0 + ch * 8) = *(const u32x4*)(lds + row * ST_ROWB + ch * 16);
        }
    }
};

#define GEMMQ_DISPATCH(nv, g, ep) do { if ((nv) > 128) gemm_tile_q<1, 4>(lds, g, ep); else if ((nv) > 64) gemm_tile_q<1, 2>(lds, g, ep); else gemm_tile_q<1, 1>(lds, g, ep); } while (0)
#ifndef G2_NPASS
#define G2_NPASS 1
#endif
template <int NMI> struct EpiSwigluQ {
    unsigned char* O; int orow0; int nrows; int oc;
    __device__ __forceinline__ void pre(int, int) {}
    __device__ __forceinline__ void pin() {}
    __device__ __forceinline__ void operator()(const f32x16 (&acc)[2][NMI], int wr, int wc, int r32, int hi, int = 0) const {
#pragma unroll
        for (int mi = 0; mi < NMI; ++mi) {
            const int tr = (2 * mi + wr) * 32 + r32;
            if (tr < nrows) {
                float v[16];
#pragma unroll
                for (int r = 0; r < 16; ++r) { const float gte = acc[0][mi][r]; v[r] = gte / (1.f + __expf(-gte)) * acc[1][mi][r]; }
                u32x4 w; w.x = pk4_fp8(v[0], v[1], v[2], v[3]); w.y = pk4_fp8(v[4], v[5], v[6], v[7]); w.z = pk4_fp8(v[8], v[9], v[10], v[11]); w.w = pk4_fp8(v[12], v[13], v[14], v[15]);
                *(u32x4*)(O + (size_t)(orow0 + tr) * DEXP + oc + wc * 32 + 16 * hi) = w;
            }
        }
    }
};
__device__ __forceinline__ void moeq_gemm1_item(unsigned char* lds_in, PP p, int layer, int id) {
    unsigned char* lds = lds_here(lds_in);
    int e, nt, m; moe_decode(lds, id, 4, e, nt, m);
    const int* c = (const int*)(lds + MS_CNT); const int* o = (const int*)(lds + MS_OFF);
    const int cnt = __builtin_amdgcn_readfirstlane(c[e]), nvalid = (cnt - m * TMB) < TMB ? (cnt - m * TMB) : TMB;
    const int oe = __builtin_amdgcn_readfirstlane(o[e]);
    int* rows = (int*)(lds + BF_ROWS);
    { const int t_ = tid_here();
      if (t_ < TMB) { const int slot = m * TMB + (t_ < nvalid ? t_ : nvalid - 1); rows[t_] = ((const int*)(p->ws + WS_TOKL))[(size_t)e * TALL + slot]; } }
    __syncthreads();
    GemmOpQ g{p->ws + WS_H1Q, DM, p->ws + WS_W13Q + layer * W13Q_LAYER + (size_t)e * 1024 * DM, DM, nt * 128, 512 + nt * 128, DM, 0, nvalid};
    EpiSwigluQ<4> ep{p->ws + WS_ACTQ, oe + m * TMB, nvalid, nt * 128};
    GEMMQ_DISPATCH(nvalid, g, ep);
}
__device__ __forceinline__ void moeq_gemm2_item(unsigned char* lds_in, PP p, int layer, int id) {
    unsigned char* lds = lds_here(lds_in);
    int e, nt, m; moe_decode(lds, id, 8 / G2_NPASS, e, nt, m); nt *= G2_NPASS;
    const int* c = (const int*)(lds + MS_CNT); const int* o = (const int*)(lds + MS_OFF);
    const int cnt = __builtin_amdgcn_readfirstlane(c[e]), nvalid = (cnt - m * TMB) < TMB ? (cnt - m * TMB) : TMB;
    const int pos0 = __builtin_amdgcn_readfirstlane(o[e]) + m * TMB;
    int* rows = (int*)(lds + BF_ROWS);
    { const int t_ = tid_here(); if (t_ < TMB) { const int s_ = t_ < nvalid ? t_ : nvalid - 1; rows[t_] = pos0 + s_;
        ((float*)(lds + BF_ROWS + 1024))[t_] = ((const float*)(p->ws + WS_GATEL))[(size_t)e * TALL + m * TMB + s_]; } }
    __syncthreads();
    GemmOpQ g{p->ws + WS_ACTQ, DEXP, p->ws + WS_W2Q + layer * W2Q_LAYER + (size_t)e * DM * DEXP, DEXP, nt * 256, nt * 256 + 128, DEXP, 256, nvalid};
    EpiScaleStoreQ8 ep{lds, p->ws + WS_Y, pos0, nvalid, nt * 256, BF_ROWS + 1024, {}};
    GEMMQ_DISPATCH(nvalid, g, ep);
}
constexpr int XB_N13 = NEXP * 16 * 8, XB_N2 = NEXP * 4 * 16, XB_TOTAL = XB_N13 + XB_N2;
constexpr int XB_LDS = 0, XB_IDW = 128 * 132;
struct XBlock { const float* src; int ldsrc; unsigned char* dst; int K; };
__device__ __forceinline__ XBlock xblock_of(PP p, int layer, int id) {
    XBlock x;
    if (id < XB_N13) { const int e = id >> 7, r = id & 127, kb = r >> 3, nb = r & 7;
        x.src = p->exp_w13 + ((size_t)layer * NEXP + e) * DM * 1024 + (size_t)(kb * 128) * 1024 + nb * 128; x.ldsrc = 1024;
        x.dst = p->ws + WS_W13Q + layer * W13Q_LAYER + (size_t)e * 1024 * DM + (size_t)(nb * 128) * DM + kb * 128; x.K = DM; }
    else { const int q = id - XB_N13, e = q >> 6, r = q & 63, kb = r >> 4, nb = r & 15;
        x.src = p->exp_w2 + ((size_t)layer * NEXP + e) * DEXP * DM + (size_t)(kb * 128) * DM + nb * 128; x.ldsrc = DM;
        x.dst = p->ws + WS_W2Q + layer * W2Q_LAYER + (size_t)e * DM * DEXP + (size_t)(nb * 128) * DEXP + kb * 128; x.K = DEXP; }
    return x;
}
#define XB_LOAD(V, X) do { _Pragma("unroll") for (int u = 0; u < 2; ++u) { const int blk_ = u * 512 + tid, k4_ = blk_ >> 5, n4_ = blk_ & 31; \
        _Pragma("unroll") for (int j = 0; j < 4; ++j) V[u][j] = __builtin_nontemporal_load((const f32x4*)((X).src + (size_t)(k4_ * 4 + j) * (X).ldsrc + n4_ * 4)); } } while (0)
#define XB_STORE(V, X) do { \
        _Pragma("unroll") for (int u = 0; u < 2; ++u) { const int blk_ = u * 512 + tid, k4_ = blk_ >> 5, n4_ = blk_ & 31; \
            _Pragma("unroll") for (int i = 0; i < 4; ++i) *(unsigned*)(lds + XB_LDS + (n4_ * 4 + i) * 132 + k4_ * 4) = pk4_fp8(V[u][0][i] * 64.f, V[u][1][i] * 64.f, V[u][2][i] * 64.f, V[u][3][i] * 64.f); } \
        __syncthreads(); \
        { const int n_ = tid >> 2, seg_ = tid & 3; const unsigned* r_ = (const unsigned*)(lds + XB_LDS + n_ * 132 + seg_ * 32); \
          u32x4 w0_, w1_; w0_.x = r_[0]; w0_.y = r_[1]; w0_.z = r_[2]; w0_.w = r_[3]; w1_.x = r_[4]; w1_.y = r_[5]; w1_.z = r_[6]; w1_.w = r_[7]; \
          unsigned char* d_ = (X).dst + (size_t)n_ * (X).K + seg_ * 32; *(u32x4*)d_ = w0_; *(u32x4*)(d_ + 16) = w1_; } \
        __syncthreads(); } while (0)
constexpr int XB_CHUNK = 4;
__device__ __forceinline__ int xb_grab(unsigned char* lds, unsigned* qword, int tid) {
    volatile int* w = (volatile int*)(lds + XB_IDW);
    if (tid == 0) *w = (int)__hip_atomic_fetch_add(qword, (unsigned)XB_CHUNK, __ATOMIC_RELAXED, __HIP_MEMORY_SCOPE_AGENT);
    __syncthreads();
    return __builtin_amdgcn_readfirstlane(*w);
}
__device__ __forceinline__ void convert_experts_queue(unsigned char* lds_in, PP p, int layer) {
    unsigned char* lds = lds_here(lds_in);
    const int tid = tid_here();
    unsigned* qword = (unsigned*)(p->ws + WS_CTL + CTL_CNT) + CNT_QWORD + 64 * layer;
    static_assert(XB_TOTAL % XB_CHUNK == 0, "whole chunks");
    int cur = xb_grab(lds, qword, tid);
    if (cur < XB_TOTAL) {
        f32x4 va[2][4], vb[2][4];
        XBlock xa = xblock_of(p, layer, cur), xb_;
        XB_LOAD(va, xa);
        for (;;) {
            int nxt_reg = 0;
            if (tid == 0) nxt_reg = (int)__hip_atomic_fetch_add(qword, (unsigned)XB_CHUNK, __ATOMIC_RELAXED, __HIP_MEMORY_SCOPE_AGENT);
            xb_ = xblock_of(p, layer, cur + 1); XB_LOAD(vb, xb_);
            XB_STORE(va, xa);
            xa = xblock_of(p, layer, cur + 2); XB_LOAD(va, xa);
            XB_STORE(vb, xb_);
            xb_ = xblock_of(p, layer, cur + 3); XB_LOAD(vb, xb_);
            XB_STORE(va, xa);
            volatile int* w = (volatile int*)(lds + XB_IDW);
            if (tid == 0) *w = nxt_reg;
            __syncthreads();
            const int nxt = __builtin_amdgcn_readfirstlane(*w);
            const bool more = nxt < XB_TOTAL;
            if (more) { xa = xblock_of(p, layer, nxt); XB_LOAD(va, xa); }
            XB_STORE(vb, xb_);
            if (!more) break;
            cur = nxt;
        }
    }
    __syncthreads();
}

__device__ __forceinline__ void shared_gemm1_item(unsigned char* lds_in, PP p, int layer, int id, int M) {
    unsigned char* lds = lds_here(lds_in);
    const int mt = id >> 2, nt = id & 3, tid = tid_here();
    int* rows = (int*)(lds + BF_ROWS);
    if (tid < TMB) { const int r = mt * TMB + tid; rows[tid] = r < M ? r : M - 1; }
    __syncthreads();
    GemmOpQ g{p->ws + WS_H1Q, DM, p->ws + WS_SHQ + (size_t)layer * SHQ_LAYER, DM, nt * 128, 512 + nt * 128, DM, 0, M - mt * TMB};
    EpiSwigluQ<4> ep{p->ws + WS_ACTQ, SH_BASE + mt * TMB, M - mt * TMB, nt * 128};
    gemm_tile_q<1, 4>(lds, g, ep);
}
__device__ __forceinline__ void shared_gemm2_item(unsigned char* lds_in, PP p, int layer, int id, int M) {
    unsigned char* lds = lds_here(lds_in);
    const int mt = id / (8 / G2_NPASS), nt = (id % (8 / G2_NPASS)) * G2_NPASS, tid = tid_here();
    int* rows = (int*)(lds + BF_ROWS);
    if (tid < TMB) { const int r = mt * TMB + tid; rows[tid] = SH_BASE + (r < M ? r : M - 1); }
    __syncthreads();
    GemmOpQ g{p->ws + WS_ACTQ, DEXP, p->ws + WS_SHQ + (size_t)layer * SHQ_LAYER + (size_t)1024 * DM, DEXP, nt * 256, nt * 256 + 128, DEXP, 256, M - mt * TMB};
    EpiScaleStoreQ8 ep{lds, p->ws + WS_Y, SH_BASE + mt * TMB, M - mt * TMB, nt * 256, -1, {}};
    gemm_tile_q<1, 4>(lds, g, ep);
}
__device__ __forceinline__ void convert_shared_q(unsigned char* lds_in, PP p, int bx, int G) {
    unsigned char* lds = lds_here(lds_in);
    const int tid = tid_here();
    constexpr int NB13 = 16 * 8, NB2 = 4 * 16;
    for (int id = bx; id < DEPTH * (NB13 + NB2); id += G) {
        const int layer = id / (NB13 + NB2), r = id % (NB13 + NB2);
        XBlock x;
        if (r < NB13) { const int kb = r >> 3, nb = r & 7; x.src = p->sh_w13 + (size_t)layer * DM * 1024 + (size_t)(kb * 128) * 1024 + nb * 128; x.ldsrc = 1024;
            x.dst = p->ws + WS_SHQ + (size_t)layer * SHQ_LAYER + (size_t)(nb * 128) * DM + kb * 128; x.K = DM; }
        else { const int q = r - NB13, kb = q >> 4, nb = q & 15; x.src = p->sh_w2 + (size_t)layer * DEXP * DM + (size_t)(kb * 128) * DM + nb * 128; x.ldsrc = DM;
            x.dst = p->ws + WS_SHQ + (size_t)layer * SHQ_LAYER + (size_t)1024 * DM + (size_t)(nb * 128) * DEXP + kb * 128; x.K = DEXP; }
        f32x4 va[2][4];
        XB_LOAD(va, x); XB_STORE(va, x);
    }
}

constexpr int TM2 = 128;
__device__ __forceinline__ void moeq_gemm2r_item(unsigned char* lds_in, PP p, int layer, int id, int nsh, int M) {
    unsigned char* lds = lds_here(lds_in);
    int* rows = (int*)(lds + R_ROWS);
    const int t_ = tid_here();
    Gemm2Op g;
    g.Y = (bf16_t*)(p->ws + WS_Y); g.X = p->ws + WS_ACTQ; g.dump = (bf16_t*)(p->ws + WS_DUMP);
    if (id < nsh) {
        const int r0 = id * TM2, nv = (M - r0) < TM2 ? (M - r0) : TM2;
        if (t_ < TM2) rows[t_] = SH_BASE + r0 + (t_ < nv ? t_ : nv - 1);
        g.Wt = p->ws + WS_SHQ + (size_t)layer * SHQ_LAYER + (size_t)1024 * DM; g.gate = nullptr; g.yrow0 = SH_BASE + r0; g.nrows = nv;
    } else {
        int e, nt, m; moe_decode(lds, id - nsh, 1, e, nt, m);
        const int* c = (const int*)(lds + MS_CNT); const int* o = (const int*)(lds + MS_OFF);
        const int cnt = __builtin_amdgcn_readfirstlane(c[e]), nv = (cnt - m * TM2) < TM2 ? (cnt - m * TM2) : TM2;
        const int pos0 = __builtin_amdgcn_readfirstlane(o[e]) + m * TM2;
        if (t_ < TM2) rows[t_] = pos0 + (t_ < nv ? t_ : nv - 1);
        g.Wt = p->ws + WS_W2Q + layer * W2Q_LAYER + (size_t)e * DM * DEXP; g.gate = (const float*)(p->ws + WS_GATEL) + (size_t)e * TALL + m * TM2; g.yrow0 = pos0; g.nrows = nv;
    }
    __syncthreads();
    gemm2_resident(lds, g);
}

__device__ __forceinline__ void phase_combine(unsigned char* lds, PP p, int layer, int M, int bx, int G) {
    const int tid = tid_here(), lane = tid & 63, gw = bx * 8 + (tid >> 6), nw = G * 8;
    const int* o = (const int*)(lds + MS_OFF);
    const bf16_t* H1 = (const bf16_t*)(p->ws + WS_H1); const unsigned char* Y = p->ws + WS_Y;
    const int* asg_e = (const int*)(p->ws + WS_ASGE); const int* asg_s = (const int*)(p->ws + WS_ASGS);
    bf16_t* hb = (bf16_t*)(p->ws + WS_HB);
    for (int row = gw; row < M; row += nw) {
        typedef int i32x4 __attribute__((ext_vector_type(4)));
        const i32x4 e0 = *(const i32x4*)(asg_e + row * 8), e1 = *(const i32x4*)(asg_e + row * 8 + 4);
        const i32x4 s0 = *(const i32x4*)(asg_s + row * 8), s1 = *(const i32x4*)(asg_s + row * 8 + 4);
        u32x4 hraw[4];
#pragma unroll
        for (int i = 0; i < 4; ++i) hraw[i] = *(const u32x4*)(H1 + (size_t)row * DM + i * 512 + lane * 8);
        int pos[9];
#pragma unroll
        for (int k = 0; k < 4; ++k) { pos[k] = o[e0[k]] + s0[k]; pos[4 + k] = o[e1[k]] + s1[k]; }
        pos[8] = SH_BASE + row;
        float v[32];
        {
            constexpr float YI = 1.f / YQ_SCALE;
            u32x2 ya[5][4];
#pragma unroll
            for (int k = 0; k < 5; ++k)
#pragma unroll
                for (int i = 0; i < 4; ++i) ya[k][i] = *(const u32x2*)(Y + (size_t)pos[k] * DM + i * 512 + lane * 8);
#pragma unroll
            for (int i = 0; i < 4; ++i) {
                v[i * 8 + 0] = DN_ALPHA * bflo(hraw[i].x); v[i * 8 + 1] = DN_ALPHA * bfhi(hraw[i].x); v[i * 8 + 2] = DN_ALPHA * bflo(hraw[i].y); v[i * 8 + 3] = DN_ALPHA * bfhi(hraw[i].y);
                v[i * 8 + 4] = DN_ALPHA * bflo(hraw[i].z); v[i * 8 + 5] = DN_ALPHA * bfhi(hraw[i].z); v[i * 8 + 6] = DN_ALPHA * bflo(hraw[i].w); v[i * 8 + 7] = DN_ALPHA * bfhi(hraw[i].w);
            }
            asm volatile("" ::: "memory");
            u32x2 yb[4][4];
#pragma unroll
            for (int k = 0; k < 4; ++k)
#pragma unroll
                for (int i = 0; i < 4; ++i) yb[k][i] = *(const u32x2*)(Y + (size_t)pos[5 + k] * DM + i * 512 + lane * 8);
#define Y_ACC(YV) do { const f32x2 a = __builtin_amdgcn_cvt_pk_f32_fp8((int)(YV).x, false), b = __builtin_amdgcn_cvt_pk_f32_fp8((int)(YV).x, true); \
                    const f32x2 c = __builtin_amdgcn_cvt_pk_f32_fp8((int)(YV).y, false), d = __builtin_amdgcn_cvt_pk_f32_fp8((int)(YV).y, true); \
                    v[i * 8 + 0] += a[0] * YI; v[i * 8 + 1] += a[1] * YI; v[i * 8 + 2] += b[0] * YI; v[i * 8 + 3] += b[1] * YI; \
                    v[i * 8 + 4] += c[0] * YI; v[i * 8 + 5] += c[1] * YI; v[i * 8 + 6] += d[0] * YI; v[i * 8 + 7] += d[1] * YI; } while (0)
#pragma unroll
            for (int k = 0; k < 5; ++k)
#pragma unroll
                for (int i = 0; i < 4; ++i) Y_ACC(ya[k][i]);
#pragma unroll
            for (int k = 0; k < 4; ++k)
#pragma unroll
                for (int i = 0; i < 4; ++i) Y_ACC(yb[k][i]);
#undef Y_ACC
        }
        ln_row32(v, p->ln2_g + layer * DM, p->ln2_b + layer * DM, lane);
        if (layer == DEPTH - 1) {
#pragma unroll
            for (int i = 0; i < 4; ++i) {
                float* dst = p->out + (size_t)row * DM + i * 512 + lane * 8;
                *(f32x4*)dst = (f32x4){v[i * 8], v[i * 8 + 1], v[i * 8 + 2], v[i * 8 + 3]};
                *(f32x4*)(dst + 4) = (f32x4){v[i * 8 + 4], v[i * 8 + 5], v[i * 8 + 6], v[i * 8 + 7]};
            }
        } else {
            store_row32_bf16(hb + (size_t)row * DM, lane, v);
            row_gates(lds, p, layer + 1, row, lane, v);
        }
    }
}

#define XB_TMO      128
#define XB_XCNT(j)  (256  + 64 * (j))
#define XB_XSUB(j)  (1280 + 64 * (j))
#define XB_XGEN(j)  (2304 + 64 * (j))
#define XB_TOP      3328
#define XB_TOPGEN   3392
#define XCD_BAR_WORDS 3456
#define XB_SPIN_CAP (1u << 18)

__device__ __forceinline__ unsigned xb_ld(unsigned* p)              { return __hip_atomic_load(p, __ATOMIC_RELAXED, __HIP_MEMORY_SCOPE_AGENT); }
__device__ __forceinline__ unsigned xb_add(unsigned* p, unsigned v) { return __hip_atomic_fetch_add(p, v, __ATOMIC_RELAXED, __HIP_MEMORY_SCOPE_AGENT); }
__device__ __forceinline__ unsigned xb_xcc_id() { return (unsigned)__builtin_amdgcn_s_getreg((3 << 11) | 20) & 0xFu; }
#define XB_SPIN(cond, bar) do { unsigned _sp = 0; while (cond) { __builtin_amdgcn_s_sleep(1); \
    if ((++_sp & 255u) == 0u) { if (xb_ld(&(bar)[XB_TMO])) break; if (_sp > XB_SPIN_CAP) { atomicAdd(&(bar)[XB_TMO], 1u); break; } } } } while (0)

struct XcdBarrier { unsigned* bar; unsigned x; volatile LAS unsigned* st; };

__device__ __forceinline__ XcdBarrier xcd_barrier_post(unsigned* bar, volatile LAS unsigned* st) {
    XcdBarrier b; b.bar = bar; b.x = xb_xcc_id(); b.st = st;
    if (threadIdx.x == 0) (void)xb_add(&bar[XB_XCNT(b.x)], 1u);
    return b;
}
__device__ __forceinline__ void xcd_barrier_complete(unsigned* bar, unsigned x, unsigned& nloc, unsigned& nx) {
    const unsigned G = gridDim.x * gridDim.y * gridDim.z;
    unsigned sum, cnt, mine, sp = 0u;
    for (;;) {
        sum = 0u; cnt = 0u; mine = 0u;
#pragma unroll
        for (unsigned j = 0; j < 16; ++j) { const unsigned c = xb_ld(&bar[XB_XCNT(j)]); sum += c; cnt += (c > 0u) ? 1u : 0u; mine = (j == x) ? c : mine; }
        if (sum == G) break;
        __builtin_amdgcn_s_sleep(1);
        if ((++sp & 255u) == 0u) { if (xb_ld(&bar[XB_TMO])) break; if (sp > XB_SPIN_CAP) { atomicAdd(&bar[XB_TMO], 1u); break; } }
    }
    nloc = mine > 0u ? mine : 1u; nx = cnt > 0u ? cnt : 1u;
}
__device__ __forceinline__ void xcd_barrier(const XcdBarrier& b) {
    asm volatile("s_waitcnt vmcnt(0)" ::: "memory");
    __syncthreads();
    if (threadIdx.x == 0) {
        unsigned* bar = b.bar;
        __builtin_amdgcn_s_waitcnt(0);
        unsigned nloc = b.st[0], nx = b.st[1];
        if (nloc == 0u) { xcd_barrier_complete(bar, b.x, nloc, nx); b.st[0] = nloc; b.st[1] = nx; }
        const unsigned old = xb_add(&bar[XB_XSUB(b.x)], 1u);
        const unsigned gen = old / nloc;
        if (old + 1u == (gen + 1u) * nloc) {
            __builtin_amdgcn_fence(__ATOMIC_RELEASE, "agent");
            asm volatile("s_waitcnt vmcnt(0)" ::: "memory");
            const unsigned og = xb_add(&bar[XB_TOP], 1u);
            const unsigned tg = og / nx;
            if (og + 1u == (tg + 1u) * nx) xb_add(&bar[XB_TOPGEN], 1u);
            else XB_SPIN(xb_ld(&bar[XB_TOPGEN]) == tg, bar);
            __builtin_amdgcn_fence(__ATOMIC_ACQUIRE, "agent");
            xb_add(&bar[XB_XGEN(b.x)], 1u);
            asm volatile("s_waitcnt vmcnt(0)" ::: "memory");
        } else {
            XB_SPIN(xb_ld(&bar[XB_XGEN(b.x)]) == gen, bar);
            __builtin_amdgcn_fence(__ATOMIC_ACQUIRE, "agent");
            asm volatile("s_waitcnt vmcnt(0)" ::: "memory");
        }
    }
    __syncthreads();
}

constexpr int NPHASES = 1 + 8 * DEPTH;
constexpr int XBW_OFF = LDS_BYTES - 16;

__global__ void __launch_bounds__(NTHREADS, 2) fwd_kernel(Params p_by_value) {
    extern __shared__ __attribute__((aligned(16))) unsigned char lds0[];
    const int tid0 = threadIdx.x, G0 = gridDim.x, bx0 = blockIdx.x;
    const int vcu0 = (G0 % 8 == 0) ? (bx0 % 8) * (G0 / 8) + bx0 / 8 : bx0;
    PP p = get_params();
    const int lo = p->ph_lo, hi = p->ph_hi;
    if (tid0 == 0) *(uint4*)(lds0 + XBW_OFF) = make_uint4(0u, 0u, 0u, 0u);
    __syncthreads();
    XcdBarrier bar; bar.bar = (unsigned*)(p->ws + WS_CTL); bar.x = 0; bar.st = (volatile LAS unsigned*)(LAS unsigned char*)(lds0 + XBW_OFF);
    if (hi - lo > 1) bar = xcd_barrier_post((unsigned*)(p->ws + WS_CTL), (volatile LAS unsigned*)(LAS unsigned char*)(lds0 + XBW_OFF));
#ifndef PHMASK
#define PHMASK 0x1FF
#endif
#define IN(k) (lo <= (k) && (k) < hi)
#define PHASE_IDS() unsigned char* lds = lds_here(lds0); const int G = sgpr_here(G0), bx = sgpr_here(bx0), vcu = sgpr_here(vcu0), tid = tid_here(); (void)G; (void)bx; (void)vcu; (void)tid
#define EN(b) (((PHMASK) >> (b)) & 1)
#ifndef REPMASK
#define REPMASK 0
#endif
#ifndef REPLAYER
#define REPLAYER -1
#endif
#define REPEAT(k) for (int rep_ = 0; rep_ <= ((((REPMASK) >> (k)) & 1) && (REPLAYER < 0 || layer == REPLAYER) ? 1 : 0); ++rep_)
#define REPBAR() do { if (rep_) xcd_barrier(bar); } while (0)
#ifndef MXMASK
#define MXMASK 0x3F
#endif
#define MXEN(b) (((MXMASK) >> (b)) & 1)
#ifndef MXDUP
#define MXDUP -1
#endif
#ifdef DBG_PHN
#define PH_T0 ((volatile unsigned long long*)(lds0 + LDS_BYTES - 32))
#define PH_BEGIN(k) do { if ((k) == DBG_PHN && layer == DBG_PHL && tid_here() == 0) *PH_T0 = __builtin_amdgcn_s_memtime(); } while (0)
#define PH_MID(k) do { if ((k) == DBG_PHN && layer == DBG_PHL && tid_here() == 0) { const unsigned long long t_ = __builtin_amdgcn_s_memtime() - *PH_T0; atomicAdd(&dbg_acc[0], t_); atomicAdd(&dbg_acc[3], 1ull); atomicMax(&dbg_acc[2], t_); atomicMax(&dbg_acc[4], 1000000000ull - t_); } } while (0)
#define PH_END(k) do { if ((k) == DBG_PHN && layer == DBG_PHL && tid_here() == 0 && blockIdx.x == 0) dbg_acc[1] = __builtin_amdgcn_s_memtime() - *PH_T0; } while (0)
#elif defined(SPIN_PHN)
#define PH_T0 ((volatile unsigned long long*)(lds0 + LDS_BYTES - 32))
#define PH_BEGIN(k) do { if ((k) == SPIN_PHN && layer == SPIN_PHL && blockIdx.x == 0 && tid_here() == 0) *PH_T0 = __builtin_amdgcn_s_memtime(); } while (0)
#define PH_MID(k)
#define PH_END(k) do { if ((k) == SPIN_PHN && layer == SPIN_PHL && blockIdx.x == 0) { __syncthreads(); const unsigned long long t1_ = __builtin_amdgcn_s_memtime(), T_ = t1_ - *PH_T0; \
        while (__builtin_amdgcn_s_memtime() < t1_ + (unsigned long long)(SPIN_K) * T_) __builtin_amdgcn_s_sleep(8); __syncthreads(); } } while (0)
#else
#define PH_BEGIN(k)
#define PH_MID(k)
#define PH_END(k)
#endif
#define SEAM(k) do { if (IN((k) + 1)) xcd_barrier(bar); } while (0)
#ifdef DBG_P2MIX
#define PH_MIDS(n) do { if ((n) != 2) PH_MID(n); } while (0)
#else
#define PH_MIDS(n) PH_MID(n)
#endif
#define SEAMN(n) do { PH_MIDS(n); if (IN(pb + (n) + 1)) xcd_barrier(bar); PH_END(n); } while (0)

#if defined(SPIN_PHN) && SPIN_PHN >= 8
    if (blockIdx.x == 0 && tid_here() == 0) *PH_T0 = __builtin_amdgcn_s_memtime();
#endif
    if (EN(8) && IN(0)) for (int rep0_ = 0; rep0_ <= (((REPMASK) >> 8) & 1); ++rep0_) { p = get_params(); PHASE_IDS(); if (rep0_) xcd_barrier(bar); phase_ln_in(lds, p, bx, G); __syncthreads(); phase_convert(lds, p, bx, G); __syncthreads(); convert_shared_q(lds, p, bx, G); router_preformat(p, bx, G); if (rep0_ == (((REPMASK) >> 8) & 1)) SEAM(0); }


#if defined(SPIN_PHN) && SPIN_PHN == 8
    if (blockIdx.x == 0) { __syncthreads(); const unsigned long long t1_ = __builtin_amdgcn_s_memtime(), T_ = t1_ - *PH_T0;
        while (__builtin_amdgcn_s_memtime() < t1_ + (unsigned long long)(SPIN_K) * T_) __builtin_amdgcn_s_sleep(8); __syncthreads(); }
#endif
    for (int layer = 0; layer < DEPTH; ++layer) {
        const int pb = 1 + 8 * layer;
        const int M = (layer == DEPTH - 1) ? TREAL : TALL;
        if (EN(0) && IN(pb + 0)) REPEAT(0) { p = get_params(); PHASE_IDS(); REPBAR(); PH_BEGIN(0);
            int* rows = (int*)(lds + BF_ROWS);
            for (int id = vcu; id < 759; id += G) {
                int mt, nt;
#if defined(EXP_ORDER) && EXP_ORDER == 1
                mt = id % 33; nt = id / 33;
#elif defined(EXP_ORDER) && EXP_ORDER == 2
                nt = id % 23; mt = id / 23;
#elif defined(EXP_ORDER) && EXP_ORDER == 3
                if (id < 736) { const int grp = id / 92, r = id % 92; nt = r >> 2; mt = grp * 4 + (r & 3); } else { mt = 32; nt = id - 736; }
#else
                if (id < 736) { const int grp = id / 184, r = id % 184; nt = r >> 3; mt = grp * 8 + (r & 7); } else { mt = 32; nt = id - 736; }
#endif
#ifdef FUSE_CONV
                if (nt < 6) {
                    const int u0 = 253 * mt - 3;
                    if (tid < TMB) { int u = u0 + tid; u = u < 0 ? 0 : (u > NB * LSEQ - 1 ? NB * LSEQ - 1 : u); const int b_ = u / LSEQ; rows[tid] = row_of(b_, u - b_ * LSEQ); }
                    __syncthreads();
                    GemmOpBf g{(const bf16_t*)(p->ws + WS_HB), DM, (const bf16_t*)(p->ws + WS_WT) + (size_t)layer * WT_LAYER + WT_IN, DM, nt * 256, nt * 256 + 128, DM};
                    EpiConvS e{lds, (bf16_t*)(p->ws + WS_QKC), p->conv_qk + (size_t)layer * 4 * 1536, u0, nt * 256};
                    gemm_tile_bf(lds, g, e);
                    continue;
                }
#endif
                if (tid < TMB) { const int r = mt * TMB + tid; rows[tid] = r < TALL ? r : TALL - 1; }
                __syncthreads();
                GemmOpBf g{(const bf16_t*)(p->ws + WS_HB), DM, (const bf16_t*)(p->ws + WS_WT) + (size_t)layer * WT_LAYER + WT_IN, DM, nt * 256, nt * 256 + 128, DM};
                EpiStoreBf16S e{lds, (bf16_t*)(p->ws + WS_PROJ), PROJ_W, mt * TMB, TALL - mt * TMB, nt * 256};
                gemm_tile_bf(lds, g, e);
            }
            SEAMN(0);
        }
#ifndef FUSE_CONV
        if (EN(1) && IN(pb + 1)) REPEAT(1) { p = get_params(); PHASE_IDS(); REPBAR(); PH_BEGIN(1); phase_conv(p, layer, bx, G); SEAMN(1); }
#endif
        if (EN(2) && IN(pb + 2)) REPEAT(2) { p = get_params(); PHASE_IDS(); REPBAR(); PH_BEGIN(2);
#ifdef REP_P2_FULL
            if (rep_) { if (bx == 0 && tid == 0) __hip_atomic_store((unsigned*)(p->ws + WS_CTL + CTL_CNT) + CNT_QWORD + 64 * layer, 0u, __ATOMIC_RELAXED, __HIP_MEMORY_SCOPE_AGENT); xcd_barrier(bar); }
#endif
#if defined(USE_FP8_EXPERTS) && CONV_A_BUDGET > 0
            if ((bx >> 3) & 1) convert_experts_queue(lds, p, layer, CONV_A_BUDGET);
#endif
            int r = 0;
            for (int base = 0; base < 704; base += G, ++r) {
                const int id = base + ((r & 1) ? (G - 1 - bx) : bx);
                if (id < 704) {
#ifdef DBG_MIX
                    const unsigned long long tm0 = __builtin_amdgcn_s_memtime(); int ityp = 0;
#endif
                    if (id < 384) {
                        const int j = 7 - id / 48, rem = id % 48, mode = rem / 24, bh = rem % 24;
#ifdef DBG_MIX
                        ityp = (j == 7) ? (mode == 0 ? 1 : 2) : 0;
#endif
                        for (int dq_ = 0, dn_ = rdup_n((MXDUP == 0 && mode == 0) || (MXDUP == 1 && mode == 1) ? 2 : 1); dq_ < dn_; ++dq_)
                        if (MXEN(0) && mode == 0) mixer_item<0>(lds, p, layer, bh / 6, bh % 6, j); else if (MXEN(1)) mixer_item<1>(lds, p, layer, bh / 6, bh % 6, j);
                    } else if (id < 656) {
                        const int q = id - 384, g = q & 3, rb = q >> 2;
#ifdef DBG_MIX
                        ityp = 3;
#endif
                        for (int dq_ = 0, dn_ = rdup_n(MXDUP == 2 ? 2 : 1); dq_ < dn_; ++dq_)
                        if (MXEN(2)) pool_item(lds, p, layer, rb / 17, rb % 17, g);
                    } else {
                        const int q = id - 656, mode = q / 24, bh = q % 24;
#ifdef DBG_MIX
                        ityp = 4 + mode;
#endif
                        if (MXEN(3) && mode == 0) mixer_meta_item<0>(lds, p, layer, bh / 6, bh % 6); else if (MXEN(4)) mixer_meta_item<1>(lds, p, layer, bh / 6, bh % 6);
                    }
#ifdef DBG_MIX
                    if (tid == 0 && ityp == DBG_MIX) { atomicAdd(&dbg_acc[2], __builtin_amdgcn_s_memtime() - tm0); atomicAdd(&dbg_acc[3], 1ull); }
#endif
                }
            }
#ifdef DBG_P2MIX
            PH_MID(2);
#endif
#ifdef USE_FP8_EXPERTS
            convert_experts_queue(lds, p, layer);
#endif
            SEAMN(2);
        }
        if (EN(3) && IN(pb + 3)) REPEAT(3) { p = get_params(); PHASE_IDS(); REPBAR(); PH_BEGIN(3);
            int* rows = (int*)(lds + BF_ROWS);
            const int ntile = (TREAL / TMB) * 8;
            if (M > TREAL) for (int it = G - 1 - bx; it < 128; it += G) outproj_meta_item(lds, p, layer, it);
            for (int id = vcu; id < ntile; id += G) {
                const int mt = id >> 3, nt = id & 7;
                if (tid < TMB) { const int r = mt * TMB + tid; rows[tid] = r < M ? r : M - 1; }
                __syncthreads();
                GemmOpBf g{(const bf16_t*)(p->ws + WS_CAT), DM, (const bf16_t*)(p->ws + WS_WT) + (size_t)layer * WT_LAYER + WT_OUT, DM, nt * 256, nt * 256 + 128, DM};
                EpiResidS e{lds, (const bf16_t*)(p->ws + WS_HB), (bf16_t*)(p->ws + WS_S1), mt * TMB, M - mt * TMB, nt * 256};
                gemm_tile_bf(lds, g, e);
            }
#ifdef TAIL_CONVERT
            if (layer + 1 < DEPTH && vcu >= ntile - ((ntile - 1) / G) * G) convert_experts_queue(lds, p, layer + 1, TAILC_P3);
#endif
            SEAMN(3);
        }
        if (EN(4) && IN(pb + 4)) REPEAT(4) { p = get_params(); PHASE_IDS(); REPBAR(); PH_BEGIN(4);
#ifdef REP_P4_RESET
            if (rep_) { if (bx == 0 && tid < 64) ((int*)(p->ws + WS_CTL + CTL_CNT) + layer * CNT_LAYER)[tid * CNT_STRIDE] = 0; __threadfence(); xcd_barrier(bar); }
#endif
            const int nit = (M + 31) >> 5;
            for (int id = bx; id < nit; id += G) router_item(lds, p, layer, id, M);
#ifdef TAIL_CONVERT
            if (layer + 1 < DEPTH && bx >= nit - ((nit - 1) / G) * G) convert_experts_queue(lds, p, layer + 1, TAILC_P4);
#endif
            SEAMN(4);
        }
        if (EN(5) && IN(pb + 5)) REPEAT(5) { p = get_params(); PHASE_IDS(); REPBAR(); PH_BEGIN(5);
#ifdef USE_FP8_EXPERTS
            moe_tables(lds, p, layer, M, TMB);
            const int nsh = ((M + TMB - 1) / TMB) * 4, nit = nsh + ((const int*)(lds + MS_TP))[65] * 4;
#ifdef EXP_ROUND_SYNC
            for (int id = vcu, rnd = 0; rnd * G < nit; id += G, ++rnd) { if (id < nit) { if (id < nsh) shared_gemm1_item(lds, p, layer, id, M); else moeq_gemm1_item(lds, p, layer, id - nsh); } if ((rnd + 1) * G < nit) xcd_barrier(bar); }
#else
            for (int id = vcu; id < nit; id += G) { if (id < nsh) shared_gemm1_item(lds, p, layer, id, M); else moeq_gemm1_item(lds, p, layer, id - nsh); }
#endif
#if defined(TAIL_CONVERT) && TAILC_P5 > 0
            if (layer + 1 < DEPTH && vcu >= nit - ((nit - 1) / G) * G) convert_experts_queue(lds, p, layer + 1, TAILC_P5);
#endif
#else
            moe_tables(lds, p, layer, M);
            const int nsh = ((M + TMB - 1) / TMB) * 4, nit = nsh + ((const int*)(lds + MS_TP))[65] * 4;
            for (int id = vcu; id < nit; id += G) { if (id < nsh) shared_gemm1_item(lds, p, layer, id, M); else moe_gemm1_item(lds, p, layer, id - nsh); }
#endif
            SEAMN(5);
        }
        if (EN(6) && IN(pb + 6)) REPEAT(6) { p = get_params(); PHASE_IDS(); REPBAR(); PH_BEGIN(6);
#ifdef USE_FP8_EXPERTS
            moe_tables(lds, p, layer, M, TMB);
            const int nsh = ((M + TMB - 1) / TMB) * (8 / G2_NPASS), nit = nsh + ((const int*)(lds + MS_TP))[65] * (8 / G2_NPASS);
            for (int id = vcu; id < nit; id += G) { if (id < nsh) shared_gemm2_item(lds, p, layer, id, M); else moeq_gemm2_item(lds, p, layer, id - nsh); }
#if defined(TAIL_CONVERT) && TAILC_P6 > 0
            if (layer + 1 < DEPTH && vcu >= nit - ((nit - 1) / G) * G) convert_experts_queue(lds, p, layer + 1, TAILC_P6);
#endif
#else
            moe_tables(lds, p, layer, M);
            const int nsh = ((M + TMB - 1) / TMB) * 8, nit = nsh + ((const int*)(lds + MS_TP))[65] * 4;
            for (int id = vcu; id < nit; id += G) { if (id < nsh) shared_gemm2_item(lds, p, layer, id, M); else moe_gemm2_item(lds, p, layer, id - nsh); }
#endif
            SEAMN(6);
        }
        if (EN(7) && IN(pb + 7)) REPEAT(7) { p = get_params(); PHASE_IDS(); REPBAR(); PH_BEGIN(7);
            moe_tables(lds, p, layer, M);
            if (layer + 1 < DEPTH) stage_gate_weights(lds, p, layer + 1);
            phase_combine(lds, p, layer, M, bx, G);
            __syncthreads();
            SEAMN(7);
        }
    }
#if defined(SPIN_PHN) && SPIN_PHN == 9
    if (blockIdx.x == 0) { __syncthreads(); const unsigned long long t1_ = __builtin_amdgcn_s_memtime(), T_ = t1_ - *PH_T0;
        while (__builtin_amdgcn_s_memtime() < t1_ + (unsigned long long)(SPIN_K) * T_) __builtin_amdgcn_s_sleep(8); __syncthreads(); }
#endif
#ifdef SPIN_MIX
    {
        xcd_barrier(bar);
        if (blockIdx.x == 0) { const unsigned long long T_ = dbg_acc[2] / (dbg_acc[3] ? dbg_acc[3] : 1ull), t1_ = __builtin_amdgcn_s_memtime();
            while (__builtin_amdgcn_s_memtime() < t1_ + (unsigned long long)(SPIN_K) * T_) __builtin_amdgcn_s_sleep(8); }
    }
#endif
#ifdef DBG_ANY
    {
        xcd_barrier(bar);
        p = get_params();
        const float frac = DBG_SEL == 8 ? (float)((double)(1000000000ull - dbg_acc[4]) / DBG_UNIT) : DBG_SEL == 7 ? (float)((double)dbg_acc[2] / DBG_UNIT) : DBG_SEL == 6 ? (float)((double)dbg_acc[0] / (double)dbg_acc[3] / DBG_UNIT) : DBG_SEL == 5 ? (float)((double)dbg_acc[1] / DBG_UNIT) : DBG_SEL == 4 ? (float)((double)dbg_acc[2] / (double)dbg_acc[0] * 0.05) : DBG_SEL == 3 ? (float)((double)dbg_acc[2] / (double)dbg_acc[3] / DBG_UNIT) : (float)((double)dbg_acc[DBG_SEL] / (double)dbg_acc[2]);
        const float cdbg = sqrtf(floorf(frac * 10.f + 0.5f));
        for (size_t i = (size_t)blockIdx.x * NTHREADS + tid_here(); i < (size_t)TREAL * DM / 4; i += (size_t)gridDim.x * NTHREADS) ((f32x4*)p->out)[i] = (f32x4){cdbg, cdbg, cdbg, cdbg};
    }
#endif
#undef IN
#undef SEAM
}

#ifndef N_LAUNCH_MODE
#define N_LAUNCH_MODE 1
#endif
extern "C" void kernel_launch(void* const* d_in, const int* in_sizes, int n_in, void* d_out, int out_size, void* d_ws, size_t ws_size, hipStream_t stream) {
    static int grid = 0;
    if (grid == 0) {
        if (n_in != 23 || ws_size < WS_END) { fprintf(stderr, "kernel_launch: unexpected n_in %d or ws %zu < %zu\n", n_in, ws_size, (size_t)WS_END); grid = -1; return; }
        int dev = 0, cus = 0, per_cu = 0;
        if (hipGetDevice(&dev) != hipSuccess || hipDeviceGetAttribute(&cus, hipDeviceAttributeMultiprocessorCount, dev) != hipSuccess) { grid = -1; return; }
        if (hipFuncSetAttribute((const void*)fwd_kernel, hipFuncAttributeMaxDynamicSharedMemorySize, LDS_BYTES) != hipSuccess) { fprintf(stderr, "kernel_launch: hipFuncSetAttribute failed\n"); grid = -1; return; }
        if (hipOccupancyMaxActiveBlocksPerMultiprocessor(&per_cu, (const void*)fwd_kernel, NTHREADS, LDS_BYTES) != hipSuccess || per_cu < 1)
            fprintf(stderr, "kernel_launch: occupancy query reports %d blocks per CU\n", per_cu);
        (void)hipGetLastError();
        grid = cus;
    }
    if (grid < 0) return;
    if (hipMemsetAsync((char*)d_ws + WS_CTL, 0, CTL_BYTES, stream) != hipSuccess) return;
    Params p{};
    const float* const* in = (const float* const*)d_in;
    p.x = in[0]; p.meta = in[1]; p.ln_in_g = in[2]; p.ln_in_b = in[3]; p.w_in = in[4]; p.b_igate = in[5]; p.b_fgate = in[6]; p.conv_qk = in[7];
    p.ml_norm_g = in[8]; p.sb_norm_g = in[9]; p.pool_w = in[10]; p.pool_scale = in[11]; p.w_out = in[12]; p.ln1_g = in[13]; p.ln1_b = in[14];
    p.router_w = in[15]; p.router_bias = in[16]; p.exp_w13 = in[17]; p.exp_w2 = in[18]; p.sh_w13 = in[19]; p.sh_w2 = in[20]; p.ln2_g = in[21]; p.ln2_b = in[22];
    p.out = (float*)d_out; p.ws = (unsigned char*)d_ws;
#if N_LAUNCH_MODE == 1
    p.ph_lo = 0; p.ph_hi = NPHASES;
    hipLaunchKernelGGL(fwd_kernel, dim3(grid), dim3(NTHREADS), LDS_BYTES, stream, p);
#else
    for (int ph = 0; ph < NPHASES; ++ph) {
        p.ph_lo = ph; p.ph_hi = ph + 1;
        hipLaunchKernelGGL(fwd_kernel, dim3(grid), dim3(NTHREADS), LDS_BYTES, stream, p);
    }
#endif
    const hipError_t le = hipPeekAtLastError();
    if (le != hipSuccess) fprintf(stderr, "kernel_launch: launch failed: %s\n", hipGetErrorName(le));
}
```

```cpp
#define USE_FP8_EXPERTS 1
#define FUSE_CONV 1
#define Y_DIRECT 1
#ifndef CONV_A_BUDGET
#define CONV_A_BUDGET 0
#endif
#include <hip/hip_runtime.h>
#include <stdint.h>
#include <stdio.h>

constexpr int DM = 2048, NB = 4, SEQ = 2048, NMETA = 16, LSEQ = SEQ + NMETA, DEPTH = 2;
constexpr int TREAL = NB * SEQ;
constexpr int TALL = TREAL + NB * NMETA;
constexpr int HD = 128, NH = 6;
constexpr int N_IN = 5900;
constexpr int PROJ_W = 5888;
constexpr int PC_MLQK = 0, PC_MLV = 1536, PC_MLO = 2304, PC_SBQ = 3072, PC_SBK = 3840, PC_SBV = 4608, PC_POOL = 5376;
constexpr int NEXP = 64, TOPK = 8, DEXP = 512;
constexpr float ROUTED_SCALE = 2.5f;
constexpr float DN_ALPHA = 1.41421356237309515f;
constexpr float LN_EPS = 1e-5f, RMS_EPS = 1e-6f;
constexpr int SH_BASE = TALL * TOPK;
constexpr int PROWS = SH_BASE + TALL;

typedef unsigned short bf16_t;
typedef short bf16x8 __attribute__((ext_vector_type(8)));
typedef short s16x4 __attribute__((ext_vector_type(4)));
typedef float f32x16 __attribute__((ext_vector_type(16)));
typedef float f32x4 __attribute__((ext_vector_type(4)));
typedef float f32x2 __attribute__((ext_vector_type(2)));
typedef unsigned u32x4 __attribute__((ext_vector_type(4)));
typedef unsigned u32x2 __attribute__((ext_vector_type(2)));
#define LAS __attribute__((address_space(3)))

constexpr int NTHREADS = 512;
constexpr int LDS_BYTES = 160 * 1024;

__device__ __forceinline__ unsigned cvtpk(float lo, float hi) {
    unsigned r; asm volatile("v_cvt_pk_bf16_f32 %0, %1, %2" : "=v"(r) : "v"(lo), "v"(hi)); return r;
}
__device__ __forceinline__ float bf2f(bf16_t v) { return __uint_as_float(((unsigned)v) << 16); }
__device__ __forceinline__ float bflo(unsigned w) { return __uint_as_float(w << 16); }
__device__ __forceinline__ float bfhi(unsigned w) { return __uint_as_float(w & 0xffff0000u); }
__device__ __forceinline__ bf16_t f2bf(float f) { return (bf16_t)(cvtpk(f, 0.f) & 0xffffu); }
__device__ __forceinline__ unsigned pk4_fp8(float a, float b, float c, float d) { int w = __builtin_amdgcn_cvt_pk_fp8_f32(a, b, 0, false); w = __builtin_amdgcn_cvt_pk_fp8_f32(c, d, w, true); return (unsigned)w; }
__device__ __forceinline__ float fp8_round(float x, float s) { int w = __builtin_amdgcn_cvt_pk_fp8_f32(x * s, 0.f, 0, false); return __builtin_amdgcn_cvt_f32_fp8(w, 0) / s; }
__device__ __forceinline__ int crow(int r, int hi) { return (r & 3) + 8 * (r >> 2) + 4 * hi; }
template <int CTRL> __device__ __forceinline__ float dpp_mov(float v) {
    return __builtin_bit_cast(float, __builtin_amdgcn_update_dpp(0, __builtin_bit_cast(int, v), CTRL, 0xf, 0xf, true));
}
__device__ __forceinline__ float rdlane(float v, int l) { return __builtin_bit_cast(float, __builtin_amdgcn_readlane(__builtin_bit_cast(int, v), l)); }
__device__ __forceinline__ float wave_sum(float v) {
    v += dpp_mov<0xB1>(v); v += dpp_mov<0x4E>(v); v += dpp_mov<0x141>(v); v += dpp_mov<0x140>(v);
    return (rdlane(v, 0) + rdlane(v, 16)) + (rdlane(v, 32) + rdlane(v, 48));
}
__device__ __forceinline__ float wave_max(float v) {
    v = fmaxf(v, dpp_mov<0xB1>(v)); v = fmaxf(v, dpp_mov<0x4E>(v)); v = fmaxf(v, dpp_mov<0x141>(v)); v = fmaxf(v, dpp_mov<0x140>(v));
    return fmaxf(fmaxf(rdlane(v, 0), rdlane(v, 16)), fmaxf(rdlane(v, 32), rdlane(v, 48)));
}
template <int CTRL, int ROWMASK> __device__ __forceinline__ float dpp_shift(float ident, float v) {
    return __builtin_bit_cast(float, __builtin_amdgcn_update_dpp(__builtin_bit_cast(int, ident), __builtin_bit_cast(int, v), CTRL, ROWMASK, 0xf, false));
}
__device__ __forceinline__ float wave_scan_sum(float x) {
    x += dpp_shift<0x111, 0xf>(0.f, x); x += dpp_shift<0x112, 0xf>(0.f, x); x += dpp_shift<0x114, 0xf>(0.f, x); x += dpp_shift<0x118, 0xf>(0.f, x);
    x += dpp_shift<0x142, 0xa>(0.f, x); x += dpp_shift<0x143, 0xc>(0.f, x);
    return x;
}
__device__ __forceinline__ float wave_scan_max(float x) {
    constexpr float NI = -3.0e38f;
    x = fmaxf(x, dpp_shift<0x111, 0xf>(NI, x)); x = fmaxf(x, dpp_shift<0x112, 0xf>(NI, x)); x = fmaxf(x, dpp_shift<0x114, 0xf>(NI, x)); x = fmaxf(x, dpp_shift<0x118, 0xf>(NI, x));
    x = fmaxf(x, dpp_shift<0x142, 0xa>(NI, x)); x = fmaxf(x, dpp_shift<0x143, 0xc>(NI, x));
    return x;
}
__device__ __forceinline__ float sigmoidf_(float x) { return __builtin_amdgcn_rcpf(1.f + __expf(-x)); }
__device__ __forceinline__ float siluf_(float x) { return x * __builtin_amdgcn_rcpf(1.f + __expf(-x)); }
__device__ __forceinline__ float logsigmoidf_(float x) { return fminf(x, 0.f) - __logf(1.f + __expf(-fabsf(x))); }

#if defined(DBG_TIMING) || defined(DBG_TIMING_BF) || (defined(DBG_MIX) && !defined(SPIN_MIX)) || defined(DBG_TQ) || defined(DBG_PHN)
#define DBG_ANY 1
#endif
#if defined(DBG_ANY) || defined(SPIN_MIX)
__device__ unsigned long long dbg_acc[8];
#ifndef DBG_BLOCK
#define DBG_BLOCK 0
#endif
#ifndef DBG_WAVE
#define DBG_WAVE 0
#endif
#endif
__device__ __forceinline__ int tid_here() { int t = threadIdx.x; asm volatile("" : "+v"(t)); return t; }
__device__ __forceinline__ int sgpr_here(int x) { asm volatile("" : "+s"(x)); return x; }
__device__ __forceinline__ unsigned char* lds_here(unsigned char* l) { LAS unsigned char* q = (LAS unsigned char*)l; asm volatile("" : "+s"(q)); return (unsigned char*)q; }

__device__ __forceinline__ int row_of(int b, int l) { return l < NMETA ? TREAL + b * NMETA + l : b * SEQ + (l - NMETA); }

constexpr size_t al256(size_t x) { return (x + 255) / 256 * 256; }
constexpr size_t WS_CTL = 0;
constexpr size_t CTL_BYTES = 64 * 1024;
constexpr size_t CTL_CNT = 32 * 1024;
constexpr int CNT_STRIDE = 32, CNT_LAYER = 64 * CNT_STRIDE, CNT_QWORD = DEPTH * CNT_LAYER;
constexpr size_t WS_HB = al256(WS_CTL + CTL_BYTES);
constexpr size_t WS_PROJ = al256(WS_HB + (size_t)TALL * DM * 2);
constexpr size_t WS_GATES = al256(WS_PROJ + (size_t)TALL * PROJ_W * 2);
constexpr size_t WS_QKC = al256(WS_GATES + (size_t)TALL * 12 * 4);
constexpr size_t WS_CAT = al256(WS_QKC + (size_t)TALL * 1536 * 2);
constexpr size_t WS_S1 = al256(WS_CAT + (size_t)TALL * DM * 2);
constexpr size_t WS_H1 = al256(WS_S1 + (size_t)TALL * DM * 2);
constexpr size_t WS_ASGE = al256(WS_H1 + (size_t)TALL * DM * 2);
constexpr size_t WS_ASGS = al256(WS_ASGE + (size_t)TALL * 8 * 4);
constexpr size_t WS_TOKL = al256(WS_ASGS + (size_t)TALL * 8 * 4);
constexpr size_t WS_GATEL = al256(WS_TOKL + (size_t)NEXP * TALL * 4);
constexpr size_t WS_ACT = al256(WS_GATEL + (size_t)NEXP * TALL * 4);
constexpr size_t WS_Y = al256(WS_ACT + (size_t)PROWS * DEXP * 2);
constexpr size_t WT_IN = 0, WT_OUT = (size_t)PROJ_W * DM, WT_SH13 = WT_OUT + (size_t)DM * DM, WT_SH2 = WT_SH13 + (size_t)1024 * DM, WT_POOL = WT_SH2 + (size_t)DM * DEXP, WT_LAYER = WT_POOL + (size_t)4 * 128 * 128;
constexpr size_t WS_WT = al256(WS_Y + (size_t)PROWS * DM * 2);
constexpr size_t WS_W13Q = al256(WS_WT + (size_t)DEPTH * WT_LAYER * 2);
constexpr size_t W13Q_LAYER = (size_t)NEXP * 1024 * DM, W2Q_LAYER = (size_t)NEXP * DM * DEXP;
constexpr size_t WS_W2Q = al256(WS_W13Q + DEPTH * W13Q_LAYER);
constexpr size_t WS_H1Q = al256(WS_W2Q + DEPTH * W2Q_LAYER);
constexpr size_t WS_ACTQ = al256(WS_H1Q + (size_t)TALL * DM);
constexpr size_t WS_SHQ = al256(WS_ACTQ + (size_t)PROWS * DEXP);
constexpr size_t SHQ_LAYER = (size_t)1024 * DM + (size_t)DM * DEXP;
constexpr size_t WS_DUMP = al256(WS_SHQ + (size_t)DEPTH * SHQ_LAYER);
constexpr size_t RWF_LAYER = (size_t)128 * 4 * 64 * 16;
constexpr size_t WS_RWF = al256(WS_DUMP + 65536);
constexpr size_t WS_END = al256(WS_RWF + DEPTH * RWF_LAYER);

struct Params {
    const float* x; const float* meta; const float* ln_in_g; const float* ln_in_b;
    const float* w_in; const float* b_igate; const float* b_fgate; const float* conv_qk;
    const float* ml_norm_g; const float* sb_norm_g; const float* pool_w; const float* pool_scale;
    const float* w_out; const float* ln1_g; const float* ln1_b; const float* router_w; const float* router_bias;
    const float* exp_w13; const float* exp_w2; const float* sh_w13; const float* sh_w2;
    const float* ln2_g; const float* ln2_b;
    float* out; unsigned char* ws;
    int ph_lo, ph_hi;
};
typedef const Params __attribute__((address_space(4)))* PP;
__device__ __forceinline__ PP get_params() {
    PP k = (PP)__builtin_amdgcn_kernarg_segment_ptr();
    asm volatile("" : "+s"(k));
    return k;
}

constexpr int TM = 192;
constexpr int A_SLOT = 24576;
constexpr int G_AS = 0, G_BS = 3 * A_SLOT, G_ROWS = G_BS + 65536;
constexpr int G_LDS_END = G_ROWS + 1024;

__device__ __forceinline__ int swz_f(int n) { return ((n >> 2) & 7) ^ ((n >> 1) & 1); }

struct GemmOp {
    const bf16_t* X; int ldx;
    const float* W; int ldb;
    int cb0, cb1;
    int K;
    int cstep;
};

#define BSET_WAIT(N, S) asm volatile("s_waitcnt vmcnt(" #N ") lgkmcnt(0)" : "+v"(S[0]), "+v"(S[1]), "+v"(S[2]), "+v"(S[3]), "+v"(S[4]), "+v"(S[5]), "+v"(S[6]), "+v"(S[7]) :: "memory")

template <int NPASS, class Epi>
__device__ __forceinline__ void gemm_tile(unsigned char* lds_in, const GemmOp& g, Epi& epi) {
    unsigned char* lds = lds_here(lds_in);
    const int tid = tid_here(), lane = tid & 63, wid = __builtin_amdgcn_readfirstlane(tid >> 6), wr = wid >> 2, wc = wid & 3, r32 = lane & 31, hi = lane >> 5;
    const int* rows = (const int*)(lds + G_ROWS);
    const int a_r = wid * 8 + (lane >> 3);
    unsigned a_off[3];
#pragma unroll
    for (int j = 0; j < 3; ++j) a_off[j] = (unsigned)rows[a_r + 64 * j] * (unsigned)g.ldx + (((lane & 7) ^ swz_f(a_r)) << 3);
    const int a_lds = wid * 1024;
    const int kg = wid, nq = lane;
    const int blk = nq >> 3, gq = nq & 7;
    const int b_col = ((blk & 1) ? g.cb1 : g.cb0) + (blk >> 1) * 32 + gq * 4;
    const int b_n0 = blk * 32 + 8 * (gq & 3) + 4 * (gq >> 2);
    const int wa0 = G_BS + b_n0 * 128 + ((kg ^ swz_f(b_n0)) << 4);
    const int wa2 = G_BS + (b_n0 + 2) * 128 + ((kg ^ swz_f(b_n0 + 2)) << 4);
    const unsigned long long wa_ = (unsigned long long)g.W;
    const char* Wu = (const char*)(((unsigned long long)(unsigned)__builtin_amdgcn_readfirstlane((int)(wa_ >> 32)) << 32) | (unsigned)__builtin_amdgcn_readfirstlane((int)wa_));
    const int ldbu = __builtin_amdgcn_readfirstlane(g.ldb);
    unsigned b_voff = (unsigned)((kg * 8 * ldbu + b_col) * 4);
    const size_t ldb4 = (size_t)ldbu * 4;
    const int lanec = (hi ^ swz_f(r32)) << 4;
    int ard[4], brd[4];
#pragma unroll
    for (int ks = 0; ks < 4; ++ks) { ard[ks] = G_AS + (wr * 32 + r32) * 128 + ((ks << 5) ^ lanec); brd[ks] = G_BS + (wc * 64 + r32) * 128 + ((ks << 5) ^ lanec); }

    f32x16 acc[2][3];

    f32x4 s0[8], s1[8];
    const int nk = g.K >> 6;
#define G_DMA_A(kt, slot_off) do { \
        _Pragma("unroll") for (int j = 0; j < 3; ++j) __builtin_amdgcn_global_load_lds((const unsigned*)(g.X + a_off[j] + (kt) * 64), \
            (unsigned*)(lds + G_AS + (slot_off) + a_lds + j * 8192), 16, 0, 0); } while (0)
#define G_LOADB(S, kt) do { const char* wb_ = Wu + (size_t)(kt) * 64 * ldb4; \
        _Pragma("unroll") for (int j = 0; j < 8; ++j) asm volatile("global_load_dwordx4 %0, %1, %2" : "=v"(S[j]) : "v"(b_voff), "s"(wb_ + j * ldb4) : "memory"); } while (0)
#define G_WRITEB(S, buf) do { u32x4 w_; \
        w_.x = cvtpk(S[0][0], S[1][0]); w_.y = cvtpk(S[2][0], S[3][0]); w_.z = cvtpk(S[4][0], S[5][0]); w_.w = cvtpk(S[6][0], S[7][0]); *(u32x4*)(lds + wa0 + (buf) * 32768) = w_; \
        w_.x = cvtpk(S[0][1], S[1][1]); w_.y = cvtpk(S[2][1], S[3][1]); w_.z = cvtpk(S[4][1], S[5][1]); w_.w = cvtpk(S[6][1], S[7][1]); *(u32x4*)(lds + wa0 + (buf) * 32768 + 128) = w_; \
        w_.x = cvtpk(S[0][2], S[1][2]); w_.y = cvtpk(S[2][2], S[3][2]); w_.z = cvtpk(S[4][2], S[5][2]); w_.w = cvtpk(S[6][2], S[7][2]); *(u32x4*)(lds + wa2 + (buf) * 32768) = w_; \
        w_.x = cvtpk(S[0][3], S[1][3]); w_.y = cvtpk(S[2][3], S[3][3]); w_.z = cvtpk(S[4][3], S[5][3]); w_.w = cvtpk(S[6][3], S[7][3]); *(u32x4*)(lds + wa2 + (buf) * 32768 + 128) = w_; } while (0)
#define G_FRAGS(F, acur_, buf, ks) do { \
        _Pragma("unroll") for (int mi = 0; mi < 3; ++mi) F[mi] = *(const bf16x8*)(lds + ard[ks] + (acur_) + mi * 8192); \
        _Pragma("unroll") for (int ni = 0; ni < 2; ++ni) F[3 + ni] = *(const bf16x8*)(lds + brd[ks] + (buf) * 32768 + ni * 4096); } while (0)
#define G_MMA(F) do { \
        _Pragma("unroll") for (int ni = 0; ni < 2; ++ni) \
        _Pragma("unroll") for (int mi = 0; mi < 3; ++mi) acc[ni][mi] = __builtin_amdgcn_mfma_f32_32x32x16_bf16(F[3 + ni], F[mi], acc[ni][mi], 0, 0, 0); } while (0)
#define SB0() __builtin_amdgcn_sched_barrier(0)
#define G_MMA1(F, q) do { const int ni_ = (q) / 3, mi_ = (q) % 3; \
        acc[ni_][mi_] = __builtin_amdgcn_mfma_f32_32x32x16_bf16(F[3 + ni_], F[mi_], acc[ni_][mi_], 0, 0, 0); } while (0)
#define G_MMA2(F, pr) do { G_MMA1(F, 2 * (pr)); G_MMA1(F, 2 * (pr) + 1); } while (0)
#define G_WPIECE(S, buf, i, WA, OFF) do { u32x4 w_; \
        w_.x = cvtpk(S[0][i], S[1][i]); w_.y = cvtpk(S[2][i], S[3][i]); w_.z = cvtpk(S[4][i], S[5][i]); w_.w = cvtpk(S[6][i], S[7][i]); *(u32x4*)(lds + WA + (buf) * 32768 + OFF) = w_; } while (0)
#define G_DMA1(kt, slot_off, j) __builtin_amdgcn_global_load_lds((const unsigned*)(g.X + a_off[j] + (kt) * 64), (unsigned*)(lds + G_AS + (slot_off) + a_lds + (j) * 8192), 16, 0, 0)
#define G_LOAD1(S, kt, j) asm volatile("global_load_dwordx4 %0, %1, %2" : "=v"(S[j]) : "v"(b_voff), "s"(Wu + ((size_t)(kt) * 64 + (j)) * ldb4) : "memory")
#define SETWAIT(N, S) asm volatile("s_waitcnt vmcnt(" #N ")" : "+v"(S[0]), "+v"(S[1]), "+v"(S[2]), "+v"(S[3]), "+v"(S[4]), "+v"(S[5]), "+v"(S[6]), "+v"(S[7]) :: "memory")
#define G_STEP(kt, SW, TOPW, BARW, DO_WRITE, DO_DMA, DO_LOAD, HAS_NEXT) do { \
        if (DO_WRITE) { SETWAIT(TOPW, SW); } \
        G_FRAGS(f1, a_cur, (kt) & 1, 1); SB0(); \
        if (DO_WRITE) G_WPIECE(SW, ((kt) + 1) & 1, 0, wa0, 0);   SB0(); G_MMA2(f0, 0); SB0(); \
        if (DO_WRITE) G_WPIECE(SW, ((kt) + 1) & 1, 1, wa0, 128); SB0(); G_MMA2(f0, 1); SB0(); \
        if (DO_WRITE) G_WPIECE(SW, ((kt) + 1) & 1, 2, wa2, 0);   SB0(); G_MMA2(f0, 2); SB0(); \
        if (DO_WRITE) G_WPIECE(SW, ((kt) + 1) & 1, 3, wa2, 128); SB0(); \
        G_FRAGS(f0, a_cur, (kt) & 1, 2); SB0(); \
        if (DO_DMA) G_DMA1((kt) + 2, a_nn, 0); SB0(); G_MMA2(f1, 0); SB0(); \
        if (DO_DMA) G_DMA1((kt) + 2, a_nn, 1); if (DO_LOAD) { G_LOAD1(SW, (kt) + 3, 0); G_LOAD1(SW, (kt) + 3, 1); } SB0(); G_MMA2(f1, 1); SB0(); \
        if (DO_DMA) G_DMA1((kt) + 2, a_nn, 2); if (DO_LOAD) { G_LOAD1(SW, (kt) + 3, 2); G_LOAD1(SW, (kt) + 3, 3); } SB0(); G_MMA2(f1, 2); SB0(); \
        G_FRAGS(f1, a_cur, (kt) & 1, 3); SB0(); \
        if (DO_LOAD) { G_LOAD1(SW, (kt) + 3, 4); G_LOAD1(SW, (kt) + 3, 5); } SB0(); G_MMA2(f0, 0); SB0(); \
        if (DO_LOAD) { G_LOAD1(SW, (kt) + 3, 6); G_LOAD1(SW, (kt) + 3, 7); } SB0(); G_MMA2(f0, 1); SB0(); \
        G_MMA2(f0, 2); SB0(); \
        a_cur = a_cur + A_SLOT; a_cur = a_cur >= 3 * A_SLOT ? 0 : a_cur; a_nn = a_nn + A_SLOT; a_nn = a_nn >= 3 * A_SLOT ? 0 : a_nn; \
        if (HAS_NEXT) { DBG_T0(); asm volatile("s_waitcnt vmcnt(" #BARW ") lgkmcnt(0)" ::: "memory"); DBG_T1(); \
            __builtin_amdgcn_s_barrier(); DBG_T2(); \
            G_FRAGS(f0, a_cur, ((kt) + 1) & 1, 0); SB0(); } \
        G_MMA2(f1, 0); G_MMA2(f1, 1); G_MMA2(f1, 2); SB0(); } while (0)

#ifdef DBG_TIMING
    unsigned long long dt0_ = 0, dt1_ = 0, dwait_ = 0, dbar_ = 0; const unsigned long long dstart_ = __builtin_amdgcn_s_memtime();
#define DBG_T0() dt0_ = __builtin_amdgcn_s_memtime()
#define DBG_T1() do { dt1_ = __builtin_amdgcn_s_memtime(); dwait_ += dt1_ - dt0_; } while (0)
#define DBG_T2() do { dbar_ += __builtin_amdgcn_s_memtime() - dt1_; } while (0)
#else
#define DBG_T0()
#define DBG_T1()
#define DBG_T2()
#endif
    G_DMA_A(0, 0); __builtin_amdgcn_sched_barrier(0);
    G_LOADB(s0, 0); __builtin_amdgcn_sched_barrier(0);
    G_DMA_A(1, A_SLOT); __builtin_amdgcn_sched_barrier(0);
    G_LOADB(s1, 1); __builtin_amdgcn_sched_barrier(0);
#pragma unroll
    for (int pass = 0; pass < NPASS; ++pass) {
#pragma unroll
    for (int ni = 0; ni < 2; ++ni)
#pragma unroll
        for (int mi = 0; mi < 3; ++mi)
#pragma unroll
            for (int r = 0; r < 16; ++r) acc[ni][mi][r] = 0.f;
    int a_cur = 0, a_nn = 2 * A_SLOT;
    BSET_WAIT(11, s0);
    G_WRITEB(s0, 0); __builtin_amdgcn_sched_barrier(0);
    G_LOADB(s0, 2); __builtin_amdgcn_sched_barrier(0);
    asm volatile("s_waitcnt lgkmcnt(0)" ::: "memory");
    __builtin_amdgcn_s_barrier();
    bf16x8 f0[5], f1[5];
    G_FRAGS(f0, 0, 0, 0); SB0();
    int kt = 0;
    G_STEP(kt, s1, 8, 17, true, true, true, true); ++kt;
    for (; kt <= nk - 5; kt += 2) { G_STEP(kt, s0, 11, 17, true, true, true, true); G_STEP(kt + 1, s1, 11, 17, true, true, true, true); }
    G_STEP(kt, s0, 11, 9, true, true, false, true); ++kt;
    G_STEP(kt, s1, 3, 0, true, false, false, true); ++kt;
    G_STEP(kt, s0, 0, 0, false, false, false, false);
    {
      const int t2 = tid_here(), l2 = t2 & 63, w2 = __builtin_amdgcn_readfirstlane(t2 >> 6);
      epi.pre(w2 >> 2, l2 & 31);
      if (pass + 1 < NPASS) {
          asm volatile("s_waitcnt vmcnt(0) lgkmcnt(0)" ::: "memory"); epi.pin();
          __builtin_amdgcn_s_barrier();
          b_voff += (unsigned)(g.cstep * 4);
          G_DMA_A(0, 0); __builtin_amdgcn_sched_barrier(0);
          G_LOADB(s0, 0); __builtin_amdgcn_sched_barrier(0);
          G_DMA_A(1, A_SLOT); __builtin_amdgcn_sched_barrier(0);
          G_LOADB(s1, 1); __builtin_amdgcn_sched_barrier(0);
      }
      epi(acc, w2 >> 2, w2 & 3, l2 & 31, l2 >> 5, pass); }
    }
#ifdef DBG_TIMING
    { const unsigned long long dtot_ = __builtin_amdgcn_s_memtime() - dstart_;
      if (blockIdx.x == DBG_BLOCK && tid == DBG_WAVE * 64) { unsigned long long* d = (unsigned long long*)(lds + 0) ; (void)d;
        atomicAdd(&dbg_acc[0], dwait_); atomicAdd(&dbg_acc[1], dbar_); atomicAdd(&dbg_acc[2], dtot_); atomicAdd(&dbg_acc[3], (unsigned long long)nk); } }
#endif
#undef DBG_T0
#undef DBG_T1
#undef DBG_T2
#undef G_DMA_A
#undef G_LOADB
#undef G_WRITEB
#undef G_FRAGS
#undef G_MMA
#undef G_STEP
#undef SETWAIT
#undef G_MMA1
#undef G_MMA2
#undef G_WPIECE
#undef G_DMA1
#undef G_LOAD1
    __syncthreads();
}

template <int NMI> struct EpiStoreBf16 {
    bf16_t* O; int ldo; int orow0; int nrows; int oc0, oc1;
    __device__ __forceinline__ void pre(int, int) {}
    __device__ __forceinline__ void pin() {}
    __device__ __forceinline__ void operator()(const f32x16 (&acc)[2][NMI], int wr, int wc, int r32, int hi, int = 0) const {
#pragma unroll
        for (int mi = 0; mi < NMI; ++mi) {
            const int tr = (2 * mi + wr) * 32 + r32;
            if (tr < nrows) {
#pragma unroll
                for (int ni = 0; ni < 2; ++ni) {
                    bf16_t* p = O + (size_t)(orow0 + tr) * ldo + (ni ? oc1 : oc0) + wc * 32 + 16 * hi;
                    u32x4 w0, w1; const f32x16& a = acc[ni][mi];
                    w0.x = cvtpk(a[0], a[1]); w0.y = cvtpk(a[2], a[3]); w0.z = cvtpk(a[4], a[5]); w0.w = cvtpk(a[6], a[7]);
                    w1.x = cvtpk(a[8], a[9]); w1.y = cvtpk(a[10], a[11]); w1.z = cvtpk(a[12], a[13]); w1.w = cvtpk(a[14], a[15]);
                    *(u32x4*)p = w0; *(u32x4*)(p + 8) = w1;
                }
            }
        }
    }
};


constexpr int TMB = 256;
#ifdef EXP_DMA2X
#define EXP_DMA2 true
#define VMW(n) VMW2_##n
#define VMW2_8 16
#define VMW2_4 8
#define VMW2_0 0
#else
#define EXP_DMA2 false
#define VMW(n) n
#endif
#define XSTR(x) STR(x)
#define STR(x) #x
constexpr int BF_AS = 0, BF_BS = 65536, BF_ROWS = 131072, BF_SLOT = 16384;
struct GemmOpBf { const bf16_t* X; int ldx; const bf16_t* Wt; int ldw; int cb0, cb1; int K; };

template <class Epi>
__device__ __forceinline__ void gemm_tile_bf(unsigned char* lds_in, const GemmOpBf& g, const Epi& epi) {
    unsigned char* lds = lds_here(lds_in);
    const int tid = tid_here(), lane = tid & 63, wid = __builtin_amdgcn_readfirstlane(tid >> 6), wr = wid >> 2, wc = wid & 3, r32 = lane & 31, hi = lane >> 5;
    const int* rows = (const int*)(lds + BF_ROWS);
    unsigned a_off[2], b_off[2];
#pragma unroll
    for (int jj = 0; jj < 2; ++jj) {
        const int r = jj * 128 + wid * 16 + (lane >> 2);
        const int cpos = ((lane & 3) ^ ((r >> 2) & 3)) << 3;
        a_off[jj] = (unsigned)rows[r] * (unsigned)g.ldx + cpos;
        const int rho = r & 31, gcol = (((r >> 5) & 1) ? g.cb1 : g.cb0) + (r >> 6) * 32 + 16 * ((rho >> 2) & 1) + (rho & 3) + 4 * (rho >> 3);
        b_off[jj] = (unsigned)gcol * (unsigned)g.ldw + cpos;
    }
    const int p_lds = wid * 1024;
    const int lanec = (hi ^ ((r32 >> 2) & 3)) << 4;
    const int ard = BF_AS + (wr * 32 + r32) * 64, brd = BF_BS + (wc * 64 + r32) * 64;
    const int co0 = lanec, co1 = 32 ^ lanec;

    f32x16 acc[2][4];
#pragma unroll
    for (int ni = 0; ni < 2; ++ni)
#pragma unroll
        for (int mi = 0; mi < 4; ++mi)
#pragma unroll
            for (int r = 0; r < 16; ++r) acc[ni][mi][r] = 0.f;
    const int nk = g.K >> 5;
#define BF_DMA(kt, slot, which) do { BF_DMA_1(kt, slot, which); if (EXP_DMA2) BF_DMA_1(kt, slot, which); } while (0)
#define BF_DMA_1(kt, slot, which) do { \
        if ((which) < 2) __builtin_amdgcn_global_load_lds((const unsigned*)(g.X + a_off[(which) & 1] + (kt) * 32), (unsigned*)(lds + BF_AS + (slot) * BF_SLOT + p_lds + ((which) & 1) * 8192), 16, 0, 0); \
        else __builtin_amdgcn_global_load_lds((const unsigned*)(g.Wt + b_off[(which) & 1] + (kt) * 32), (unsigned*)(lds + BF_BS + (slot) * BF_SLOT + p_lds + ((which) & 1) * 8192), 16, 0, 0); } while (0)
#define BF_FRAGS(F, slot, co) do { \
        _Pragma("unroll") for (int mi = 0; mi < 4; ++mi) F[mi] = *(const bf16x8*)(lds + ard + (slot) * BF_SLOT + mi * 4096 + (co)); \
        _Pragma("unroll") for (int ni = 0; ni < 2; ++ni) F[4 + ni] = *(const bf16x8*)(lds + brd + (slot) * BF_SLOT + ni * 2048 + (co)); } while (0)
#define BF_MMA1(F, q) do { const int ni_ = (q) >> 2, mi_ = (q) & 3; \
        acc[ni_][mi_] = __builtin_amdgcn_mfma_f32_32x32x16_bf16(F[4 + ni_], F[mi_], acc[ni_][mi_], 0, 0, 0); } while (0)
#define BF_MMA2(F, pr) do { BF_MMA1(F, 2 * (pr)); BF_MMA1(F, 2 * (pr) + 1); } while (0)
#define SB0() __builtin_amdgcn_sched_barrier(0)
#define BF_STEP(kt, slot, WAITN, DO_ISSUE, HAS_NEXT) do { \
        BF_FRAGS(f1, slot, co1); SB0(); \
        BF_MMA2(f0, 0); BF_MMA2(f0, 1); BF_MMA2(f0, 2); BF_MMA2(f0, 3); SB0(); \
        if (HAS_NEXT) { BDBG_T0(); asm volatile("s_waitcnt vmcnt(" XSTR(VMW(WAITN)) ")" ::: "memory"); BDBG_T1(); \
            __builtin_amdgcn_s_barrier(); BDBG_T2(); \
            BF_FRAGS(f0, ((slot) + 1) & 3, co0); SB0(); } \
        if (DO_ISSUE) BF_DMA((kt) + 3, ((slot) + 3) & 3, 0); SB0(); BF_MMA2(f1, 0); SB0(); \
        if (DO_ISSUE) BF_DMA((kt) + 3, ((slot) + 3) & 3, 2); SB0(); BF_MMA2(f1, 1); SB0(); \
        if (DO_ISSUE) BF_DMA((kt) + 3, ((slot) + 3) & 3, 1); SB0(); BF_MMA2(f1, 2); SB0(); \
        if (DO_ISSUE) BF_DMA((kt) + 3, ((slot) + 3) & 3, 3); SB0(); BF_MMA2(f1, 3); SB0(); } while (0)

#ifdef DBG_TIMING_BF
    unsigned long long dt0_ = 0, dt1_ = 0, dwait_ = 0, dbar_ = 0; const unsigned long long dstart_ = __builtin_amdgcn_s_memtime(); const unsigned long long drt_ = __builtin_amdgcn_s_memrealtime();
#define BDBG_T0() dt0_ = __builtin_amdgcn_s_memtime()
#define BDBG_T1() do { dt1_ = __builtin_amdgcn_s_memtime(); dwait_ += dt1_ - dt0_; } while (0)
#define BDBG_T2() do { dbar_ += __builtin_amdgcn_s_memtime() - dt1_; } while (0)
#else
#define BDBG_T0()
#define BDBG_T1()
#define BDBG_T2()
#endif
#pragma unroll
    for (int t = 0; t < 3; ++t) { BF_DMA(t, t, 0); BF_DMA(t, t, 2); BF_DMA(t, t, 1); BF_DMA(t, t, 3); }
    SB0();
    asm volatile("s_waitcnt vmcnt(" XSTR(VMW(8)) ")" ::: "memory");
    __builtin_amdgcn_s_barrier();
    bf16x8 f0[6], f1[6];
    BF_FRAGS(f0, 0, co0); SB0();
    int kt = 0;
    for (; kt < nk - 4; kt += 4) {
        BF_STEP(kt, 0, 4, true, true); BF_STEP(kt + 1, 1, 4, true, true); BF_STEP(kt + 2, 2, 4, true, true); BF_STEP(kt + 3, 3, 4, true, true);
    }
    BF_STEP(kt, 0, 4, true, true); BF_STEP(kt + 1, 1, 4, false, true); BF_STEP(kt + 2, 2, 0, false, true); BF_STEP(kt + 3, 3, 0, false, false);
#ifdef DBG_TIMING_BF
    { const unsigned long long dtot_ = __builtin_amdgcn_s_memtime() - dstart_; const unsigned long long drtot_ = __builtin_amdgcn_s_memrealtime() - drt_;
      if (tid == DBG_WAVE * 64) { atomicAdd(&dbg_acc[0], DBG_SEL == 4 ? drtot_ : dwait_); atomicAdd(&dbg_acc[1], dbar_); atomicAdd(&dbg_acc[2], dtot_); atomicAdd(&dbg_acc[3], (unsigned long long)nk); if (DBG_SEL == 5) atomicMax(&dbg_acc[1], dtot_ / (unsigned long long)nk); } }
#endif
#undef BDBG_T0
#undef BDBG_T1
#undef BDBG_T2
#undef BF_DMA
#undef BF_DMA_1
#undef BF_FRAGS
#undef BF_MMA1
#undef BF_MMA2
#undef BF_STEP
    __syncthreads();
    {
      const int t2 = tid_here(), l2 = t2 & 63, w2 = __builtin_amdgcn_readfirstlane(t2 >> 6);
      epi(acc, w2 >> 2, w2 & 3, l2 & 31, l2 >> 5); }
    __syncthreads();
}

typedef int i32x8 __attribute__((ext_vector_type(8)));
struct GemmOpQ { const unsigned char* X; int ldx; const unsigned char* Wt; int ldw; int cb0, cb1; int K; int cstep; int nrows; };
constexpr int WQ_SCALE_BYTE = 0x79;

template <int NPASS, int NMIU, class Epi>
__device__ __forceinline__ void gemm_tile_q(unsigned char* lds_in, const GemmOpQ& g, Epi& epi) {
    unsigned char* lds = lds_here(lds_in);
#ifdef DBG_TQ
    const unsigned long long dq0_ = __builtin_amdgcn_s_memtime(); unsigned long long dq1_ = 0;
#endif
    const int tid = tid_here(), lane = tid & 63, wid = __builtin_amdgcn_readfirstlane(tid >> 6), wr = wid >> 2, wc = wid & 3, r32 = lane & 31, hi = lane >> 5;
    const int* rows = (const int*)(lds + BF_ROWS);
    unsigned a_off[2], b_off[2];
#pragma unroll
    for (int jj = 0; jj < 2; ++jj) {
        const int r = jj * 128 + wid * 16 + (lane >> 2);
        const int cpos = ((lane & 3) ^ ((r >> 2) & 3)) << 4;
        a_off[jj] = (unsigned)rows[r] * (unsigned)g.ldx + cpos;
        const int rho = r & 31, gcol = (((r >> 5) & 1) ? g.cb1 : g.cb0) + (r >> 6) * 32 + 16 * ((rho >> 2) & 1) + (rho & 3) + 4 * (rho >> 3);
        b_off[jj] = (unsigned)gcol * (unsigned)g.ldw + cpos;
    }
    const int p_lds = wid * 1024;
    const int c0 = ((2 * hi) ^ ((r32 >> 2) & 3)) << 4;
    const int ard = BF_AS + (wr * 32 + r32) * 64, brd = BF_BS + (wc * 64 + r32) * 64;
    constexpr int nmi = NMIU;

    f32x16 acc[2][4];
    const int nk = g.K >> 6;
#define Q_DMA(kt, slot, which) do { \
        if ((which) < 2) __builtin_amdgcn_global_load_lds((const unsigned*)(g.X + a_off[(which) & 1] + (kt) * 64), (unsigned*)(lds + BF_AS + (slot) * BF_SLOT + p_lds + ((which) & 1) * 8192), 16, 0, 0); \
        else __builtin_amdgcn_global_load_lds((const unsigned*)(g.Wt + b_off[(which) & 1] + (kt) * 64), (unsigned*)(lds + BF_BS + (slot) * BF_SLOT + p_lds + ((which) & 1) * 8192), 16, 0, 0); } while (0)
#define Q_FRAG(dst, base) do { typedef int i32x4_ __attribute__((ext_vector_type(4))); \
        const i32x4_ lo_ = *(const i32x4_*)(lds + (base) + c0), hi_ = *(const i32x4_*)(lds + (base) + (c0 ^ 16)); \
        dst = __builtin_shufflevector(lo_, hi_, 0, 1, 2, 3, 4, 5, 6, 7); } while (0)
#define Q_MMA(ni, mi) acc[ni][mi] = __builtin_amdgcn_mfma_scale_f32_32x32x64_f8f6f4(fw[ni], fx[mi], acc[ni][mi], 0, 0, 0, WQ_SCALE_BYTE * 0x01010101, 0, 0x7f7f7f7f)
#define Q_MMAX(FWv, FXv, ni, mi, j) acc[ni][mi] = __builtin_amdgcn_mfma_scale_f32_32x32x64_f8f6f4(FWv[ni], FXv[j], acc[ni][mi], 0, 0, 0, WQ_SCALE_BYTE * 0x01010101, 0, 0x7f7f7f7f)
#define Q_STEP(kt, slot, WAITN, DO_ISSUE, HAS_NEXT, FW, FXA, FWN, FXAN) do { \
        i32x8 fxb[2]; \
        Q_FRAG(FXA[0], ard + (slot) * BF_SLOT); if (nmi > 1) Q_FRAG(FXA[1], ard + (slot) * BF_SLOT + 4096); \
        if (nmi > 2) Q_FRAG(fxb[0], ard + (slot) * BF_SLOT + 8192); \
        if (nmi > 3) Q_FRAG(fxb[1], ard + (slot) * BF_SLOT + 12288); SB0(); \
        if (nmi > 0) { Q_MMAX(FW, FXA, 0, 0, 0); Q_MMAX(FW, FXA, 1, 0, 0); } if (nmi > 1) { Q_MMAX(FW, FXA, 0, 1, 1); Q_MMAX(FW, FXA, 1, 1, 1); } SB0(); \
        if (HAS_NEXT) { asm volatile("s_waitcnt vmcnt(" #WAITN ")" ::: "memory"); \
            __builtin_amdgcn_s_barrier(); \
            if (nmi > 0) { Q_FRAG(FWN[0], brd + (((slot) + 1) & 3) * BF_SLOT); Q_FRAG(FWN[1], brd + (((slot) + 1) & 3) * BF_SLOT + 2048); } SB0(); } \
        if (DO_ISSUE) Q_DMA((kt) + 3, ((slot) + 3) & 3, 0); SB0(); if (nmi > 2) Q_MMAX(FW, fxb, 0, 2, 0); SB0(); \
        if (DO_ISSUE) Q_DMA((kt) + 3, ((slot) + 3) & 3, 2); SB0(); if (nmi > 2) Q_MMAX(FW, fxb, 1, 2, 0); SB0(); \
        if (DO_ISSUE) Q_DMA((kt) + 3, ((slot) + 3) & 3, 1); SB0(); if (nmi > 3) Q_MMAX(FW, fxb, 0, 3, 1); SB0(); \
        if (DO_ISSUE) Q_DMA((kt) + 3, ((slot) + 3) & 3, 3); SB0(); if (nmi > 3) Q_MMAX(FW, fxb, 1, 3, 1); SB0(); } while (0)

#pragma unroll
    for (int t = 0; t < 3; ++t) { Q_DMA(t, t, 0); Q_DMA(t, t, 2); Q_DMA(t, t, 1); Q_DMA(t, t, 3); }
    SB0();
#pragma unroll
    for (int pass = 0; pass < NPASS; ++pass) {
#pragma unroll
    for (int ni = 0; ni < 2; ++ni)
#pragma unroll
        for (int mi = 0; mi < 4; ++mi)
#pragma unroll
            for (int r = 0; r < 16; ++r) acc[ni][mi][r] = 0.f;
    asm volatile("s_waitcnt vmcnt(8)" ::: "memory");
    __builtin_amdgcn_s_barrier();
    i32x8 fw0[2], fx0[2], fw1[2], fx1[2];
    if (nmi > 0) { Q_FRAG(fw0[0], brd); Q_FRAG(fw0[1], brd + 2048); } SB0();
    int kt = 0;
    for (; kt < nk - 4; kt += 4) {
        Q_STEP(kt, 0, 4, true, true, fw0, fx0, fw1, fx1); Q_STEP(kt + 1, 1, 4, true, true, fw1, fx1, fw0, fx0);
        Q_STEP(kt + 2, 2, 4, true, true, fw0, fx0, fw1, fx1); Q_STEP(kt + 3, 3, 4, true, true, fw1, fx1, fw0, fx0);
    }
    Q_STEP(kt, 0, 4, true, true, fw0, fx0, fw1, fx1); Q_STEP(kt + 1, 1, 4, false, true, fw1, fx1, fw0, fx0);
    Q_STEP(kt + 2, 2, 0, false, true, fw0, fx0, fw1, fx1); Q_STEP(kt + 3, 3, 0, false, false, fw1, fx1, fw0, fx0);
#ifdef DBG_TQ
    dq1_ = __builtin_amdgcn_s_memtime();
#endif
#pragma unroll
    for (int ni = 0; ni < 2; ++ni)
#pragma unroll
        for (int mi = 0; mi < 4; ++mi) asm volatile("" : "+v"(acc[ni][mi]));
    { const int t2 = tid_here(), l2 = t2 & 63, w2 = __builtin_amdgcn_readfirstlane(t2 >> 6);
      if (pass == 0) epi.pre(w2 >> 2, l2 & 31);
#ifndef Y_DIRECT
      if (NPASS == 1) __syncthreads();
#endif
      if (pass + 1 < NPASS) {
          asm volatile("s_waitcnt vmcnt(0) lgkmcnt(0)" ::: "memory"); epi.pin();
          __builtin_amdgcn_s_barrier();
          b_off[0] += (unsigned)g.cstep * (unsigned)g.ldw; b_off[1] += (unsigned)g.cstep * (unsigned)g.ldw;
          _Pragma("unroll") for (int t = 0; t < 3; ++t) { Q_DMA(t, t, 0); Q_DMA(t, t, 2); Q_DMA(t, t, 1); Q_DMA(t, t, 3); }
          SB0();
      }
      epi(acc, w2 >> 2, w2 & 3, l2 & 31, l2 >> 5, pass); }
    }
#undef Q_DMA
#undef Q_FRAG
#undef Q_MMA
#undef Q_MMAX
#undef Q_STEP
    __syncthreads();
#ifdef DBG_TQ
    if (g.K == DBG_TQ && tid_here() == 0) { const unsigned long long dq2_ = __builtin_amdgcn_s_memtime(); atomicAdd(&dbg_acc[0], dq1_ - dq0_); atomicAdd(&dbg_acc[2], dq2_ - dq0_); atomicAdd(&dbg_acc[3], 1ull); }
#endif
}

constexpr int R_AS = 0, R_BS = 65536, R_ROWS = 131072;
struct Gemm2Op { const unsigned char* X; const unsigned char* Wt; bf16_t* Y; const float* gate; int yrow0; int nrows; bf16_t* dump; };

__device__ __forceinline__ void gemm2_resident(unsigned char* lds_in, const Gemm2Op& g) {
    unsigned char* lds = lds_here(lds_in);
    const int tid = tid_here(), lane = tid & 63, wid = __builtin_amdgcn_readfirstlane(tid >> 6), wr = wid >> 2, wc = wid & 3, r32 = lane & 31, hi = lane >> 5;
    const int* rows = (const int*)(lds + R_ROWS);
    const int xr = wid * 16 + (lane >> 2);
    const unsigned x_off = (unsigned)rows[xr] * (unsigned)DEXP + ((((lane & 3) ^ ((xr >> 2) & 3))) << 4);
    unsigned b_off[2];
#pragma unroll
    for (int jj = 0; jj < 2; ++jj) {
        const int r = jj * 128 + wid * 16 + (lane >> 2);
        const int cpos = ((lane & 3) ^ ((r >> 2) & 3)) << 4;
        const int rho = r & 31, gcol = ((r >> 5) & 1) * 128 + (r >> 6) * 32 + 16 * ((rho >> 2) & 1) + (rho & 3) + 4 * (rho >> 3);
        b_off[jj] = (unsigned)gcol * (unsigned)DEXP + cpos;
    }
    const int p_lds = wid * 1024;
    const int c0 = ((2 * hi) ^ ((r32 >> 2) & 3)) << 4;
    const int ard = R_AS + (wr * 64 + r32) * 64, brd = R_BS + (wc * 64 + r32) * 64;
    float gsc[2];
#pragma unroll
    for (int mi = 0; mi < 2; ++mi) gsc[mi] = g.gate ? g.gate[wr * 64 + mi * 32 + r32] : 1.f;
    asm volatile("s_waitcnt vmcnt(0)" : "+v"(gsc[0]), "+v"(gsc[1]) :: "memory");

#define R_DMAX(ks) __builtin_amdgcn_global_load_lds((const unsigned*)(g.X + x_off + (ks) * 64), (unsigned*)(lds + R_AS + (ks) * 8192 + p_lds), 16, 0, 0)
#define R_DMAW(s, slot, jj) __builtin_amdgcn_global_load_lds((const unsigned*)(g.Wt + (size_t)((s) >> 3) * 256 * DEXP + b_off[jj] + ((s) & 7) * 64), (unsigned*)(lds + R_BS + (slot) * BF_SLOT + p_lds + (jj) * 8192), 16, 0, 0)
#define R_FRAG(dst, base) do { typedef int i32x4_ __attribute__((ext_vector_type(4))); \
        const i32x4_ lo_ = *(const i32x4_*)(lds + (base) + c0), hi_ = *(const i32x4_*)(lds + (base) + (c0 ^ 16)); \
        dst = __builtin_shufflevector(lo_, hi_, 0, 1, 2, 3, 4, 5, 6, 7); } while (0)
#define R_MMA(ni, mi) acc[ni][mi] = __builtin_amdgcn_mfma_scale_f32_32x32x64_f8f6f4(fw[ni], fx[mi], acc[ni][mi], 0, 0, 0, WQ_SCALE_BYTE * 0x01010101, 0, 0x7f7f7f7f)
#define R_STEP(s, ks, WAITN, DO_ISSUE) do { \
        asm volatile("s_waitcnt vmcnt(" #WAITN ")" ::: "memory"); \
        __builtin_amdgcn_s_barrier(); \
        i32x8 fx[2], fw[2]; \
        R_FRAG(fw[0], brd + ((ks) & 3) * BF_SLOT); R_FRAG(fw[1], brd + ((ks) & 3) * BF_SLOT + 2048); \
        R_FRAG(fx[0], ard + (ks) * 8192); R_FRAG(fx[1], ard + (ks) * 8192 + 2048); SB0(); \
        if (DO_ISSUE) R_DMAW((s) + 3, ((ks) + 3) & 3, 0); SB0(); R_MMA(0, 0); R_MMA(1, 0); SB0(); \
        if (DO_ISSUE) R_DMAW((s) + 3, ((ks) + 3) & 3, 1); SB0(); R_MMA(0, 1); R_MMA(1, 1); SB0(); } while (0)
#define R_STORE(nt) do { \
        _Pragma("unroll") for (int ni = 0; ni < 2; ++ni) _Pragma("unroll") for (int mi = 0; mi < 2; ++mi) asm volatile("" : "+v"(acc[ni][mi])); \
        _Pragma("unroll") for (int mi = 0; mi < 2; ++mi) { const int tr = wr * 64 + mi * 32 + r32; \
            _Pragma("unroll") for (int ni = 0; ni < 2; ++ni) { const f32x16& a = acc[ni][mi]; const float sc = gsc[mi]; u32x4 w0, w1; \
                w0.x = cvtpk(a[0] * sc, a[1] * sc); w0.y = cvtpk(a[2] * sc, a[3] * sc); w0.z = cvtpk(a[4] * sc, a[5] * sc); w0.w = cvtpk(a[6] * sc, a[7] * sc); \
                w1.x = cvtpk(a[8] * sc, a[9] * sc); w1.y = cvtpk(a[10] * sc, a[11] * sc); w1.z = cvtpk(a[12] * sc, a[13] * sc); w1.w = cvtpk(a[14] * sc, a[15] * sc); \
                bf16_t* q = tr < g.nrows ? g.Y + (size_t)(g.yrow0 + tr) * DM + (nt) * 256 + ni * 128 + wc * 32 + 16 * hi : g.dump + tid * 16;     \
                *(u32x4*)q = w0; *(u32x4*)(q + 8) = w1; } } } while (0)

#pragma unroll
    for (int ks = 0; ks < 8; ++ks) R_DMAX(ks);
#pragma unroll
    for (int t = 0; t < 3; ++t) { R_DMAW(t, t, 0); R_DMAW(t, t, 1); }
    SB0();
    f32x16 acc[2][2];
#define R_ZERO() do { _Pragma("unroll") for (int ni = 0; ni < 2; ++ni) _Pragma("unroll") for (int mi = 0; mi < 2; ++mi) _Pragma("unroll") for (int r = 0; r < 16; ++r) acc[ni][mi][r] = 0.f; } while (0)
    R_ZERO();
    R_STEP(0, 0, 4, true); R_STEP(1, 1, 4, true); R_STEP(2, 2, 4, true); R_STEP(3, 3, 4, true);
    R_STEP(4, 4, 4, true); R_STEP(5, 5, 4, true); R_STEP(6, 6, 4, true); R_STEP(7, 7, 4, true);
    R_STORE(0);
#pragma nounroll
    for (int nt = 1; nt < 7; ++nt) {
        const int s0 = nt * 8;
        R_ZERO();
        R_STEP(s0 + 0, 0, 12, true); R_STEP(s0 + 1, 1, 12, true); R_STEP(s0 + 2, 2, 12, true); R_STEP(s0 + 3, 3, 4, true);
        R_STEP(s0 + 4, 4, 4, true); R_STEP(s0 + 5, 5, 4, true); R_STEP(s0 + 6, 6, 4, true); R_STEP(s0 + 7, 7, 4, true);
        R_STORE(nt);
    }
    R_ZERO();
    R_STEP(56, 0, 12, true); R_STEP(57, 1, 12, true); R_STEP(58, 2, 12, true); R_STEP(59, 3, 4, true);
    R_STEP(60, 4, 4, true); R_STEP(61, 5, 4, false); R_STEP(62, 6, 2, false); R_STEP(63, 7, 0, false);
    R_STORE(7);
#undef R_DMAX
#undef R_DMAW
#undef R_FRAG
#undef R_MMA
#undef R_STEP
#undef R_STORE
#undef R_ZERO
    __syncthreads();
}

__device__ __forceinline__ void load_row32_f32(const float* src, int lane, float (&v)[32]) {
#pragma unroll
    for (int i = 0; i < 4; ++i) {
        const f32x4 a = *(const f32x4*)(src + i * 512 + lane * 8), b = *(const f32x4*)(src + i * 512 + lane * 8 + 4);
        v[i * 8 + 0] = a[0]; v[i * 8 + 1] = a[1]; v[i * 8 + 2] = a[2]; v[i * 8 + 3] = a[3];
        v[i * 8 + 4] = b[0]; v[i * 8 + 5] = b[1]; v[i * 8 + 6] = b[2]; v[i * 8 + 7] = b[3];
    }
}
__device__ __forceinline__ void load_row32_bf16(const bf16_t* src, int lane, float (&v)[32]) {
#pragma unroll
    for (int i = 0; i < 4; ++i) {
        const u32x4 a = *(const u32x4*)(src + i * 512 + lane * 8);
        v[i * 8 + 0] = bflo(a.x); v[i * 8 + 1] = bfhi(a.x); v[i * 8 + 2] = bflo(a.y); v[i * 8 + 3] = bfhi(a.y);
        v[i * 8 + 4] = bflo(a.z); v[i * 8 + 5] = bfhi(a.z); v[i * 8 + 6] = bflo(a.w); v[i * 8 + 7] = bfhi(a.w);
    }
}
__device__ __forceinline__ void ln_row32(float (&v)[32], const float* g, const float* bb, int lane) {
    float s = 0.f;
#pragma unroll
    for (int i = 0; i < 32; ++i) s += v[i];
    const float mu = wave_sum(s) * (1.f / DM);
    float q = 0.f;
#pragma unroll
    for (int i = 0; i < 32; ++i) { const float d = v[i] - mu; q += d * d; }
    const float rstd = rsqrtf(wave_sum(q) * (1.f / DM) + LN_EPS);
#pragma unroll
    for (int i = 0; i < 4; ++i) {
        const f32x4 g0 = *(const f32x4*)(g + i * 512 + lane * 8), g1 = *(const f32x4*)(g + i * 512 + lane * 8 + 4);
        const f32x4 b0 = *(const f32x4*)(bb + i * 512 + lane * 8), b1 = *(const f32x4*)(bb + i * 512 + lane * 8 + 4);
#pragma unroll
        for (int e = 0; e < 4; ++e) {
            v[i * 8 + e] = (v[i * 8 + e] - mu) * rstd * g0[e] + b0[e];
            v[i * 8 + 4 + e] = (v[i * 8 + 4 + e] - mu) * rstd * g1[e] + b1[e];
        }
    }
}
__device__ __forceinline__ void store_row32_bf16(bf16_t* dst, int lane, const float (&v)[32]) {
#pragma unroll
    for (int i = 0; i < 4; ++i) {
        u32x4 w; w.x = cvtpk(v[i * 8 + 0], v[i * 8 + 1]); w.y = cvtpk(v[i * 8 + 2], v[i * 8 + 3]); w.z = cvtpk(v[i * 8 + 4], v[i * 8 + 5]); w.w = cvtpk(v[i * 8 + 6], v[i * 8 + 7]);
        *(u32x4*)(dst + i * 512 + lane * 8) = w;
    }
}


constexpr int WG_LDS = 0;
__device__ __forceinline__ void stage_gate_weights(unsigned char* lds, PP p, int layer) {
    float* Wg = (float*)(lds + WG_LDS);
    const float* w = p->w_in + (size_t)layer * DM * N_IN + 3072;
    const int tid = tid_here();
    for (int i = tid; i < DM * 3; i += NTHREADS) {
        const int k = i / 3, c = (i % 3) * 4;
        const f32x4 a = *(const f32x4*)(w + (size_t)k * N_IN + c);
        Wg[(c + 0) * DM + k] = a[0]; Wg[(c + 1) * DM + k] = a[1]; Wg[(c + 2) * DM + k] = a[2]; Wg[(c + 3) * DM + k] = a[3];
    }
    __syncthreads();
}
__device__ __forceinline__ void row_gates(const unsigned char* lds, PP p, int layer, int row, int lane, const float (&v)[32]) {
    const float* Wg = (const float*)(lds + WG_LDS);
    float g = 0.f;
#pragma nounroll
    for (int c = 0; c < 12; ++c) {
        float a = 0.f;
#pragma unroll
        for (int i = 0; i < 4; ++i) {
            const f32x4 w0 = *(const f32x4*)(Wg + c * DM + i * 512 + lane * 8), w1 = *(const f32x4*)(Wg + c * DM + i * 512 + lane * 8 + 4);
            a += v[i * 8 + 0] * w0[0] + v[i * 8 + 1] * w0[1] + v[i * 8 + 2] * w0[2] + v[i * 8 + 3] * w0[3]
               + v[i * 8 + 4] * w1[0] + v[i * 8 + 5] * w1[1] + v[i * 8 + 6] * w1[2] + v[i * 8 + 7] * w1[3];
        }
        a = wave_sum(a);
        g = (lane == c) ? a : g;
    }
    if (lane < 12) {
        if (lane < 6) g += p->b_igate[layer * 6 + lane];
        else g = logsigmoidf_(g + p->b_fgate[layer * 6 + lane - 6]);
        ((float*)(p->ws + WS_GATES))[(size_t)row * 12 + lane] = g;
    }
}

__device__ __forceinline__ void phase_ln_in(unsigned char* lds, PP p, int bx, int G) {
    stage_gate_weights(lds, p, 0);
    const int tid = tid_here(), lane = tid & 63, gw = bx * 8 + (tid >> 6), nw = G * 8;
    bf16_t* hb = (bf16_t*)(p->ws + WS_HB);
    for (int row = gw; row < TALL; row += nw) {
        const float* src = row < TREAL ? p->x + (size_t)row * DM : p->meta + (size_t)((row - TREAL) & 15) * DM;
        float v[32];
        load_row32_f32(src, lane, v);
        ln_row32(v, p->ln_in_g, p->ln_in_b, lane);
        store_row32_bf16(hb + (size_t)row * DM, lane, v);
        row_gates(lds, p, 0, row, lane, v);
    }
}

__device__ __forceinline__ void gates_item(unsigned char* lds_in, PP p, int layer, int item) {
    unsigned char* lds = lds_here(lds_in);
    const int tid = tid_here(), lane = tid & 63, wid = tid >> 6;
    float* Wg = (float*)lds;
    const float* w = p->w_in + (size_t)layer * DM * N_IN + 3072;
    for (int i = tid; i < DM * 3; i += NTHREADS) { const int k = i / 3, c = i % 3; *(f32x4*)(Wg + k * 12 + c * 4) = *(const f32x4*)(w + (size_t)k * N_IN + c * 4); }
    __syncthreads();
    const bf16_t* hb = (const bf16_t*)(p->ws + WS_HB);
    float* gates = (float*)(p->ws + WS_GATES);
    for (int rr = 0; rr < 4; ++rr) {
        const int row = item * 32 + wid * 4 + rr;
        if (row < TALL) {
            float acc[12];
#pragma unroll
            for (int c = 0; c < 12; ++c) acc[c] = 0.f;
            const bf16_t* xr = hb + (size_t)row * DM;
            for (int i = 0; i < 32; ++i) {
                const int k = i * 64 + lane;
                const float xv = bf2f(xr[k]);
                const f32x4 w0 = *(const f32x4*)(Wg + k * 12), w1 = *(const f32x4*)(Wg + k * 12 + 4), w2 = *(const f32x4*)(Wg + k * 12 + 8);
#pragma unroll
                for (int e = 0; e < 4; ++e) { acc[e] += xv * w0[e]; acc[4 + e] += xv * w1[e]; acc[8 + e] += xv * w2[e]; }
            }
#pragma unroll
            for (int c = 0; c < 12; ++c) acc[c] = wave_sum(acc[c]);
            if (lane < 12) {
                float v = 0.f;
#pragma unroll
                for (int c = 0; c < 12; ++c) v = (lane == c) ? acc[c] : v;
                if (lane < 6) v += p->b_igate[layer * 6 + lane];
                else v = logsigmoidf_(v + p->b_fgate[layer * 6 + lane - 6]);
                gates[(size_t)row * 12 + lane] = v;
            }
        }
    }
    __syncthreads();
}

__device__ __forceinline__ void phase_conv(PP p, int layer, int bx, int G) {
    const bf16_t* proj = (const bf16_t*)(p->ws + WS_PROJ);
    bf16_t* qkc = (bf16_t*)(p->ws + WS_QKC);
    const float* cw = p->conv_qk + (size_t)layer * 4 * 1536;
    const int total = TALL * 192;
    for (int idx = bx * NTHREADS + tid_here(); idx < total; idx += G * NTHREADS) {
        const int row = idx / 192, c0 = (idx % 192) * 8;
        int b, l;
        if (row < TREAL) { b = row >> 11; l = NMETA + (row & 2047); } else { b = (row - TREAL) >> 4; l = (row - TREAL) & 15; }
        float acc[8];
#pragma unroll
        for (int e = 0; e < 8; ++e) acc[e] = 0.f;
#pragma unroll
        for (int i = 0; i < 4; ++i) {
            const int ls = l - 3 + i;
            if (ls >= 0) {
                const u32x4 a = *(const u32x4*)(proj + (size_t)row_of(b, ls) * PROJ_W + PC_MLQK + c0);
                const f32x4 w0 = *(const f32x4*)(cw + i * 1536 + c0), w1 = *(const f32x4*)(cw + i * 1536 + c0 + 4);
                acc[0] += bflo(a.x) * w0[0]; acc[1] += bfhi(a.x) * w0[1]; acc[2] += bflo(a.y) * w0[2]; acc[3] += bfhi(a.y) * w0[3];
                acc[4] += bflo(a.z) * w1[0]; acc[5] += bfhi(a.z) * w1[1]; acc[6] += bflo(a.w) * w1[2]; acc[7] += bfhi(a.w) * w1[3];
            }
        }
        const float sc = c0 < 768 ? 0.08838834764831845f : 1.f;
#pragma unroll
        for (int e = 0; e < 8; ++e) acc[e] = siluf_(acc[e]) * sc;
        u32x4 w; w.x = cvtpk(acc[0], acc[1]); w.y = cvtpk(acc[2], acc[3]); w.z = cvtpk(acc[4], acc[5]); w.w = cvtpk(acc[6], acc[7]);
        *(u32x4*)(qkc + (size_t)row * 1536 + c0) = w;
    }
}

template <int NB>
__device__ __forceinline__ void transpose_strip(unsigned char* lds_in, const float* src, int ldsrc, int scol0, int k0, bf16_t* dst, int K, int n0) {
    unsigned char* lds = lds_here(lds_in);
    const int tid = tid_here();
    bf16_t* T = (bf16_t*)(lds + 100352);
    {
        const int k = tid >> 3, c8 = (tid & 7) * 8;
        f32x4 a[NB], b[NB];
#pragma unroll
        for (int q = 0; q < NB; ++q) { a[q] = *(const f32x4*)(src + (size_t)(k0 + k) * ldsrc + scol0 + q * 64 + c8); b[q] = *(const f32x4*)(src + (size_t)(k0 + k) * ldsrc + scol0 + q * 64 + c8 + 4); }
#pragma unroll
        for (int q = 0; q < NB; ++q) {
            bf16_t* Tq = T + (q * 64 + c8) * 66 + k;
            Tq[0 * 66] = f2bf(a[q][0]); Tq[1 * 66] = f2bf(a[q][1]); Tq[2 * 66] = f2bf(a[q][2]); Tq[3 * 66] = f2bf(a[q][3]);
            Tq[4 * 66] = f2bf(b[q][0]); Tq[5 * 66] = f2bf(b[q][1]); Tq[6 * 66] = f2bf(b[q][2]); Tq[7 * 66] = f2bf(b[q][3]);
        }
    }
    __syncthreads();
    {
        const int n = tid >> 3, k8 = (tid & 7) * 8;
#pragma unroll
        for (int q = 0; q < NB; ++q) {
            const unsigned* r = (const unsigned*)(T + (q * 64 + n) * 66 + k8);
            u32x4 w; w.x = r[0]; w.y = r[1]; w.z = r[2]; w.w = r[3];
            *(u32x4*)(dst + (size_t)(n0 + q * 64 + n) * K + k0 + k8) = w;
        }
    }
    __syncthreads();
}
struct Strip { const float* src; int ldsrc; bf16_t* dst; int K; };
constexpr int CV_IN_S = 32 * 23, CV_OUT_S = 32 * 8, CV_PER_LAYER = CV_IN_S + CV_OUT_S, CV_MAIN = DEPTH * CV_PER_LAYER;
__device__ __forceinline__ Strip strip_of(PP p, int id) {
    const int layer = id / CV_PER_LAYER, r = id % CV_PER_LAYER;
    bf16_t* base = (bf16_t*)(p->ws + WS_WT) + (size_t)layer * WT_LAYER;
    Strip s;
    if (r < CV_IN_S) { const int nb = r >> 5, kb = r & 31, n0 = nb * 256;
        s.src = p->w_in + (size_t)layer * DM * N_IN + (size_t)(kb * 64) * N_IN + (n0 < 3072 ? n0 : n0 + 12); s.ldsrc = N_IN; s.dst = base + WT_IN + (size_t)n0 * DM + kb * 64; s.K = DM; }
    else { const int q = r - CV_IN_S, nb = q >> 5, kb = q & 31;
        s.src = p->w_out + (size_t)layer * DM * DM + (size_t)(kb * 64) * DM + nb * 256; s.ldsrc = DM; s.dst = base + WT_OUT + (size_t)(nb * 256) * DM + kb * 64; s.K = DM; }
    return s;
}
#define STRIP_LOAD(A, B, S) do { const int k_ = tid >> 3, c8_ = (tid & 7) * 8; _Pragma("unroll") for (int q = 0; q < 4; ++q) { \
        A[q] = *(const f32x4*)((S).src + (size_t)k_ * (S).ldsrc + q * 64 + c8_); B[q] = *(const f32x4*)((S).src + (size_t)k_ * (S).ldsrc + q * 64 + c8_ + 4); } } while (0)
#define STRIP_STORE(A, B, S) do { { const int k_ = tid >> 3, c8_ = (tid & 7) * 8; _Pragma("unroll") for (int q = 0; q < 4; ++q) { bf16_t* Tq = T + (q * 64 + c8_) * 66 + k_; \
            Tq[0 * 66] = f2bf(A[q][0]); Tq[1 * 66] = f2bf(A[q][1]); Tq[2 * 66] = f2bf(A[q][2]); Tq[3 * 66] = f2bf(A[q][3]); \
            Tq[4 * 66] = f2bf(B[q][0]); Tq[5 * 66] = f2bf(B[q][1]); Tq[6 * 66] = f2bf(B[q][2]); Tq[7 * 66] = f2bf(B[q][3]); } } \
        __syncthreads(); \
        { const int n_ = tid >> 3, k8_ = (tid & 7) * 8; _Pragma("unroll") for (int q = 0; q < 4; ++q) { const unsigned* r_ = (const unsigned*)(T + (q * 64 + n_) * 66 + k8_); \
            u32x4 w_; w_.x = r_[0]; w_.y = r_[1]; w_.z = r_[2]; w_.w = r_[3]; *(u32x4*)((S).dst + (size_t)(q * 64 + n_) * (S).K + k8_) = w_; } } \
        __syncthreads(); } while (0)
__device__ __forceinline__ void phase_convert(unsigned char* lds_in, PP p, int bx, int G, int layer_lo, int layer_hi) {
    unsigned char* lds = lds_here(lds_in);
    const int tid = tid_here();
    bf16_t* T = (bf16_t*)(lds + 100352);
    {
        f32x4 a0[4], b0[4], a1[4], b1[4];
        Strip s0, s1;
        const int id_end = layer_hi * CV_PER_LAYER;
        int id = layer_lo * CV_PER_LAYER + bx;
        if (id < id_end) { s0 = strip_of(p, id); STRIP_LOAD(a0, b0, s0); }
        for (; id < id_end; id += 2 * G) {
            const int id1 = id + G, id2 = id + 2 * G;
            if (id1 < id_end) { s1 = strip_of(p, id1); STRIP_LOAD(a1, b1, s1); }
            STRIP_STORE(a0, b0, s0);
            if (id2 < id_end) { s0 = strip_of(p, id2); STRIP_LOAD(a0, b0, s0); }
            if (id1 < id_end) STRIP_STORE(a1, b1, s1);
        }
    }
    if (layer_lo == 0) for (int id = G - 1 - bx; id < DEPTH * 8; id += G) {
        const int layer = id >> 3, r = id & 7, g = r >> 1, kb = r & 1;
        transpose_strip<2>(lds, p->pool_w + ((size_t)layer * 4 + g) * 128 * 128, 128, 0, kb * 64, (bf16_t*)(p->ws + WS_WT) + (size_t)layer * WT_LAYER + WT_POOL + (size_t)g * 128 * 128, 128, 0);
    }
}

#define KSWZ(row, colB) ((row) * 256 + ((colB) ^ (((row) & 15) << 4)))
#define SBAR() __builtin_amdgcn_sched_barrier(0)
constexpr int MX_V = 0, MX_K = 16384, MX_BUF = 32768, MX_C = 65536, MX_MQ = MX_C + 2112 * 4, MX_EM = MX_MQ + 1024, MX_WS = MX_EM + 1024, MX_Q = 77824, MX_END = MX_Q + 65536, MX_K3 = MX_END;

__device__ __forceinline__ int v_st(int k, int c) { const int kk = (k & ~0xC) | ((k & 4) << 1) | ((k & 8) >> 1); return ((kk >> 3) * 4 + (c >> 5)) * 512 + ((kk & 7) * 32 + (c & 31)) * 2; }
__device__ __forceinline__ int v_rd_base(int lane) { return ((lane & 3) << 3) | (((lane >> 2) & 3) << 6) | (((lane >> 4) & 1) << 5) | (((lane >> 5) & 1) << 8); }
constexpr int v_rd_off(int d0, int ks, int half) { return d0 * 512 + ks * 4096 + half * 2048; }
template <int OFF> __device__ __forceinline__ s16x4 tr_read(int vb) {
    s16x4 r; asm volatile("ds_read_b64_tr_b16 %0, %1 offset:%2" : "=&v"(r) : "v"(vb), "i"(OFF) : "memory"); return r;
}
template <int D0> __device__ __forceinline__ void pv_one(f32x16& od, int vb, bf16x8 pa0, bf16x8 pa1, bf16x8 pa2, bf16x8 pa3) {
    const s16x4 l0 = tr_read<v_rd_off(D0, 0, 0)>(vb), h0 = tr_read<v_rd_off(D0, 0, 1)>(vb), l1 = tr_read<v_rd_off(D0, 1, 0)>(vb), h1 = tr_read<v_rd_off(D0, 1, 1)>(vb);
    const s16x4 l2 = tr_read<v_rd_off(D0, 2, 0)>(vb), h2 = tr_read<v_rd_off(D0, 2, 1)>(vb), l3 = tr_read<v_rd_off(D0, 3, 0)>(vb), h3 = tr_read<v_rd_off(D0, 3, 1)>(vb);
    asm volatile("s_waitcnt lgkmcnt(0)" ::: "memory"); SBAR();
#define PK(L, H) (bf16x8){L[0], L[1], L[2], L[3], H[0], H[1], H[2], H[3]}
    __builtin_amdgcn_s_setprio(1);
    od = __builtin_amdgcn_mfma_f32_32x32x16_bf16(pa0, PK(l0, h0), od, 0, 0, 0);
    od = __builtin_amdgcn_mfma_f32_32x32x16_bf16(pa1, PK(l1, h1), od, 0, 0, 0);
    od = __builtin_amdgcn_mfma_f32_32x32x16_bf16(pa2, PK(l2, h2), od, 0, 0, 0);
    od = __builtin_amdgcn_mfma_f32_32x32x16_bf16(pa3, PK(l3, h3), od, 0, 0, 0);
    __builtin_amdgcn_s_setprio(0);
#undef PK
}
__device__ __forceinline__ void qkt(f32x16& p0, f32x16& p1, const unsigned char* Ks, const unsigned char* Qw, int r32, int hi) {
#pragma unroll
    for (int r = 0; r < 16; ++r) { p0[r] = 0.f; p1[r] = 0.f; }
#pragma unroll
    for (int d0 = 0; d0 < 8; ++d0) {
        const int cb = (d0 * 16 + hi * 8) * 2;
        const bf16x8 b0 = *(const bf16x8*)(Ks + KSWZ(r32, cb));
        const bf16x8 b1 = *(const bf16x8*)(Ks + KSWZ(32 + r32, cb));
        const bf16x8 q = *(const bf16x8*)(Qw + KSWZ(r32, cb));
        p0 = __builtin_amdgcn_mfma_f32_32x32x16_bf16(b0, q, p0, 0, 0, 0);
        p1 = __builtin_amdgcn_mfma_f32_32x32x16_bf16(b1, q, p1, 0, 0, 0);
    }
}
__device__ __forceinline__ float swap_sum(float v) {
    auto rr = __builtin_amdgcn_permlane32_swap(__float_as_uint(v), __float_as_uint(v), false, false);
    return __uint_as_float(rr[0]) + __uint_as_float(rr[1]);
}

#ifndef MIXER_INLINE
#define MIXER_INLINE __forceinline__
#endif
struct MixSrc { const bf16_t* Q; int ldq; const bf16_t* K; int ldk; const bf16_t* V; int ldv; };

template <int MODE>
__device__ MIXER_INLINE void mixer_item(unsigned char* lds_in, PP p, int layer, int b, int h, int j) {
    unsigned char* lds = lds_here(lds_in);
    const int tid = tid_here(), wid = tid >> 6, lane = tid & 63, r32 = lane & 31, hi = lane >> 5;
    const bf16_t* proj = (const bf16_t*)(p->ws + WS_PROJ);
    const bf16_t* qkc = (const bf16_t*)(p->ws + WS_QKC);
    const float* gates = (const float*)(p->ws + WS_GATES);
    bf16_t* cat = (bf16_t*)(p->ws + WS_CAT);
    MixSrc S;
    if (MODE == 0) { S.Q = proj + PC_SBQ + h * HD; S.ldq = PROJ_W; S.K = proj + PC_SBK + h * HD; S.ldk = PROJ_W; S.V = proj + PC_SBV + h * HD; S.ldv = PROJ_W; }
    else { S.Q = qkc + h * HD; S.ldq = 1536; S.K = qkc + 768 + h * HD; S.ldk = 1536; S.V = proj + PC_MLV + h * HD; S.ldv = PROJ_W; }
    unsigned char* V_lds = lds + MX_V; unsigned char* K_lds = lds + MX_K;
    float* carr = (float*)(lds + MX_C); float* mqa = (float*)(lds + MX_MQ); float* ema = (float*)(lds + MX_EM);
    float* wsc = (float*)(lds + MX_WS) + wid * 32;

    const int s0 = 256 * j;
    const int qrow = b * SEQ + s0 + wid * 32 + r32;
    const int lq = NMETA + s0 + wid * 32 + r32;
    unsigned char* Qw = lds + MX_Q + wid * 32 * 256;
#pragma unroll
    for (int d0 = 0; d0 < 8; ++d0) *(bf16x8*)(Qw + KSWZ(r32, (d0 * 16 + hi * 8) * 2)) = *(const bf16x8*)(S.Q + (size_t)qrow * S.ldq + d0 * 16 + hi * 8);

    float mq = 0.f;
    if (MODE == 1) {
        const int Lend = NMETA + s0 + 256;
        if (wid == 0) {
            float csum = 0.f, cmax = -3.0e38f;
            for (int base0 = 0; base0 < Lend; base0 += 512) {
                float lfv[8], liv[8];
#pragma unroll
                for (int u = 0; u < 8; ++u) {
                    const int l = base0 + u * 64 + lane; const bool ok = l < Lend;
                    const int row = row_of(b, ok ? l : 0);
                    lfv[u] = ok ? gates[(size_t)row * 12 + 6 + h] : 0.f;
                    liv[u] = ok ? gates[(size_t)row * 12 + h] : 0.f;
                }
#pragma unroll
                for (int u = 0; u < 8; ++u) {
                    const int l = base0 + u * 64 + lane; const bool ok = l < Lend;
                    const float cB = csum + wave_scan_sum(lfv[u]);
                    const float c = ok ? liv[u] - cB : -3.0e38f;
                    const float pm = fmaxf(cmax, wave_scan_max(c));
                    if (ok) {
                        carr[l] = c * 1.4426950408889634f;
                        if (l >= Lend - 256) { const float m0 = fmaxf(pm, 0.f); mqa[l - (Lend - 256)] = m0 * 1.4426950408889634f; ema[l - (Lend - 256)] = __expf(-(cB + m0)); }
                    }
                    csum = rdlane(cB, 63); cmax = rdlane(pm, 63);
                }
            }
        }
        __syncthreads();
        mq = mqa[wid * 32 + r32];
        {
            float* tileC = (float*)(lds + MX_WS) + 256;
            for (int ti = wid; ti < 4 * j + 5; ti += 8) {
                const int lb = ti == 0 ? 0 : NMETA + 64 * (ti - 1), nv = ti == 0 ? NMETA : 64;
                const float c = lane < nv ? carr[lb + lane] : -3.0e38f;
                const float C = wave_max(c);
                if (lane < nv) carr[lb + lane] = __builtin_amdgcn_exp2f(c - C);
                if (lane == 0) tileC[ti] = C;
            }
        }
        __syncthreads();
    }

    const int ntiles = 4 * j + 5;
    const int last_tile = 1 + (s0 + 32 * wid + 31 - (MODE == 0 ? 1 : 0)) / 64;
    const int sr = tid >> 4, sc = (tid & 15) * 8;
    const int vst0 = v_st(sr, sc), vst1 = v_st(32 + sr, sc);
    const int vb0 = (int)(uintptr_t)(LAS unsigned char*)V_lds + v_rd_base(lane);
    bf16x8 vs0, vs1, ks0, ks1;
#define SLOAD(it) do { int r0_, r1_; \
        if ((it) == 0) { r0_ = TREAL + b * NMETA + (sr < NMETA ? sr : NMETA - 1); r1_ = TREAL + b * NMETA + NMETA - 1; } \
        else { r0_ = b * SEQ + 64 * ((it) - 1) + sr; r1_ = r0_ + 32; } \
        vs0 = *(const bf16x8*)(S.V + (size_t)r0_ * S.ldv + sc); vs1 = *(const bf16x8*)(S.V + (size_t)r1_ * S.ldv + sc); \
        ks0 = *(const bf16x8*)(S.K + (size_t)r0_ * S.ldk + sc); ks1 = *(const bf16x8*)(S.K + (size_t)r1_ * S.ldk + sc); } while (0)
#define SWRITE(bo) do { *(bf16x8*)(V_lds + (bo) + vst0) = vs0; *(bf16x8*)(V_lds + (bo) + vst1) = vs1; \
        *(bf16x8*)(K_lds + (bo) + KSWZ(sr, sc * 2)) = ks0; *(bf16x8*)(K_lds + (bo) + KSWZ(32 + sr, sc * 2)) = ks1; } while (0)

    f32x16 o[4];
#pragma unroll
    for (int d = 0; d < 4; ++d)
#pragma unroll
        for (int r = 0; r < 16; ++r) o[d][r] = 0.f;
    float R = (MODE == 0) ? 1.f : 0.f, den = 0.f;

    if (MODE == 1) {
        const int T = ntiles - 1;
#define TROWS(t, R0, R1) do { if ((t) == 0) { R0 = TREAL + b * NMETA + (sr < NMETA ? sr : NMETA - 1); R1 = TREAL + b * NMETA + NMETA - 1; } \
        else { R0 = b * SEQ + 64 * ((t) - 1) + sr; R1 = R0 + 32; } } while (0)
#define KOFF(t) (((t) % 3) == 0 ? MX_K : ((t) % 3) == 1 ? MX_K + MX_BUF : MX_K3)
#define KLOAD(t) do { int r0_, r1_; TROWS(t, r0_, r1_); ks0 = *(const bf16x8*)(S.K + (size_t)r0_ * S.ldk + sc); ks1 = *(const bf16x8*)(S.K + (size_t)r1_ * S.ldk + sc); } while (0)
#define VLOAD(t) do { int r0_, r1_; TROWS(t, r0_, r1_); vs0 = *(const bf16x8*)(S.V + (size_t)r0_ * S.ldv + sc); vs1 = *(const bf16x8*)(S.V + (size_t)r1_ * S.ldv + sc); } while (0)
#define KWRITE(t) do { unsigned char* kd_ = lds + KOFF(t); *(bf16x8*)(kd_ + KSWZ(sr, sc * 2)) = ks0; *(bf16x8*)(kd_ + KSWZ(32 + sr, sc * 2)) = ks1; } while (0)
#define VWRITE(t) do { unsigned char* vd_ = V_lds + ((t) & 1) * MX_BUF; *(bf16x8*)(vd_ + vst0) = vs0; *(bf16x8*)(vd_ + vst1) = vs1; } while (0)
        KLOAD(T); VLOAD(T); KWRITE(T); VWRITE(T);
        if (T >= 1) { KLOAD(T - 1); KWRITE(T - 1); VLOAD(T - 1); }
        if (T >= 2) KLOAD(T - 2);
        __syncthreads();
        f32x16 p0, p1;
        if (T <= last_tile) qkt(p0, p1, lds + KOFF(T), Qw, r32, hi);
        for (int it = T; it >= 0; --it) {
            if (it < T) __syncthreads();
            if (it >= 2) KWRITE(it - 2);
            if (it >= 1) VWRITE(it - 1);
            if (it >= 3) KLOAD(it - 3);
            if (it >= 2) VLOAD(it - 2);
            f32x16 n0, n1;
            const bool has_next = it >= 1 && it - 1 <= last_tile;
            const int lbase = it == 0 ? 0 : NMETA + 64 * (it - 1);
            const float bt = __builtin_amdgcn_exp2f(fminf(((const float*)(lds + MX_WS))[256 + it] - mq, 126.f));
            if (has_next && it <= last_tile && NMETA + s0 + wid * 32 + 1 - lbase >= 64) {
                const unsigned char* Kn = lds + KOFF(it - 1);
#pragma unroll
                for (int r = 0; r < 16; ++r) { n0[r] = 0.f; n1[r] = 0.f; }
#pragma unroll
                for (int d0 = 0; d0 < 8; ++d0) {
                    const int cb = (d0 * 16 + hi * 8) * 2;
                    const bf16x8 b0 = *(const bf16x8*)(Kn + KSWZ(r32, cb));
                    const bf16x8 b1 = *(const bf16x8*)(Kn + KSWZ(32 + r32, cb));
                    const bf16x8 qf = *(const bf16x8*)(Qw + KSWZ(r32, cb));
                    n0 = __builtin_amdgcn_mfma_f32_32x32x16_bf16(b0, qf, n0, 0, 0, 0);
                    n1 = __builtin_amdgcn_mfma_f32_32x32x16_bf16(b1, qf, n1, 0, 0, 0);
                    const f32x4 c4 = *(const f32x4*)(carr + lbase + 8 * d0 + 4 * hi);
#pragma unroll
                    for (int i = 0; i < 4; ++i) {
                        const float w = c4[i] * bt;
                        if (d0 < 4) { p0[4 * d0 + i] *= w; den += p0[4 * d0 + i]; } else { p1[4 * (d0 - 4) + i] *= w; den += p1[4 * (d0 - 4) + i]; }
                    }
                }
            } else {
            if (has_next) qkt(n0, n1, lds + KOFF(it - 1), Qw, r32, hi);
            if (it <= last_tile) {
                int kmax = lq - lbase + 1;
                const int nvalid = it == 0 ? NMETA : 64;
                kmax = kmax < nvalid ? kmax : nvalid;
                if (it > 0 && NMETA + s0 + wid * 32 + 1 - lbase >= 64) {
#pragma unroll
                    for (int q = 0; q < 8; ++q) {
                        const f32x4 c4 = *(const f32x4*)(carr + lbase + 8 * q + 4 * hi);
#pragma unroll
                        for (int i = 0; i < 4; ++i) {
                            const float w = c4[i] * bt;
                            if (q < 4) { p0[4 * q + i] *= w; den += p0[4 * q + i]; } else { p1[4 * (q - 4) + i] *= w; den += p1[4 * (q - 4) + i]; }
                        }
                    }
                } else {
#pragma unroll
                    for (int q = 0; q < 8; ++q) {
                        const f32x4 c4 = *(const f32x4*)(carr + lbase + 8 * q + 4 * hi);
#pragma unroll
                        for (int i = 0; i < 4; ++i) {
                            const int kk = 8 * q + 4 * hi + i;
                            const float w = kk < kmax ? c4[i] * bt : 0.f;
                            if (q < 4) { p0[4 * q + i] *= w; den += p0[4 * q + i]; } else { p1[4 * (q - 4) + i] *= w; den += p1[4 * (q - 4) + i]; }
                        }
                    }
                }
            }
            }
            if (it <= last_tile) {
                bf16x8 pa0, pa1, pa2, pa3;
#define PK4(P, BASE, OUT) do { unsigned a0 = cvtpk(P[BASE + 0], P[BASE + 1]), a1 = cvtpk(P[BASE + 2], P[BASE + 3]); \
        unsigned b0 = cvtpk(P[BASE + 4], P[BASE + 5]), b1 = cvtpk(P[BASE + 6], P[BASE + 7]); \
        auto r0 = __builtin_amdgcn_permlane32_swap(a0, b0, false, false); auto r1 = __builtin_amdgcn_permlane32_swap(a1, b1, false, false); \
        u32x4 w = {r0[0], r1[0], r0[1], r1[1]}; OUT = *reinterpret_cast<bf16x8*>(&w); } while (0)
                PK4(p0, 0, pa0); PK4(p0, 8, pa1); PK4(p1, 0, pa2); PK4(p1, 8, pa3);
#undef PK4
                const int vbo = vb0 + (it & 1) * MX_BUF;
                pv_one<0>(o[0], vbo, pa0, pa1, pa2, pa3); pv_one<1>(o[1], vbo, pa0, pa1, pa2, pa3);
                pv_one<2>(o[2], vbo, pa0, pa1, pa2, pa3); pv_one<3>(o[3], vbo, pa0, pa1, pa2, pa3);
            }
            if (has_next) { p0 = n0; p1 = n1; }
        }
#undef TROWS
#undef KOFF
#undef KLOAD
#undef VLOAD
#undef KWRITE
#undef VWRITE
    } else {
    SLOAD(ntiles - 1);
    SWRITE(((ntiles - 1) & 1) * MX_BUF);
    if (ntiles > 1) SLOAD(ntiles - 2);
    for (int it = ntiles - 1; it >= 0; --it) {
        const int bo = (it & 1) * MX_BUF;
        __syncthreads();
        if (MODE == 0 && it < ntiles - 1) {
            const volatile int* fl = (const volatile int*)(lds + MX_MQ) + ((it + 1) & 1) * 8;
            const int any = fl[0] | fl[1] | fl[2] | fl[3] | fl[4] | fl[5] | fl[6] | fl[7];
            if (__builtin_amdgcn_readfirstlane(any) == 0) break;
        }
        if (it > 0) { SWRITE(MX_BUF - bo); if (it > 1) SLOAD(it - 2); }
        if (it <= last_tile) {
            f32x16 p0, p1;
            qkt(p0, p1, K_lds + bo, Qw, r32, hi);
            const int lbase = it == 0 ? 0 : NMETA + 64 * (it - 1);
            int kmax = lq - lbase + (MODE == 1 ? 1 : 0);
            const int nvalid = it == 0 ? NMETA : 64;
            kmax = kmax < nvalid ? kmax : nvalid;
            if (MODE == 0) {
                constexpr float SC = 0.08838834764831845f * 1.4426950408889634f;
                float x[32];
#pragma unroll
                for (int r = 0; r < 16; ++r) {
                    const float z0 = crow(r, hi) < kmax ? fminf(p0[r] * SC, 60.f) : -1.0e30f;
                    const float z1 = 32 + crow(r, hi) < kmax ? fminf(p1[r] * SC, 60.f) : -1.0e30f;
                    const float e0 = __builtin_amdgcn_exp2f(z0), e1 = __builtin_amdgcn_exp2f(z1);
                    const float k0 = __builtin_amdgcn_rcpf(1.f + e0), k1 = __builtin_amdgcn_rcpf(1.f + e1);
                    x[r] = k0; x[16 + r] = k1; p0[r] = e0 * k0; p1[r] = e1 * k1;
                }
                float run = R;
                float sown[8];
#pragma unroll
                for (int q = 7; q >= 0; --q) {
                    const float g = (x[4 * q] * x[4 * q + 1]) * (x[4 * q + 2] * x[4 * q + 3]);
                    auto rr = __builtin_amdgcn_permlane32_swap(__float_as_uint(g), __float_as_uint(g), false, false);
                    const float lo_q = __uint_as_float(rr[0]), up_q = __uint_as_float(rr[1]);
                    const float s_up = run; run *= up_q;
                    const float s_lo = run; run *= lo_q;
                    sown[q] = hi ? s_up : s_lo;
                }
                R = run;
#pragma unroll
                for (int q = 0; q < 8; ++q) {
                    const float E3 = sown[q], E2 = E3 * x[4 * q + 3], E1 = E2 * x[4 * q + 2], E0 = E1 * x[4 * q + 1];
                    if (q < 4) { p0[4 * q] *= E0; p0[4 * q + 1] *= E1; p0[4 * q + 2] *= E2; p0[4 * q + 3] *= E3; }
                    else { p1[4 * (q - 4)] *= E0; p1[4 * (q - 4) + 1] *= E1; p1[4 * (q - 4) + 2] *= E2; p1[4 * (q - 4) + 3] *= E3; }
                }
            } else {
                if (it > 0 && NMETA + s0 + wid * 32 + 1 - lbase >= 64) {
#pragma unroll
                    for (int q = 0; q < 8; ++q) {
                        const f32x4 c4 = *(const f32x4*)(carr + lbase + 8 * q + 4 * hi);
#pragma unroll
                        for (int i = 0; i < 4; ++i) {
                            const float w = __builtin_amdgcn_exp2f(c4[i] - mq);
                            if (q < 4) { p0[4 * q + i] *= w; den += p0[4 * q + i]; } else { p1[4 * (q - 4) + i] *= w; den += p1[4 * (q - 4) + i]; }
                        }
                    }
                } else {
#pragma unroll
                    for (int q = 0; q < 8; ++q) {
                        const f32x4 c4 = *(const f32x4*)(carr + lbase + 8 * q + 4 * hi);
#pragma unroll
                        for (int i = 0; i < 4; ++i) {
                            const int kk = 8 * q + 4 * hi + i;
                            const float w = kk < kmax ? __builtin_amdgcn_exp2f(c4[i] - mq) : 0.f;
                            if (q < 4) { p0[4 * q + i] *= w; den += p0[4 * q + i]; } else { p1[4 * (q - 4) + i] *= w; den += p1[4 * (q - 4) + i]; }
                        }
                    }
                }
            }
            bf16x8 pa0, pa1, pa2, pa3;
#define PK4(P, BASE, OUT) do { unsigned a0 = cvtpk(P[BASE + 0], P[BASE + 1]), a1 = cvtpk(P[BASE + 2], P[BASE + 3]); \
        unsigned b0 = cvtpk(P[BASE + 4], P[BASE + 5]), b1 = cvtpk(P[BASE + 6], P[BASE + 7]); \
        auto r0 = __builtin_amdgcn_permlane32_swap(a0, b0, false, false); auto r1 = __builtin_amdgcn_permlane32_swap(a1, b1, false, false); \
        u32x4 w = {r0[0], r1[0], r0[1], r1[1]}; OUT = *reinterpret_cast<bf16x8*>(&w); } while (0)
            PK4(p0, 0, pa0); PK4(p0, 8, pa1); PK4(p1, 0, pa2); PK4(p1, 8, pa3);
#undef PK4
            pv_one<0>(o[0], vb0 + bo, pa0, pa1, pa2, pa3); pv_one<1>(o[1], vb0 + bo, pa0, pa1, pa2, pa3);
            pv_one<2>(o[2], vb0 + bo, pa0, pa1, pa2, pa3); pv_one<3>(o[3], vb0 + bo, pa0, pa1, pa2, pa3);
        }
        if (MODE == 0) {
            const bool alive = (it > last_tile) || (__ballot(R > 0.f) != 0ull);
            if (lane == 0) ((volatile int*)(lds + MX_MQ))[(it & 1) * 8 + wid] = alive ? 1 : 0;
        }
    }
    }
#undef SLOAD
#undef SWRITE
    float rden[16];
    if (MODE == 1) {
        den = swap_sum(den);
        if (hi == 0) wsc[r32] = den;
        asm volatile("s_waitcnt lgkmcnt(0)" ::: "memory");
#pragma unroll
        for (int r = 0; r < 16; ++r) { const int qi = crow(r, hi); rden[r] = __builtin_amdgcn_rcpf(fmaxf(fabsf(wsc[qi]), ema[wid * 32 + qi])); }
#pragma unroll
        for (int d = 0; d < 4; ++d)
#pragma unroll
            for (int r = 0; r < 16; ++r) o[d][r] *= rden[r];
    }
    float ss[16];
#pragma unroll
    for (int r = 0; r < 16; ++r) ss[r] = o[0][r] * o[0][r] + o[1][r] * o[1][r] + o[2][r] * o[2][r] + o[3][r] * o[3][r];
#pragma unroll
    for (int off = 1; off < 32; off <<= 1)
#pragma unroll
        for (int r = 0; r < 16; ++r) ss[r] += __shfl_xor(ss[r], off, 64);
    const float* ng = (MODE == 0 ? p->sb_norm_g : p->ml_norm_g) + layer * 768 + h * HD;
    const int ccol = (MODE == 0 ? 768 : 0) + h * HD;
    float gv[4];
#pragma unroll
    for (int d = 0; d < 4; ++d) gv[d] = ng[d * 32 + r32];
#pragma unroll
    for (int r = 0; r < 16; ++r) {
        const float rn = rsqrtf(ss[r] * (1.f / HD) + RMS_EPS);
        const int orow = b * SEQ + s0 + wid * 32 + crow(r, hi);
#pragma unroll
        for (int d = 0; d < 4; ++d) {
            float v = o[d][r] * rn * gv[d];
            if (MODE == 1) v *= sigmoidf_(bf2f(proj[(size_t)orow * PROJ_W + PC_MLO + h * HD + d * 32 + r32]));
            cat[(size_t)orow * DM + ccol + d * 32 + r32] = f2bf(v);
        }
    }
    __syncthreads();
}

template <int MODE>
__device__ __forceinline__ void mixer_meta_item(unsigned char* lds_in, PP p, int layer, int b, int h) {
    unsigned char* lds = lds_here(lds_in);
    const int tid = tid_here();
    const bf16_t* proj = (const bf16_t*)(p->ws + WS_PROJ);
    const bf16_t* qkc = (const bf16_t*)(p->ws + WS_QKC);
    const float* gates = (const float*)(p->ws + WS_GATES);
    bf16_t* cat = (bf16_t*)(p->ws + WS_CAT);
    MixSrc S;
    if (MODE == 0) { S.Q = proj + PC_SBQ + h * HD; S.ldq = PROJ_W; S.K = proj + PC_SBK + h * HD; S.ldk = PROJ_W; S.V = proj + PC_SBV + h * HD; S.ldv = PROJ_W; }
    else { S.Q = qkc + h * HD; S.ldq = 1536; S.K = qkc + 768 + h * HD; S.ldk = 1536; S.V = proj + PC_MLV + h * HD; S.ldv = PROJ_W; }
    float* Ss = (float*)lds; float* As = Ss + 256; float* dn = As + 256;
    const int row0 = TREAL + b * NMETA;
    if (tid < 256) {
        const int qi = tid >> 4, ki = tid & 15;
        const bf16_t* q = S.Q + (size_t)(row0 + qi) * S.ldq; const bf16_t* k = S.K + (size_t)(row0 + ki) * S.ldk;
        float s = 0.f;
        for (int d = 0; d < HD; ++d) s += bf2f(q[d]) * bf2f(k[d]);
        Ss[qi * 16 + ki] = s;
    }
    __syncthreads();
    if (tid < 16) {
        const int qi = tid;
        if (MODE == 0) {
            float R = 0.f;
            for (int jj = 15; jj >= 0; --jj) {
                float a = 0.f;
                if (jj < qi) {
                    const float z = Ss[qi * 16 + jj] * 0.08838834764831845f;
                    const float lk = -(fmaxf(z, 0.f) + __logf(1.f + __expf(-fabsf(z))));
                    a = __expf(z + lk + R); R += lk;
                }
                As[qi * 16 + jj] = a;
            }
            dn[qi] = 1.f;
        } else {
            float cB = 0.f, pm = -3.0e38f, cs[16];
            float cBq = 0.f;
            for (int jj = 0; jj < 16; ++jj) {
                cB += gates[(size_t)(row0 + jj) * 12 + 6 + h];
                cs[jj] = gates[(size_t)(row0 + jj) * 12 + h] - cB;
                if (jj <= qi) { pm = fmaxf(pm, cs[jj]); cBq = cB; }
            }
            const float m0 = fmaxf(pm, 0.f);
            float den = 0.f;
            for (int jj = 0; jj < 16; ++jj) {
                float a = 0.f;
                if (jj <= qi) { a = __expf(cs[jj] - m0) * Ss[qi * 16 + jj]; den += a; }
                As[qi * 16 + jj] = a;
            }
            dn[qi] = 1.f / fmaxf(fabsf(den), __expf(-(cBq + m0)));
        }
    }
    __syncthreads();
    {
        const int qi = tid >> 5, d4 = (tid & 31) * 4;
        float o[4] = {0.f, 0.f, 0.f, 0.f};
        for (int jj = 0; jj < 16; ++jj) {
            const float a = As[qi * 16 + jj];
            const u32x2 v = *(const u32x2*)(S.V + (size_t)(row0 + jj) * S.ldv + d4);
            o[0] += a * bflo(v.x); o[1] += a * bfhi(v.x); o[2] += a * bflo(v.y); o[3] += a * bfhi(v.y);
        }
        const float dd = dn[qi];
        float ss = 0.f;
#pragma unroll
        for (int e = 0; e < 4; ++e) { o[e] *= dd; ss += o[e] * o[e]; }
#pragma unroll
        for (int off = 1; off < 32; off <<= 1) ss += __shfl_xor(ss, off, 64);
        const float rn = rsqrtf(ss * (1.f / HD) + RMS_EPS);
        const float* ng = (MODE == 0 ? p->sb_norm_g : p->ml_norm_g) + layer * 768 + h * HD;
        const int ccol = (MODE == 0 ? 768 : 0) + h * HD;
        const int orow = row0 + qi;
#pragma unroll
        for (int e = 0; e < 4; ++e) {
            float v = o[e] * rn * ng[d4 + e];
            if (MODE == 1) v *= sigmoidf_(bf2f(proj[(size_t)orow * PROJ_W + PC_MLO + h * HD + d4 + e]));
            cat[(size_t)orow * DM + ccol + d4 + e] = f2bf(v);
        }
    }
    __syncthreads();
}

constexpr int PL_U = 0, PL_P = 36864, PL_W = PL_P + 32768;
__device__ __forceinline__ void pool_item(unsigned char* lds_in, PP p, int layer, int b, int pb, int g) {
    unsigned char* lds = lds_here(lds_in);
    const int tid = tid_here(), lane = tid & 63, wid = tid >> 6, r32 = lane & 31, hi = lane >> 5;
    const bf16_t* proj = (const bf16_t*)(p->ws + WS_PROJ);
    bf16_t* cat = (bf16_t*)(p->ws + WS_CAT);
    const bf16_t* wt = (const bf16_t*)(p->ws + WS_WT) + (size_t)layer * WT_LAYER + WT_POOL + (size_t)g * 128 * 128;
    const int win = 2 << g;
    const int l0 = pb * 128, nl = (LSEQ - l0) < 128 ? (LSEQ - l0) : 128;
    for (int idx = tid; idx < 143 * 16; idx += NTHREADS) {
        const int li = idx >> 4, ch = idx & 15, l = l0 - 15 + li;
        u32x4 v = {0u, 0u, 0u, 0u};
        if (l >= 0 && l < LSEQ) v = *(const u32x4*)(proj + (size_t)row_of(b, l) * PROJ_W + PC_POOL + g * 128 + ch * 8);
        *(u32x4*)(lds + PL_U + li * 256 + ch * 16) = v;
    }
    for (int idx = tid; idx < 128 * 16; idx += NTHREADS) {
        const int d = idx >> 4, ch = idx & 15;
        *(u32x4*)(lds + PL_W + KSWZ(d, ch * 16)) = *(const u32x4*)(wt + (size_t)d * 128 + ch * 8);
    }
    __syncthreads();
    {
        const int c = tid & 127, chn = tid >> 7;
        const bf16_t* U = (const bf16_t*)(lds + PL_U);
        const int i0 = chn * 32;
        float sum = 0.f;
        for (int t = 1; t < win; ++t) sum += bf2f(U[(15 + i0 - t) * 128 + c]);
        for (int i = 0; i < 32; ++i) {
            const int l = l0 + i0 + i;
            const float u = bf2f(U[(15 + i0 + i) * 128 + c]);
            sum += u;
            const int cnt = (l + 1) < win ? (l + 1) : win;
            const float pv = sum * __builtin_amdgcn_rcpf((float)cnt) - u;
            sum -= bf2f(U[(15 + i0 + i - win + 1) * 128 + c]);
            *(bf16_t*)(lds + PL_P + KSWZ(i0 + i, c * 2)) = f2bf(pv);
        }
    }
    __syncthreads();
    {
        const int rt = wid >> 1, ch2 = wid & 1;
        f32x16 acc0, acc1;
#pragma unroll
        for (int r = 0; r < 16; ++r) { acc0[r] = 0.f; acc1[r] = 0.f; }
#pragma unroll
        for (int ks = 0; ks < 8; ++ks) {
            const int cb = (ks * 16 + hi * 8) * 2;
            const bf16x8 pf = *(const bf16x8*)(lds + PL_P + KSWZ(rt * 32 + r32, cb));
            const bf16x8 w0 = *(const bf16x8*)(lds + PL_W + KSWZ(ch2 * 64 + r32, cb));
            const bf16x8 w1 = *(const bf16x8*)(lds + PL_W + KSWZ(ch2 * 64 + 32 + r32, cb));
            acc0 = __builtin_amdgcn_mfma_f32_32x32x16_bf16(w0, pf, acc0, 0, 0, 0);
            acc1 = __builtin_amdgcn_mfma_f32_32x32x16_bf16(w1, pf, acc1, 0, 0, 0);
        }
        const int li = rt * 32 + r32;
        if (li < nl) {
            bf16_t* orow = cat + (size_t)row_of(b, l0 + li) * DM + 1536 + g * 128 + ch2 * 64;
            const float* sc = p->pool_scale + layer * 512 + g * 128 + ch2 * 64;
#pragma unroll
            for (int q = 0; q < 4; ++q) {
                const int d0 = 8 * q + 4 * hi;
                const f32x4 s0 = *(const f32x4*)(sc + d0), s1 = *(const f32x4*)(sc + 32 + d0);
                u32x2 w0, w1;
                w0.x = cvtpk(acc0[4 * q] * s0[0], acc0[4 * q + 1] * s0[1]); w0.y = cvtpk(acc0[4 * q + 2] * s0[2], acc0[4 * q + 3] * s0[3]);
                w1.x = cvtpk(acc1[4 * q] * s1[0], acc1[4 * q + 1] * s1[1]); w1.y = cvtpk(acc1[4 * q + 2] * s1[2], acc1[4 * q + 3] * s1[3]);
                *(u32x2*)(orow + d0) = w0; *(u32x2*)(orow + 32 + d0) = w1;
            }
        }
    }
    __syncthreads();
}

template <int NMI> struct EpiResid {
    const bf16_t* H; bf16_t* O; int orow0; int nrows; int oc0, oc1;
    __device__ __forceinline__ void pre(int, int) {}
    __device__ __forceinline__ void pin() {}
    __device__ __forceinline__ void operator()(const f32x16 (&acc)[2][NMI], int wr, int wc, int r32, int hi, int = 0) const {
#pragma unroll
        for (int mi = 0; mi < NMI; ++mi) {
            const int tr = (2 * mi + wr) * 32 + r32;
            if (tr < nrows) {
#pragma unroll
                for (int ni = 0; ni < 2; ++ni) {
                    const size_t o = (size_t)(orow0 + tr) * DM + (ni ? oc1 : oc0) + wc * 32 + 16 * hi;
                    const u32x4 h0 = *(const u32x4*)(H + o), h1 = *(const u32x4*)(H + o + 8);
                    const f32x16& a = acc[ni][mi];
                    u32x4 w0, w1;
                    w0.x = cvtpk(DN_ALPHA * bflo(h0.x) + a[0], DN_ALPHA * bfhi(h0.x) + a[1]); w0.y = cvtpk(DN_ALPHA * bflo(h0.y) + a[2], DN_ALPHA * bfhi(h0.y) + a[3]);
                    w0.z = cvtpk(DN_ALPHA * bflo(h0.z) + a[4], DN_ALPHA * bfhi(h0.z) + a[5]); w0.w = cvtpk(DN_ALPHA * bflo(h0.w) + a[6], DN_ALPHA * bfhi(h0.w) + a[7]);
                    w1.x = cvtpk(DN_ALPHA * bflo(h1.x) + a[8], DN_ALPHA * bfhi(h1.x) + a[9]); w1.y = cvtpk(DN_ALPHA * bflo(h1.y) + a[10], DN_ALPHA * bfhi(h1.y) + a[11]);
                    w1.z = cvtpk(DN_ALPHA * bflo(h1.z) + a[12], DN_ALPHA * bfhi(h1.z) + a[13]); w1.w = cvtpk(DN_ALPHA * bflo(h1.w) + a[14], DN_ALPHA * bfhi(h1.w) + a[15]);
                    *(u32x4*)(O + o) = w0; *(u32x4*)(O + o + 8) = w1;
                }
            }
        }
    }
};

#ifndef RDUP_NA
#define RDUP_NA 1
#endif
#ifndef RDUP_NB
#define RDUP_NB 1
#endif
#ifndef RDUP_NC
#define RDUP_NC 1
#endif
#ifndef RDUP_ND
#define RDUP_ND 1
#endif
#ifndef RDUP_NE
#define RDUP_NE 1
#endif
__device__ __forceinline__ int rdup_n(int n) { if (n > 1) asm volatile("" : "+s"(n)); return n; }
#define RDUP_LOOP(X) for (int q##X##_ = 0, n##X##_ = rdup_n(RDUP_N##X); q##X##_ < n##X##_; ++q##X##_)
#define RDUP_LAST(X) (q##X##_ == n##X##_ - 1)
constexpr int RX_STRIDE = 4112;
constexpr int RT_XN = 0, RT_PART = 0, RT_LG = 32 * RX_STRIDE, RT_ST = RT_LG + 8192, RT_HIST = RT_ST + 256, RT_BASE = RT_HIST + 256, RT_END = RT_BASE + 256;
static_assert(RT_END <= LDS_BYTES - 64, "router LDS");
__device__ __forceinline__ void split_bf16x8(const float (&x)[8], bf16x8& h, bf16x8& l) {
    u32x4 hw, lw;
    hw.x = cvtpk(x[0], x[1]); hw.y = cvtpk(x[2], x[3]); hw.z = cvtpk(x[4], x[5]); hw.w = cvtpk(x[6], x[7]);
    lw.x = cvtpk(x[0] - bflo(hw.x), x[1] - bfhi(hw.x)); lw.y = cvtpk(x[2] - bflo(hw.y), x[3] - bfhi(hw.y));
    lw.z = cvtpk(x[4] - bflo(hw.z), x[5] - bfhi(hw.z)); lw.w = cvtpk(x[6] - bflo(hw.w), x[7] - bfhi(hw.w));
    h = *reinterpret_cast<bf16x8*>(&hw); l = *reinterpret_cast<bf16x8*>(&lw);
}
__device__ __forceinline__ void router_preformat(PP p, int bx, int G) {
    const int tid = tid_here();
    for (int idx = (G - 1 - bx) * NTHREADS + tid; idx < DEPTH * 128 * 64; idx += G * NTHREADS) {
        const int lane = idx & 63, ksg = (idx >> 6) & 127, layer = idx >> 13, r32 = lane & 31, k0 = ksg * 16 + (lane >> 5) * 8;
        const float* rw = p->router_w + (size_t)layer * DM * NEXP;
        float w0[8], w1[8];
#pragma unroll
        for (int j = 0; j < 8; ++j) { w0[j] = rw[(size_t)(k0 + j) * NEXP + r32]; w1[j] = rw[(size_t)(k0 + j) * NEXP + 32 + r32]; }
        bf16x8 wh0, wl0, wh1, wl1; split_bf16x8(w0, wh0, wl0); split_bf16x8(w1, wh1, wl1);
        u32x4* dst = (u32x4*)(p->ws + WS_RWF + (size_t)layer * RWF_LAYER) + (size_t)(ksg * 4) * 64 + lane;
        dst[0] = __builtin_bit_cast(u32x4, wh0); dst[64] = __builtin_bit_cast(u32x4, wl0); dst[128] = __builtin_bit_cast(u32x4, wh1); dst[192] = __builtin_bit_cast(u32x4, wl1);
    }
}
__device__ __forceinline__ void router_item(unsigned char* lds_in, PP p, int layer, int item, int M) {
    unsigned char* lds = lds_here(lds_in);
    const int tid = tid_here(), lane = tid & 63, wid = tid >> 6, r32 = lane & 31, hi = lane >> 5;
    const bf16_t* S1 = (const bf16_t*)(p->ws + WS_S1);
    bf16_t* H1 = (bf16_t*)(p->ws + WS_H1);
    float* part = (float*)(lds + RT_PART);
    float* lgs = (float*)(lds + RT_LG);
    int* hist = (int*)(lds + RT_HIST); int* basev = (int*)(lds + RT_BASE);
    const float* g1 = p->ln1_g + layer * DM; const float* b1 = p->ln1_b + layer * DM;
    if (tid < 64) hist[tid] = 0;
    f32x16 d0, d1;
    {
        u32x4 raw[4][4];
        float mu[4], rs[4];
        RDUP_LOOP(A) {
#pragma unroll
        for (int rr = 0; rr < 4; ++rr) {
            const int row = item * 32 + wid * 4 + rr, rowc = row < M ? row : M - 1;
#pragma unroll
            for (int i = 0; i < 4; ++i) raw[rr][i] = *(const u32x4*)(S1 + (size_t)rowc * DM + i * 512 + lane * 8);
        }
#pragma unroll
        for (int rr = 0; rr < 4; ++rr) {
            float s = 0.f;
#pragma unroll
            for (int i = 0; i < 4; ++i) s += (bflo(raw[rr][i].x) + bfhi(raw[rr][i].x)) + (bflo(raw[rr][i].y) + bfhi(raw[rr][i].y)) + (bflo(raw[rr][i].z) + bfhi(raw[rr][i].z)) + (bflo(raw[rr][i].w) + bfhi(raw[rr][i].w));
            mu[rr] = wave_sum(s) * (1.f / DM);
            float q = 0.f;
#pragma unroll
            for (int i = 0; i < 4; ++i) {
                const unsigned ww[4] = {raw[rr][i].x, raw[rr][i].y, raw[rr][i].z, raw[rr][i].w};
#pragma unroll
                for (int e = 0; e < 4; ++e) { const float da = bflo(ww[e]) - mu[rr], db = bfhi(ww[e]) - mu[rr]; q += da * da + db * db; }
            }
            rs[rr] = rsqrtf(wave_sum(q) * (1.f / DM) + LN_EPS);
        }
        }
        RDUP_LOOP(B) {
#pragma unroll
        for (int r = 0; r < 16; ++r) { d0[r] = 0.f; d1[r] = 0.f; }
        const u32x4* wf = (const u32x4*)(p->ws + WS_RWF + (size_t)layer * RWF_LAYER);
#pragma unroll
        for (int h = 0; h < 2; ++h) {
            RDUP_LOOP(D)
#pragma unroll
            for (int ii = 0; ii < 2; ++ii) {
                const int i = 2 * h + ii;
                const f32x4 ga = *(const f32x4*)(g1 + i * 512 + lane * 8), gb = *(const f32x4*)(g1 + i * 512 + lane * 8 + 4);
                const f32x4 ba = *(const f32x4*)(b1 + i * 512 + lane * 8), bb = *(const f32x4*)(b1 + i * 512 + lane * 8 + 4);
#pragma unroll
                for (int rr = 0; rr < 4; ++rr) {
                    const int lr = wid * 4 + rr, row = item * 32 + lr;
                    const u32x4 a = raw[rr][i];
                    float x[8];
                    x[0] = (bflo(a.x) - mu[rr]) * rs[rr] * ga[0] + ba[0]; x[1] = (bfhi(a.x) - mu[rr]) * rs[rr] * ga[1] + ba[1];
                    x[2] = (bflo(a.y) - mu[rr]) * rs[rr] * ga[2] + ba[2]; x[3] = (bfhi(a.y) - mu[rr]) * rs[rr] * ga[3] + ba[3];
                    x[4] = (bflo(a.z) - mu[rr]) * rs[rr] * gb[0] + bb[0]; x[5] = (bfhi(a.z) - mu[rr]) * rs[rr] * gb[1] + bb[1];
                    x[6] = (bflo(a.w) - mu[rr]) * rs[rr] * gb[2] + bb[2]; x[7] = (bfhi(a.w) - mu[rr]) * rs[rr] * gb[3] + bb[3];
                    if (row < M) {
                        u32x4 hw; hw.x = cvtpk(x[0], x[1]); hw.y = cvtpk(x[2], x[3]); hw.z = cvtpk(x[4], x[5]); hw.w = cvtpk(x[6], x[7]);
                        *(u32x4*)(H1 + (size_t)row * DM + i * 512 + lane * 8) = hw;
                        u32x2 qw; qw.x = pk4_fp8(x[0], x[1], x[2], x[3]); qw.y = pk4_fp8(x[4], x[5], x[6], x[7]);
                        *(u32x2*)(p->ws + WS_H1Q + (size_t)row * DM + i * 512 + lane * 8) = qw;
                    }
                    float* xd = (float*)(lds + RT_XN + lr * RX_STRIDE) + ii * 512 + lane * 8;
                    *(f32x4*)xd = (f32x4){x[0], x[1], x[2], x[3]}; *(f32x4*)(xd + 4) = (f32x4){x[4], x[5], x[6], x[7]};
                }
            }
            __syncthreads();
            RDUP_LOOP(E) {
#if RDUP_NE > 1
            const f32x16 sv0 = d0, sv1 = d1;
#endif
#pragma unroll
            for (int ks = 0; ks < 8; ++ks) {
                const float* xs = (const float*)(lds + RT_XN + r32 * RX_STRIDE) + wid * 128 + ks * 16 + hi * 8;
                const f32x4 xa = *(const f32x4*)xs, xb = *(const f32x4*)(xs + 4);
                const float x[8] = {xa[0], xa[1], xa[2], xa[3], xb[0], xb[1], xb[2], xb[3]};
                bf16x8 xh, xl; split_bf16x8(x, xh, xl);
                const u32x4* wp = wf + (size_t)((h * 64 + wid * 8 + ks) * 4) * 64 + lane;
                const u32x4 q0 = wp[0], q1 = wp[64], q2 = wp[128], q3 = wp[192];
                const bf16x8 wh0 = __builtin_bit_cast(bf16x8, q0), wl0 = __builtin_bit_cast(bf16x8, q1), wh1 = __builtin_bit_cast(bf16x8, q2), wl1 = __builtin_bit_cast(bf16x8, q3);
                d0 = __builtin_amdgcn_mfma_f32_32x32x16_bf16(xh, wh0, d0, 0, 0, 0); d1 = __builtin_amdgcn_mfma_f32_32x32x16_bf16(xh, wh1, d1, 0, 0, 0);
                d0 = __builtin_amdgcn_mfma_f32_32x32x16_bf16(xh, wl0, d0, 0, 0, 0); d1 = __builtin_amdgcn_mfma_f32_32x32x16_bf16(xh, wl1, d1, 0, 0, 0);
                d0 = __builtin_amdgcn_mfma_f32_32x32x16_bf16(xl, wh0, d0, 0, 0, 0); d1 = __builtin_amdgcn_mfma_f32_32x32x16_bf16(xl, wh1, d1, 0, 0, 0);
            }
#if RDUP_NE > 1
            if (!RDUP_LAST(E)) { d0 = sv0; d1 = sv1; }
#endif
            }
            __syncthreads();
        }
        }
#pragma unroll
        for (int r = 0; r < 16; ++r) { part[(wid * 32 + crow(r, hi)) * 64 + r32] = d0[r]; part[(wid * 32 + crow(r, hi)) * 64 + 32 + r32] = d1[r]; }
    }
    __syncthreads();
    {
        f32x4 sum = *(const f32x4*)(part + tid * 4);
#pragma unroll
        for (int w = 1; w < 8; ++w) { const f32x4 t = *(const f32x4*)(part + w * 2048 + tid * 4); sum[0] += t[0]; sum[1] += t[1]; sum[2] += t[2]; sum[3] += t[3]; }
        *(f32x4*)(lgs + tid * 4) = sum;
    }
    __syncthreads();
    float lg[4];
#pragma unroll
    for (int rr = 0; rr < 4; ++rr) lg[rr] = lgs[(wid * 4 + rr) * 64 + lane];
    const float bias = p->router_bias[layer * NEXP + lane];
    int my_e[4], my_rank[4]; float my_g[4];
    RDUP_LOOP(C)
    for (int rr = 0; rr < 4; ++rr) {
        const int row = item * 32 + wid * 4 + rr;
        const float score = 1.f / (1.f + __expf(-lg[rr]));
        float sel = score + bias;
        int e_k = 0; float s_k = 0.f; float ssum = 0.f;
        for (int k = 0; k < TOPK; ++k) {
            const float m = wave_max(sel);
            const unsigned long long bal = __ballot(sel == m);
            const int idx = __ffsll((long long)bal) - 1;
            const float sc = rdlane(score, __builtin_amdgcn_readfirstlane(idx));
            ssum += sc;
            if (lane == k) { e_k = idx; s_k = sc; }
            if (lane == idx) sel = -3.0e38f;
        }
        my_e[rr] = e_k; my_g[rr] = s_k / ssum * ROUTED_SCALE; my_rank[rr] = 0;
        if (RDUP_LAST(C) && lane < TOPK && row < M) my_rank[rr] = atomicAdd(&hist[e_k], 1);
    }
    __syncthreads();
    int* cnt = (int*)(p->ws + WS_CTL + CTL_CNT) + layer * CNT_LAYER;
    if (tid < 64) basev[tid] = atomicAdd(&cnt[tid * CNT_STRIDE], hist[tid]);
#ifdef PROBE_ATOM2
    if (tid < 64) basev[64 + tid] = atomicAdd(&cnt[DEPTH * CNT_LAYER + 4096 + layer * CNT_LAYER + tid * CNT_STRIDE], hist[tid]);
#endif
    __syncthreads();
    int* asg_e = (int*)(p->ws + WS_ASGE); int* asg_s = (int*)(p->ws + WS_ASGS);
    int* tokl = (int*)(p->ws + WS_TOKL); float* gatel = (float*)(p->ws + WS_GATEL);
    for (int rr = 0; rr < 4; ++rr) {
        const int row = item * 32 + wid * 4 + rr;
        if (lane < TOPK && row < M) {
            const int e = my_e[rr], slot = basev[e] + my_rank[rr];
            asg_e[row * 8 + lane] = e; asg_s[row * 8 + lane] = slot;
            tokl[(size_t)e * TALL + slot] = row; gatel[(size_t)e * TALL + slot] = my_g[rr];
        }
    }
    __syncthreads();
}

constexpr int MS_BASE = G_LDS_END;
constexpr int MS_CNT = MS_BASE, MS_OFF = MS_BASE + 66 * 4, MS_TP = MS_BASE + 132 * 4, MS_END = MS_BASE + 200 * 4;
__device__ __forceinline__ void moe_tables(unsigned char* lds, PP p, int layer, int M, int tmrows = TM) {
    int* c = (int*)(lds + MS_CNT); int* o = (int*)(lds + MS_OFF); int* tp = (int*)(lds + MS_TP);
    const int tid = tid_here();
    if (tid < 64) {
        const int* cnt = (const int*)(p->ws + WS_CTL + CTL_CNT) + layer * CNT_LAYER;
        const int n = __hip_atomic_load(&cnt[tid * CNT_STRIDE], __ATOMIC_RELAXED, __HIP_MEMORY_SCOPE_AGENT);
        const int nt = (n + tmrows - 1) / tmrows;
        int so = n, st = nt;
#pragma unroll
        for (int d = 1; d < 64; d <<= 1) { const int a = __shfl_up(so, d, 64), b2 = __shfl_up(st, d, 64); if (tid >= d) { so += a; st += b2; } }
        c[tid] = n; o[tid] = so - n; tp[tid] = st - nt;
        if (tid == 63) { c[64] = M; o[64] = SH_BASE; tp[64] = st; tp[65] = st; }
    }
    __syncthreads();
}
__device__ __forceinline__ void moe_decode(const unsigned char* lds, int id, int ntn, int& e, int& nt, int& m) {
    const int* tp = (const int*)(lds + MS_TP);
    int lo = 0;
#pragma unroll
    for (int step = 32; step >= 1; step >>= 1) { const int cand = lo + step; if (cand <= 63 && tp[cand] * ntn <= id) lo = cand; }
    e = __builtin_amdgcn_readfirstlane(lo); const int rem = id - __builtin_amdgcn_readfirstlane(tp[e]) * ntn, nm = __builtin_amdgcn_readfirstlane(tp[e + 1] - tp[e]);
    nt = __builtin_amdgcn_readfirstlane(rem / nm); m = __builtin_amdgcn_readfirstlane(rem % nm);
}

template <int NMI> struct EpiSwiglu {
    bf16_t* O; int orow0; int nrows; int oc;
    __device__ __forceinline__ void pre(int, int) {}
    __device__ __forceinline__ void pin() {}
    __device__ __forceinline__ void operator()(const f32x16 (&acc)[2][NMI], int wr, int wc, int r32, int hi, int pass = 0) const {
#pragma unroll
        for (int mi = 0; mi < NMI; ++mi) {
            const int tr = (2 * mi + wr) * 32 + r32;
            if (tr < nrows) {
                float v[16];
#pragma unroll
                for (int r = 0; r < 16; ++r) { const float gte = acc[0][mi][r]; v[r] = gte * __builtin_amdgcn_rcpf(1.f + __expf(-gte)) * acc[1][mi][r]; }
                u32x4 w0, w1;
                w0.x = cvtpk(v[0], v[1]); w0.y = cvtpk(v[2], v[3]); w0.z = cvtpk(v[4], v[5]); w0.w = cvtpk(v[6], v[7]);
                w1.x = cvtpk(v[8], v[9]); w1.y = cvtpk(v[10], v[11]); w1.z = cvtpk(v[12], v[13]); w1.w = cvtpk(v[14], v[15]);
                bf16_t* q = O + (size_t)(orow0 + tr) * DEXP + oc + pass * 128 + wc * 32 + 16 * hi;
                *(u32x4*)q = w0; *(u32x4*)(q + 8) = w1;
            }
        }
    }
};
template <int NMI> struct EpiScaleStore {
    bf16_t* O; int orow0; int nrows; int oc0, oc1; const float* gate;
    float gpre[NMI];
    __device__ __forceinline__ void pre(int wr, int r32) {
#pragma unroll
        for (int mi = 0; mi < NMI; ++mi) gpre[mi] = gate ? gate[(2 * mi + wr) * 32 + r32] : 1.f;
    }
    __device__ __forceinline__ void pin() {
#pragma unroll
        for (int mi = 0; mi < NMI; ++mi) asm volatile("" : "+v"(gpre[mi]));
    }
    __device__ __forceinline__ void operator()(const f32x16 (&acc)[2][NMI], int wr, int wc, int r32, int hi, int pass = 0) const {
#pragma unroll
        for (int mi = 0; mi < NMI; ++mi) {
            const int tr = (2 * mi + wr) * 32 + r32;
            if (tr < nrows) {
                const float gsc = gpre[mi];
#pragma unroll
                for (int ni = 0; ni < 2; ++ni) {
                    const f32x16& a = acc[ni][mi];
                    u32x4 w0, w1;
                    w0.x = cvtpk(a[0] * gsc, a[1] * gsc); w0.y = cvtpk(a[2] * gsc, a[3] * gsc); w0.z = cvtpk(a[4] * gsc, a[5] * gsc); w0.w = cvtpk(a[6] * gsc, a[7] * gsc);
                    w1.x = cvtpk(a[8] * gsc, a[9] * gsc); w1.y = cvtpk(a[10] * gsc, a[11] * gsc); w1.z = cvtpk(a[12] * gsc, a[13] * gsc); w1.w = cvtpk(a[14] * gsc, a[15] * gsc);
                    bf16_t* q = O + (size_t)(orow0 + tr) * DM + (ni ? oc1 : oc0) + pass * 256 + wc * 32 + 16 * hi;
                    *(u32x4*)q = w0; *(u32x4*)(q + 8) = w1;
                }
            }
        }
    }
};

__device__ __forceinline__ void moe_gemm1_item(unsigned char* lds_in, PP p, int layer, int id) {
    unsigned char* lds = lds_here(lds_in);
    int e, nt, m; moe_decode(lds, id, 4, e, nt, m);
    const int* c = (const int*)(lds + MS_CNT); const int* o = (const int*)(lds + MS_OFF);
    const int cnt = __builtin_amdgcn_readfirstlane(c[e]), nvalid = (cnt - m * TM) < TM ? (cnt - m * TM) : TM;
    const int oe = __builtin_amdgcn_readfirstlane(o[e]);
    int* rows = (int*)(lds + G_ROWS);
    { const int t_ = tid_here();
      if (t_ < TM) {
        const int slot = m * TM + (t_ < nvalid ? t_ : nvalid - 1);
        rows[t_] = ((const int*)(p->ws + WS_TOKL))[(size_t)e * TALL + slot];
      } }
    __syncthreads();
    const float* W = p->exp_w13 + ((size_t)layer * 64 + e) * DM * 1024;
    GemmOp g{(const bf16_t*)(p->ws + WS_H1), DM, W, 1024, nt * 128, 512 + nt * 128, DM, 128};
    EpiSwiglu<3> ep{(bf16_t*)(p->ws + WS_ACT), oe + m * TM, nvalid, nt * 128};
    gemm_tile<1>(lds, g, ep);
}
__device__ __forceinline__ void moe_gemm2_item(unsigned char* lds_in, PP p, int layer, int id) {
    unsigned char* lds = lds_here(lds_in);
    int e, nt, m; moe_decode(lds, id, 4, e, nt, m); nt *= 2;
    const int* c = (const int*)(lds + MS_CNT); const int* o = (const int*)(lds + MS_OFF);
    const int cnt = __builtin_amdgcn_readfirstlane(c[e]), nvalid = (cnt - m * TM) < TM ? (cnt - m * TM) : TM;
    const int pos0 = __builtin_amdgcn_readfirstlane(o[e]) + m * TM;
    int* rows = (int*)(lds + G_ROWS);
    { const int t_ = tid_here(); if (t_ < TM) rows[t_] = pos0 + (t_ < nvalid ? t_ : nvalid - 1); }
    __syncthreads();
    const float* W = p->exp_w2 + ((size_t)layer * 64 + e) * DEXP * DM;
    GemmOp g{(const bf16_t*)(p->ws + WS_ACT), DEXP, W, DM, nt * 256, nt * 256 + 128, DEXP, 256};
    EpiScaleStore<3> ep{(bf16_t*)(p->ws + WS_Y), pos0, nvalid, nt * 256, nt * 256 + 128, (const float*)(p->ws + WS_GATEL) + (size_t)e * TALL + m * TM, {}};
    gemm_tile<2>(lds, g, ep);
}


constexpr int ST_ROWB = 528;
__device__ __forceinline__ void stage_put(unsigned char* lds, const f32x16& a, float sc, int row, int col) {
    u32x4 w0, w1;
    w0.x = cvtpk(a[0] * sc, a[1] * sc); w0.y = cvtpk(a[2] * sc, a[3] * sc); w0.z = cvtpk(a[4] * sc, a[5] * sc); w0.w = cvtpk(a[6] * sc, a[7] * sc);
    w1.x = cvtpk(a[8] * sc, a[9] * sc); w1.y = cvtpk(a[10] * sc, a[11] * sc); w1.z = cvtpk(a[12] * sc, a[13] * sc); w1.w = cvtpk(a[14] * sc, a[15] * sc);
    *(u32x4*)(lds + row * ST_ROWB + col * 2) = w0; *(u32x4*)(lds + row * ST_ROWB + col * 2 + 16) = w1;
}
struct EpiStoreBf16S {
    unsigned char* lds; bf16_t* O; int ldo; int orow0; int nrows; int oc0;
    __device__ __forceinline__ void pre(int, int) {}
    __device__ __forceinline__ void pin() {}
    __device__ __forceinline__ void operator()(const f32x16 (&acc)[2][4], int wr, int wc, int r32, int hi, int = 0) const {
#pragma unroll
        for (int mi = 0; mi < 4; ++mi)
#pragma unroll
            for (int ni = 0; ni < 2; ++ni) stage_put(lds, acc[ni][mi], 1.f, (2 * mi + wr) * 32 + r32, ni * 128 + wc * 32 + 16 * hi);
        __syncthreads();
        const int tid = tid_here();
#pragma unroll 4
        for (int i = 0; i < 16; ++i) {
            const int c = i * 512 + tid, row = c >> 5, ch = c & 31;
            if (row < nrows) *(u32x4*)(O + (size_t)(orow0 + row) * ldo + oc0 + ch * 8) = *(const u32x4*)(lds + row * ST_ROWB + ch * 16);
        }
    }
};

struct EpiConvS {
    unsigned char* lds; bf16_t* Q; const float* cw; int u0; int oc0;
    __device__ __forceinline__ void pre(int, int) {}
    __device__ __forceinline__ void pin() {}
    __device__ __forceinline__ void operator()(const f32x16 (&acc)[2][4], int wr, int wc, int r32, int hi, int = 0) const {
#pragma unroll
        for (int mi = 0; mi < 4; ++mi)
#pragma unroll
            for (int ni = 0; ni < 2; ++ni) stage_put(lds, acc[ni][mi], 1.f, (2 * mi + wr) * 32 + r32, ni * 128 + wc * 32 + 16 * hi);
        const int tid = tid_here();
        f32x4 cwv[4][2];
#pragma unroll
        for (int t = 0; t < 4; ++t) { cwv[t][0] = *(const f32x4*)(cw + t * 1536 + oc0 + (tid & 31) * 8); cwv[t][1] = *(const f32x4*)(cw + t * 1536 + oc0 + (tid & 31) * 8 + 4); }
        __syncthreads();
#pragma unroll 2
        for (int i = 0; i < 16; ++i) {
            const int c = i * 512 + tid, row = c >> 5, ch = c & 31, u = u0 + row;
            if (row >= 3 && u < NB * LSEQ) {
                const int b = u / LSEQ, l = u - b * LSEQ, col = oc0 + ch * 8;
                float a8[8];
#pragma unroll
                for (int e = 0; e < 8; ++e) a8[e] = 0.f;
#pragma unroll
                for (int t = 0; t < 4; ++t) {
                    if (l - 3 + t >= 0) {
                        const u32x4 x = *(const u32x4*)(lds + (row - 3 + t) * ST_ROWB + ch * 16);
                        const f32x4 w0 = cwv[t][0], w1 = cwv[t][1];
                        a8[0] += bflo(x.x) * w0[0]; a8[1] += bfhi(x.x) * w0[1]; a8[2] += bflo(x.y) * w0[2]; a8[3] += bfhi(x.y) * w0[3];
                        a8[4] += bflo(x.z) * w1[0]; a8[5] += bfhi(x.z) * w1[1]; a8[6] += bflo(x.w) * w1[2]; a8[7] += bfhi(x.w) * w1[3];
                    }
                }
                const float sc = col < 768 ? 0.08838834764831845f : 1.f;
#pragma unroll
                for (int e = 0; e < 8; ++e) a8[e] = siluf_(a8[e]) * sc;
                u32x4 w; w.x = cvtpk(a8[0], a8[1]); w.y = cvtpk(a8[2], a8[3]); w.z = cvtpk(a8[4], a8[5]); w.w = cvtpk(a8[6], a8[7]);
                *(u32x4*)(Q + (size_t)row_of(b, l) * 1536 + col) = w;
            }
        }
    }
};
struct EpiResidS {
    unsigned char* lds; const bf16_t* H; bf16_t* O; int orow0; int nrows; int oc0;
    __device__ __forceinline__ void pre(int, int) {}
    __device__ __forceinline__ void pin() {}
    __device__ __forceinline__ void operator()(const f32x16 (&acc)[2][4], int wr, int wc, int r32, int hi, int = 0) const {
#pragma unroll
        for (int mi = 0; mi < 4; ++mi)
#pragma unroll
            for (int ni = 0; ni < 2; ++ni) stage_put(lds, acc[ni][mi], 1.f, (2 * mi + wr) * 32 + r32, ni * 128 + wc * 32 + 16 * hi);
        const int tid = tid_here();
#pragma unroll
        for (int half = 0; half < 2; ++half) {
            u32x4 hv[8];
#pragma unroll
            for (int i = 0; i < 8; ++i) {
                const int c = (half * 8 + i) * 512 + tid, row = c >> 5, ch = c & 31, rowc = row < nrows ? row : nrows - 1;
                hv[i] = *(const u32x4*)(H + (size_t)(orow0 + rowc) * DM + oc0 + ch * 8);
            }
            if (half == 0) __syncthreads();
#pragma unroll
            for (int i = 0; i < 8; ++i) {
                const int c = (half * 8 + i) * 512 + tid, row = c >> 5, ch = c & 31;
                if (row < nrows) {
                    const u32x4 a = *(const u32x4*)(lds + row * ST_ROWB + ch * 16), h = hv[i];
                    u32x4 w;
                    w.x = cvtpk(DN_ALPHA * bflo(h.x) + bflo(a.x), DN_ALPHA * bfhi(h.x) + bfhi(a.x)); w.y = cvtpk(DN_ALPHA * bflo(h.y) + bflo(a.y), DN_ALPHA * bfhi(h.y) + bfhi(a.y));
                    w.z = cvtpk(DN_ALPHA * bflo(h.z) + bflo(a.z), DN_ALPHA * bfhi(h.z) + bfhi(a.z)); w.w = cvtpk(DN_ALPHA * bflo(h.w) + bflo(a.w), DN_ALPHA * bfhi(h.w) + bfhi(a.w));
                    *(u32x4*)(O + (size_t)(orow0 + row) * DM + oc0 + ch * 8) = w;
                }
            }
        }
    }
};

__device__ __forceinline__ void outproj_meta_item(unsigned char* lds_in, PP p, int layer, int item) {
    unsigned char* lds = lds_here(lds_in);
    const int tid = tid_here(), lane = tid & 63, wid = tid >> 6, r32 = lane & 31, hi = lane >> 5;
    const int row0 = TREAL + (item & 1) * 32, col0 = (item >> 1) * 32;
    const bf16_t* X = (const bf16_t*)(p->ws + WS_CAT) + (size_t)(row0 + r32) * DM + wid * 256 + hi * 8;
    const bf16_t* W = (const bf16_t*)(p->ws + WS_WT) + (size_t)layer * WT_LAYER + WT_OUT + (size_t)(col0 + r32) * DM + wid * 256 + hi * 8;
    f32x16 d;
#pragma unroll
    for (int r = 0; r < 16; ++r) d[r] = 0.f;
#pragma unroll
    for (int ks = 0; ks < 16; ++ks) {
        const bf16x8 a = *(const bf16x8*)(X + ks * 16), b = *(const bf16x8*)(W + ks * 16);
        d = __builtin_amdgcn_mfma_f32_32x32x16_bf16(a, b, d, 0, 0, 0);
    }
    float* part = (float*)lds;
#pragma unroll
    for (int r = 0; r < 16; ++r) part[(wid * 32 + crow(r, hi)) * 32 + r32] = d[r];
    __syncthreads();
    {
        const int row = tid >> 4, c2 = (tid & 15) * 2;
        float s0 = 0.f, s1 = 0.f;
#pragma unroll
        for (int w = 0; w < 8; ++w) { const f32x2 t = *(const f32x2*)(part + (w * 32 + row) * 32 + c2); s0 += t[0]; s1 += t[1]; }
        const size_t o = (size_t)(row0 + row) * DM + col0 + c2;
        const unsigned h = *(const unsigned*)((const bf16_t*)(p->ws + WS_HB) + o);
        *(unsigned*)((bf16_t*)(p->ws + WS_S1) + o) = cvtpk(DN_ALPHA * bflo(h) + s0, DN_ALPHA * bfhi(h) + s1);
    }
    __syncthreads();
}

constexpr float YQ_SCALE = 8.f;
struct EpiScaleStoreQ8 {
    unsigned char* lds; unsigned char* O; int orow0; int nrows; int oc0; int goff;
    float gpre[4];
    __device__ __forceinline__ void pre(int wr, int r32) {
#pragma unroll
        for (int mi = 0; mi < 4; ++mi) gpre[mi] = (goff >= 0 ? *(const float*)(lds + goff + ((2 * mi + wr) * 32 + r32) * 4) : 1.f) * YQ_SCALE;
    }
    __device__ __forceinline__ void pin() {}
    __device__ __forceinline__ void operator()(const f32x16 (&acc)[2][4], int wr, int wc, int r32, int hi, int = 0) const {
#ifdef Y_DIRECT
#pragma unroll
        for (int mi = 0; mi < 4; ++mi) {
            const int row = (2 * mi + wr) * 32 + r32;
            if (row < nrows) {
#pragma unroll
                for (int ni = 0; ni < 2; ++ni) {
                    const f32x16& a = acc[ni][mi]; const float sc = gpre[mi];
                    u32x4 w; w.x = pk4_fp8(a[0] * sc, a[1] * sc, a[2] * sc, a[3] * sc); w.y = pk4_fp8(a[4] * sc, a[5] * sc, a[6] * sc, a[7] * sc);
                    w.z = pk4_fp8(a[8] * sc, a[9] * sc, a[10] * sc, a[11] * sc); w.w = pk4_fp8(a[12] * sc, a[13] * sc, a[14] * sc, a[15] * sc);
                    *(u32x4*)(O + (size_t)(orow0 + row) * DM + oc0 + ni * 128 + wc * 32 + 16 * hi) = w;
                }
            }
        }
#else
#pragma unroll
        for (int mi = 0; mi < 4; ++mi)
#pragma unroll
            for (int ni = 0; ni < 2; ++ni) {
                const f32x16& a = acc[ni][mi]; const float sc = gpre[mi];
                u32x4 w; w.x = pk4_fp8(a[0] * sc, a[1] * sc, a[2] * sc, a[3] * sc); w.y = pk4_fp8(a[4] * sc, a[5] * sc, a[6] * sc, a[7] * sc);
                w.z = pk4_fp8(a[8] * sc, a[9] * sc, a[10] * sc, a[11] * sc); w.w = pk4_fp8(a[12] * sc, a[13] * sc, a[14] * sc, a[15] * sc);
                *(u32x4*)(lds + ((2 * mi + wr) * 32 + r32) * 272 + ni * 128 + wc * 32 + 16 * hi) = w;
            }
        __syncthreads();
        const int tid = tid_here();
#pragma unroll 4
        for (int i = 0; i < 8; ++i) {
            const int c = i * 512 + tid, row = c >> 4, ch = c & 15;
            if (row < nrows) *(u32x4*)(O + (size_t)(orow0 + row) * DM + oc0 + ch * 16) = *(const u32x4*)(lds + row * 272 + ch * 16);
        }
#endif
    }
};
struct EpiScaleStoreS {
    unsigned char* lds; bf16_t* O; int orow0; int nrows; int oc0; const float* gate;
    float gpre[4];
    __device__ __forceinline__ void pre(int wr, int r32) {
#pragma unroll
        for (int mi = 0; mi < 4; ++mi) gpre[mi] = gate ? gate[(2 * mi + wr) * 32 + r32] : 1.f;
    }
    __device__ __forceinline__ void pin() {}
    __device__ __forceinline__ void operator()(const f32x16 (&acc)[2][4], int wr, int wc, int r32, int hi, int = 0) const {
#pragma unroll
        for (int mi = 0; mi < 4; ++mi)
#pragma unroll
            for (int ni = 0; ni < 2; ++ni) stage_put(lds, acc[ni][mi], gpre[mi], (2 * mi + wr) * 32 + r32, ni * 128 + wc * 32 + 16 * hi);
        __syncthreads();
        const int tid = tid_here();
#pragma unroll 4
        for (int i = 0; i < 16; ++i) {
            const int c = i * 512 + tid, row = c >> 5, ch = c & 31;
            if (row < nrows) *(u32x4*)(O + (size_t)(orow0 + row) * DM + oc0 + ch * 8) = *(const u32x4*)(lds + row * ST_ROWB + ch * 16);
        }
    }
};

#define GEMMQ_DISPATCH(nv, g, ep) do { if ((nv) > 128) gemm_tile_q<1, 4>(lds, g, ep); else if ((nv) > 64) gemm_tile_q<1, 2>(lds, g, ep); else gemm_tile_q<1, 1>(lds, g, ep); } while (0)
#ifndef G2_NPASS
#define G2_NPASS 1
#endif
template <int NMI> struct EpiSwigluQ {
    unsigned char* O; int orow0; int nrows; int oc;
    __device__ __forceinline__ void pre(int, int) {}
    __device__ __forceinline__ void pin() {}
    __device__ __forceinline__ void operator()(const f32x16 (&acc)[2][NMI], int wr, int wc, int r32, int hi, int = 0) const {
#pragma unroll
        for (int mi = 0; mi < NMI; ++mi) {
            const int tr = (2 * mi + wr) * 32 + r32;
            if (tr < nrows) {
                float v[16];
#pragma unroll
                for (int r = 0; r < 16; r += 2) {
                    const f32x2 g2 = {acc[0][mi][r], acc[0][mi][r + 1]}, u2 = {acc[1][mi][r], acc[1][mi][r + 1]};
                    const f32x2 t2 = g2 * (f32x2){-1.4426950408889634f, -1.4426950408889634f};
                    const f32x2 d2 = (f32x2){__builtin_amdgcn_exp2f(t2[0]), __builtin_amdgcn_exp2f(t2[1])} + (f32x2){1.f, 1.f};
                    const f32x2 o2 = g2 * u2 * (f32x2){__builtin_amdgcn_rcpf(d2[0]), __builtin_amdgcn_rcpf(d2[1])};
                    v[r] = o2[0]; v[r + 1] = o2[1];
                }
                u32x4 w; w.x = pk4_fp8(v[0], v[1], v[2], v[3]); w.y = pk4_fp8(v[4], v[5], v[6], v[7]); w.z = pk4_fp8(v[8], v[9], v[10], v[11]); w.w = pk4_fp8(v[12], v[13], v[14], v[15]);
                *(u32x4*)(O + (size_t)(orow0 + tr) * DEXP + oc + wc * 32 + 16 * hi) = w;
            }
        }
    }
};
__device__ __forceinline__ void moeq_gemm1_item(unsigned char* lds_in, PP p, int layer, int id) {
    unsigned char* lds = lds_here(lds_in);
    int e, nt, m; moe_decode(lds, id, 4, e, nt, m);
    const int* c = (const int*)(lds + MS_CNT); const int* o = (const int*)(lds + MS_OFF);
    const int cnt = __builtin_amdgcn_readfirstlane(c[e]), nvalid = (cnt - m * TMB) < TMB ? (cnt - m * TMB) : TMB;
    const int oe = __builtin_amdgcn_readfirstlane(o[e]);
    int* rows = (int*)(lds + BF_ROWS);
    { const int t_ = tid_here();
      if (t_ < TMB) { const int slot = m * TMB + (t_ < nvalid ? t_ : nvalid - 1); rows[t_] = ((const int*)(p->ws + WS_TOKL))[(size_t)e * TALL + slot]; } }
    __syncthreads();
    GemmOpQ g{p->ws + WS_H1Q, DM, p->ws + WS_W13Q + layer * W13Q_LAYER + (size_t)e * 1024 * DM, DM, nt * 128, 512 + nt * 128, DM, 0, nvalid};
    EpiSwigluQ<4> ep{p->ws + WS_ACTQ, oe + m * TMB, nvalid, nt * 128};
    GEMMQ_DISPATCH(nvalid, g, ep);
}
__device__ __forceinline__ void moeq_gemm2_item(unsigned char* lds_in, PP p, int layer, int id) {
    unsigned char* lds = lds_here(lds_in);
    int e, nt, m; moe_decode(lds, id, 8 / G2_NPASS, e, nt, m); nt *= G2_NPASS;
    const int* c = (const int*)(lds + MS_CNT); const int* o = (const int*)(lds + MS_OFF);
    const int cnt = __builtin_amdgcn_readfirstlane(c[e]), nvalid = (cnt - m * TMB) < TMB ? (cnt - m * TMB) : TMB;
    const int pos0 = __builtin_amdgcn_readfirstlane(o[e]) + m * TMB;
    int* rows = (int*)(lds + BF_ROWS);
    { const int t_ = tid_here(); if (t_ < TMB) { const int s_ = t_ < nvalid ? t_ : nvalid - 1; rows[t_] = pos0 + s_;
        ((float*)(lds + BF_ROWS + 1024))[t_] = ((const float*)(p->ws + WS_GATEL))[(size_t)e * TALL + m * TMB + s_]; } }
    __syncthreads();
    GemmOpQ g{p->ws + WS_ACTQ, DEXP, p->ws + WS_W2Q + layer * W2Q_LAYER + (size_t)e * DM * DEXP, DEXP, nt * 256, nt * 256 + 128, DEXP, 256, nvalid};
    EpiScaleStoreQ8 ep{lds, p->ws + WS_Y, pos0, nvalid, nt * 256, BF_ROWS + 1024, {}};
    GEMMQ_DISPATCH(nvalid, g, ep);
}
constexpr int XB_N13 = NEXP * 16 * 8, XB_N2 = NEXP * 4 * 16, XB_TOTAL = XB_N13 + XB_N2;
constexpr int XB_LDS = 0, XB_IDW = 128 * 132;
struct XBlock { const float* src; int ldsrc; unsigned char* dst; int K; };
__device__ __forceinline__ XBlock xblock_of(PP p, int layer, int id) {
    XBlock x;
    if (id < XB_N13) { const int e = id >> 7, r = id & 127, kb = r >> 3, nb = r & 7;
        x.src = p->exp_w13 + ((size_t)layer * NEXP + e) * DM * 1024 + (size_t)(kb * 128) * 1024 + nb * 128; x.ldsrc = 1024;
        x.dst = p->ws + WS_W13Q + layer * W13Q_LAYER + (size_t)e * 1024 * DM + (size_t)(nb * 128) * DM + kb * 128; x.K = DM; }
    else { const int q = id - XB_N13, e = q >> 6, r = q & 63, kb = r >> 4, nb = r & 15;
        x.src = p->exp_w2 + ((size_t)layer * NEXP + e) * DEXP * DM + (size_t)(kb * 128) * DM + nb * 128; x.ldsrc = DM;
        x.dst = p->ws + WS_W2Q + layer * W2Q_LAYER + (size_t)e * DM * DEXP + (size_t)(nb * 128) * DEXP + kb * 128; x.K = DEXP; }
    return x;
}
#define XB_LOAD(V, X) do { _Pragma("unroll") for (int u = 0; u < 2; ++u) { const int blk_ = u * 512 + tid, k4_ = blk_ >> 5, n4_ = blk_ & 31; \
        _Pragma("unroll") for (int j = 0; j < 4; ++j) V[u][j] = __builtin_nontemporal_load((const f32x4*)((X).src + (size_t)(k4_ * 4 + j) * (X).ldsrc + n4_ * 4)); } } while (0)
#define XB_STORE(V, X) do { \
        _Pragma("unroll") for (int u = 0; u < 2; ++u) { const int blk_ = u * 512 + tid, k4_ = blk_ >> 5, n4_ = blk_ & 31; \
            _Pragma("unroll") for (int i = 0; i < 4; ++i) *(unsigned*)(lds + XB_LDS + (n4_ * 4 + i) * 132 + k4_ * 4) = pk4_fp8(V[u][0][i] * 64.f, V[u][1][i] * 64.f, V[u][2][i] * 64.f, V[u][3][i] * 64.f); } \
        __syncthreads(); \
        { const int n_ = tid >> 2, seg_ = tid & 3; const unsigned* r_ = (const unsigned*)(lds + XB_LDS + n_ * 132 + seg_ * 32); \
          u32x4 w0_, w1_; w0_.x = r_[0]; w0_.y = r_[1]; w0_.z = r_[2]; w0_.w = r_[3]; w1_.x = r_[4]; w1_.y = r_[5]; w1_.z = r_[6]; w1_.w = r_[7]; \
          unsigned char* d_ = (X).dst + (size_t)n_ * (X).K + seg_ * 32; *(u32x4*)d_ = w0_; *(u32x4*)(d_ + 16) = w1_; } \
        __syncthreads(); } while (0)
constexpr int XB_CHUNK = 4;
__device__ __forceinline__ int xb_grab(unsigned char* lds, unsigned* qword, int tid) {
    volatile int* w = (volatile int*)(lds + XB_IDW);
    if (tid == 0) *w = (int)__hip_atomic_fetch_add(qword, (unsigned)XB_CHUNK, __ATOMIC_RELAXED, __HIP_MEMORY_SCOPE_AGENT);
    __syncthreads();
    return __builtin_amdgcn_readfirstlane(*w);
}
__device__ __forceinline__ void convert_experts_queue(unsigned char* lds_in, PP p, int layer) {
    unsigned char* lds = lds_here(lds_in);
    const int tid = tid_here();
    unsigned* qword = (unsigned*)(p->ws + WS_CTL + CTL_CNT) + CNT_QWORD + 64 * layer;
    static_assert(XB_TOTAL % XB_CHUNK == 0, "whole chunks");
    int cur = xb_grab(lds, qword, tid);
    if (cur < XB_TOTAL) {
        f32x4 va[2][4], vb[2][4];
        XBlock xa = xblock_of(p, layer, cur), xb_;
        XB_LOAD(va, xa);
        for (;;) {
            int nxt_reg = 0;
            if (tid == 0) nxt_reg = (int)__hip_atomic_fetch_add(qword, (unsigned)XB_CHUNK, __ATOMIC_RELAXED, __HIP_MEMORY_SCOPE_AGENT);
            xb_ = xblock_of(p, layer, cur + 1); XB_LOAD(vb, xb_);
            XB_STORE(va, xa);
            xa = xblock_of(p, layer, cur + 2); XB_LOAD(va, xa);
            XB_STORE(vb, xb_);
            xb_ = xblock_of(p, layer, cur + 3); XB_LOAD(vb, xb_);
            XB_STORE(va, xa);
            volatile int* w = (volatile int*)(lds + XB_IDW);
            if (tid == 0) *w = nxt_reg;
            __syncthreads();
            const int nxt = __builtin_amdgcn_readfirstlane(*w);
            const bool more = nxt < XB_TOTAL;
            if (more) { xa = xblock_of(p, layer, nxt); XB_LOAD(va, xa); }
            XB_STORE(vb, xb_);
            if (!more) break;
            cur = nxt;
        }
    }
    __syncthreads();
}

__device__ __forceinline__ void shared_gemm1_item(unsigned char* lds_in, PP p, int layer, int id, int M) {
    unsigned char* lds = lds_here(lds_in);
    const int mt = id >> 2, nt = id & 3, tid = tid_here();
    int* rows = (int*)(lds + BF_ROWS);
    if (tid < TMB) { const int r = mt * TMB + tid; rows[tid] = r < M ? r : M - 1; }
    __syncthreads();
    GemmOpQ g{p->ws + WS_H1Q, DM, p->ws + WS_SHQ + (size_t)layer * SHQ_LAYER, DM, nt * 128, 512 + nt * 128, DM, 0, M - mt * TMB};
    EpiSwigluQ<4> ep{p->ws + WS_ACTQ, SH_BASE + mt * TMB, M - mt * TMB, nt * 128};
    gemm_tile_q<1, 4>(lds, g, ep);
}
__device__ __forceinline__ void shared_gemm2_item(unsigned char* lds_in, PP p, int layer, int id, int M) {
    unsigned char* lds = lds_here(lds_in);
    const int mt = id / (8 / G2_NPASS), nt = (id % (8 / G2_NPASS)) * G2_NPASS, tid = tid_here();
    int* rows = (int*)(lds + BF_ROWS);
    if (tid < TMB) { const int r = mt * TMB + tid; rows[tid] = SH_BASE + (r < M ? r : M - 1); }
    __syncthreads();
    GemmOpQ g{p->ws + WS_ACTQ, DEXP, p->ws + WS_SHQ + (size_t)layer * SHQ_LAYER + (size_t)1024 * DM, DEXP, nt * 256, nt * 256 + 128, DEXP, 256, M - mt * TMB};
    EpiScaleStoreQ8 ep{lds, p->ws + WS_Y, SH_BASE + mt * TMB, M - mt * TMB, nt * 256, -1, {}};
    gemm_tile_q<1, 4>(lds, g, ep);
}
__device__ __forceinline__ void convert_shared_q(unsigned char* lds_in, PP p, int bx, int G) {
    unsigned char* lds = lds_here(lds_in);
    const int tid = tid_here();
    constexpr int NB13 = 16 * 8, NB2 = 4 * 16;
    for (int id = bx; id < DEPTH * (NB13 + NB2); id += G) {
        const int layer = id / (NB13 + NB2), r = id % (NB13 + NB2);
        XBlock x;
        if (r < NB13) { const int kb = r >> 3, nb = r & 7; x.src = p->sh_w13 + (size_t)layer * DM * 1024 + (size_t)(kb * 128) * 1024 + nb * 128; x.ldsrc = 1024;
            x.dst = p->ws + WS_SHQ + (size_t)layer * SHQ_LAYER + (size_t)(nb * 128) * DM + kb * 128; x.K = DM; }
        else { const int q = r - NB13, kb = q >> 4, nb = q & 15; x.src = p->sh_w2 + (size_t)layer * DEXP * DM + (size_t)(kb * 128) * DM + nb * 128; x.ldsrc = DM;
            x.dst = p->ws + WS_SHQ + (size_t)layer * SHQ_LAYER + (size_t)1024 * DM + (size_t)(nb * 128) * DEXP + kb * 128; x.K = DEXP; }
        f32x4 va[2][4];
        XB_LOAD(va, x); XB_STORE(va, x);
    }
}

constexpr int TM2 = 128;
__device__ __forceinline__ void moeq_gemm2r_item(unsigned char* lds_in, PP p, int layer, int id, int nsh, int M) {
    unsigned char* lds = lds_here(lds_in);
    int* rows = (int*)(lds + R_ROWS);
    const int t_ = tid_here();
    Gemm2Op g;
    g.Y = (bf16_t*)(p->ws + WS_Y); g.X = p->ws + WS_ACTQ; g.dump = (bf16_t*)(p->ws + WS_DUMP);
    if (id < nsh) {
        const int r0 = id * TM2, nv = (M - r0) < TM2 ? (M - r0) : TM2;
        if (t_ < TM2) rows[t_] = SH_BASE + r0 + (t_ < nv ? t_ : nv - 1);
        g.Wt = p->ws + WS_SHQ + (size_t)layer * SHQ_LAYER + (size_t)1024 * DM; g.gate = nullptr; g.yrow0 = SH_BASE + r0; g.nrows = nv;
    } else {
        int e, nt, m; moe_decode(lds, id - nsh, 1, e, nt, m);
        const int* c = (const int*)(lds + MS_CNT); const int* o = (const int*)(lds + MS_OFF);
        const int cnt = __builtin_amdgcn_readfirstlane(c[e]), nv = (cnt - m * TM2) < TM2 ? (cnt - m * TM2) : TM2;
        const int pos0 = __builtin_amdgcn_readfirstlane(o[e]) + m * TM2;
        if (t_ < TM2) rows[t_] = pos0 + (t_ < nv ? t_ : nv - 1);
        g.Wt = p->ws + WS_W2Q + layer * W2Q_LAYER + (size_t)e * DM * DEXP; g.gate = (const float*)(p->ws + WS_GATEL) + (size_t)e * TALL + m * TM2; g.yrow0 = pos0; g.nrows = nv;
    }
    __syncthreads();
    gemm2_resident(lds, g);
}

__device__ __forceinline__ void phase_combine(unsigned char* lds, PP p, int layer, int M, int bx, int G) {
    const int tid = tid_here(), lane = tid & 63, gw = bx * 8 + (tid >> 6), nw = G * 8;
    const int* o = (const int*)(lds + MS_OFF);
    const bf16_t* H1 = (const bf16_t*)(p->ws + WS_H1); const unsigned char* Y = p->ws + WS_Y;
    const int* asg_e = (const int*)(p->ws + WS_ASGE); const int* asg_s = (const int*)(p->ws + WS_ASGS);
    bf16_t* hb = (bf16_t*)(p->ws + WS_HB);
    for (int row = gw; row < M; row += nw) {
        typedef int i32x4 __attribute__((ext_vector_type(4)));
        const i32x4 e0 = *(const i32x4*)(asg_e + row * 8), e1 = *(const i32x4*)(asg_e + row * 8 + 4);
        const i32x4 s0 = *(const i32x4*)(asg_s + row * 8), s1 = *(const i32x4*)(asg_s + row * 8 + 4);
        u32x4 hraw[4];
#pragma unroll
        for (int i = 0; i < 4; ++i) hraw[i] = *(const u32x4*)(H1 + (size_t)row * DM + i * 512 + lane * 8);
        int pos[9];
#pragma unroll
        for (int k = 0; k < 4; ++k) { pos[k] = o[e0[k]] + s0[k]; pos[4 + k] = o[e1[k]] + s1[k]; }
        pos[8] = SH_BASE + row;
        float v[32];
        {
            constexpr float YI = 1.f / YQ_SCALE;
            u32x2 ya[5][4];
#pragma unroll
            for (int k = 0; k < 5; ++k)
#pragma unroll
                for (int i = 0; i < 4; ++i) ya[k][i] = *(const u32x2*)(Y + (size_t)pos[k] * DM + i * 512 + lane * 8);
#pragma unroll
            for (int i = 0; i < 4; ++i) {
                v[i * 8 + 0] = DN_ALPHA * bflo(hraw[i].x); v[i * 8 + 1] = DN_ALPHA * bfhi(hraw[i].x); v[i * 8 + 2] = DN_ALPHA * bflo(hraw[i].y); v[i * 8 + 3] = DN_ALPHA * bfhi(hraw[i].y);
                v[i * 8 + 4] = DN_ALPHA * bflo(hraw[i].z); v[i * 8 + 5] = DN_ALPHA * bfhi(hraw[i].z); v[i * 8 + 6] = DN_ALPHA * bflo(hraw[i].w); v[i * 8 + 7] = DN_ALPHA * bfhi(hraw[i].w);
            }
            asm volatile("" ::: "memory");
            u32x2 yb[4][4];
#pragma unroll
            for (int k = 0; k < 4; ++k)
#pragma unroll
                for (int i = 0; i < 4; ++i) yb[k][i] = *(const u32x2*)(Y + (size_t)pos[5 + k] * DM + i * 512 + lane * 8);
#define Y_ACC(YV) do { const f32x2 a = __builtin_amdgcn_cvt_pk_f32_fp8((int)(YV).x, false), b = __builtin_amdgcn_cvt_pk_f32_fp8((int)(YV).x, true); \
                    const f32x2 c = __builtin_amdgcn_cvt_pk_f32_fp8((int)(YV).y, false), d = __builtin_amdgcn_cvt_pk_f32_fp8((int)(YV).y, true); \
                    v[i * 8 + 0] += a[0] * YI; v[i * 8 + 1] += a[1] * YI; v[i * 8 + 2] += b[0] * YI; v[i * 8 + 3] += b[1] * YI; \
                    v[i * 8 + 4] += c[0] * YI; v[i * 8 + 5] += c[1] * YI; v[i * 8 + 6] += d[0] * YI; v[i * 8 + 7] += d[1] * YI; } while (0)
#pragma unroll
            for (int k = 0; k < 5; ++k)
#pragma unroll
                for (int i = 0; i < 4; ++i) Y_ACC(ya[k][i]);
#pragma unroll
            for (int k = 0; k < 4; ++k)
#pragma unroll
                for (int i = 0; i < 4; ++i) Y_ACC(yb[k][i]);
#undef Y_ACC
        }
        ln_row32(v, p->ln2_g + layer * DM, p->ln2_b + layer * DM, lane);
        if (layer == DEPTH - 1) {
#pragma unroll
            for (int i = 0; i < 4; ++i) {
                float* dst = p->out + (size_t)row * DM + i * 512 + lane * 8;
                *(f32x4*)dst = (f32x4){v[i * 8], v[i * 8 + 1], v[i * 8 + 2], v[i * 8 + 3]};
                *(f32x4*)(dst + 4) = (f32x4){v[i * 8 + 4], v[i * 8 + 5], v[i * 8 + 6], v[i * 8 + 7]};
            }
        } else {
            store_row32_bf16(hb + (size_t)row * DM, lane, v);
            row_gates(lds, p, layer + 1, row, lane, v);
        }
    }
}

#define XB_TMO      128
#define XB_XCNT(j)  (256  + 64 * (j))
#define XB_XSUB(j)  (1280 + 64 * (j))
#define XB_XGEN(j)  (2304 + 64 * (j))
#define XB_TOP      3328
#define XB_TOPGEN   3392
#define XCD_BAR_WORDS 3456
#define XB_SPIN_CAP (1u << 18)

__device__ __forceinline__ unsigned xb_ld(unsigned* p)              { return __hip_atomic_load(p, __ATOMIC_RELAXED, __HIP_MEMORY_SCOPE_AGENT); }
__device__ __forceinline__ unsigned xb_add(unsigned* p, unsigned v) { return __hip_atomic_fetch_add(p, v, __ATOMIC_RELAXED, __HIP_MEMORY_SCOPE_AGENT); }
__device__ __forceinline__ unsigned xb_xcc_id() { return (unsigned)__builtin_amdgcn_s_getreg((3 << 11) | 20) & 0xFu; }
#define XB_SPIN(cond, bar) do { unsigned _sp = 0; while (cond) { __builtin_amdgcn_s_sleep(1); \
    if ((++_sp & 255u) == 0u) { if (xb_ld(&(bar)[XB_TMO])) break; if (_sp > XB_SPIN_CAP) { atomicAdd(&(bar)[XB_TMO], 1u); break; } } } } while (0)

struct XcdBarrier { unsigned* bar; unsigned x; volatile LAS unsigned* st; };

__device__ __forceinline__ XcdBarrier xcd_barrier_post(unsigned* bar, volatile LAS unsigned* st) {
    XcdBarrier b; b.bar = bar; b.x = xb_xcc_id(); b.st = st;
    if (threadIdx.x == 0) (void)xb_add(&bar[XB_XCNT(b.x)], 1u);
    return b;
}
__device__ __forceinline__ void xcd_barrier_complete(unsigned* bar, unsigned x, unsigned& nloc, unsigned& nx) {
    const unsigned G = gridDim.x * gridDim.y * gridDim.z;
    unsigned sum, cnt, mine, sp = 0u;
    for (;;) {
        sum = 0u; cnt = 0u; mine = 0u;
#pragma unroll
        for (unsigned j = 0; j < 16; ++j) { const unsigned c = xb_ld(&bar[XB_XCNT(j)]); sum += c; cnt += (c > 0u) ? 1u : 0u; mine = (j == x) ? c : mine; }
        if (sum == G) break;
        __builtin_amdgcn_s_sleep(1);
        if ((++sp & 255u) == 0u) { if (xb_ld(&bar[XB_TMO])) break; if (sp > XB_SPIN_CAP) { atomicAdd(&bar[XB_TMO], 1u); break; } }
    }
    nloc = mine > 0u ? mine : 1u; nx = cnt > 0u ? cnt : 1u;
}
__device__ __forceinline__ void xcd_barrier(const XcdBarrier& b) {
    asm volatile("s_waitcnt vmcnt(0)" ::: "memory");
    __syncthreads();
    if (threadIdx.x == 0) {
        unsigned* bar = b.bar;
        __builtin_amdgcn_s_waitcnt(0);
        unsigned nloc = b.st[0], nx = b.st[1];
        if (nloc == 0u) { xcd_barrier_complete(bar, b.x, nloc, nx); b.st[0] = nloc; b.st[1] = nx; }
        const unsigned old = xb_add(&bar[XB_XSUB(b.x)], 1u);
        const unsigned gen = old / nloc;
        if (old + 1u == (gen + 1u) * nloc) {
            __builtin_amdgcn_fence(__ATOMIC_RELEASE, "agent");
            asm volatile("s_waitcnt vmcnt(0)" ::: "memory");
            const unsigned og = xb_add(&bar[XB_TOP], 1u);
            const unsigned tg = og / nx;
            if (og + 1u == (tg + 1u) * nx) xb_add(&bar[XB_TOPGEN], 1u);
            else XB_SPIN(xb_ld(&bar[XB_TOPGEN]) == tg, bar);
            __builtin_amdgcn_fence(__ATOMIC_ACQUIRE, "agent");
            xb_add(&bar[XB_XGEN(b.x)], 1u);
            asm volatile("s_waitcnt vmcnt(0)" ::: "memory");
        } else {
            XB_SPIN(xb_ld(&bar[XB_XGEN(b.x)]) == gen, bar);
            __builtin_amdgcn_fence(__ATOMIC_ACQUIRE, "agent");
            asm volatile("s_waitcnt vmcnt(0)" ::: "memory");
        }
    }
    __syncthreads();
}

constexpr int NPHASES = 1 + 8 * DEPTH;
constexpr int XBW_OFF = LDS_BYTES - 16;

__global__ void __launch_bounds__(NTHREADS, 2) fwd_kernel(Params p_by_value) {
    extern __shared__ __attribute__((aligned(16))) unsigned char lds0[];
    const int tid0 = threadIdx.x, G0 = gridDim.x, bx0 = blockIdx.x;
    const int vcu0 = (G0 % 8 == 0) ? (bx0 % 8) * (G0 / 8) + bx0 / 8 : bx0;
    PP p = get_params();
    const int lo = p->ph_lo, hi = p->ph_hi;
    if (tid0 == 0) *(uint4*)(lds0 + XBW_OFF) = make_uint4(0u, 0u, 0u, 0u);
    __syncthreads();
    XcdBarrier bar; bar.bar = (unsigned*)(p->ws + WS_CTL); bar.x = 0; bar.st = (volatile LAS unsigned*)(LAS unsigned char*)(lds0 + XBW_OFF);
    if (hi - lo > 1) bar = xcd_barrier_post((unsigned*)(p->ws + WS_CTL), (volatile LAS unsigned*)(LAS unsigned char*)(lds0 + XBW_OFF));
#ifndef PHMASK
#define PHMASK 0x1FF
#endif
#define IN(k) (lo <= (k) && (k) < hi)
#define PHASE_IDS() unsigned char* lds = lds_here(lds0); const int G = sgpr_here(G0), bx = sgpr_here(bx0), vcu = sgpr_here(vcu0), tid = tid_here(); (void)G; (void)bx; (void)vcu; (void)tid
#define EN(b) (((PHMASK) >> (b)) & 1)
#ifndef REPMASK
#define REPMASK 0
#endif
#ifndef REPLAYER
#define REPLAYER -1
#endif
#define REPEAT(k) for (int rep_ = 0; rep_ <= ((((REPMASK) >> (k)) & 1) && (REPLAYER < 0 || layer == REPLAYER) ? 1 : 0); ++rep_)
#define REPBAR() do { if (rep_) xcd_barrier(bar); } while (0)
#ifndef MXMASK
#define MXMASK 0x3F
#endif
#define MXEN(b) (((MXMASK) >> (b)) & 1)
#ifndef MXDUP
#define MXDUP -1
#endif
#ifdef DBG_PHN
#define PH_T0 ((volatile unsigned long long*)(lds0 + LDS_BYTES - 32))
#define PH_BEGIN(k) do { if ((k) == DBG_PHN && layer == DBG_PHL && tid_here() == 0) *PH_T0 = __builtin_amdgcn_s_memtime(); } while (0)
#define PH_MID(k) do { if ((k) == DBG_PHN && layer == DBG_PHL && tid_here() == 0) { const unsigned long long t_ = __builtin_amdgcn_s_memtime() - *PH_T0; atomicAdd(&dbg_acc[0], t_); atomicAdd(&dbg_acc[3], 1ull); atomicMax(&dbg_acc[2], t_); atomicMax(&dbg_acc[4], 1000000000ull - t_); } } while (0)
#define PH_END(k) do { if ((k) == DBG_PHN && layer == DBG_PHL && tid_here() == 0 && blockIdx.x == 0) dbg_acc[1] = __builtin_amdgcn_s_memtime() - *PH_T0; } while (0)
#elif defined(SPIN_PHN)
#define PH_T0 ((volatile unsigned long long*)(lds0 + LDS_BYTES - 32))
#define PH_BEGIN(k) do { if ((k) == SPIN_PHN && layer == SPIN_PHL && blockIdx.x == 0 && tid_here() == 0) *PH_T0 = __builtin_amdgcn_s_memtime(); } while (0)
#define PH_MID(k)
#define PH_END(k) do { if ((k) == SPIN_PHN && layer == SPIN_PHL && blockIdx.x == 0) { __syncthreads(); const unsigned long long t1_ = __builtin_amdgcn_s_memtime(), T_ = t1_ - *PH_T0; \
        while (__builtin_amdgcn_s_memtime() < t1_ + (unsigned long long)(SPIN_K) * T_) __builtin_amdgcn_s_sleep(8); __syncthreads(); } } while (0)
#else
#define PH_BEGIN(k)
#define PH_MID(k)
#define PH_END(k)
#endif
#define SEAM(k) do { if (IN((k) + 1)) xcd_barrier(bar); } while (0)
#ifdef DBG_P2MIX
#define PH_MIDS(n) do { if ((n) != 2) PH_MID(n); } while (0)
#else
#define PH_MIDS(n) PH_MID(n)
#endif
#define SEAMN(n) do { PH_MIDS(n); if (IN(pb + (n) + 1)) xcd_barrier(bar); PH_END(n); } while (0)

#if defined(SPIN_PHN) && SPIN_PHN >= 8
    if (blockIdx.x == 0 && tid_here() == 0) *PH_T0 = __builtin_amdgcn_s_memtime();
#endif
    if (EN(8) && IN(0)) for (int rep0_ = 0; rep0_ <= (((REPMASK) >> 8) & 1); ++rep0_) { p = get_params(); PHASE_IDS(); if (rep0_) xcd_barrier(bar); phase_ln_in(lds, p, bx, G); __syncthreads(); phase_convert(lds, p, bx, G, 0, 1); __syncthreads(); convert_shared_q(lds, p, bx, G); router_preformat(p, bx, G); if (rep0_ == (((REPMASK) >> 8) & 1)) SEAM(0); }


#if defined(SPIN_PHN) && SPIN_PHN == 8
    if (blockIdx.x == 0) { __syncthreads(); const unsigned long long t1_ = __builtin_amdgcn_s_memtime(), T_ = t1_ - *PH_T0;
        while (__builtin_amdgcn_s_memtime() < t1_ + (unsigned long long)(SPIN_K) * T_) __builtin_amdgcn_s_sleep(8); __syncthreads(); }
#endif
    for (int layer = 0; layer < DEPTH; ++layer) {
        const int pb = 1 + 8 * layer;
        const int M = (layer == DEPTH - 1) ? TREAL : TALL;
        if (EN(0) && IN(pb + 0)) REPEAT(0) { p = get_params(); PHASE_IDS(); REPBAR(); PH_BEGIN(0);
            int* rows = (int*)(lds + BF_ROWS);
            for (int id = vcu; id < 759; id += G) {
                int mt, nt;
#if defined(EXP_ORDER) && EXP_ORDER == 1
                mt = id % 33; nt = id / 33;
#elif defined(EXP_ORDER) && EXP_ORDER == 2
                nt = id % 23; mt = id / 23;
#elif defined(EXP_ORDER) && EXP_ORDER == 3
                if (id < 736) { const int grp = id / 92, r = id % 92; nt = r >> 2; mt = grp * 4 + (r & 3); } else { mt = 32; nt = id - 736; }
#else
                if (id < 736) { const int grp = id / 184, r = id % 184; nt = r >> 3; mt = grp * 8 + (r & 7); } else { mt = 32; nt = id - 736; }
#endif
#ifdef FUSE_CONV
                if (nt < 6) {
                    const int u0 = 253 * mt - 3;
                    if (tid < TMB) { int u = u0 + tid; u = u < 0 ? 0 : (u > NB * LSEQ - 1 ? NB * LSEQ - 1 : u); const int b_ = u / LSEQ; rows[tid] = row_of(b_, u - b_ * LSEQ); }
                    __syncthreads();
                    GemmOpBf g{(const bf16_t*)(p->ws + WS_HB), DM, (const bf16_t*)(p->ws + WS_WT) + (size_t)layer * WT_LAYER + WT_IN, DM, nt * 256, nt * 256 + 128, DM};
                    EpiConvS e{lds, (bf16_t*)(p->ws + WS_QKC), p->conv_qk + (size_t)layer * 4 * 1536, u0, nt * 256};
                    gemm_tile_bf(lds, g, e);
                    continue;
                }
#endif
                if (tid < TMB) { const int r = mt * TMB + tid; rows[tid] = r < TALL ? r : TALL - 1; }
                __syncthreads();
                GemmOpBf g{(const bf16_t*)(p->ws + WS_HB), DM, (const bf16_t*)(p->ws + WS_WT) + (size_t)layer * WT_LAYER + WT_IN, DM, nt * 256, nt * 256 + 128, DM};
                EpiStoreBf16S e{lds, (bf16_t*)(p->ws + WS_PROJ), PROJ_W, mt * TMB, TALL - mt * TMB, nt * 256};
                gemm_tile_bf(lds, g, e);
            }
            SEAMN(0);
        }
#ifndef FUSE_CONV
        if (EN(1) && IN(pb + 1)) REPEAT(1) { p = get_params(); PHASE_IDS(); REPBAR(); PH_BEGIN(1); phase_conv(p, layer, bx, G); SEAMN(1); }
#endif
        if (EN(2) && IN(pb + 2)) REPEAT(2) { p = get_params(); PHASE_IDS(); REPBAR(); PH_BEGIN(2);
#ifdef REP_P2_FULL
            if (rep_) { if (bx == 0 && tid == 0) __hip_atomic_store((unsigned*)(p->ws + WS_CTL + CTL_CNT) + CNT_QWORD + 64 * layer, 0u, __ATOMIC_RELAXED, __HIP_MEMORY_SCOPE_AGENT); xcd_barrier(bar); }
#endif
#if defined(USE_FP8_EXPERTS) && CONV_A_BUDGET > 0
            if ((bx >> 3) & 1) convert_experts_queue(lds, p, layer, CONV_A_BUDGET);
#endif
            int r = 0;
            for (int base = 0; base < 704; base += G, ++r) {
                const int id = base + ((r & 1) ? (G - 1 - bx) : bx);
                if (id < 704) {
#ifdef DBG_MIX
                    const unsigned long long tm0 = __builtin_amdgcn_s_memtime(); int ityp = 0;
#endif
                    if (id < 384) {
                        const int j = 7 - id / 48, rem = id % 48, mode = rem / 24, bh = rem % 24;
#ifdef DBG_MIX
                        ityp = (j == 7) ? (mode == 0 ? 1 : 2) : 0;
#endif
                        for (int dq_ = 0, dn_ = rdup_n((MXDUP == 0 && mode == 0) || (MXDUP == 1 && mode == 1) ? 2 : 1); dq_ < dn_; ++dq_)
                        if (MXEN(0) && mode == 0) mixer_item<0>(lds, p, layer, bh / 6, bh % 6, j); else if (MXEN(1)) mixer_item<1>(lds, p, layer, bh / 6, bh % 6, j);
                    } else if (id < 656) {
                        const int q = id - 384, g = q & 3, rb = q >> 2;
#ifdef DBG_MIX
                        ityp = 3;
#endif
                        for (int dq_ = 0, dn_ = rdup_n(MXDUP == 2 ? 2 : 1); dq_ < dn_; ++dq_)
                        if (MXEN(2)) pool_item(lds, p, layer, rb / 17, rb % 17, g);
                    } else {
                        const int q = id - 656, mode = q / 24, bh = q % 24;
#ifdef DBG_MIX
                        ityp = 4 + mode;
#endif
                        if (layer + 1 < DEPTH) { if (MXEN(3) && mode == 0) mixer_meta_item<0>(lds, p, layer, bh / 6, bh % 6); else if (MXEN(4)) mixer_meta_item<1>(lds, p, layer, bh / 6, bh % 6); }
                    }
#ifdef DBG_MIX
                    if (tid == 0 && ityp == DBG_MIX) { atomicAdd(&dbg_acc[2], __builtin_amdgcn_s_memtime() - tm0); atomicAdd(&dbg_acc[3], 1ull); }
#endif
                }
            }
#ifdef DBG_P2MIX
            PH_MID(2);
#endif
#ifdef USE_FP8_EXPERTS
            convert_experts_queue(lds, p, layer);
#endif
            SEAMN(2);
        }
        if (EN(3) && IN(pb + 3)) REPEAT(3) { p = get_params(); PHASE_IDS(); REPBAR(); PH_BEGIN(3);
            int* rows = (int*)(lds + BF_ROWS);
            const int ntile = (TREAL / TMB) * 8;
            if (M > TREAL) for (int it = G - 1 - bx; it < 128; it += G) outproj_meta_item(lds, p, layer, it);
            for (int id = vcu; id < ntile; id += G) {
                const int mt = id >> 3, nt = id & 7;
                if (tid < TMB) { const int r = mt * TMB + tid; rows[tid] = r < M ? r : M - 1; }
                __syncthreads();
                GemmOpBf g{(const bf16_t*)(p->ws + WS_CAT), DM, (const bf16_t*)(p->ws + WS_WT) + (size_t)layer * WT_LAYER + WT_OUT, DM, nt * 256, nt * 256 + 128, DM};
                EpiResidS e{lds, (const bf16_t*)(p->ws + WS_HB), (bf16_t*)(p->ws + WS_S1), mt * TMB, M - mt * TMB, nt * 256};
                gemm_tile_bf(lds, g, e);
            }
#ifdef TAIL_CONVERT
            if (layer + 1 < DEPTH && vcu >= ntile - ((ntile - 1) / G) * G) convert_experts_queue(lds, p, layer + 1, TAILC_P3);
#endif
            SEAMN(3);
        }
        if (EN(4) && IN(pb + 4)) REPEAT(4) { p = get_params(); PHASE_IDS(); REPBAR(); PH_BEGIN(4);
#ifdef REP_P4_RESET
            if (rep_) { if (bx == 0 && tid < 64) ((int*)(p->ws + WS_CTL + CTL_CNT) + layer * CNT_LAYER)[tid * CNT_STRIDE] = 0; __threadfence(); xcd_barrier(bar); }
#endif
            const int nit = (M + 31) >> 5;
            for (int id = bx; id < nit; id += G) router_item(lds, p, layer, id, M);
#ifdef TAIL_CONVERT
            if (layer + 1 < DEPTH && bx >= nit - ((nit - 1) / G) * G) convert_experts_queue(lds, p, layer + 1, TAILC_P4);
#endif
            SEAMN(4);
        }
        if (EN(5) && IN(pb + 5)) REPEAT(5) { p = get_params(); PHASE_IDS(); REPBAR(); PH_BEGIN(5);
#ifdef USE_FP8_EXPERTS
            moe_tables(lds, p, layer, M, TMB);
            const int nsh = ((M + TMB - 1) / TMB) * 4, nit = nsh + ((const int*)(lds + MS_TP))[65] * 4;
#ifdef EXP_ROUND_SYNC
            for (int id = vcu, rnd = 0; rnd * G < nit; id += G, ++rnd) { if (id < nit) { if (id < nsh) shared_gemm1_item(lds, p, layer, id, M); else moeq_gemm1_item(lds, p, layer, id - nsh); } if ((rnd + 1) * G < nit) xcd_barrier(bar); }
#else
            for (int id = vcu; id < nit; id += G) { if (id < nsh) shared_gemm1_item(lds, p, layer, id, M); else moeq_gemm1_item(lds, p, layer, id - nsh); }
#endif
#if defined(TAIL_CONVERT) && TAILC_P5 > 0
            if (layer + 1 < DEPTH && vcu >= nit - ((nit - 1) / G) * G) convert_experts_queue(lds, p, layer + 1, TAILC_P5);
#endif
#else
            moe_tables(lds, p, layer, M);
            const int nsh = ((M + TMB - 1) / TMB) * 4, nit = nsh + ((const int*)(lds + MS_TP))[65] * 4;
            for (int id = vcu; id < nit; id += G) { if (id < nsh) shared_gemm1_item(lds, p, layer, id, M); else moe_gemm1_item(lds, p, layer, id - nsh); }
#endif
            SEAMN(5);
        }
        if (EN(6) && IN(pb + 6)) REPEAT(6) { p = get_params(); PHASE_IDS(); REPBAR(); PH_BEGIN(6);
#ifdef USE_FP8_EXPERTS
            if (!(EN(5) && IN(pb + 5))) moe_tables(lds, p, layer, M, TMB);
            const int nsh = ((M + TMB - 1) / TMB) * (8 / G2_NPASS), nit = nsh + ((const int*)(lds + MS_TP))[65] * (8 / G2_NPASS);
            for (int id = vcu; id < nit; id += G) { if (id < nsh) shared_gemm2_item(lds, p, layer, id, M); else moeq_gemm2_item(lds, p, layer, id - nsh); }
#if defined(TAIL_CONVERT) && TAILC_P6 > 0
            if (layer + 1 < DEPTH && vcu >= nit - ((nit - 1) / G) * G) convert_experts_queue(lds, p, layer + 1, TAILC_P6);
#endif
#else
            moe_tables(lds, p, layer, M);
            const int nsh = ((M + TMB - 1) / TMB) * 8, nit = nsh + ((const int*)(lds + MS_TP))[65] * 4;
            for (int id = vcu; id < nit; id += G) { if (id < nsh) shared_gemm2_item(lds, p, layer, id, M); else moe_gemm2_item(lds, p, layer, id - nsh); }
#endif
            SEAMN(6);
        }
        if (EN(7) && IN(pb + 7)) REPEAT(7) { p = get_params(); PHASE_IDS(); REPBAR(); PH_BEGIN(7);
            if (!(EN(5) && IN(pb + 5))) moe_tables(lds, p, layer, M);
            if (layer + 1 < DEPTH) stage_gate_weights(lds, p, layer + 1);
            phase_combine(lds, p, layer, M, bx, G);
            __syncthreads();
            if (layer + 1 < DEPTH) phase_convert(lds, p, bx, G, layer + 1, layer + 2);
            SEAMN(7);
        }
    }
#if defined(SPIN_PHN) && SPIN_PHN == 9
    if (blockIdx.x == 0) { __syncthreads(); const unsigned long long t1_ = __builtin_amdgcn_s_memtime(), T_ = t1_ - *PH_T0;
        while (__builtin_amdgcn_s_memtime() < t1_ + (unsigned long long)(SPIN_K) * T_) __builtin_amdgcn_s_sleep(8); __syncthreads(); }
#endif
#ifdef SPIN_MIX
    {
        xcd_barrier(bar);
        if (blockIdx.x == 0) { const unsigned long long T_ = dbg_acc[2] / (dbg_acc[3] ? dbg_acc[3] : 1ull), t1_ = __builtin_amdgcn_s_memtime();
            while (__builtin_amdgcn_s_memtime() < t1_ + (unsigned long long)(SPIN_K) * T_) __builtin_amdgcn_s_sleep(8); }
    }
#endif
#ifdef DBG_ANY
    {
        xcd_barrier(bar);
        p = get_params();
        const float frac = DBG_SEL == 8 ? (float)((double)(1000000000ull - dbg_acc[4]) / DBG_UNIT) : DBG_SEL == 7 ? (float)((double)dbg_acc[2] / DBG_UNIT) : DBG_SEL == 6 ? (float)((double)dbg_acc[0] / (double)dbg_acc[3] / DBG_UNIT) : DBG_SEL == 5 ? (float)((double)dbg_acc[1] / DBG_UNIT) : DBG_SEL == 4 ? (float)((double)dbg_acc[2] / (double)dbg_acc[0] * 0.05) : DBG_SEL == 3 ? (float)((double)dbg_acc[2] / (double)dbg_acc[3] / DBG_UNIT) : (float)((double)dbg_acc[DBG_SEL] / (double)dbg_acc[2]);
        const float cdbg = sqrtf(floorf(frac * 10.f + 0.5f));
        for (size_t i = (size_t)blockIdx.x * NTHREADS + tid_here(); i < (size_t)TREAL * DM / 4; i += (size_t)gridDim.x * NTHREADS) ((f32x4*)p->out)[i] = (f32x4){cdbg, cdbg, cdbg, cdbg};
    }
#endif
#undef IN
#undef SEAM
}

#ifndef N_LAUNCH_MODE
#define N_LAUNCH_MODE 1
#endif
extern "C" void kernel_launch(void* const* d_in, const int* in_sizes, int n_in, void* d_out, int out_size, void* d_ws, size_t ws_size, hipStream_t stream) {
    static int grid = 0;
    if (grid == 0) {
        if (n_in != 23 || ws_size < WS_END) { fprintf(stderr, "kernel_launch: unexpected n_in %d or ws %zu < %zu\n", n_in, ws_size, (size_t)WS_END); grid = -1; return; }
        int dev = 0, cus = 0, per_cu = 0;
        if (hipGetDevice(&dev) != hipSuccess || hipDeviceGetAttribute(&cus, hipDeviceAttributeMultiprocessorCount, dev) != hipSuccess) { grid = -1; return; }
        if (hipFuncSetAttribute((const void*)fwd_kernel, hipFuncAttributeMaxDynamicSharedMemorySize, LDS_BYTES) != hipSuccess) { fprintf(stderr, "kernel_launch: hipFuncSetAttribute failed\n"); grid = -1; return; }
        if (hipOccupancyMaxActiveBlocksPerMultiprocessor(&per_cu, (const void*)fwd_kernel, NTHREADS, LDS_BYTES) != hipSuccess || per_cu < 1)
            fprintf(stderr, "kernel_launch: occupancy query reports %d blocks per CU\n", per_cu);
        (void)hipGetLastError();
        grid = cus;
    }
    if (grid < 0) return;
    if (hipMemsetAsync((char*)d_ws + WS_CTL, 0, CTL_BYTES, stream) != hipSuccess) return;
    Params p{};
    const float* const* in = (const float* const*)d_in;
    p.x = in[0]; p.meta = in[1]; p.ln_in_g = in[2]; p.ln_in_b = in[3]; p.w_in = in[4]; p.b_igate = in[5]; p.b_fgate = in[6]; p.conv_qk = in[7];
    p.ml_norm_g = in[8]; p.sb_norm_g = in[9]; p.pool_w = in[10]; p.pool_scale = in[11]; p.w_out = in[12]; p.ln1_g = in[13]; p.ln1_b = in[14];
    p.router_w = in[15]; p.router_bias = in[16]; p.exp_w13 = in[17]; p.exp_w2 = in[18]; p.sh_w13 = in[19]; p.sh_w2 = in[20]; p.ln2_g = in[21]; p.ln2_b = in[22];
    p.out = (float*)d_out; p.ws = (unsigned char*)d_ws;
#if N_LAUNCH_MODE == 1
    p.ph_lo = 0; p.ph_hi = NPHASES;
    hipLaunchKernelGGL(fwd_kernel, dim3(grid), dim3(NTHREADS), LDS_BYTES, stream, p);
#else
    for (int ph = 0; ph < NPHASES; ++ph) {
        p.ph_lo = ph; p.ph_hi = ph + 1;
        hipLaunchKernelGGL(fwd_kernel, dim3(grid), dim3(NTHREADS), LDS_BYTES, stream, p);
    }
#endif
    const hipError_t le = hipPeekAtLastError();
    if (le != hipSuccess) fprintf(stderr, "kernel_launch: launch failed: %s\n", hipGetErrorName(le));
}
```
